# Optimizing an MI355X kernel written in HIP

```python
import jax, jax.numpy as jnp
from jax import lax
import numpy as np

D_MODEL = 2048
BATCH = 2
SEQ = 4096
DEPTH = 4

N_MIXERS = 2
EPS = 1e-6

HGRN_EXPAND = 128
HGRN_HEADS = D_MODEL // HGRN_EXPAND
HGRN_DK = HGRN_EXPAND
HGRN_DV = D_MODEL // HGRN_HEADS
HGRN_CHUNK = 64
HGRN_IN = 5 * D_MODEL

HEAD_DIM = 128
ATTN_HEADS = D_MODEL // HEAD_DIM
DILATED_GROUPS = ((128, 1), (512, 4), (2048, 16))
N_GROUPS = len(DILATED_GROUPS)
ATTN_IN = N_GROUPS * 3 * ATTN_HEADS * HEAD_DIM
ROPE_THETA = 500000.0
ROPE_DIM = HEAD_DIM // 4
NEG_INF = -1e30

D_FF = ((8 * D_MODEL // 3 + 255) // 256) * 256

N_HGRN_LAYERS = (DEPTH + 1) // 2
N_ATTN_LAYERS = DEPTH // 2

kernel_name = "hybrid_hgrn2_dilated_attn_encoder"


def rmsnorm(x, w):
    x32 = x.astype(jnp.float32)
    y = x32 * lax.rsqrt(jnp.mean(x32 * x32, axis=-1, keepdims=True) + EPS)
    return (y * w.astype(jnp.float32)).astype(x.dtype)


def chunk_gla(q, k, v, log_f):
    B, H, S, dk = q.shape
    dv = v.shape[-1]
    n = S // HGRN_CHUNK

    def to_chunks(t):
        return jnp.moveaxis(t.reshape(B, H, n, HGRN_CHUNK, t.shape[-1]), 2, 0)

    tri = jnp.tril(jnp.ones((HGRN_CHUNK, HGRN_CHUNK), dtype=bool))

    def step(state, inp):
        qc, kc, vc, gc = inp
        b = jnp.cumsum(gc, axis=2)
        diff = b[:, :, :, None, :] - b[:, :, None, :, :]
        decay = jnp.exp(jnp.where(tri[:, :, None], diff, -jnp.inf))
        scores = jnp.einsum('bhtd,bhsd,bhtsd->bhts', qc, kc, decay)
        o = (jnp.einsum('bhts,bhsv->bhtv', scores, vc)
             + jnp.einsum('bhtd,bhdv->bhtv', qc * jnp.exp(b), state))
        b_last = b[:, :, -1:, :]
        state = (jnp.exp(b_last[:, :, 0, :, None]) * state
                 + jnp.einsum('bhsd,bhsv->bhdv', kc * jnp.exp(b_last - b), vc))
        return state, o

    state0 = jnp.zeros((B, H, dk, dv), jnp.float32)
    _, o = lax.scan(step, state0, (to_chunks(q), to_chunks(k), to_chunks(v), to_chunks(log_f)))
    return jnp.moveaxis(o, 0, 2).reshape(B, H, S, dv)


def hgrn2_mixer(h, w_in, lb_fwd, lb_bwd, g_norm_w):
    B, S, _ = h.shape
    proj = jnp.einsum('bsd,de->bse', h, w_in)
    q, f_fwd, f_bwd, i, g = jnp.split(proj, 5, axis=-1)

    def heads(t, dh):
        return t.reshape(B, S, HGRN_HEADS, dh).transpose(0, 2, 1, 3).astype(jnp.float32)

    q = heads(jax.nn.silu(q), HGRN_DK)
    v = heads(i, HGRN_DV)

    def gates(f, lb):
        fg = lb + (1.0 - lb) * jax.nn.sigmoid(f.astype(jnp.float32))
        return heads(1.0 - fg, HGRN_DK), heads(jnp.log(fg), HGRN_DK)

    k_f, lg_f = gates(f_fwd, lb_fwd)
    k_b, lg_b = gates(f_bwd, lb_bwd)
    o_f = chunk_gla(q, k_f, v, lg_f)
    o_b = jnp.flip(chunk_gla(jnp.flip(q, 2), jnp.flip(k_b, 2), jnp.flip(v, 2), jnp.flip(lg_b, 2)), 2)
    o = rmsnorm(o_f + o_b, g_norm_w)
    o = o.transpose(0, 2, 1, 3).reshape(B, S, D_MODEL).astype(h.dtype)
    return o * jax.nn.silu(g)


def partial_rope(x, cos, sin):
    xr, xp = x[..., :ROPE_DIM], x[..., ROPE_DIM:]
    x1, x2 = jnp.split(xr, 2, axis=-1)
    rot = jnp.concatenate([-x2, x1], axis=-1)
    xr = (xr * cos + rot * sin).astype(x.dtype)
    return jnp.concatenate([xr, xp], axis=-1)


def dilated_group_attention(q, k, v, window, dilation):
    B, S, H, dh = q.shape
    radius = window // (2 * dilation)
    W = radius
    L = S // dilation
    nblk = -(-L // W)
    Lp = nblk * W

    def strided(t, pad_lo, pad_hi):
        t = t.reshape(B, L, dilation, H, dh)
        return jnp.pad(t, ((0, 0), (pad_lo, pad_hi), (0, 0), (0, 0), (0, 0)))

    qs = strided(q, 0, Lp - L).reshape(B, nblk, W, dilation, H, dh).astype(jnp.float32)

    def neighbourhood(t):
        t = strided(t, W, Lp - L + W).reshape(B, nblk + 2, W, dilation, H, dh)
        return jnp.concatenate([t[:, :-2], t[:, 1:-1], t[:, 2:]], axis=2).astype(jnp.float32)

    kn = neighbourhood(k)
    vn = neighbourhood(v)
    u_q = jnp.arange(nblk)[:, None] * W + jnp.arange(W)[None, :]
    u_k = (jnp.arange(nblk)[:, None] - 1) * W + jnp.arange(3 * W)[None, :]
    rel = u_k[:, None, :] - u_q[:, :, None]
    mask = (jnp.abs(rel) <= radius) & (u_k[:, None, :] >= 0) & (u_k[:, None, :] < L)

    s = jnp.einsum('bnidhe,bnjdhe->bndhij', qs, kn) * (HEAD_DIM ** -0.5)
    s = jnp.where(mask[None, :, None, None], s, NEG_INF)
    m = jnp.max(s, axis=-1, keepdims=True)
    p = jnp.exp(s - m)
    l = jnp.sum(p, axis=-1)
    o = jnp.einsum('bndhij,bnjdhe->bnidhe', p, vn)
    l_t = l.transpose(0, 1, 4, 2, 3)
    o = o / l_t[..., None]
    lse = (m[..., 0] + jnp.log(l)).transpose(0, 1, 4, 2, 3)
    o = o.reshape(B, Lp, dilation, H, dh)[:, :L].reshape(B, S, H, dh)
    lse = lse.reshape(B, Lp, dilation, H)[:, :L].reshape(B, S, H)
    return o, lse


def dilated_mixer(h, w_in, cos, sin):
    B, S, _ = h.shape
    proj = jnp.einsum('bsd,de->bse', h, w_in).reshape(B, S, N_GROUPS, 3, ATTN_HEADS, HEAD_DIM)
    outs, lses = [], []
    for g, (window, dilation) in enumerate(DILATED_GROUPS):
        q = partial_rope(proj[:, :, g, 0], cos, sin)
        k = partial_rope(proj[:, :, g, 1], cos, sin)
        v = proj[:, :, g, 2]
        o, lse = dilated_group_attention(q, k, v, window, dilation)
        outs.append(o)
        lses.append(lse)
    wts = jax.nn.softmax(jnp.stack(lses, axis=0), axis=0)
    o = jnp.sum(wts[..., None] * jnp.stack(outs, axis=0), axis=0)
    return o.reshape(B, S, ATTN_HEADS * HEAD_DIM).astype(h.dtype)


def swiglu_ffn(h, w_in, w_out):
    gate, up = jnp.split(jnp.einsum('bsd,df->bsf', h, w_in), 2, axis=-1)
    return jnp.einsum('bsf,fd->bsd', jax.nn.silu(gate) * up, w_out)


def setup_inputs(seed: int = 0) -> dict:
    key = jax.random.key(seed)
    ks = jax.random.split(key, 9)
    f32 = jnp.float32
    x = jax.random.normal(ks[0], (BATCH, SEQ, D_MODEL), f32)
    norm_w = 1.0 + 0.02 * jax.random.normal(ks[1], (DEPTH, 4, D_MODEL), f32)
    w_in_hgrn = jax.random.normal(ks[2], (N_HGRN_LAYERS, D_MODEL, HGRN_IN), f32) * D_MODEL ** -0.5
    hgrn_lower_bounds = 0.1 * jax.random.normal(ks[3], (2, DEPTH, HGRN_HEADS * HGRN_DK), f32)
    hgrn_gnorm = 1.0 + 0.02 * jax.random.normal(ks[4], (N_HGRN_LAYERS, HGRN_DV), f32)
    w_in_attn = jax.random.normal(ks[5], (N_ATTN_LAYERS, D_MODEL, ATTN_IN), f32) * D_MODEL ** -0.5
    w_out = jax.random.normal(ks[6], (DEPTH, D_MODEL, D_MODEL), f32) * D_MODEL ** -0.5
    w_ffn_in = jax.random.normal(ks[7], (DEPTH, D_MODEL, 2 * D_FF), f32) * D_MODEL ** -0.5
    w_ffn_out = jax.random.normal(ks[8], (DEPTH, D_FF, D_MODEL), f32) * D_FF ** -0.5
    return {"x": x, "norm_w": norm_w, "w_in_hgrn": w_in_hgrn,
            "hgrn_lower_bounds": hgrn_lower_bounds, "hgrn_gnorm": hgrn_gnorm,
            "w_in_attn": w_in_attn, "w_out": w_out,
            "w_ffn_in": w_ffn_in, "w_ffn_out": w_ffn_out}


def reference(x, norm_w, w_in_hgrn, hgrn_lower_bounds, hgrn_gnorm, w_in_attn, w_out, w_ffn_in, w_ffn_out):
    S = x.shape[1]
    lb = jnp.cumsum(jax.nn.softmax(hgrn_lower_bounds.astype(jnp.float32), axis=1), axis=1)
    lb = lb - lb[:, :1]
    pos = jnp.arange(S, dtype=jnp.float32)
    inv_freq = ROPE_THETA ** (-(jnp.arange(0, ROPE_DIM, 2, dtype=jnp.float32) / ROPE_DIM))
    ang = pos[:, None] * inv_freq[None, :]
    ang = jnp.concatenate([ang, ang], axis=-1)
    cos = jnp.cos(ang)[:, None, :]
    sin = jnp.sin(ang)[:, None, :]

    for layer in range(DEPTH):
        mixer = layer % N_MIXERS
        slot = layer // N_MIXERS
        h = rmsnorm(x, norm_w[layer, 0])
        if mixer == 0:
            h = hgrn2_mixer(h, w_in_hgrn[slot], lb[0, layer], lb[1, layer], hgrn_gnorm[slot])
        else:
            h = dilated_mixer(h, w_in_attn[slot], cos, sin)
        h = jnp.einsum('bsd,de->bse', h, w_out[layer])
        x = x + rmsnorm(h, norm_w[layer, 1])
        h = swiglu_ffn(rmsnorm(x, norm_w[layer, 2]), w_ffn_in[layer], w_ffn_out[layer])
        x = x + rmsnorm(h, norm_w[layer, 3])
    return x
```

```cpp
#include <hip/hip_runtime.h>
#include <cstdio>
#include <cstdint>
namespace pg8 {
#define PG8_LAS __attribute__((address_space(3)))
typedef unsigned short bf16_t;
typedef short bf16x8 __attribute__((ext_vector_type(8)));
typedef float f32x4 __attribute__((ext_vector_type(4)));
typedef unsigned u32x4 __attribute__((ext_vector_type(4)));
constexpr int BM = 256, BK = 64, HALF = 128, HTB = HALF * BK * 2  , STAGE_BYTES = 8 * HTB, NXCD = 8, WGM = 8;

__host__ __device__ __forceinline__ int lds_byte(int r, int c) { const int st = (r >> 4) * 2 + (c >> 5), rr = r & 15, cc = c & 31, ob = rr * 64 + cc * 2; return st * 1024 + (ob ^ (((ob >> 9) & 1) << 5)); }
__host__ __device__ __forceinline__ void stage_rc(int b, int& R, int& C) { const int st = b / 1024, sb = b % 1024, swz = sb ^ (((sb >> 9) & 1) << 5); R = (st >> 1) * 16 + swz / 64; C = (st & 1) * 32 + (swz % 64) / 2; }
__host__ __device__ __forceinline__ int perm32(int rho) { const int n = rho >> 4, i = rho & 15; return 8 * (i >> 2) + 4 * n + (i & 3); }

struct Unit { int pm, pn; };
struct Gemm { const bf16_t* A; const bf16_t* Bt; int M, N, K; };

struct StaticOrder {
    int nM, nN, nwg, G, c;
    __host__ __device__ void init(int M, int N, int G_, int c_) { nM = M / BM; nN = N / BM; nwg = nM * nN; G = G_; c = c_; }
    __host__ __device__ bool next(int i, Unit& u) const {
        const long L = (long)i * G + c; if (L >= nwg) return false;
        int wgid = (int)L; { const int q = nwg / NXCD, r = nwg % NXCD, xcd = wgid % NXCD, off = wgid / NXCD; wgid = (xcd < r ? xcd * (q + 1) : r * (q + 1) + (xcd - r) * q) + off; }
        const int nig = WGM * nN, gid = wgid / nig, fm = gid * WGM, gsz = (nM - fm) < WGM ? (nM - fm) : WGM;
        u.pm = fm + ((wgid % nig) % gsz); u.pn = (wgid % nig) / gsz; return true;
    }
    __device__ __forceinline__ void a_ready(const Unit&) const {}
    __device__ __forceinline__ void done(const Unit&) const {}
};

__device__ __forceinline__ unsigned cvt_pk_bf16(float lo, float hi) { unsigned r; asm volatile("v_cvt_pk_bf16_f32 %0, %1, %2" : "=v"(r) : "v"(lo), "v"(hi)); return r; }
typedef float f32x2 __attribute__((ext_vector_type(2)));
__device__ __forceinline__ f32x2 gelu_pk(f32x2 v) {
    const f32x2 av = __builtin_elementwise_abs(v), d = av * 0.2316418882f + 1.0f;
    f32x2 t; t.x = __builtin_amdgcn_rcpf(d.x); t.y = __builtin_amdgcn_rcpf(d.y);
    f32x2 q = t * 0.5307027145f + (-0.7265760135f); q = q * t + 0.7107068705f; q = q * t + (-0.142248368f); q = q * t + 0.127414796f; q = q * t;
    const f32x2 s = (v * v) * (-0.72134752044f);
    f32x2 e; e.x = __builtin_amdgcn_exp2f(s.x); e.y = __builtin_amdgcn_exp2f(s.y);
    const f32x2 m = v * (q * e), r = v - m;
    f32x2 o; o.x = v.x < 0.f ? m.x : r.x; o.y = v.y < 0.f ? m.y : r.y; return o;
}

template <int ACT  > struct EpiBf16 {
    static constexpr bool PERM = true, AFTER_DRAIN = false; static_assert(ACT == 0 || ACT == 1, "EpiBf16: ACT is 0 (none) or 1 (gelu_pk)");
    bf16_t* O; int ldc; const float* bias; int split_cols; size_t split_stride; float scale0;
    __device__ __forceinline__ void operator()(const f32x4 (&acc)[2][2][4][2], const Unit& u, int wr, int wc, int fr, int fq) const {
        const int row0 = u.pm * BM + wr * 64 + fr; int colt = u.pn * BM; bf16_t* base = O;
        float sc = 1.f; if (split_cols) { const int t = colt / split_cols; base += (size_t)t * split_stride; colt -= t * split_cols; if (t == 0) sc = scale0; }
        const int col0 = colt + wc * 32 + 8 * fq, bcol0 = u.pn * BM + wc * 32 + 8 * fq;
        f32x4 bv[2][2];
#pragma unroll
        for (int bj = 0; bj < 2; ++bj)
#pragma unroll
            for (int n = 0; n < 2; ++n) bv[bj][n] = bias ? *(const f32x4*)(bias + bcol0 + bj * HALF + 4 * n) : (f32x4){0.f, 0.f, 0.f, 0.f};
#pragma unroll
        for (int ai = 0; ai < 2; ++ai)
#pragma unroll
            for (int m = 0; m < 4; ++m) { bf16_t* rowp = base + (size_t)(row0 + ai * HALF + m * 16) * ldc + col0;
#pragma unroll
                for (int bj = 0; bj < 2; ++bj) { f32x4 v0 = acc[ai][bj][m][0] + bv[bj][0], v1 = acc[ai][bj][m][1] + bv[bj][1];
                    if (ACT == 1) { f32x2 a = gelu_pk((f32x2){v0[0], v0[1]}), b = gelu_pk((f32x2){v0[2], v0[3]}), c = gelu_pk((f32x2){v1[0], v1[1]}), d = gelu_pk((f32x2){v1[2], v1[3]});
                        v0 = (f32x4){a.x, a.y, b.x, b.y}; v1 = (f32x4){c.x, c.y, d.x, d.y}; }
                    v0 = v0 * sc; v1 = v1 * sc; u32x4 w; w.x = cvt_pk_bf16(v0[0], v0[1]); w.y = cvt_pk_bf16(v0[2], v0[3]); w.z = cvt_pk_bf16(v1[0], v1[1]); w.w = cvt_pk_bf16(v1[2], v1[3]);
                    *(u32x4*)(rowp + bj * HALF) = w; } }
    }
};

template <class Epi, class Sched, bool ALIGN_EPI = false, bool SP2 = false>
__device__ __forceinline__ void gemm_phase(PG8_LAS unsigned char* lds, const Gemm g, const Sched& S, const Epi& E) {
    int tid_l = threadIdx.x; asm volatile("" : "+v"(tid_l));
    const int tid = tid_l, wid = __builtin_amdgcn_readfirstlane(tid >> 6), lane = tid & 63, wr = wid >> 2, wc = wid & 3, fr = lane & 15, fq = lane >> 4;
    const int K = g.K, nt = K / BK;
    unsigned voffA[2], voffB[2];
#pragma unroll
    for (int i = 0; i < 2; ++i) { int R, C; stage_rc(tid * 16 + i * 8192, R, C); const int Rb = Epi::PERM ? ((R & ~31) + perm32(R & 31)) : R;
        voffA[i] = (unsigned)(R * K + C) * 2u; voffB[i] = (unsigned)(Rb * K + C) * 2u; }
    const size_t kstep = (size_t)(BK * 2);
    const size_t hstep = (size_t)HALF * K * 2;
    const size_t tstep = 2 * hstep;
    const unsigned ldsw = (unsigned)wid * 1024u;
    const int aoff = lds_byte(wr * 64 + fr, fq * 8), boff = lds_byte(wc * 32 + fr, fq * 8);
#define PG8_SA(b, h) (((b) * 2 + (h)) * HTB)
#define PG8_SB(b, h) ((4 + (b) * 2 + (h)) * HTB)
#define PG8_STAGE(bufoff, gbase, voff) do { _Pragma("unroll") for (int _i = 0; _i < 2; ++_i) \
        __builtin_amdgcn_global_load_lds((const unsigned*)((const char*)(gbase) + (voff)[_i]), (PG8_LAS unsigned*)(lds + (bufoff) + ldsw + _i * 8192), 16, 0, 0); } while (0)
#define PG8_LDA(dst, b, h) do { _Pragma("unroll") for (int m = 0; m < 4; ++m) _Pragma("unroll") for (int k = 0; k < 2; ++k) dst[m][k] = *(const PG8_LAS bf16x8*)(lds + PG8_SA(b, h) + aoff + m * 2048 + k * 1024); } while (0)
#define PG8_LDB(dst, b, h) do { _Pragma("unroll") for (int n = 0; n < 2; ++n) _Pragma("unroll") for (int k = 0; k < 2; ++k) dst[n][k] = *(const PG8_LAS bf16x8*)(lds + PG8_SB(b, h) + boff + n * 2048 + k * 1024); } while (0)
#define PG8_MMA(ai, bj, At, Bt) do { __builtin_amdgcn_s_setprio(1); _Pragma("unroll") for (int m = 0; m < 4; ++m) _Pragma("unroll") for (int n = 0; n < 2; ++n) _Pragma("unroll") for (int k = 0; k < 2; ++k) \
        acc[ai][bj][m][n] = __builtin_amdgcn_mfma_f32_16x16x32_bf16(Bt[n][k], At[m][k], acc[ai][bj][m][n], 0, 0, 0); __builtin_amdgcn_s_setprio(0); } while (0)
#define PG8_WAIT_V(n) asm volatile("s_waitcnt vmcnt(" #n ")" ::: "memory")
#define PG8_WAIT_L(n) asm volatile("s_waitcnt lgkmcnt(" #n ")" ::: "memory")
#define PG8_BAR __builtin_amdgcn_s_barrier()
#define PG8_SCHED __builtin_amdgcn_sched_barrier(0)
    Unit cur, nxt; int ui = 0;
    if (!S.next(0, cur)) return;
    f32x4 acc[2][2][4][2];
#pragma unroll
    for (int a = 0; a < 2; ++a)
#pragma unroll
        for (int b = 0; b < 2; ++b)
#pragma unroll
            for (int m = 0; m < 4; ++m)
#pragma unroll
                for (int n = 0; n < 2; ++n) acc[a][b][m][n] = (f32x4){0.f, 0.f, 0.f, 0.f};
    bf16x8 At[4][2], B0[2][2], B1[2][2];
    const char* cA = (const char*)g.A + (size_t)cur.pm * tstep; const char* cB = (const char*)g.Bt + (size_t)cur.pn * tstep;
    S.a_ready(cur);
    if constexpr (SP2) {
        PG8_STAGE(PG8_SB(0, 0), cB, voffB); PG8_STAGE(PG8_SB(0, 1), cB + hstep, voffB); PG8_STAGE(PG8_SA(0, 0), cA, voffA); PG8_STAGE(PG8_SA(0, 1), cA + hstep, voffA);
        if (wr == 1) PG8_BAR;
        PG8_WAIT_V(2); PG8_BAR;
        PG8_STAGE(PG8_SB(1, 0), cB + kstep, voffB); PG8_STAGE(PG8_SA(1, 0), cA + kstep, voffA); PG8_STAGE(PG8_SB(1, 1), cB + hstep + kstep, voffB);
        PG8_WAIT_V(6); PG8_BAR;
    } else {
        PG8_STAGE(PG8_SB(0, 0), cB, voffB); PG8_STAGE(PG8_SA(0, 0), cA, voffA); PG8_STAGE(PG8_SB(0, 1), cB + hstep, voffB); PG8_STAGE(PG8_SA(0, 1), cA + hstep, voffA);
        if (wr == 1) PG8_BAR;
        PG8_WAIT_V(4); PG8_BAR;
        PG8_STAGE(PG8_SB(1, 0), cB + kstep, voffB); PG8_STAGE(PG8_SA(1, 0), cA + kstep, voffA); PG8_STAGE(PG8_SB(1, 1), cB + hstep + kstep, voffB);
        PG8_WAIT_V(6); PG8_BAR;
    }
    for (;;) {
        const bool has_next = S.next(ui + 1, nxt);
        const char* nA = has_next ? (const char*)g.A + (size_t)nxt.pm * tstep : cA; const char* nB = has_next ? (const char*)g.Bt + (size_t)nxt.pn * tstep : cB;
        for (int t = 0; t < nt; t += 2) {
            const bool last = (t == nt - 2);
            const char* a1 = cA + (size_t)(t + 1) * kstep;
            const char* a2 = last ? nA : cA + (size_t)(t + 2) * kstep; const char* b2 = last ? nB : cB + (size_t)(t + 2) * kstep;
            const char* a3 = a2 + kstep; const char* b3 = b2 + kstep;
            if (last && has_next) S.a_ready(nxt);
            if constexpr (SP2) {
            PG8_LDB(B0, 0, 0); PG8_LDB(B1, 0, 1); PG8_SCHED; PG8_LDA(At, 0, 0); PG8_STAGE(PG8_SA(1, 1), a1 + hstep, voffA);
            PG8_WAIT_V(8); PG8_WAIT_L(0); PG8_BAR; PG8_MMA(0, 0, At, B0); PG8_MMA(0, 1, At, B1); PG8_BAR; PG8_SCHED;
            PG8_LDA(At, 0, 1); PG8_STAGE(PG8_SB(0, 0), b2, voffB); PG8_STAGE(PG8_SB(0, 1), b2 + hstep, voffB); PG8_STAGE(PG8_SA(0, 0), a2, voffA);
            PG8_WAIT_V(8); PG8_WAIT_L(0); PG8_BAR; PG8_MMA(1, 0, At, B0); PG8_MMA(1, 1, At, B1); PG8_BAR; PG8_SCHED;
            PG8_LDB(B0, 1, 0); PG8_LDB(B1, 1, 1); PG8_SCHED; PG8_LDA(At, 1, 0); PG8_STAGE(PG8_SA(0, 1), a2 + hstep, voffA);
            PG8_WAIT_V(8); PG8_WAIT_L(0); PG8_BAR; PG8_MMA(0, 0, At, B0); PG8_MMA(0, 1, At, B1); PG8_BAR; PG8_SCHED;
            PG8_LDA(At, 1, 1); PG8_STAGE(PG8_SB(1, 0), b3, voffB); PG8_STAGE(PG8_SB(1, 1), b3 + hstep, voffB); PG8_STAGE(PG8_SA(1, 0), a3, voffA);
            PG8_WAIT_V(8); PG8_WAIT_L(0); PG8_BAR; PG8_MMA(1, 0, At, B0); PG8_MMA(1, 1, At, B1); PG8_BAR; PG8_SCHED;
            } else {
            PG8_LDB(B0, 0, 0); PG8_SCHED; PG8_LDA(At, 0, 0); PG8_STAGE(PG8_SA(1, 1), a1 + hstep, voffA);
            PG8_WAIT_L(8); PG8_BAR; PG8_WAIT_L(0); PG8_MMA(0, 0, At, B0); PG8_BAR; PG8_SCHED;
            PG8_LDB(B1, 0, 1); PG8_STAGE(PG8_SB(0, 0), b2, voffB);
            PG8_BAR; PG8_WAIT_L(0); PG8_MMA(0, 1, At, B1); PG8_BAR;
            PG8_LDA(At, 0, 1); PG8_STAGE(PG8_SA(0, 0), a2, voffA);
            PG8_BAR; PG8_WAIT_L(0); PG8_MMA(1, 0, At, B0); PG8_BAR; PG8_SCHED;
            PG8_STAGE(PG8_SB(0, 1), b2 + hstep, voffB);
            PG8_WAIT_V(6); PG8_BAR; PG8_MMA(1, 1, At, B1); PG8_BAR;
            PG8_LDB(B0, 1, 0); PG8_SCHED; PG8_LDA(At, 1, 0); PG8_STAGE(PG8_SA(0, 1), a2 + hstep, voffA);
            PG8_WAIT_L(8); PG8_BAR; PG8_WAIT_L(0); PG8_MMA(0, 0, At, B0); PG8_BAR; PG8_SCHED;
            PG8_LDB(B1, 1, 1); PG8_STAGE(PG8_SB(1, 0), b3, voffB);
            PG8_BAR; PG8_WAIT_L(0); PG8_MMA(0, 1, At, B1); PG8_BAR;
            PG8_LDA(At, 1, 1); PG8_STAGE(PG8_SA(1, 0), a3, voffA);
            PG8_BAR; PG8_WAIT_L(0); PG8_MMA(1, 0, At, B0); PG8_BAR; PG8_SCHED;
            PG8_STAGE(PG8_SB(1, 1), b3 + hstep, voffB);
            PG8_WAIT_V(6); PG8_BAR; PG8_MMA(1, 1, At, B1); PG8_BAR;
            }
        }
        if constexpr (ALIGN_EPI) { if (wr == 0) PG8_BAR; }
        if constexpr (!Epi::AFTER_DRAIN) { E(acc, cur, wr, wc, fr, fq); S.done(cur); }
        if (!has_next) break;
#pragma unroll
        for (int a = 0; a < 2; ++a)
#pragma unroll
            for (int b = 0; b < 2; ++b)
#pragma unroll
                for (int m = 0; m < 4; ++m)
#pragma unroll
                    for (int n = 0; n < 2; ++n) acc[a][b][m][n] = (f32x4){0.f, 0.f, 0.f, 0.f};
        cur = nxt; cA = nA; cB = nB; ++ui;
        if constexpr (ALIGN_EPI) { if (wr == 1) PG8_BAR; }
    }
    PG8_WAIT_V(0);
    if constexpr (!ALIGN_EPI) { if (wr == 0) PG8_BAR; }
    PG8_BAR;
    if constexpr (Epi::AFTER_DRAIN) { E.fused(acc, cur, wr, wc, fr, fq, lds, wid, lane); S.done(cur); }
#undef PG8_SA
#undef PG8_SB
#undef PG8_STAGE
#undef PG8_LDA
#undef PG8_LDB
#undef PG8_MMA
#undef PG8_WAIT_V
#undef PG8_WAIT_L
#undef PG8_BAR
#undef PG8_SCHED
}
}
namespace pg8 {
__device__ __forceinline__ float silu_f(float x) { return x * __builtin_amdgcn_rcpf(1.0f + __builtin_amdgcn_exp2f(-1.44269504f * x)); }
struct EpiSwiGLU {
    static constexpr bool PERM = true, AFTER_DRAIN = false;
    bf16_t* O; int ldc;
    __device__ __forceinline__ void operator()(const f32x4 (&acc)[2][2][4][2], const Unit& u, int wr, int wc, int fr, int fq) const {
        const int row0 = u.pm * BM + wr * 64 + fr; const int col0 = u.pn * HALF + wc * 32 + 8 * fq;
#pragma unroll
        for (int ai = 0; ai < 2; ++ai)
#pragma unroll
            for (int m = 0; m < 4; ++m) { bf16_t* rowp = O + (size_t)(row0 + ai * HALF + m * 16) * ldc + col0;
                const f32x4 g0 = acc[ai][0][m][0], g1 = acc[ai][0][m][1], u0 = acc[ai][1][m][0], u1 = acc[ai][1][m][1];
                u32x4 w; w.x = cvt_pk_bf16(silu_f(g0[0]) * u0[0], silu_f(g0[1]) * u0[1]); w.y = cvt_pk_bf16(silu_f(g0[2]) * u0[2], silu_f(g0[3]) * u0[3]);
                w.z = cvt_pk_bf16(silu_f(g1[0]) * u1[0], silu_f(g1[1]) * u1[1]); w.w = cvt_pk_bf16(silu_f(g1[2]) * u1[2], silu_f(g1[3]) * u1[3]);
                *(u32x4*)rowp = w; }
    }
};
}
#define GAS __attribute__((address_space(1)))
#define LAS __attribute__((address_space(3)))
typedef unsigned short bf16;
typedef unsigned v4u __attribute__((ext_vector_type(4)));
typedef float f32x4 __attribute__((ext_vector_type(4)));
typedef short bf16x8 __attribute__((ext_vector_type(8)));
typedef GAS unsigned gu32;
typedef GAS unsigned long long gu64;
#define RLX_AGENT __ATOMIC_RELAXED, __HIP_MEMORY_SCOPE_AGENT
#define LDS_WAIT() asm volatile("s_waitcnt lgkmcnt(0)" ::: "memory")
#define VM_WAIT() asm volatile("s_waitcnt vmcnt(0)" ::: "memory")
__device__ __forceinline__ unsigned long long rt() { return __builtin_amdgcn_s_memrealtime(); }
__device__ __forceinline__ unsigned f2bf(float f) { unsigned u = __builtin_bit_cast(unsigned, f); return (u + 0x7fffu + ((u >> 16) & 1u)) >> 16; }
__device__ __forceinline__ unsigned pk2(float lo, float hi) { return f2bf(lo) | (f2bf(hi) << 16); }

#define XB_TMO      128
#define XB_XCNT(j)  (256  + 64 * (j))
#define XB_XSUB(j)  (1280 + 64 * (j))
#define XB_XGEN(j)  (2304 + 64 * (j))
#define XB_TOP      3328
#define XB_TOPGEN   3392
#define XCD_BAR_WORDS 3456
#define XB_SPIN_CAP (1u << 18)

__device__ __forceinline__ unsigned xb_ld(unsigned* p)              { return __hip_atomic_load(p, __ATOMIC_RELAXED, __HIP_MEMORY_SCOPE_AGENT); }
__device__ __forceinline__ unsigned xb_add(unsigned* p, unsigned v) { return __hip_atomic_fetch_add(p, v, __ATOMIC_RELAXED, __HIP_MEMORY_SCOPE_AGENT); }
__device__ __forceinline__ unsigned xb_xcc_id() { return (unsigned)__builtin_amdgcn_s_getreg((3 << 11) | 20) & 0xFu; }
#define XB_SPIN(cond, bar) do { unsigned _sp = 0; while (cond) { __builtin_amdgcn_s_sleep(1); \
    if ((++_sp & 255u) == 0u) { if (xb_ld(&(bar)[XB_TMO])) break; if (_sp > XB_SPIN_CAP) { atomicAdd(&(bar)[XB_TMO], 1u); break; } } } } while (0)

struct XcdBarrier {
    unsigned* bar; unsigned x;
    volatile LAS unsigned* st;
};

__device__ __forceinline__ XcdBarrier xcd_barrier_post(unsigned* bar, volatile LAS unsigned* st) {
    XcdBarrier b; b.bar = bar; b.x = xb_xcc_id(); b.st = st;
    if (threadIdx.x == 0) (void)xb_add(&bar[XB_XCNT(b.x)], 1u);
    return b;
}
__device__ __forceinline__ void xcd_barrier_complete(unsigned* bar, unsigned x, unsigned& nloc, unsigned& nx) {
    const unsigned G = gridDim.x * gridDim.y * gridDim.z;
    unsigned sum, cnt, mine, sp = 0u;
    for (;;) {
        sum = 0u; cnt = 0u; mine = 0u;
#pragma unroll
        for (unsigned j = 0; j < 16; ++j) { const unsigned c = xb_ld(&bar[XB_XCNT(j)]); sum += c; cnt += (c > 0u) ? 1u : 0u; mine = (j == x) ? c : mine; }
        if (sum == G) break;
        __builtin_amdgcn_s_sleep(1);
        if ((++sp & 255u) == 0u) { if (xb_ld(&bar[XB_TMO])) break; if (sp > XB_SPIN_CAP) { atomicAdd(&bar[XB_TMO], 1u); break; } }
    }
    nloc = mine > 0u ? mine : 1u; nx = cnt > 0u ? cnt : 1u;
}

__device__ __forceinline__ void xcd_barrier(const XcdBarrier& b) {
    asm volatile("s_waitcnt vmcnt(0)" ::: "memory");
    __syncthreads();
    if (threadIdx.x == 0) {
        unsigned* bar = b.bar;
        __builtin_amdgcn_s_waitcnt(0);
        unsigned nloc = b.st[0], nx = b.st[1];
        if (nloc == 0u) { xcd_barrier_complete(bar, b.x, nloc, nx); b.st[0] = nloc; b.st[1] = nx; }
        const unsigned old = xb_add(&bar[XB_XSUB(b.x)], 1u);
        const unsigned gen = old / nloc;
        if (old + 1u == (gen + 1u) * nloc) {
            __builtin_amdgcn_fence(__ATOMIC_RELEASE, "agent");
            asm volatile("s_waitcnt vmcnt(0)" ::: "memory");
            const unsigned og = xb_add(&bar[XB_TOP], 1u);
            const unsigned tg = og / nx;
            if (og + 1u == (tg + 1u) * nx) xb_add(&bar[XB_TOPGEN], 1u);
            else XB_SPIN(xb_ld(&bar[XB_TOPGEN]) == tg, bar);
            __builtin_amdgcn_fence(__ATOMIC_ACQUIRE, "agent");
            xb_add(&bar[XB_XGEN(b.x)], 1u);
            asm volatile("s_waitcnt vmcnt(0)" ::: "memory");
        } else {
            XB_SPIN(xb_ld(&bar[XB_XGEN(b.x)]) == gen, bar);
            __builtin_amdgcn_fence(__ATOMIC_ACQUIRE, "agent");
            asm volatile("s_waitcnt vmcnt(0)" ::: "memory");
        }
    }
    __syncthreads();
}

constexpr int NWAVES = 8, NTHREADS = 512;
constexpr int BATCH = 2, SEQ = 4096, D = 2048, M = BATCH * SEQ, DEPTH = 4, NH = 16, HD = 128;
constexpr int HGRN_N = 5 * D, ATTN_N = 9 * D, DFF = 5632, FFN_N = 2 * DFF;
constexpr float EPS = 1e-6f;
constexpr int NPHASES = 1 + 8 * DEPTH;

constexpr size_t MiB = 1u << 20;
constexpr size_t WS_CTL = 0, CTL_ZERO_BYTES = 1 * MiB;
constexpr size_t WS_TAB = 1 * MiB;
constexpr size_t TAB_COS = 0, TAB_SIN = 262144, TAB_LB = 524288;
constexpr size_t WS_WHG = 2 * MiB;
constexpr size_t WS_WAT = 82 * MiB;
constexpr size_t WS_WO = 226 * MiB;
constexpr size_t WS_WF1 = 258 * MiB;
constexpr size_t WS_WF2 = 434 * MiB;
constexpr size_t WS_H = 522 * MiB;
constexpr size_t WS_PROJ = 554 * MiB;
constexpr size_t WS_MIX = 842 * MiB;
constexpr size_t WS_O = 942 * MiB;
constexpr size_t WS_G = 974 * MiB;
constexpr size_t WS_END = 1006 * MiB;
constexpr int CW_BAR = 4096;

constexpr int RING_BYTES = 131072;
constexpr int LDSCTL_OFF = RING_BYTES, MISC_OFF = LDSCTL_OFF + 320;
constexpr int LDS_BYTES = 147456;

__device__ __forceinline__ float bf2f(unsigned short b) { return __builtin_bit_cast(float, (unsigned)b << 16); }
__device__ __forceinline__ float bflo(unsigned w) { return __builtin_bit_cast(float, w << 16); }
__device__ __forceinline__ float bfhi(unsigned w) { return __builtin_bit_cast(float, w & 0xffff0000u); }
__device__ __forceinline__ float wave_sum(float v) {
#pragma unroll
    for (int o = 1; o < 64; o <<= 1) v += __shfl_xor(v, o);
    return v;
}
__device__ __forceinline__ float sigmoid_f(float x) { return __builtin_amdgcn_rcpf(1.0f + __builtin_amdgcn_exp2f(-1.44269504f * x)); }

__device__ __forceinline__ void transpose_item(const float* W, int K, int N, bf16* WT, int k0, int n0, int drow0, LAS float* scr, int lane) {
#pragma unroll 8
    for (int i = 0; i < 32; ++i) { const int kk = 2 * i + (lane >> 5); scr[kk * 33 + (lane & 31)] = W[(size_t)(k0 + kk) * N + n0 + (lane & 31)]; }
    LDS_WAIT(); asm volatile("" ::: "memory");
    const int c = lane & 7;
#pragma unroll
    for (int j = 0; j < 4; ++j) { const int n = (lane >> 3) + 8 * j; const LAS float* s = scr + (8 * c) * 33 + n;
        v4u o; o.x = pk2(s[0 * 33], s[1 * 33]); o.y = pk2(s[2 * 33], s[3 * 33]); o.z = pk2(s[4 * 33], s[5 * 33]); o.w = pk2(s[6 * 33], s[7 * 33]);
        *(GAS v4u*)(WT + (size_t)(drow0 + n) * K + k0 + 8 * c) = o; }
    LDS_WAIT(); asm volatile("" ::: "memory");
}
__device__ __forceinline__ void transpose_matrix(const float* W, int K, int N, bf16* WT, int mode, LAS float* scr, int gw, int NGW, int lane) {
    const int nblk = N / 32, nitems = (K / 64) * nblk;
    for (int it = gw; it < nitems; it += NGW) {
        const int kb = it / nblk, nb = it - kb * nblk, n0 = 32 * nb;
        int drow0 = n0;
        if (mode == 1) { const int up = n0 >= DFF, nn = up ? n0 - DFF : n0; drow0 = (nn >> 7) * 256 + (up ? 128 : 0) + (nn & 127); }
        transpose_item(W, K, N, WT, 64 * kb, n0, drow0, scr, lane);
    }
}

template <bool RES, bool NORM2>
__device__ __forceinline__ void norm_rows(const bf16* gin, const float* x_in, float* x_out, const float* w1, const float* w2, bf16* hout, int gw, int NGW, int lane) {
    for (int m = gw; m < M; m += NGW) {
        float xv[4][8];
#pragma unroll
        for (int j = 0; j < 4; ++j) { const GAS f32x4* xp = (const GAS f32x4*)(x_in + (size_t)m * D + 8 * (64 * j + lane));
            const f32x4 a = xp[0], b = xp[1]; xv[j][0] = a.x; xv[j][1] = a.y; xv[j][2] = a.z; xv[j][3] = a.w; xv[j][4] = b.x; xv[j][5] = b.y; xv[j][6] = b.z; xv[j][7] = b.w; }
        if (RES) {
            float gv[4][8]; float ss = 0.f;
#pragma unroll
            for (int j = 0; j < 4; ++j) { const v4u g = *(const GAS v4u*)(gin + (size_t)m * D + 8 * (64 * j + lane));
                gv[j][0] = bflo(g.x); gv[j][1] = bfhi(g.x); gv[j][2] = bflo(g.y); gv[j][3] = bfhi(g.y); gv[j][4] = bflo(g.z); gv[j][5] = bfhi(g.z); gv[j][6] = bflo(g.w); gv[j][7] = bfhi(g.w);
#pragma unroll
                for (int i = 0; i < 8; ++i) ss += gv[j][i] * gv[j][i]; }
            const float r1 = 1.0f / sqrtf(wave_sum(ss) * (1.0f / D) + EPS);
#pragma unroll
            for (int j = 0; j < 4; ++j) { const GAS f32x4* wp = (const GAS f32x4*)(w1 + 8 * (64 * j + lane)); const f32x4 a = wp[0], b = wp[1];
                const float wv[8] = {a.x, a.y, a.z, a.w, b.x, b.y, b.z, b.w};
#pragma unroll
                for (int i = 0; i < 8; ++i) xv[j][i] += gv[j][i] * r1 * wv[i];
                GAS f32x4* op = (GAS f32x4*)(x_out + (size_t)m * D + 8 * (64 * j + lane));
                op[0] = (f32x4){xv[j][0], xv[j][1], xv[j][2], xv[j][3]}; op[1] = (f32x4){xv[j][4], xv[j][5], xv[j][6], xv[j][7]}; }
        }
        if (NORM2) {
            float ss = 0.f;
#pragma unroll
            for (int j = 0; j < 4; ++j)
#pragma unroll
                for (int i = 0; i < 8; ++i) ss += xv[j][i] * xv[j][i];
            const float r2 = 1.0f / sqrtf(wave_sum(ss) * (1.0f / D) + EPS);
#pragma unroll
            for (int j = 0; j < 4; ++j) { const GAS f32x4* wp = (const GAS f32x4*)(w2 + 8 * (64 * j + lane)); const f32x4 a = wp[0], b = wp[1];
                v4u o; o.x = pk2(xv[j][0] * r2 * a.x, xv[j][1] * r2 * a.y); o.y = pk2(xv[j][2] * r2 * a.z, xv[j][3] * r2 * a.w);
                o.z = pk2(xv[j][4] * r2 * b.x, xv[j][5] * r2 * b.y); o.w = pk2(xv[j][6] * r2 * b.z, xv[j][7] * r2 * b.w);
                *(GAS v4u*)(hout + (size_t)m * D + 8 * (64 * j + lane)) = o; }
        }
    }
}

__device__ __forceinline__ void hgrn_core_simple(LAS unsigned char* lds, const bf16* P, const float* lbt, bf16* OD, int tid) {
    const int chain = blockIdx.x;
    if (chain >= 64) return;
    const int b = chain >> 5, hh = (chain >> 1) & 15, dir = chain & 1;
    LAS float* qs = (LAS float*)lds; LAS float* ks = qs + 4096; LAS float* fs = ks + 4096; LAS float* vs = fs + 4096;
    const int v = tid >> 2, dg = tid & 3;
    float S[32];
#pragma unroll
    for (int j = 0; j < 32; ++j) S[j] = 0.f;
    const float* lb = lbt + (size_t)dir * 4 * D + hh * HD;
    bf16* od = OD + (size_t)dir * M * D;
    for (int blk = 0; blk < SEQ / 32; ++blk) {
        __syncthreads();
        for (int e = tid; e < 4096; e += NTHREADS) {
            const int tt = e >> 7, d = e & 127; const int ts = blk * 32 + tt; const int t = dir ? (SEQ - 1 - ts) : ts;
            const bf16* row = P + (size_t)(b * SEQ + t) * HGRN_N + hh * HD + d;
            const float qv = bf2f(row[0]); const float fv = bf2f(row[(1 + dir) * D]); const float iv = bf2f(row[3 * D]);
            const float lbv = lb[d]; const float fg = lbv + (1.0f - lbv) * sigmoid_f(fv);
            qs[e] = qv * sigmoid_f(qv); ks[e] = 1.0f - fg; fs[e] = fg; vs[e] = iv;
        }
        __syncthreads();
        for (int tt = 0; tt < 32; ++tt) {
            const float vt = vs[tt * 128 + v]; float o = 0.f;
            const LAS float* qr = qs + tt * 128 + dg * 32; const LAS float* kr = ks + tt * 128 + dg * 32; const LAS float* fr = fs + tt * 128 + dg * 32;
#pragma unroll
            for (int j = 0; j < 32; ++j) { S[j] = fr[j] * S[j] + kr[j] * vt; o += qr[j] * S[j]; }
            o += __shfl_xor(o, 1); o += __shfl_xor(o, 2);
            const int ts = blk * 32 + tt; const int t = dir ? (SEQ - 1 - ts) : ts;
            if (dg == 0) od[(size_t)(b * SEQ + t) * D + hh * HD + v] = (bf16)f2bf(o);
        }
    }
}
__device__ __forceinline__ void hgrn_finalize(const bf16* P, const bf16* OD, const float* gnorm, bf16* O, int gw, int NGW, int lane) {
    for (int m = gw; m < M; m += NGW) {
#pragma unroll
        for (int j = 0; j < 4; ++j) {
            const int e0 = 8 * (64 * j + lane);
            const v4u a = *(const GAS v4u*)(OD + (size_t)m * D + e0), b = *(const GAS v4u*)(OD + (size_t)M * D + (size_t)m * D + e0);
            const v4u g = *(const GAS v4u*)(P + (size_t)m * HGRN_N + 4 * D + e0);
            float s[8] = {bflo(a.x) + bflo(b.x), bfhi(a.x) + bfhi(b.x), bflo(a.y) + bflo(b.y), bfhi(a.y) + bfhi(b.y), bflo(a.z) + bflo(b.z), bfhi(a.z) + bfhi(b.z), bflo(a.w) + bflo(b.w), bfhi(a.w) + bfhi(b.w)};
            const float gv[8] = {bflo(g.x), bfhi(g.x), bflo(g.y), bfhi(g.y), bflo(g.z), bfhi(g.z), bflo(g.w), bfhi(g.w)};
            float ss = 0.f;
#pragma unroll
            for (int i = 0; i < 8; ++i) ss += s[i] * s[i];
            ss += __shfl_xor(ss, 1); ss += __shfl_xor(ss, 2); ss += __shfl_xor(ss, 4); ss += __shfl_xor(ss, 8);
            const float r = 1.0f / sqrtf(ss * (1.0f / HD) + EPS);
            const GAS f32x4* wp = (const GAS f32x4*)(gnorm + (e0 & 127)); const f32x4 wa = wp[0], wb = wp[1];
            const float wv[8] = {wa.x, wa.y, wa.z, wa.w, wb.x, wb.y, wb.z, wb.w};
            float o[8];
#pragma unroll
            for (int i = 0; i < 8; ++i) o[i] = s[i] * r * wv[i] * (gv[i] * sigmoid_f(gv[i]));
            v4u w; w.x = pk2(o[0], o[1]); w.y = pk2(o[2], o[3]); w.z = pk2(o[4], o[5]); w.w = pk2(o[6], o[7]);
            *(GAS v4u*)(O + (size_t)m * D + e0) = w;
        }
    }
}

__device__ __forceinline__ void rope_pair(float& x0, float& x1, const float* cosT, const float* sinT, int pos, int lane) {
    const float p0 = __shfl_xor(x0, 8), p1 = __shfl_xor(x1, 8);
    if (lane < 16) {
        const int dd = 2 * (lane & 7);
        const float c0 = cosT[pos * 16 + dd], c1 = cosT[pos * 16 + dd + 1], s0 = sinT[pos * 16 + dd], s1 = sinT[pos * 16 + dd + 1];
        if (lane < 8) { x0 = x0 * c0 - p0 * s0; x1 = x1 * c1 - p1 * s1; }
        else          { x0 = x0 * c0 + p0 * s0; x1 = x1 * c1 + p1 * s1; }
    }
}
__device__ __forceinline__ void attn_core_simple(const bf16* P, const float* cosT, const float* sinT, bf16* OG, float* LSE, int gw, int NGW, int lane) {
    const float scale = 0.08838834764831845f;
    for (int task = gw; task < M * NH * 3; task += NGW) {
        const int g = task % 3, rh = task / 3, hh = rh & 15, row = rh >> 4, b = row >> 12, t = row & (SEQ - 1);
        const int r = (g == 0) ? 1 : (g == 1 ? 4 : 16);
        const unsigned qq = ((const GAS unsigned*)(P + (size_t)row * ATTN_N + ((g * 3 + 0) * NH + hh) * HD))[lane];
        float q0 = bflo(qq), q1 = bfhi(qq);
        rope_pair(q0, q1, cosT, sinT, t, lane);
        float mx = -1e30f, l = 0.f, o0 = 0.f, o1 = 0.f;
        for (int j = -64; j <= 64; ++j) {
            const int tk = t + r * j;
            if (tk < 0 || tk >= SEQ) continue;
            const bf16* krow = P + (size_t)(b * SEQ + tk) * ATTN_N + ((g * 3 + 1) * NH + hh) * HD;
            const unsigned kk = ((const GAS unsigned*)krow)[lane]; const unsigned vv = ((const GAS unsigned*)(krow + NH * HD))[lane];
            float k0 = bflo(kk), k1 = bfhi(kk);
            rope_pair(k0, k1, cosT, sinT, tk, lane);
            const float s = wave_sum(q0 * k0 + q1 * k1) * scale;
            const float mn = fmaxf(mx, s), c = __expf(mx - mn), p = __expf(s - mn);
            l = l * c + p; o0 = o0 * c + p * bflo(vv); o1 = o1 * c + p * bfhi(vv); mx = mn;
        }
        const float il = 1.0f / l;
        ((GAS unsigned*)(OG + ((size_t)g * M + row) * D + hh * HD))[lane] = pk2(o0 * il, o1 * il);
        if (lane == 0) LSE[((size_t)g * M + row) * NH + hh] = mx + __logf(l);
    }
}
__device__ __forceinline__ void attn_finalize(const bf16* OG, const float* LSE, bf16* O, int gw, int NGW, int lane) {
    for (int m = gw; m < M; m += NGW) {
#pragma unroll
        for (int j = 0; j < 4; ++j) {
            const int e0 = 8 * (64 * j + lane), hh = e0 >> 7;
            const float l0 = LSE[((size_t)0 * M + m) * NH + hh], l1 = LSE[((size_t)1 * M + m) * NH + hh], l2 = LSE[((size_t)2 * M + m) * NH + hh];
            const float mx = fmaxf(l0, fmaxf(l1, l2)); float w0 = __expf(l0 - mx), w1 = __expf(l1 - mx), w2 = __expf(l2 - mx);
            const float inv = 1.0f / (w0 + w1 + w2); w0 *= inv; w1 *= inv; w2 *= inv;
            const v4u a = *(const GAS v4u*)(OG + ((size_t)0 * M + m) * D + e0), b = *(const GAS v4u*)(OG + ((size_t)1 * M + m) * D + e0), c = *(const GAS v4u*)(OG + ((size_t)2 * M + m) * D + e0);
            v4u w;
            w.x = pk2(w0 * bflo(a.x) + w1 * bflo(b.x) + w2 * bflo(c.x), w0 * bfhi(a.x) + w1 * bfhi(b.x) + w2 * bfhi(c.x));
            w.y = pk2(w0 * bflo(a.y) + w1 * bflo(b.y) + w2 * bflo(c.y), w0 * bfhi(a.y) + w1 * bfhi(b.y) + w2 * bfhi(c.y));
            w.z = pk2(w0 * bflo(a.z) + w1 * bflo(b.z) + w2 * bflo(c.z), w0 * bfhi(a.z) + w1 * bfhi(b.z) + w2 * bfhi(c.z));
            w.w = pk2(w0 * bflo(a.w) + w1 * bflo(b.w) + w2 * bflo(c.w), w0 * bfhi(a.w) + w1 * bfhi(b.w) + w2 * bfhi(c.w));
            *(GAS v4u*)(O + (size_t)m * D + e0) = w;
        }
    }
}

struct Args { const float* in[9]; float* out; unsigned char* ws; int ph_lo, ph_hi; };
__global__ void __launch_bounds__(NTHREADS, 2) fwd(Args args) {
    extern __shared__ __attribute__((aligned(16))) unsigned char lds_raw[];
    LAS unsigned char* lds = (LAS unsigned char*)lds_raw;
    volatile LAS unsigned* MISC = (volatile LAS unsigned*)(lds + MISC_OFF);
    const int G = gridDim.x; const int bx = blockIdx.x;
    const int vcu = (G % 8 == 0) ? (bx % 8) * (G / 8) + bx / 8 : bx;
    const int NGW = G * NWAVES;
    unsigned char* ws = args.ws;
    const float* x_in = args.in[0]; const float* norm_w = args.in[1]; const float* w_in_hgrn = args.in[2]; const float* lbnd = args.in[3]; const float* gnorm = args.in[4];
    const float* w_in_attn = args.in[5]; const float* w_out = args.in[6]; const float* w_ffn_in = args.in[7]; const float* w_ffn_out = args.in[8];
    float* xres = args.out;
    float* cosT = (float*)(ws + WS_TAB + TAB_COS); float* sinT = (float*)(ws + WS_TAB + TAB_SIN); float* lbT = (float*)(ws + WS_TAB + TAB_LB);
    bf16* WHG = (bf16*)(ws + WS_WHG); bf16* WAT = (bf16*)(ws + WS_WAT); bf16* WO = (bf16*)(ws + WS_WO); bf16* WF1 = (bf16*)(ws + WS_WF1); bf16* WF2 = (bf16*)(ws + WS_WF2);
    bf16* H = (bf16*)(ws + WS_H); bf16* PROJ = (bf16*)(ws + WS_PROJ); bf16* MIX = (bf16*)(ws + WS_MIX); bf16* OB = (bf16*)(ws + WS_O); bf16* GB = (bf16*)(ws + WS_G);
    float* LSE = (float*)(ws + WS_MIX + 96 * MiB);

    for (int u = threadIdx.x; u < (LDS_BYTES - LDSCTL_OFF) / 4; u += NTHREADS) ((LAS unsigned*)(lds + LDSCTL_OFF))[u] = 0u;
    __syncthreads();
    const int lo = args.ph_lo, hi = args.ph_hi;
    const bool use_bar = (hi - lo) > 1;
    XcdBarrier bar; bar.bar = (unsigned*)(ws + WS_CTL) + CW_BAR; bar.x = 0; bar.st = nullptr;
    if (use_bar) bar = xcd_barrier_post((unsigned*)(ws + WS_CTL) + CW_BAR, MISC + 8);
#define IN(k) (lo <= (k) && (k) < hi)
#define PH_IDS int tid_p = threadIdx.x; asm volatile("" : "+v"(tid_p)); const int lane_p = tid_p & 63; const int wave_p = __builtin_amdgcn_readfirstlane(tid_p >> 6); const int gw_p = vcu * NWAVES + wave_p; (void)lane_p; (void)gw_p;
#define SEAM(k) do { if (IN(k) && IN((k) + 1)) xcd_barrier(bar); } while (0)

    if (IN(0)) {
        PH_IDS
        const int lane = lane_p, gw = gw_p, tid = tid_p;
        LAS float* scr = (LAS float*)(lds + wave_p * 16384);
        for (int s = 0; s < 2; ++s) transpose_matrix(w_in_hgrn + (size_t)s * D * HGRN_N, D, HGRN_N, WHG + (size_t)s * HGRN_N * D, 0, scr, gw, NGW, lane);
        for (int s = 0; s < 2; ++s) transpose_matrix(w_in_attn + (size_t)s * D * ATTN_N, D, ATTN_N, WAT + (size_t)s * ATTN_N * D, 0, scr, gw, NGW, lane);
        for (int s = 0; s < 4; ++s) transpose_matrix(w_out + (size_t)s * D * D, D, D, WO + (size_t)s * D * D, 0, scr, gw, NGW, lane);
        for (int s = 0; s < 4; ++s) transpose_matrix(w_ffn_in + (size_t)s * D * FFN_N, D, FFN_N, WF1 + (size_t)s * FFN_N * D, 1, scr, gw, NGW, lane);
        for (int s = 0; s < 4; ++s) transpose_matrix(w_ffn_out + (size_t)s * DFF * D, DFF, D, WF2 + (size_t)s * D * DFF, 0, scr, gw, NGW, lane);
        const int gt = vcu * NTHREADS + tid, NGT = G * NTHREADS;
        for (int idx = gt; idx < SEQ * 16; idx += NGT) { const int pos = idx >> 4, i = idx & 15;
            const float inv = powf(500000.0f, -(float)(2 * i) / 32.0f); const float ang = (float)pos * inv; cosT[idx] = cosf(ang); sinT[idx] = sinf(ang); }
        for (int idx = gt; idx < 2 * D; idx += NGT) { const int dir = idx >> 11, c = idx & (D - 1);
            float xl[4]; float mx = -3.0e38f;
#pragma unroll
            for (int l = 0; l < 4; ++l) { xl[l] = lbnd[(size_t)(dir * 4 + l) * D + c]; mx = fmaxf(mx, xl[l]); }
            float sum = 0.f;
#pragma unroll
            for (int l = 0; l < 4; ++l) { xl[l] = expf(xl[l] - mx); sum += xl[l]; }
            float cum = 0.f, c0 = 0.f;
#pragma unroll
            for (int l = 0; l < 4; ++l) { cum += xl[l] / sum; if (l == 0) c0 = cum; lbT[(size_t)(dir * 4 + l) * D + c] = cum - c0; } }
        norm_rows<false, true>(nullptr, x_in, nullptr, nullptr, norm_w, H, gw, NGW, lane);
    }
    SEAM(0);

    for (int L = 0; L < DEPTH; ++L) {
        const int pb = 1 + 8 * L; const bool hg = (L & 1) == 0; const int slot = L >> 1;
        const float* nw = norm_w + (size_t)L * 4 * D;
        const int NPROJ = hg ? HGRN_N : ATTN_N;
        if (IN(pb)) {
            pg8::Gemm g{H, hg ? WHG + (size_t)slot * HGRN_N * D : WAT + (size_t)slot * ATTN_N * D, M, NPROJ, D}; pg8::StaticOrder S; S.init(M, NPROJ, G, bx);
            pg8::EpiBf16<0> E{PROJ, NPROJ, nullptr, 0, 0, 1.f};
            pg8::gemm_phase<pg8::EpiBf16<0>, pg8::StaticOrder, true, true>(lds, g, S, E);
        }
        SEAM(pb);
        if (IN(pb + 1)) {
            PH_IDS
            const int lane = lane_p, gw = gw_p, tid = tid_p;
            if (hg) hgrn_core_simple(lds, PROJ, lbT + (size_t)L * D, MIX, tid);
            else attn_core_simple(PROJ, cosT, sinT, MIX, LSE, gw, NGW, lane);
        }
        SEAM(pb + 1);
        if (IN(pb + 2)) {
            PH_IDS
            const int lane = lane_p, gw = gw_p;
            if (hg) hgrn_finalize(PROJ, MIX, gnorm + (size_t)slot * HD, OB, gw, NGW, lane);
            else attn_finalize(MIX, LSE, OB, gw, NGW, lane);
        }
        SEAM(pb + 2);
        if (IN(pb + 3)) {
            pg8::Gemm g{OB, WO + (size_t)L * D * D, M, D, D}; pg8::StaticOrder S; S.init(M, D, G, bx);
            pg8::EpiBf16<0> E{GB, D, nullptr, 0, 0, 1.f};
            pg8::gemm_phase<pg8::EpiBf16<0>, pg8::StaticOrder, true, true>(lds, g, S, E);
        }
        SEAM(pb + 3);
        if (IN(pb + 4)) { PH_IDS norm_rows<true, true>(GB, L == 0 ? x_in : xres, xres, nw + D, nw + 2 * D, H, gw_p, NGW, lane_p); }
        SEAM(pb + 4);
        if (IN(pb + 5)) {
            pg8::Gemm g{H, WF1 + (size_t)L * FFN_N * D, M, FFN_N, D}; pg8::StaticOrder S; S.init(M, FFN_N, G, bx);
            pg8::EpiSwiGLU E{PROJ, DFF};
            pg8::gemm_phase<pg8::EpiSwiGLU, pg8::StaticOrder, true, true>(lds, g, S, E);
        }
        SEAM(pb + 5);
        if (IN(pb + 6)) {
            pg8::Gemm g{PROJ, WF2 + (size_t)L * D * DFF, M, D, DFF}; pg8::StaticOrder S; S.init(M, D, G, bx);
            pg8::EpiBf16<0> E{GB, D, nullptr, 0, 0, 1.f};
            pg8::gemm_phase<pg8::EpiBf16<0>, pg8::StaticOrder, true, true>(lds, g, S, E);
        }
        SEAM(pb + 6);
        if (IN(pb + 7)) {
            PH_IDS
            const int lane = lane_p, gw = gw_p;
            if (L + 1 < DEPTH) norm_rows<true, true>(GB, xres, xres, nw + 3 * D, nw + 4 * D, H, gw, NGW, lane);
            else norm_rows<true, false>(GB, xres, xres, nw + 3 * D, nullptr, nullptr, gw, NGW, lane);
        }
        SEAM(pb + 7);
    }
#undef IN
#undef SEAM
}

#ifndef MK_PER_PHASE
#define MK_PER_PHASE 0
#endif
extern "C" void kernel_launch(void* const* d_in, const int* in_sizes, int n_in, void* d_out, int out_size, void* d_ws, size_t ws_size, hipStream_t stream) {
    static int grid = 0;
    if (grid == 0) {
        if (n_in != 9 || in_sizes[0] != M * D || out_size != M * D || ws_size < WS_END) { fprintf(stderr, "kernel_launch: unexpected shapes (n_in %d, in0 %d, out %d, ws %zu); nothing launched\n", n_in, n_in > 0 ? in_sizes[0] : -1, out_size, ws_size); grid = -1; return; }
        int dev = 0, cus = 0, per_cu = 0;
        if (hipGetDevice(&dev) != hipSuccess || hipDeviceGetAttribute(&cus, hipDeviceAttributeMultiprocessorCount, dev) != hipSuccess) { grid = -1; return; }
        if (hipFuncSetAttribute((const void*)fwd, hipFuncAttributeMaxDynamicSharedMemorySize, LDS_BYTES) != hipSuccess) { fprintf(stderr, "kernel_launch: hipFuncSetAttribute failed\n"); grid = -1; return; }
        if (hipOccupancyMaxActiveBlocksPerMultiprocessor(&per_cu, (const void*)fwd, NTHREADS, LDS_BYTES) != hipSuccess || per_cu < 1) fprintf(stderr, "kernel_launch: occupancy query reports %d\n", per_cu);
        (void)hipGetLastError();
        grid = cus;
    }
    if (grid < 0) return;
    if (hipMemsetAsync((char*)d_ws + WS_CTL, 0, CTL_ZERO_BYTES, stream) != hipSuccess) return;
    Args a{};
    for (int i = 0; i < 9; ++i) a.in[i] = (const float*)d_in[i];
    a.out = (float*)d_out; a.ws = (unsigned char*)d_ws;
#if MK_PER_PHASE
    for (int p = 0; p < NPHASES; ++p) { a.ph_lo = p; a.ph_hi = p + 1; hipLaunchKernelGGL(fwd, dim3(grid), dim3(NTHREADS), LDS_BYTES, stream, a); }
#else
    a.ph_lo = 0; a.ph_hi = NPHASES; hipLaunchKernelGGL(fwd, dim3(grid), dim3(NTHREADS), LDS_BYTES, stream, a);
#endif
}
```

```cpp
#include <hip/hip_runtime.h>
#include <cstdio>
#include <cstdint>
namespace pg8 {
#define PG8_LAS __attribute__((address_space(3)))
typedef unsigned short bf16_t;
typedef short bf16x8 __attribute__((ext_vector_type(8)));
typedef float f32x4 __attribute__((ext_vector_type(4)));
typedef unsigned u32x4 __attribute__((ext_vector_type(4)));
constexpr int BM = 256, BK = 64, HALF = 128, HTB = HALF * BK * 2  , STAGE_BYTES = 8 * HTB, NXCD = 8, WGM = 8;

__host__ __device__ __forceinline__ int lds_byte(int r, int c) { const int st = (r >> 4) * 2 + (c >> 5), rr = r & 15, cc = c & 31, ob = rr * 64 + cc * 2; return st * 1024 + (ob ^ (((ob >> 9) & 1) << 5)); }
__host__ __device__ __forceinline__ void stage_rc(int b, int& R, int& C) { const int st = b / 1024, sb = b % 1024, swz = sb ^ (((sb >> 9) & 1) << 5); R = (st >> 1) * 16 + swz / 64; C = (st & 1) * 32 + (swz % 64) / 2; }
__host__ __device__ __forceinline__ int perm32(int rho) { const int n = rho >> 4, i = rho & 15; return 8 * (i >> 2) + 4 * n + (i & 3); }

struct Unit { int pm, pn; };
struct Gemm { const bf16_t* A; const bf16_t* Bt; int M, N, K; };

struct StaticOrder {
    int nM, nN, nwg, G, c;
    __host__ __device__ void init(int M, int N, int G_, int c_) { nM = M / BM; nN = N / BM; nwg = nM * nN; G = G_; c = c_; }
    __host__ __device__ bool next(int i, Unit& u) const {
        const long L = (long)i * G + c; if (L >= nwg) return false;
        int wgid = (int)L; { const int q = nwg / NXCD, r = nwg % NXCD, xcd = wgid % NXCD, off = wgid / NXCD; wgid = (xcd < r ? xcd * (q + 1) : r * (q + 1) + (xcd - r) * q) + off; }
        const int nig = WGM * nN, gid = wgid / nig, fm = gid * WGM, gsz = (nM - fm) < WGM ? (nM - fm) : WGM;
        u.pm = fm + ((wgid % nig) % gsz); u.pn = (wgid % nig) / gsz; return true;
    }
    __device__ __forceinline__ void a_ready(const Unit&) const {}
    __device__ __forceinline__ void done(const Unit&) const {}
};

__device__ __forceinline__ unsigned cvt_pk_bf16(float lo, float hi) { unsigned r; asm volatile("v_cvt_pk_bf16_f32 %0, %1, %2" : "=v"(r) : "v"(lo), "v"(hi)); return r; }
typedef float f32x2 __attribute__((ext_vector_type(2)));
__device__ __forceinline__ f32x2 gelu_pk(f32x2 v) {
    const f32x2 av = __builtin_elementwise_abs(v), d = av * 0.2316418882f + 1.0f;
    f32x2 t; t.x = __builtin_amdgcn_rcpf(d.x); t.y = __builtin_amdgcn_rcpf(d.y);
    f32x2 q = t * 0.5307027145f + (-0.7265760135f); q = q * t + 0.7107068705f; q = q * t + (-0.142248368f); q = q * t + 0.127414796f; q = q * t;
    const f32x2 s = (v * v) * (-0.72134752044f);
    f32x2 e; e.x = __builtin_amdgcn_exp2f(s.x); e.y = __builtin_amdgcn_exp2f(s.y);
    const f32x2 m = v * (q * e), r = v - m;
    f32x2 o; o.x = v.x < 0.f ? m.x : r.x; o.y = v.y < 0.f ? m.y : r.y; return o;
}

template <int ACT  > struct EpiBf16 {
    static constexpr bool PERM = true, AFTER_DRAIN = false; static_assert(ACT == 0 || ACT == 1, "EpiBf16: ACT is 0 (none) or 1 (gelu_pk)");
    bf16_t* O; int ldc; const float* bias; int split_cols; size_t split_stride; float scale0;
    __device__ __forceinline__ void operator()(const f32x4 (&acc)[2][2][4][2], const Unit& u, int wr, int wc, int fr, int fq) const {
        const int row0 = u.pm * BM + wr * 64 + fr; int colt = u.pn * BM; bf16_t* base = O;
        float sc = 1.f; if (split_cols) { const int t = colt / split_cols; base += (size_t)t * split_stride; colt -= t * split_cols; if (t == 0) sc = scale0; }
        const int col0 = colt + wc * 32 + 8 * fq, bcol0 = u.pn * BM + wc * 32 + 8 * fq;
        f32x4 bv[2][2];
#pragma unroll
        for (int bj = 0; bj < 2; ++bj)
#pragma unroll
            for (int n = 0; n < 2; ++n) bv[bj][n] = bias ? *(const f32x4*)(bias + bcol0 + bj * HALF + 4 * n) : (f32x4){0.f, 0.f, 0.f, 0.f};
#pragma unroll
        for (int ai = 0; ai < 2; ++ai)
#pragma unroll
            for (int m = 0; m < 4; ++m) { bf16_t* rowp = base + (size_t)(row0 + ai * HALF + m * 16) * ldc + col0;
#pragma unroll
                for (int bj = 0; bj < 2; ++bj) { f32x4 v0 = acc[ai][bj][m][0] + bv[bj][0], v1 = acc[ai][bj][m][1] + bv[bj][1];
                    if (ACT == 1) { f32x2 a = gelu_pk((f32x2){v0[0], v0[1]}), b = gelu_pk((f32x2){v0[2], v0[3]}), c = gelu_pk((f32x2){v1[0], v1[1]}), d = gelu_pk((f32x2){v1[2], v1[3]});
                        v0 = (f32x4){a.x, a.y, b.x, b.y}; v1 = (f32x4){c.x, c.y, d.x, d.y}; }
                    v0 = v0 * sc; v1 = v1 * sc; u32x4 w; w.x = cvt_pk_bf16(v0[0], v0[1]); w.y = cvt_pk_bf16(v0[2], v0[3]); w.z = cvt_pk_bf16(v1[0], v1[1]); w.w = cvt_pk_bf16(v1[2], v1[3]);
                    *(u32x4*)(rowp + bj * HALF) = w; } }
    }
};

template <class Epi, class Sched, bool ALIGN_EPI = false, bool SP2 = false>
__device__ __forceinline__ void gemm_phase(PG8_LAS unsigned char* lds, const Gemm g, const Sched& S, const Epi& E) {
    int tid_l = threadIdx.x; asm volatile("" : "+v"(tid_l));
    const int tid = tid_l, wid = __builtin_amdgcn_readfirstlane(tid >> 6), lane = tid & 63, wr = wid >> 2, wc = wid & 3, fr = lane & 15, fq = lane >> 4;
    const int K = g.K, nt = K / BK;
    unsigned voffA[2], voffB[2];
#pragma unroll
    for (int i = 0; i < 2; ++i) { int R, C; stage_rc(tid * 16 + i * 8192, R, C); const int Rb = Epi::PERM ? ((R & ~31) + perm32(R & 31)) : R;
        voffA[i] = (unsigned)(R * K + C) * 2u; voffB[i] = (unsigned)(Rb * K + C) * 2u; }
    const size_t kstep = (size_t)(BK * 2);
    const size_t hstep = (size_t)HALF * K * 2;
    const size_t tstep = 2 * hstep;
    const unsigned ldsw = (unsigned)wid * 1024u;
    const int aoff = lds_byte(wr * 64 + fr, fq * 8), boff = lds_byte(wc * 32 + fr, fq * 8);
#define PG8_SA(b, h) (((b) * 2 + (h)) * HTB)
#define PG8_SB(b, h) ((4 + (b) * 2 + (h)) * HTB)
#define PG8_STAGE(bufoff, gbase, voff) do { _Pragma("unroll") for (int _i = 0; _i < 2; ++_i) \
        __builtin_amdgcn_global_load_lds((const unsigned*)((const char*)(gbase) + (voff)[_i]), (PG8_LAS unsigned*)(lds + (bufoff) + ldsw + _i * 8192), 16, 0, 0); } while (0)
#define PG8_LDA(dst, b, h) do { _Pragma("unroll") for (int m = 0; m < 4; ++m) _Pragma("unroll") for (int k = 0; k < 2; ++k) dst[m][k] = *(const PG8_LAS bf16x8*)(lds + PG8_SA(b, h) + aoff + m * 2048 + k * 1024); } while (0)
#define PG8_LDB(dst, b, h) do { _Pragma("unroll") for (int n = 0; n < 2; ++n) _Pragma("unroll") for (int k = 0; k < 2; ++k) dst[n][k] = *(const PG8_LAS bf16x8*)(lds + PG8_SB(b, h) + boff + n * 2048 + k * 1024); } while (0)
#define PG8_MMA(ai, bj, At, Bt) do { __builtin_amdgcn_s_setprio(1); _Pragma("unroll") for (int m = 0; m < 4; ++m) _Pragma("unroll") for (int n = 0; n < 2; ++n) _Pragma("unroll") for (int k = 0; k < 2; ++k) \
        acc[ai][bj][m][n] = __builtin_amdgcn_mfma_f32_16x16x32_bf16(Bt[n][k], At[m][k], acc[ai][bj][m][n], 0, 0, 0); __builtin_amdgcn_s_setprio(0); } while (0)
#define PG8_WAIT_V(n) asm volatile("s_waitcnt vmcnt(" #n ")" ::: "memory")
#define PG8_WAIT_L(n) asm volatile("s_waitcnt lgkmcnt(" #n ")" ::: "memory")
#define PG8_BAR __builtin_amdgcn_s_barrier()
#define PG8_SCHED __builtin_amdgcn_sched_barrier(0)
    Unit cur, nxt; int ui = 0;
    if (!S.next(0, cur)) return;
    f32x4 acc[2][2][4][2];
#pragma unroll
    for (int a = 0; a < 2; ++a)
#pragma unroll
        for (int b = 0; b < 2; ++b)
#pragma unroll
            for (int m = 0; m < 4; ++m)
#pragma unroll
                for (int n = 0; n < 2; ++n) acc[a][b][m][n] = (f32x4){0.f, 0.f, 0.f, 0.f};
    bf16x8 At[4][2], B0[2][2], B1[2][2];
    const char* cA = (const char*)g.A + (size_t)cur.pm * tstep; const char* cB = (const char*)g.Bt + (size_t)cur.pn * tstep;
    S.a_ready(cur);
    if constexpr (SP2) {
        PG8_STAGE(PG8_SB(0, 0), cB, voffB); PG8_STAGE(PG8_SB(0, 1), cB + hstep, voffB); PG8_STAGE(PG8_SA(0, 0), cA, voffA); PG8_STAGE(PG8_SA(0, 1), cA + hstep, voffA);
        if (wr == 1) PG8_BAR;
        PG8_WAIT_V(2); PG8_BAR;
        PG8_STAGE(PG8_SB(1, 0), cB + kstep, voffB); PG8_STAGE(PG8_SA(1, 0), cA + kstep, voffA); PG8_STAGE(PG8_SB(1, 1), cB + hstep + kstep, voffB);
        PG8_WAIT_V(6); PG8_BAR;
    } else {
        PG8_STAGE(PG8_SB(0, 0), cB, voffB); PG8_STAGE(PG8_SA(0, 0), cA, voffA); PG8_STAGE(PG8_SB(0, 1), cB + hstep, voffB); PG8_STAGE(PG8_SA(0, 1), cA + hstep, voffA);
        if (wr == 1) PG8_BAR;
        PG8_WAIT_V(4); PG8_BAR;
        PG8_STAGE(PG8_SB(1, 0), cB + kstep, voffB); PG8_STAGE(PG8_SA(1, 0), cA + kstep, voffA); PG8_STAGE(PG8_SB(1, 1), cB + hstep + kstep, voffB);
        PG8_WAIT_V(6); PG8_BAR;
    }
    for (;;) {
        const bool has_next = S.next(ui + 1, nxt);
        const char* nA = has_next ? (const char*)g.A + (size_t)nxt.pm * tstep : cA; const char* nB = has_next ? (const char*)g.Bt + (size_t)nxt.pn * tstep : cB;
        for (int t = 0; t < nt; t += 2) {
            const bool last = (t == nt - 2);
            const char* a1 = cA + (size_t)(t + 1) * kstep;
            const char* a2 = last ? nA : cA + (size_t)(t + 2) * kstep; const char* b2 = last ? nB : cB + (size_t)(t + 2) * kstep;
            const char* a3 = a2 + kstep; const char* b3 = b2 + kstep;
            if (last && has_next) S.a_ready(nxt);
            if constexpr (SP2) {
            PG8_LDB(B0, 0, 0); PG8_LDB(B1, 0, 1); PG8_SCHED; PG8_LDA(At, 0, 0); PG8_STAGE(PG8_SA(1, 1), a1 + hstep, voffA);
            PG8_WAIT_V(8); PG8_WAIT_L(0); PG8_BAR; PG8_MMA(0, 0, At, B0); PG8_MMA(0, 1, At, B1); PG8_BAR; PG8_SCHED;
            PG8_LDA(At, 0, 1); PG8_STAGE(PG8_SB(0, 0), b2, voffB); PG8_STAGE(PG8_SB(0, 1), b2 + hstep, voffB); PG8_STAGE(PG8_SA(0, 0), a2, voffA);
            PG8_WAIT_V(8); PG8_WAIT_L(0); PG8_BAR; PG8_MMA(1, 0, At, B0); PG8_MMA(1, 1, At, B1); PG8_BAR; PG8_SCHED;
            PG8_LDB(B0, 1, 0); PG8_LDB(B1, 1, 1); PG8_SCHED; PG8_LDA(At, 1, 0); PG8_STAGE(PG8_SA(0, 1), a2 + hstep, voffA);
            PG8_WAIT_V(8); PG8_WAIT_L(0); PG8_BAR; PG8_MMA(0, 0, At, B0); PG8_MMA(0, 1, At, B1); PG8_BAR; PG8_SCHED;
            PG8_LDA(At, 1, 1); PG8_STAGE(PG8_SB(1, 0), b3, voffB); PG8_STAGE(PG8_SB(1, 1), b3 + hstep, voffB); PG8_STAGE(PG8_SA(1, 0), a3, voffA);
            PG8_WAIT_V(8); PG8_WAIT_L(0); PG8_BAR; PG8_MMA(1, 0, At, B0); PG8_MMA(1, 1, At, B1); PG8_BAR; PG8_SCHED;
            } else {
            PG8_LDB(B0, 0, 0); PG8_SCHED; PG8_LDA(At, 0, 0); PG8_STAGE(PG8_SA(1, 1), a1 + hstep, voffA);
            PG8_WAIT_L(8); PG8_BAR; PG8_WAIT_L(0); PG8_MMA(0, 0, At, B0); PG8_BAR; PG8_SCHED;
            PG8_LDB(B1, 0, 1); PG8_STAGE(PG8_SB(0, 0), b2, voffB);
            PG8_BAR; PG8_WAIT_L(0); PG8_MMA(0, 1, At, B1); PG8_BAR;
            PG8_LDA(At, 0, 1); PG8_STAGE(PG8_SA(0, 0), a2, voffA);
            PG8_BAR; PG8_WAIT_L(0); PG8_MMA(1, 0, At, B0); PG8_BAR; PG8_SCHED;
            PG8_STAGE(PG8_SB(0, 1), b2 + hstep, voffB);
            PG8_WAIT_V(6); PG8_BAR; PG8_MMA(1, 1, At, B1); PG8_BAR;
            PG8_LDB(B0, 1, 0); PG8_SCHED; PG8_LDA(At, 1, 0); PG8_STAGE(PG8_SA(0, 1), a2 + hstep, voffA);
            PG8_WAIT_L(8); PG8_BAR; PG8_WAIT_L(0); PG8_MMA(0, 0, At, B0); PG8_BAR; PG8_SCHED;
            PG8_LDB(B1, 1, 1); PG8_STAGE(PG8_SB(1, 0), b3, voffB);
            PG8_BAR; PG8_WAIT_L(0); PG8_MMA(0, 1, At, B1); PG8_BAR;
            PG8_LDA(At, 1, 1); PG8_STAGE(PG8_SA(1, 0), a3, voffA);
            PG8_BAR; PG8_WAIT_L(0); PG8_MMA(1, 0, At, B0); PG8_BAR; PG8_SCHED;
            PG8_STAGE(PG8_SB(1, 1), b3 + hstep, voffB);
            PG8_WAIT_V(6); PG8_BAR; PG8_MMA(1, 1, At, B1); PG8_BAR;
            }
        }
        if constexpr (ALIGN_EPI) { if (wr == 0) PG8_BAR; }
        if constexpr (!Epi::AFTER_DRAIN) { E(acc, cur, wr, wc, fr, fq); S.done(cur); }
        if (!has_next) break;
#pragma unroll
        for (int a = 0; a < 2; ++a)
#pragma unroll
            for (int b = 0; b < 2; ++b)
#pragma unroll
                for (int m = 0; m < 4; ++m)
#pragma unroll
                    for (int n = 0; n < 2; ++n) acc[a][b][m][n] = (f32x4){0.f, 0.f, 0.f, 0.f};
        cur = nxt; cA = nA; cB = nB; ++ui;
        if constexpr (ALIGN_EPI) { if (wr == 1) PG8_BAR; }
    }
    PG8_WAIT_V(0);
    if constexpr (!ALIGN_EPI) { if (wr == 0) PG8_BAR; }
    PG8_BAR;
    if constexpr (Epi::AFTER_DRAIN) { E.fused(acc, cur, wr, wc, fr, fq, lds, wid, lane); S.done(cur); }
#undef PG8_SA
#undef PG8_SB
#undef PG8_STAGE
#undef PG8_LDA
#undef PG8_LDB
#undef PG8_MMA
#undef PG8_WAIT_V
#undef PG8_WAIT_L
#undef PG8_BAR
#undef PG8_SCHED
}
}
namespace pg8 {
__device__ __forceinline__ float silu_f(float x) { return x * __builtin_amdgcn_rcpf(1.0f + __builtin_amdgcn_exp2f(-1.44269504f * x)); }
struct EpiSwiGLU {
    static constexpr bool PERM = true, AFTER_DRAIN = false;
    bf16_t* O; int ldc;
    __device__ __forceinline__ void operator()(const f32x4 (&acc)[2][2][4][2], const Unit& u, int wr, int wc, int fr, int fq) const {
        const int row0 = u.pm * BM + wr * 64 + fr; const int col0 = u.pn * HALF + wc * 32 + 8 * fq;
#pragma unroll
        for (int ai = 0; ai < 2; ++ai)
#pragma unroll
            for (int m = 0; m < 4; ++m) { bf16_t* rowp = O + (size_t)(row0 + ai * HALF + m * 16) * ldc + col0;
                const f32x4 g0 = acc[ai][0][m][0], g1 = acc[ai][0][m][1], u0 = acc[ai][1][m][0], u1 = acc[ai][1][m][1];
                u32x4 w; w.x = cvt_pk_bf16(silu_f(g0[0]) * u0[0], silu_f(g0[1]) * u0[1]); w.y = cvt_pk_bf16(silu_f(g0[2]) * u0[2], silu_f(g0[3]) * u0[3]);
                w.z = cvt_pk_bf16(silu_f(g1[0]) * u1[0], silu_f(g1[1]) * u1[1]); w.w = cvt_pk_bf16(silu_f(g1[2]) * u1[2], silu_f(g1[3]) * u1[3]);
                *(u32x4*)rowp = w; }
    }
};
}
namespace pg8 {
struct EpiRope {
    static constexpr bool PERM = true, AFTER_DRAIN = false;
    bf16_t* O; int ldc; const float* cosT; const float* sinT;
    __device__ __forceinline__ void operator()(const f32x4 (&acc)[2][2][4][2], const Unit& u, int wr, int wc, int fr, int fq) const {
        const int row0 = u.pm * BM + wr * 64 + fr; const int colt = u.pn * BM; const int col0 = colt + wc * 32 + 8 * fq;
        const bool rot = (((colt >> 11) % 3) < 2) && (wc == 0);
        const int dd0 = 8 * (fq & 1); const float sgn = (fq < 2) ? -1.0f : 1.0f;
#pragma unroll
        for (int ai = 0; ai < 2; ++ai)
#pragma unroll
            for (int m = 0; m < 4; ++m) { const int row = row0 + ai * HALF + m * 16; bf16_t* rowp = O + (size_t)row * ldc + col0;
                f32x4 c0 = (f32x4){1.f, 1.f, 1.f, 1.f}, c1 = c0, s0 = (f32x4){0.f, 0.f, 0.f, 0.f}, s1 = s0;
                if (rot) { const int pos = row & 4095; const f32x4* cp = (const f32x4*)(cosT + pos * 16 + dd0); const f32x4* sp = (const f32x4*)(sinT + pos * 16 + dd0);
                    c0 = cp[0]; c1 = cp[1]; s0 = sp[0] * sgn; s1 = sp[1] * sgn; }
#pragma unroll
                for (int bj = 0; bj < 2; ++bj) { f32x4 v0 = acc[ai][bj][m][0], v1 = acc[ai][bj][m][1];
                    if (rot) { f32x4 p0, p1;
#pragma unroll
                        for (int i = 0; i < 4; ++i) { p0[i] = __shfl_xor(v0[i], 32); p1[i] = __shfl_xor(v1[i], 32); }
                        v0 = v0 * c0 + p0 * s0; v1 = v1 * c1 + p1 * s1; }
                    u32x4 w; w.x = cvt_pk_bf16(v0[0], v0[1]); w.y = cvt_pk_bf16(v0[2], v0[3]); w.z = cvt_pk_bf16(v1[0], v1[1]); w.w = cvt_pk_bf16(v1[2], v1[3]);
                    *(u32x4*)(rowp + bj * HALF) = w; } }
    }
};
}
#define GAS __attribute__((address_space(1)))
#define LAS __attribute__((address_space(3)))
typedef unsigned short bf16;
typedef unsigned v4u __attribute__((ext_vector_type(4)));
typedef float f32x4 __attribute__((ext_vector_type(4)));
typedef short bf16x8 __attribute__((ext_vector_type(8)));
typedef GAS unsigned gu32;
typedef GAS unsigned long long gu64;
#define RLX_AGENT __ATOMIC_RELAXED, __HIP_MEMORY_SCOPE_AGENT
#define LDS_WAIT() asm volatile("s_waitcnt lgkmcnt(0)" ::: "memory")
#define VM_WAIT() asm volatile("s_waitcnt vmcnt(0)" ::: "memory")
__device__ __forceinline__ unsigned long long rt() { return __builtin_amdgcn_s_memrealtime(); }
__device__ __forceinline__ unsigned f2bf(float f) { unsigned u = __builtin_bit_cast(unsigned, f); return (u + 0x7fffu + ((u >> 16) & 1u)) >> 16; }
__device__ __forceinline__ unsigned pk2(float lo, float hi) { return f2bf(lo) | (f2bf(hi) << 16); }

#define XB_TMO      128
#define XB_XCNT(j)  (256  + 64 * (j))
#define XB_XSUB(j)  (1280 + 64 * (j))
#define XB_XGEN(j)  (2304 + 64 * (j))
#define XB_TOP      3328
#define XB_TOPGEN   3392
#define XCD_BAR_WORDS 3456
#define XB_SPIN_CAP (1u << 18)

__device__ __forceinline__ unsigned xb_ld(unsigned* p)              { return __hip_atomic_load(p, __ATOMIC_RELAXED, __HIP_MEMORY_SCOPE_AGENT); }
__device__ __forceinline__ unsigned xb_add(unsigned* p, unsigned v) { return __hip_atomic_fetch_add(p, v, __ATOMIC_RELAXED, __HIP_MEMORY_SCOPE_AGENT); }
__device__ __forceinline__ unsigned xb_xcc_id() { return (unsigned)__builtin_amdgcn_s_getreg((3 << 11) | 20) & 0xFu; }
#define XB_SPIN(cond, bar) do { unsigned _sp = 0; while (cond) { __builtin_amdgcn_s_sleep(1); \
    if ((++_sp & 255u) == 0u) { if (xb_ld(&(bar)[XB_TMO])) break; if (_sp > XB_SPIN_CAP) { atomicAdd(&(bar)[XB_TMO], 1u); break; } } } } while (0)

struct XcdBarrier {
    unsigned* bar; unsigned x;
    volatile LAS unsigned* st;
};

__device__ __forceinline__ XcdBarrier xcd_barrier_post(unsigned* bar, volatile LAS unsigned* st) {
    XcdBarrier b; b.bar = bar; b.x = xb_xcc_id(); b.st = st;
    if (threadIdx.x == 0) (void)xb_add(&bar[XB_XCNT(b.x)], 1u);
    return b;
}
__device__ __forceinline__ void xcd_barrier_complete(unsigned* bar, unsigned x, unsigned& nloc, unsigned& nx) {
    const unsigned G = gridDim.x * gridDim.y * gridDim.z;
    unsigned sum, cnt, mine, sp = 0u;
    for (;;) {
        sum = 0u; cnt = 0u; mine = 0u;
#pragma unroll
        for (unsigned j = 0; j < 16; ++j) { const unsigned c = xb_ld(&bar[XB_XCNT(j)]); sum += c; cnt += (c > 0u) ? 1u : 0u; mine = (j == x) ? c : mine; }
        if (sum == G) break;
        __builtin_amdgcn_s_sleep(1);
        if ((++sp & 255u) == 0u) { if (xb_ld(&bar[XB_TMO])) break; if (sp > XB_SPIN_CAP) { atomicAdd(&bar[XB_TMO], 1u); break; } }
    }
    nloc = mine > 0u ? mine : 1u; nx = cnt > 0u ? cnt : 1u;
}

__device__ __forceinline__ void xcd_barrier(const XcdBarrier& b) {
    asm volatile("s_waitcnt vmcnt(0)" ::: "memory");
    __syncthreads();
    if (threadIdx.x == 0) {
        unsigned* bar = b.bar;
        __builtin_amdgcn_s_waitcnt(0);
        unsigned nloc = b.st[0], nx = b.st[1];
        if (nloc == 0u) { xcd_barrier_complete(bar, b.x, nloc, nx); b.st[0] = nloc; b.st[1] = nx; }
        const unsigned old = xb_add(&bar[XB_XSUB(b.x)], 1u);
        const unsigned gen = old / nloc;
        if (old + 1u == (gen + 1u) * nloc) {
            __builtin_amdgcn_fence(__ATOMIC_RELEASE, "agent");
            asm volatile("s_waitcnt vmcnt(0)" ::: "memory");
            const unsigned og = xb_add(&bar[XB_TOP], 1u);
            const unsigned tg = og / nx;
            if (og + 1u == (tg + 1u) * nx) xb_add(&bar[XB_TOPGEN], 1u);
            else XB_SPIN(xb_ld(&bar[XB_TOPGEN]) == tg, bar);
            __builtin_amdgcn_fence(__ATOMIC_ACQUIRE, "agent");
            xb_add(&bar[XB_XGEN(b.x)], 1u);
            asm volatile("s_waitcnt vmcnt(0)" ::: "memory");
        } else {
            XB_SPIN(xb_ld(&bar[XB_XGEN(b.x)]) == gen, bar);
            __builtin_amdgcn_fence(__ATOMIC_ACQUIRE, "agent");
            asm volatile("s_waitcnt vmcnt(0)" ::: "memory");
        }
    }
    __syncthreads();
}

constexpr int NWAVES = 8, NTHREADS = 512;
constexpr int BATCH = 2, SEQ = 4096, D = 2048, M = BATCH * SEQ, DEPTH = 4, NH = 16, HD = 128;
constexpr int HGRN_N = 5 * D, ATTN_N = 9 * D, DFF = 5632, FFN_N = 2 * DFF;
constexpr float EPS = 1e-6f;
constexpr int NPHASES = 1 + 9 * DEPTH;

constexpr size_t MiB = 1u << 20;
constexpr size_t WS_CTL = 0, CTL_ZERO_BYTES = 1 * MiB;
constexpr size_t WS_TAB = 1 * MiB;
constexpr size_t TAB_COS = 0, TAB_SIN = 262144, TAB_LB = 524288;
constexpr size_t WS_WHG = 2 * MiB;
constexpr size_t WS_WAT = 82 * MiB;
constexpr size_t WS_WO = 226 * MiB;
constexpr size_t WS_WF1 = 258 * MiB;
constexpr size_t WS_WF2 = 434 * MiB;
constexpr size_t WS_H = 522 * MiB;
constexpr size_t WS_PROJ = 554 * MiB;
constexpr size_t WS_MIX = 842 * MiB;
constexpr size_t WS_O = 942 * MiB;
constexpr size_t WS_G = 974 * MiB;
constexpr size_t WS_KH = 1006 * MiB;
constexpr size_t WS_END = 1076 * MiB;
constexpr int CW_BAR = 4096;

constexpr int RING_BYTES = 131072;
constexpr int LDSCTL_OFF = RING_BYTES, MISC_OFF = LDSCTL_OFF + 320;
constexpr int LDS_BYTES = 147456;

__device__ __forceinline__ float bf2f(unsigned short b) { return __builtin_bit_cast(float, (unsigned)b << 16); }
__device__ __forceinline__ float bflo(unsigned w) { return __builtin_bit_cast(float, w << 16); }
__device__ __forceinline__ float bfhi(unsigned w) { return __builtin_bit_cast(float, w & 0xffff0000u); }
__device__ __forceinline__ float wave_sum(float v) {
#pragma unroll
    for (int o = 1; o < 64; o <<= 1) v += __shfl_xor(v, o);
    return v;
}
__device__ __forceinline__ float sigmoid_f(float x) { return __builtin_amdgcn_rcpf(1.0f + __builtin_amdgcn_exp2f(-1.44269504f * x)); }

__device__ __forceinline__ void transpose_item(const float* W, int K, int N, bf16* WT, int k0, int n0, int drow0, LAS float* scr, int lane) {
#pragma unroll 8
    for (int i = 0; i < 32; ++i) { const int kk = 2 * i + (lane >> 5); scr[kk * 33 + (lane & 31)] = W[(size_t)(k0 + kk) * N + n0 + (lane & 31)]; }
    LDS_WAIT(); asm volatile("" ::: "memory");
    const int c = lane & 7;
#pragma unroll
    for (int j = 0; j < 4; ++j) { const int n = (lane >> 3) + 8 * j; const LAS float* s = scr + (8 * c) * 33 + n;
        v4u o; o.x = pk2(s[0 * 33], s[1 * 33]); o.y = pk2(s[2 * 33], s[3 * 33]); o.z = pk2(s[4 * 33], s[5 * 33]); o.w = pk2(s[6 * 33], s[7 * 33]);
        *(GAS v4u*)(WT + (size_t)(drow0 + n) * K + k0 + 8 * c) = o; }
    LDS_WAIT(); asm volatile("" ::: "memory");
}
__device__ __forceinline__ void transpose_matrix(const float* W, int K, int N, bf16* WT, int mode, LAS float* scr, int gw, int NGW, int lane) {
    const int nblk = N / 32, nitems = (K / 64) * nblk;
    for (int it = gw; it < nitems; it += NGW) {
        const int kb = it / nblk, nb = it - kb * nblk, n0 = 32 * nb;
        int drow0 = n0;
        if (mode == 1) { const int up = n0 >= DFF, nn = up ? n0 - DFF : n0; drow0 = (nn >> 7) * 256 + (up ? 128 : 0) + (nn & 127); }
        transpose_item(W, K, N, WT, 64 * kb, n0, drow0, scr, lane);
    }
}

template <bool RES, bool NORM2>
__device__ __forceinline__ void norm_rows(const bf16* gin, const float* x_in, float* x_out, const float* w1, const float* w2, bf16* hout, int gw, int NGW, int lane) {
    for (int m = gw; m < M; m += NGW) {
        float xv[4][8];
#pragma unroll
        for (int j = 0; j < 4; ++j) { const GAS f32x4* xp = (const GAS f32x4*)(x_in + (size_t)m * D + 8 * (64 * j + lane));
            const f32x4 a = xp[0], b = xp[1]; xv[j][0] = a.x; xv[j][1] = a.y; xv[j][2] = a.z; xv[j][3] = a.w; xv[j][4] = b.x; xv[j][5] = b.y; xv[j][6] = b.z; xv[j][7] = b.w; }
        if (RES) {
            float gv[4][8]; float ss = 0.f;
#pragma unroll
            for (int j = 0; j < 4; ++j) { const v4u g = *(const GAS v4u*)(gin + (size_t)m * D + 8 * (64 * j + lane));
                gv[j][0] = bflo(g.x); gv[j][1] = bfhi(g.x); gv[j][2] = bflo(g.y); gv[j][3] = bfhi(g.y); gv[j][4] = bflo(g.z); gv[j][5] = bfhi(g.z); gv[j][6] = bflo(g.w); gv[j][7] = bfhi(g.w);
#pragma unroll
                for (int i = 0; i < 8; ++i) ss += gv[j][i] * gv[j][i]; }
            const float r1 = 1.0f / sqrtf(wave_sum(ss) * (1.0f / D) + EPS);
#pragma unroll
            for (int j = 0; j < 4; ++j) { const GAS f32x4* wp = (const GAS f32x4*)(w1 + 8 * (64 * j + lane)); const f32x4 a = wp[0], b = wp[1];
                const float wv[8] = {a.x, a.y, a.z, a.w, b.x, b.y, b.z, b.w};
#pragma unroll
                for (int i = 0; i < 8; ++i) xv[j][i] += gv[j][i] * r1 * wv[i];
                GAS f32x4* op = (GAS f32x4*)(x_out + (size_t)m * D + 8 * (64 * j + lane));
                op[0] = (f32x4){xv[j][0], xv[j][1], xv[j][2], xv[j][3]}; op[1] = (f32x4){xv[j][4], xv[j][5], xv[j][6], xv[j][7]}; }
        }
        if (NORM2) {
            float ss = 0.f;
#pragma unroll
            for (int j = 0; j < 4; ++j)
#pragma unroll
                for (int i = 0; i < 8; ++i) ss += xv[j][i] * xv[j][i];
            const float r2 = 1.0f / sqrtf(wave_sum(ss) * (1.0f / D) + EPS);
#pragma unroll
            for (int j = 0; j < 4; ++j) { const GAS f32x4* wp = (const GAS f32x4*)(w2 + 8 * (64 * j + lane)); const f32x4 a = wp[0], b = wp[1];
                v4u o; o.x = pk2(xv[j][0] * r2 * a.x, xv[j][1] * r2 * a.y); o.y = pk2(xv[j][2] * r2 * a.z, xv[j][3] * r2 * a.w);
                o.z = pk2(xv[j][4] * r2 * b.x, xv[j][5] * r2 * b.y); o.w = pk2(xv[j][6] * r2 * b.z, xv[j][7] * r2 * b.w);
                *(GAS v4u*)(hout + (size_t)m * D + 8 * (64 * j + lane)) = o; }
        }
    }
}

__device__ __forceinline__ void hgrn_core_simple(LAS unsigned char* lds, const bf16* P, const float* lbt, bf16* OD, int tid) {
    const int chain = blockIdx.x;
    if (chain >= 64) return;
    const int b = chain >> 5, hh = (chain >> 1) & 15, dir = chain & 1;
    LAS float* qs = (LAS float*)lds; LAS float* ks = qs + 4096; LAS float* fs = ks + 4096; LAS float* vs = fs + 4096;
    const int v = tid >> 2, dg = tid & 3;
    float S[32];
#pragma unroll
    for (int j = 0; j < 32; ++j) S[j] = 0.f;
    const float* lb = lbt + (size_t)dir * 4 * D + hh * HD;
    bf16* od = OD + (size_t)dir * M * D;
    for (int blk = 0; blk < SEQ / 32; ++blk) {
        __syncthreads();
        for (int e = tid; e < 4096; e += NTHREADS) {
            const int tt = e >> 7, d = e & 127; const int ts = blk * 32 + tt; const int t = dir ? (SEQ - 1 - ts) : ts;
            const bf16* row = P + (size_t)(b * SEQ + t) * HGRN_N + hh * HD + d;
            const float qv = bf2f(row[0]); const float fv = bf2f(row[(1 + dir) * D]); const float iv = bf2f(row[3 * D]);
            const float lbv = lb[d]; const float fg = lbv + (1.0f - lbv) * sigmoid_f(fv);
            qs[e] = qv * sigmoid_f(qv); ks[e] = 1.0f - fg; fs[e] = fg; vs[e] = iv;
        }
        __syncthreads();
        for (int tt = 0; tt < 32; ++tt) {
            const float vt = vs[tt * 128 + v]; float o = 0.f;
            const LAS float* qr = qs + tt * 128 + dg * 32; const LAS float* kr = ks + tt * 128 + dg * 32; const LAS float* fr = fs + tt * 128 + dg * 32;
#pragma unroll
            for (int j = 0; j < 32; ++j) { S[j] = fr[j] * S[j] + kr[j] * vt; o += qr[j] * S[j]; }
            o += __shfl_xor(o, 1); o += __shfl_xor(o, 2);
            const int ts = blk * 32 + tt; const int t = dir ? (SEQ - 1 - ts) : ts;
            if (dg == 0) od[(size_t)(b * SEQ + t) * D + hh * HD + v] = (bf16)f2bf(o);
        }
    }
}
__device__ __forceinline__ void hgrn_finalize(const bf16* P, const bf16* OD, const float* gnorm, bf16* O, int gw, int NGW, int lane) {
    for (int m = gw; m < M; m += NGW) {
#pragma unroll
        for (int j = 0; j < 4; ++j) {
            const int e0 = 8 * (64 * j + lane);
            const v4u a = *(const GAS v4u*)(OD + (size_t)m * D + e0), b = *(const GAS v4u*)(OD + (size_t)M * D + (size_t)m * D + e0);
            const v4u g = *(const GAS v4u*)(P + (size_t)m * HGRN_N + 4 * D + e0);
            float s[8] = {bflo(a.x) + bflo(b.x), bfhi(a.x) + bfhi(b.x), bflo(a.y) + bflo(b.y), bfhi(a.y) + bfhi(b.y), bflo(a.z) + bflo(b.z), bfhi(a.z) + bfhi(b.z), bflo(a.w) + bflo(b.w), bfhi(a.w) + bfhi(b.w)};
            const float gv[8] = {bflo(g.x), bfhi(g.x), bflo(g.y), bfhi(g.y), bflo(g.z), bfhi(g.z), bflo(g.w), bfhi(g.w)};
            float ss = 0.f;
#pragma unroll
            for (int i = 0; i < 8; ++i) ss += s[i] * s[i];
            ss += __shfl_xor(ss, 1); ss += __shfl_xor(ss, 2); ss += __shfl_xor(ss, 4); ss += __shfl_xor(ss, 8);
            const float r = 1.0f / sqrtf(ss * (1.0f / HD) + EPS);
            const GAS f32x4* wp = (const GAS f32x4*)(gnorm + (e0 & 127)); const f32x4 wa = wp[0], wb = wp[1];
            const float wv[8] = {wa.x, wa.y, wa.z, wa.w, wb.x, wb.y, wb.z, wb.w};
            float o[8];
#pragma unroll
            for (int i = 0; i < 8; ++i) o[i] = s[i] * r * wv[i] * (gv[i] * sigmoid_f(gv[i]));
            v4u w; w.x = pk2(o[0], o[1]); w.y = pk2(o[2], o[3]); w.z = pk2(o[4], o[5]); w.w = pk2(o[6], o[7]);
            *(GAS v4u*)(O + (size_t)m * D + e0) = w;
        }
    }
}

__device__ __forceinline__ void rope_pair(float& x0, float& x1, const float* cosT, const float* sinT, int pos, int lane) {
    const float p0 = __shfl_xor(x0, 8), p1 = __shfl_xor(x1, 8);
    if (lane < 16) {
        const int dd = 2 * (lane & 7);
        const float c0 = cosT[pos * 16 + dd], c1 = cosT[pos * 16 + dd + 1], s0 = sinT[pos * 16 + dd], s1 = sinT[pos * 16 + dd + 1];
        if (lane < 8) { x0 = x0 * c0 - p0 * s0; x1 = x1 * c1 - p1 * s1; }
        else          { x0 = x0 * c0 + p0 * s0; x1 = x1 * c1 + p1 * s1; }
    }
}
__device__ __forceinline__ void attn_core_simple(const bf16* P, const float* cosT, const float* sinT, bf16* OG, float* LSE, int gw, int NGW, int lane) {
    const float scale = 0.08838834764831845f;
    for (int task = gw; task < M * NH * 3; task += NGW) {
        const int g = task % 3, rh = task / 3, hh = rh & 15, row = rh >> 4, b = row >> 12, t = row & (SEQ - 1);
        const int r = (g == 0) ? 1 : (g == 1 ? 4 : 16);
        const unsigned qq = ((const GAS unsigned*)(P + (size_t)row * ATTN_N + ((g * 3 + 0) * NH + hh) * HD))[lane];
        float q0 = bflo(qq), q1 = bfhi(qq);
        float mx = -1e30f, l = 0.f, o0 = 0.f, o1 = 0.f;
        for (int j = -64; j <= 64; ++j) {
            const int tk = t + r * j;
            if (tk < 0 || tk >= SEQ) continue;
            const bf16* krow = P + (size_t)(b * SEQ + tk) * ATTN_N + ((g * 3 + 1) * NH + hh) * HD;
            const unsigned kk = ((const GAS unsigned*)krow)[lane]; const unsigned vv = ((const GAS unsigned*)(krow + NH * HD))[lane];
            float k0 = bflo(kk), k1 = bfhi(kk);
            const float s = wave_sum(q0 * k0 + q1 * k1) * scale;
            const float mn = fmaxf(mx, s), c = __expf(mx - mn), p = __expf(s - mn);
            l = l * c + p; o0 = o0 * c + p * bflo(vv); o1 = o1 * c + p * bfhi(vv); mx = mn;
        }
        const float il = 1.0f / l;
        ((GAS unsigned*)(OG + ((size_t)g * M + row) * D + hh * HD))[lane] = pk2(o0 * il, o1 * il);
        if (lane == 0) LSE[((size_t)g * M + row) * NH + hh] = mx + __logf(l);
    }
}
__device__ __forceinline__ void attn_finalize(const bf16* OG, const float* LSE, bf16* O, int gw, int NGW, int lane) {
    for (int m = gw; m < M; m += NGW) {
#pragma unroll
        for (int j = 0; j < 4; ++j) {
            const int e0 = 8 * (64 * j + lane), hh = e0 >> 7;
            const float l0 = LSE[((size_t)0 * M + m) * NH + hh], l1 = LSE[((size_t)1 * M + m) * NH + hh], l2 = LSE[((size_t)2 * M + m) * NH + hh];
            const float mx = fmaxf(l0, fmaxf(l1, l2)); float w0 = __expf(l0 - mx), w1 = __expf(l1 - mx), w2 = __expf(l2 - mx);
            const float inv = 1.0f / (w0 + w1 + w2); w0 *= inv; w1 *= inv; w2 *= inv;
            const v4u a = *(const GAS v4u*)(OG + ((size_t)0 * M + m) * D + e0), b = *(const GAS v4u*)(OG + ((size_t)1 * M + m) * D + e0), c = *(const GAS v4u*)(OG + ((size_t)2 * M + m) * D + e0);
            v4u w;
            w.x = pk2(w0 * bflo(a.x) + w1 * bflo(b.x) + w2 * bflo(c.x), w0 * bfhi(a.x) + w1 * bfhi(b.x) + w2 * bfhi(c.x));
            w.y = pk2(w0 * bflo(a.y) + w1 * bflo(b.y) + w2 * bflo(c.y), w0 * bfhi(a.y) + w1 * bfhi(b.y) + w2 * bfhi(c.y));
            w.z = pk2(w0 * bflo(a.z) + w1 * bflo(b.z) + w2 * bflo(c.z), w0 * bfhi(a.z) + w1 * bfhi(b.z) + w2 * bfhi(c.z));
            w.w = pk2(w0 * bflo(a.w) + w1 * bflo(b.w) + w2 * bflo(c.w), w0 * bfhi(a.w) + w1 * bfhi(b.w) + w2 * bfhi(c.w));
            *(GAS v4u*)(O + (size_t)m * D + e0) = w;
        }
    }
}

typedef short s16x4 __attribute__((ext_vector_type(4)));
typedef short v4i16_t __attribute__((ext_vector_type(4)));
typedef unsigned v2u __attribute__((ext_vector_type(2)));
__device__ __forceinline__ s16x4 tr_read(LAS const unsigned char* p) { return __builtin_bit_cast(s16x4, __builtin_amdgcn_ds_read_tr16_b64_v4i16((LAS v4i16_t*)p)); }
__device__ __forceinline__ bf16x8 cat44(s16x4 a, s16x4 b) { return (bf16x8){a[0], a[1], a[2], a[3], b[0], b[1], b[2], b[3]}; }
__device__ __forceinline__ void attn_core_mfma(LAS unsigned char* lds, const bf16* P, bf16* OG, float* LSE, int vcu, int G) {
    int tid_l = threadIdx.x; asm volatile("" : "+v"(tid_l));
    const int tid = tid_l, lane = tid & 63, w = __builtin_amdgcn_readfirstlane(tid >> 6), fr = lane & 15, q4 = lane >> 4;
    const float sc2 = 0.08838834764831845f * 1.44269504f;
    constexpr int K_OFF = 0, V_OFF = 65536;
    for (int uid = vcu; uid < 3072; uid += G) {
        const int bi = uid & 31, bhg = uid >> 5, g = bhg % 3, bh = bhg / 3, hh = bh & 15, b = bh >> 4;
        const int rsh = 2 * g, nbs = 5 - rsh, rho = bi >> nbs, blk = bi & ((1 << nbs) - 1), L = SEQ >> rsh, u0 = blk * 128;
        const bf16* Qb = P + (size_t)b * SEQ * ATTN_N + ((g * 3 + 0) * NH + hh) * HD; const bf16* Kb = Qb + NH * HD; const bf16* Vb = Kb + NH * HD;
#pragma unroll
        for (int i = 0; i < 8; ++i) { const int pc = w + 8 * i, row = 4 * pc + (lane >> 4), ph = lane & 15;
            int uk = u0 - 64 + row; uk = uk < 0 ? 0 : (uk >= L ? L - 1 : uk);
            const size_t roff = (size_t)((uk << rsh) + rho) * ATTN_N;
            const int lck = ph ^ (row & 15), lcv = ((((ph >> 1) ^ (row & 7)) << 1) | (ph & 1));
            __builtin_amdgcn_global_load_lds((const unsigned*)(Kb + roff + lck * 8), (LAS unsigned*)(lds + K_OFF + pc * 1024), 16, 0, 0);
            __builtin_amdgcn_global_load_lds((const unsigned*)(Vb + roff + lcv * 8), (LAS unsigned*)(lds + V_OFF + pc * 1024), 16, 0, 0); }
        const int uq = u0 + 16 * w + fr; const int qtok = (uq << rsh) + rho;
        bf16x8 qf[4];
#pragma unroll
        for (int ks = 0; ks < 4; ++ks) qf[ks] = *(const GAS bf16x8*)(Qb + (size_t)qtok * ATTN_N + 32 * ks + 8 * q4);
        asm volatile("s_waitcnt vmcnt(0)" ::: "memory"); __builtin_amdgcn_s_barrier(); asm volatile("" ::: "memory");
        f32x4 S[9];
#pragma unroll
        for (int kt = 0; kt < 9; ++kt) { S[kt] = (f32x4){0.f, 0.f, 0.f, 0.f};
            const int R = 16 * (w + kt) + fr;
#pragma unroll
            for (int ks = 0; ks < 4; ++ks) { const bf16x8 kf = *(const LAS bf16x8*)(lds + K_OFF + R * 256 + (((4 * ks + q4) ^ fr) << 4));
                S[kt] = __builtin_amdgcn_mfma_f32_16x16x32_bf16(kf, qf[ks], S[kt], 0, 0, 0); } }
        float mx = -1e30f;
#pragma unroll
        for (int kt = 0; kt < 9; ++kt)
#pragma unroll
            for (int r = 0; r < 4; ++r) { const int rr = 4 * q4 + r; const int uk = u0 + 16 * w - 64 + 16 * kt + rr;
                const bool ok = (kt > 0 || rr >= fr) && (kt < 8 || rr <= fr) && uk >= 0 && uk < L;
                const float s = ok ? S[kt][r] * sc2 : -1e30f; S[kt][r] = s; mx = fmaxf(mx, s); }
        mx = fmaxf(mx, __shfl_xor(mx, 16)); mx = fmaxf(mx, __shfl_xor(mx, 32));
        float l = 0.f;
#pragma unroll
        for (int kt = 0; kt < 9; ++kt)
#pragma unroll
            for (int r = 0; r < 4; ++r) { const float p = __builtin_amdgcn_exp2f(S[kt][r] - mx); S[kt][r] = p; l += p; }
        l += __shfl_xor(l, 16); l += __shfl_xor(l, 32);
        f32x4 O[8];
#pragma unroll
        for (int dt = 0; dt < 8; ++dt) O[dt] = (f32x4){0.f, 0.f, 0.f, 0.f};
#pragma unroll
        for (int pi = 0; pi < 5; ++pi) { const int T0 = 2 * pi, T1 = (2 * pi + 1 < 9) ? 2 * pi + 1 : 8;
            v4u pw; pw.x = pg8::cvt_pk_bf16(S[T0][0], S[T0][1]); pw.y = pg8::cvt_pk_bf16(S[T0][2], S[T0][3]);
            if (2 * pi + 1 < 9) { pw.z = pg8::cvt_pk_bf16(S[T1][0], S[T1][1]); pw.w = pg8::cvt_pk_bf16(S[T1][2], S[T1][3]); } else { pw.z = 0u; pw.w = 0u; }
            const bf16x8 pf = __builtin_bit_cast(bf16x8, pw);
            const int R0 = 16 * (w + T0) + 4 * q4 + ((lane >> 2) & 3), R1 = 16 * (w + T1) + 4 * q4 + ((lane >> 2) & 3);
#pragma unroll
            for (int dt = 0; dt < 8; ++dt) {
                const s16x4 a0 = tr_read(lds + V_OFF + R0 * 256 + ((dt ^ (R0 & 7)) << 5) + ((lane & 3) << 3));
                const s16x4 a1 = tr_read(lds + V_OFF + R1 * 256 + ((dt ^ (R1 & 7)) << 5) + ((lane & 3) << 3));
                O[dt] = __builtin_amdgcn_mfma_f32_16x16x32_bf16(cat44(a0, a1), pf, O[dt], 0, 0, 0); } }
        const float il = 1.0f / l; const size_t orow = (size_t)g * M + (size_t)b * SEQ + qtok;
        bf16* op = OG + orow * D + hh * HD + 4 * q4;
#pragma unroll
        for (int dt = 0; dt < 8; ++dt) { v2u o2; o2.x = pk2(O[dt][0] * il, O[dt][1] * il); o2.y = pk2(O[dt][2] * il, O[dt][3] * il); *(GAS v2u*)(op + 16 * dt) = o2; }
        if (q4 == 0) LSE[orow * NH + hh] = mx * 0.6931471805599453f + __logf(l);
        asm volatile("s_waitcnt lgkmcnt(0)" ::: "memory"); __builtin_amdgcn_s_barrier(); asm volatile("" ::: "memory");
    }
}
__device__ __forceinline__ void hgrn_gates(const bf16* P, const float* lbt, bf16* QT, bf16* KT, bf16* KH, float* PREF, float* E63, int gw, int NGW, int lane) {
    for (int item = gw; item < 4096; item += NGW) {
        const int cb = item & 15, chunk = (item >> 4) & 127, dir = item >> 11;
        const int c = cb * 128 + 2 * lane; const size_t row0 = (size_t)chunk * 64;
        const float lb0 = lbt[(size_t)dir * 4 * D + c], lb1 = lbt[(size_t)dir * 4 * D + c + 1];
        const bf16* fcol = P + (1 + dir) * D + c; const bf16* qcol = P + c;
        bf16* qt = QT + (size_t)dir * M * D + c; bf16* kt = KT + (size_t)dir * M * D + c; bf16* kh = KH + (size_t)dir * M * D + c;
        float fga[32], fgb[32];
        float sx0 = 1.f, sx1 = 1.f, a0 = 1.f, a1 = 1.f;
#pragma unroll
        for (int tau = 63; tau >= 0; --tau) {
            const size_t t = dir ? row0 + 63 - tau : row0 + tau;
            const unsigned fw = *(const GAS unsigned*)(fcol + t * HGRN_N);
            const float g0 = lb0 + (1.0f - lb0) * sigmoid_f(bflo(fw)), g1 = lb1 + (1.0f - lb1) * sigmoid_f(bfhi(fw));
            const float k0 = 1.0f - g0, k1 = 1.0f - g1;
            *(GAS unsigned*)(kh + t * D) = pk2(k0 * sx0, k1 * sx1); sx0 *= g0; sx1 *= g1;
            if (tau >= 32) { fga[tau - 32] = g0; fgb[tau - 32] = g1; }
            else { const unsigned qw = *(const GAS unsigned*)(qcol + t * HGRN_N); const float q0 = bflo(qw), q1 = bfhi(qw);
                *(GAS unsigned*)(qt + t * D) = pk2(q0 * sigmoid_f(q0) * __builtin_amdgcn_rcpf(fmaxf(a0, 1e-30f)), q1 * sigmoid_f(q1) * __builtin_amdgcn_rcpf(fmaxf(a1, 1e-30f)));
                *(GAS unsigned*)(kt + t * D) = pk2(k0 * a0, k1 * a1); a0 *= g0; a1 *= g1; }
        }
        float b0 = 1.f, b1 = 1.f;
#pragma unroll
        for (int tau = 32; tau < 64; ++tau) {
            const size_t t = dir ? row0 + 63 - tau : row0 + tau;
            const float g0 = fga[tau - 32], g1 = fgb[tau - 32]; b0 *= g0; b1 *= g1;
            const unsigned qw = *(const GAS unsigned*)(qcol + t * HGRN_N); const float q0 = bflo(qw), q1 = bfhi(qw);
            *(GAS unsigned*)(qt + t * D) = pk2(q0 * sigmoid_f(q0) * b0, q1 * sigmoid_f(q1) * b1);
            *(GAS unsigned*)(kt + t * D) = pk2((1.0f - g0) * __builtin_amdgcn_rcpf(fmaxf(b0, 1e-30f)), (1.0f - g1) * __builtin_amdgcn_rcpf(fmaxf(b1, 1e-30f)));
        }
        const size_t vo = ((size_t)dir * (M / 64) + chunk) * D + c;
        PREF[vo] = a0; PREF[vo + 1] = a1; E63[vo] = a0 * b0; E63[vo + 1] = a1 * b1;
    }
}

__device__ __forceinline__ void hgrn_scan_mfma(LAS unsigned char* lds, const bf16* P, const bf16* QT, const bf16* KT, const bf16* KH, const float* PREF, const float* E63, bf16* OD, int vcu, int G) {
    int tid_l = threadIdx.x; asm volatile("" : "+v"(tid_l));
    const int tid = tid_l, lane = tid & 63, w = __builtin_amdgcn_readfirstlane(tid >> 6), fr = lane & 15, q4 = lane >> 4, vt = w & 1, tt = w >> 1;
    constexpr int STG = 54272, QS = 0, KS = 16384, KHS = 32768, VS = 49152, VEC = 53248;
    for (int unit = vcu; unit < 256; unit += G) {
        const int chain = unit >> 2, slice = unit & 3, b = chain >> 5, hh = (chain >> 1) & 15, dir = chain & 1;
        const size_t dOff = (size_t)dir * M * D;
        f32x4 S[8];
#pragma unroll
        for (int T = 0; T < 8; ++T) S[T] = (f32x4){0.f, 0.f, 0.f, 0.f};
#define HG_STAGE(step_, sb_) do { const int ck_ = dir ? 63 - (step_) : (step_); const size_t tok0_ = (size_t)b * SEQ + (size_t)ck_ * 64; \
        _Pragma("unroll") for (int i_ = 0; i_ < 7; ++i_) { const int pc_ = w + 8 * i_; if (pc_ < 53) { const unsigned char* src_; \
            if (pc_ < 48) { const int ar_ = pc_ >> 4, p_ = pc_ & 15, row_ = 4 * p_ + (lane >> 4), ph_ = lane & 15; \
                const int lc_ = (ar_ < 2) ? (ph_ ^ (row_ & 15)) : ((((ph_ >> 1) ^ (row_ & 7)) << 1) | (ph_ & 1)); \
                const bf16* base_ = (ar_ == 0) ? QT : (ar_ == 1 ? KT : KH); \
                src_ = (const unsigned char*)(base_ + dOff + (tok0_ + row_) * D + hh * HD + lc_ * 8); } \
            else if (pc_ < 52) { const int p_ = pc_ - 48, row_ = 16 * p_ + (lane >> 2), ph_ = lane & 3; const int lc_ = ((((ph_ >> 1) ^ ((row_ >> 2) & 1)) << 1) | (ph_ & 1)); \
                src_ = (const unsigned char*)(P + (tok0_ + row_) * HGRN_N + 3 * D + hh * HD + slice * 32 + lc_ * 8); } \
            else { const float* vb_ = (lane < 32) ? PREF : E63; src_ = (const unsigned char*)(vb_ + ((size_t)dir * (M / 64) + (tok0_ >> 6)) * D + hh * HD + 4 * (lane & 31)); } \
            __builtin_amdgcn_global_load_lds((const unsigned*)src_, (LAS unsigned*)(lds + (sb_) + pc_ * 1024), 16, 0, 0); } } } while (0)
        HG_STAGE(0, 0);
        for (int step = 0; step < 64; ++step) {
            const int sb = (step & 1) * STG;
            asm volatile("s_waitcnt vmcnt(0)" ::: "memory"); __builtin_amdgcn_s_barrier(); asm volatile("" ::: "memory");
            if (step + 1 < 64) HG_STAGE(step + 1, ((step + 1) & 1) * STG);
            LAS const unsigned char* st = lds + sb;
            f32x4 Pt[4];
#pragma unroll
            for (int s4 = 0; s4 < 4; ++s4) Pt[s4] = (f32x4){0.f, 0.f, 0.f, 0.f};
#pragma unroll
            for (int ks = 0; ks < 4; ++ks) { const int co = (((4 * ks + q4) ^ fr) << 4);
                const bf16x8 qf = *(const LAS bf16x8*)(st + QS + (16 * tt + fr) * 256 + co);
#pragma unroll
                for (int s4 = 0; s4 < 4; ++s4) { const bf16x8 kf = *(const LAS bf16x8*)(st + KS + (16 * s4 + fr) * 256 + co);
                    Pt[s4] = __builtin_amdgcn_mfma_f32_16x16x32_bf16(kf, qf, Pt[s4], 0, 0, 0); } }
            const int tix = 16 * tt + fr;
#pragma unroll
            for (int s4 = 0; s4 < 4; ++s4)
#pragma unroll
                for (int r = 0; r < 4; ++r) { const int six = 16 * s4 + 4 * q4 + r; const bool keep = dir ? (six >= tix) : (six <= tix); Pt[s4][r] = keep ? Pt[s4][r] : 0.f; }
            bf16x8 vf[2];
#pragma unroll
            for (int pi = 0; pi < 2; ++pi) { const int R0 = 32 * pi + 4 * q4 + ((lane >> 2) & 3), R1 = R0 + 16;
                const s16x4 a0 = tr_read(st + VS + R0 * 64 + ((vt ^ ((R0 >> 2) & 1)) << 5) + ((lane & 3) << 3));
                const s16x4 a1 = tr_read(st + VS + R1 * 64 + ((vt ^ ((R1 >> 2) & 1)) << 5) + ((lane & 3) << 3));
                vf[pi] = cat44(a0, a1); }
            f32x4 o = (f32x4){0.f, 0.f, 0.f, 0.f};
#pragma unroll
            for (int pi = 0; pi < 2; ++pi) { v4u pw; pw.x = pg8::cvt_pk_bf16(Pt[2 * pi][0], Pt[2 * pi][1]); pw.y = pg8::cvt_pk_bf16(Pt[2 * pi][2], Pt[2 * pi][3]);
                pw.z = pg8::cvt_pk_bf16(Pt[2 * pi + 1][0], Pt[2 * pi + 1][1]); pw.w = pg8::cvt_pk_bf16(Pt[2 * pi + 1][2], Pt[2 * pi + 1][3]);
                o = __builtin_amdgcn_mfma_f32_16x16x32_bf16(vf[pi], __builtin_bit_cast(bf16x8, pw), o, 0, 0, 0); }
#pragma unroll
            for (int ks = 0; ks < 4; ++ks) { const int T0 = 2 * ks, T1 = 2 * ks + 1;
                const f32x4 p0 = *(const LAS f32x4*)(st + VEC + (16 * T0 + 4 * q4) * 4), p1 = *(const LAS f32x4*)(st + VEC + (16 * T1 + 4 * q4) * 4);
                v4u aw; aw.x = pg8::cvt_pk_bf16(S[T0][0] * p0[0], S[T0][1] * p0[1]); aw.y = pg8::cvt_pk_bf16(S[T0][2] * p0[2], S[T0][3] * p0[3]);
                aw.z = pg8::cvt_pk_bf16(S[T1][0] * p1[0], S[T1][1] * p1[1]); aw.w = pg8::cvt_pk_bf16(S[T1][2] * p1[2], S[T1][3] * p1[3]);
                const s16x4 qa = *(const LAS s16x4*)(st + QS + (16 * tt + fr) * 256 + (((2 * T0 + (q4 >> 1)) ^ fr) << 4) + ((q4 & 1) << 3));
                const s16x4 qb = *(const LAS s16x4*)(st + QS + (16 * tt + fr) * 256 + (((2 * T1 + (q4 >> 1)) ^ fr) << 4) + ((q4 & 1) << 3));
                o = __builtin_amdgcn_mfma_f32_16x16x32_bf16(__builtin_bit_cast(bf16x8, aw), cat44(qa, qb), o, 0, 0, 0); }
            { const int ck = dir ? 63 - step : step; const size_t tok = (size_t)b * SEQ + (size_t)ck * 64 + 16 * tt + fr;
              v2u o2; o2.x = pk2(o[0], o[1]); o2.y = pk2(o[2], o[3]);
              *(GAS v2u*)(OD + dOff + tok * D + hh * HD + slice * 32 + 16 * vt + 4 * q4) = o2; }
#pragma unroll
            for (int T = 0; T < 8; ++T) { const f32x4 e4 = *(const LAS f32x4*)(st + VEC + 512 + (16 * T + 4 * q4) * 4); S[T] = S[T] * e4;
#pragma unroll
                for (int pi = 0; pi < 2; ++pi) { const int R0 = 32 * pi + 4 * q4 + ((lane >> 2) & 3), R1 = R0 + 16;
                    const s16x4 a0 = tr_read(st + KHS + R0 * 256 + ((T ^ (R0 & 7)) << 5) + ((lane & 3) << 3));
                    const s16x4 a1 = tr_read(st + KHS + R1 * 256 + ((T ^ (R1 & 7)) << 5) + ((lane & 3) << 3));
                    S[T] = __builtin_amdgcn_mfma_f32_16x16x32_bf16(cat44(a0, a1), vf[pi], S[T], 0, 0, 0); } }
        }
#undef HG_STAGE
        asm volatile("s_waitcnt lgkmcnt(0)" ::: "memory"); __builtin_amdgcn_s_barrier(); asm volatile("" ::: "memory");
    }
}
struct Args { const float* in[9]; float* out; unsigned char* ws; int ph_lo, ph_hi; };
__global__ void __launch_bounds__(NTHREADS, 2) fwd(Args args) {
    extern __shared__ __attribute__((aligned(16))) unsigned char lds_raw[];
    LAS unsigned char* lds = (LAS unsigned char*)lds_raw;
    volatile LAS unsigned* MISC = (volatile LAS unsigned*)(lds + MISC_OFF);
    const int G = gridDim.x; const int bx = blockIdx.x;
    const int vcu = (G % 8 == 0) ? (bx % 8) * (G / 8) + bx / 8 : bx;
    const int NGW = G * NWAVES;
    unsigned char* ws = args.ws;
    const float* x_in = args.in[0]; const float* norm_w = args.in[1]; const float* w_in_hgrn = args.in[2]; const float* lbnd = args.in[3]; const float* gnorm = args.in[4];
    const float* w_in_attn = args.in[5]; const float* w_out = args.in[6]; const float* w_ffn_in = args.in[7]; const float* w_ffn_out = args.in[8];
    float* xres = args.out;
    float* cosT = (float*)(ws + WS_TAB + TAB_COS); float* sinT = (float*)(ws + WS_TAB + TAB_SIN); float* lbT = (float*)(ws + WS_TAB + TAB_LB);
    bf16* WHG = (bf16*)(ws + WS_WHG); bf16* WAT = (bf16*)(ws + WS_WAT); bf16* WO = (bf16*)(ws + WS_WO); bf16* WF1 = (bf16*)(ws + WS_WF1); bf16* WF2 = (bf16*)(ws + WS_WF2);
    bf16* H = (bf16*)(ws + WS_H); bf16* PROJ = (bf16*)(ws + WS_PROJ); bf16* MIX = (bf16*)(ws + WS_MIX); bf16* OB = (bf16*)(ws + WS_O); bf16* GB = (bf16*)(ws + WS_G);
    float* LSE = (float*)(ws + WS_MIX + 96 * MiB);
    bf16* QT = (bf16*)(ws + WS_PROJ + 160 * MiB); bf16* KT = (bf16*)(ws + WS_PROJ + 224 * MiB); bf16* KH = (bf16*)(ws + WS_KH);
    float* PREF = (float*)(ws + WS_KH + 64 * MiB); float* E63V = (float*)(ws + WS_KH + 66 * MiB);

    for (int u = threadIdx.x; u < (LDS_BYTES - LDSCTL_OFF) / 4; u += NTHREADS) ((LAS unsigned*)(lds + LDSCTL_OFF))[u] = 0u;
    __syncthreads();
    const int lo = args.ph_lo, hi = args.ph_hi;
    const bool use_bar = (hi - lo) > 1;
    XcdBarrier bar; bar.bar = (unsigned*)(ws + WS_CTL) + CW_BAR; bar.x = 0; bar.st = nullptr;
    if (use_bar) bar = xcd_barrier_post((unsigned*)(ws + WS_CTL) + CW_BAR, MISC + 8);
#define IN(k) (lo <= (k) && (k) < hi)
#define PH_IDS int tid_p = threadIdx.x; asm volatile("" : "+v"(tid_p)); const int lane_p = tid_p & 63; const int wave_p = __builtin_amdgcn_readfirstlane(tid_p >> 6); const int gw_p = vcu * NWAVES + wave_p; (void)lane_p; (void)gw_p;
#define SEAM(k) do { if (IN(k) && IN((k) + 1)) xcd_barrier(bar); } while (0)

    if (IN(0)) {
        PH_IDS
        const int lane = lane_p, gw = gw_p, tid = tid_p;
        LAS float* scr = (LAS float*)(lds + wave_p * 16384);
        for (int s = 0; s < 2; ++s) transpose_matrix(w_in_hgrn + (size_t)s * D * HGRN_N, D, HGRN_N, WHG + (size_t)s * HGRN_N * D, 0, scr, gw, NGW, lane);
        for (int s = 0; s < 2; ++s) transpose_matrix(w_in_attn + (size_t)s * D * ATTN_N, D, ATTN_N, WAT + (size_t)s * ATTN_N * D, 0, scr, gw, NGW, lane);
        for (int s = 0; s < 4; ++s) transpose_matrix(w_out + (size_t)s * D * D, D, D, WO + (size_t)s * D * D, 0, scr, gw, NGW, lane);
        for (int s = 0; s < 4; ++s) transpose_matrix(w_ffn_in + (size_t)s * D * FFN_N, D, FFN_N, WF1 + (size_t)s * FFN_N * D, 1, scr, gw, NGW, lane);
        for (int s = 0; s < 4; ++s) transpose_matrix(w_ffn_out + (size_t)s * DFF * D, DFF, D, WF2 + (size_t)s * D * DFF, 0, scr, gw, NGW, lane);
        const int gt = vcu * NTHREADS + tid, NGT = G * NTHREADS;
        for (int idx = gt; idx < SEQ * 16; idx += NGT) { const int pos = idx >> 4, i = idx & 15;
            const float inv = powf(500000.0f, -(float)(2 * i) / 32.0f); const float ang = (float)pos * inv; cosT[idx] = cosf(ang); sinT[idx] = sinf(ang); }
        for (int idx = gt; idx < 2 * D; idx += NGT) { const int dir = idx >> 11, c = idx & (D - 1);
            float xl[4]; float mx = -3.0e38f;
#pragma unroll
            for (int l = 0; l < 4; ++l) { xl[l] = lbnd[(size_t)(dir * 4 + l) * D + c]; mx = fmaxf(mx, xl[l]); }
            float sum = 0.f;
#pragma unroll
            for (int l = 0; l < 4; ++l) { xl[l] = expf(xl[l] - mx); sum += xl[l]; }
            float cum = 0.f, c0 = 0.f;
#pragma unroll
            for (int l = 0; l < 4; ++l) { cum += xl[l] / sum; if (l == 0) c0 = cum; lbT[(size_t)(dir * 4 + l) * D + c] = cum - c0; } }
        norm_rows<false, true>(nullptr, x_in, nullptr, nullptr, norm_w, H, gw, NGW, lane);
    }
    SEAM(0);

    for (int L = 0; L < DEPTH; ++L) {
        const int pb = 1 + 9 * L; const bool hg = (L & 1) == 0; const int slot = L >> 1;
        const float* nw = norm_w + (size_t)L * 4 * D;
        const int NPROJ = hg ? HGRN_N : ATTN_N;
        if (IN(pb)) {
            if (hg) { pg8::Gemm g{H, WHG + (size_t)slot * HGRN_N * D, M, HGRN_N, D}; pg8::StaticOrder S; S.init(M, HGRN_N, G, bx);
                pg8::EpiBf16<0> E{PROJ, HGRN_N, nullptr, 0, 0, 1.f};
                pg8::gemm_phase<pg8::EpiBf16<0>, pg8::StaticOrder, true, true>(lds, g, S, E); }
            else { pg8::Gemm g{H, WAT + (size_t)slot * ATTN_N * D, M, ATTN_N, D}; pg8::StaticOrder S; S.init(M, ATTN_N, G, bx);
                pg8::EpiRope E{PROJ, ATTN_N, cosT, sinT};
                pg8::gemm_phase<pg8::EpiRope, pg8::StaticOrder, true, true>(lds, g, S, E); }
        }
        SEAM(pb);
        if (hg) {
            if (IN(pb + 1)) { PH_IDS hgrn_gates(PROJ, lbT + (size_t)L * D, QT, KT, KH, PREF, E63V, gw_p, NGW, lane_p); }
            SEAM(pb + 1);
        }
        if (IN(pb + 2)) {
            if (hg) hgrn_scan_mfma(lds, PROJ, QT, KT, KH, PREF, E63V, MIX, vcu, G);
            else attn_core_mfma(lds, PROJ, MIX, LSE, vcu, G);
        }
        SEAM(pb + 2);
        if (IN(pb + 3)) {
            PH_IDS
            const int lane = lane_p, gw = gw_p;
            if (hg) hgrn_finalize(PROJ, MIX, gnorm + (size_t)slot * HD, OB, gw, NGW, lane);
            else attn_finalize(MIX, LSE, OB, gw, NGW, lane);
        }
        SEAM(pb + 3);
        if (IN(pb + 4)) {
            pg8::Gemm g{OB, WO + (size_t)L * D * D, M, D, D}; pg8::StaticOrder S; S.init(M, D, G, bx);
            pg8::EpiBf16<0> E{GB, D, nullptr, 0, 0, 1.f};
            pg8::gemm_phase<pg8::EpiBf16<0>, pg8::StaticOrder, true, true>(lds, g, S, E);
        }
        SEAM(pb + 4);
        if (IN(pb + 5)) { PH_IDS norm_rows<true, true>(GB, L == 0 ? x_in : xres, xres, nw + D, nw + 2 * D, H, gw_p, NGW, lane_p); }
        SEAM(pb + 5);
        if (IN(pb + 6)) {
            pg8::Gemm g{H, WF1 + (size_t)L * FFN_N * D, M, FFN_N, D}; pg8::StaticOrder S; S.init(M, FFN_N, G, bx);
            pg8::EpiSwiGLU E{PROJ, DFF};
            pg8::gemm_phase<pg8::EpiSwiGLU, pg8::StaticOrder, true, true>(lds, g, S, E);
        }
        SEAM(pb + 6);
        if (IN(pb + 7)) {
            pg8::Gemm g{PROJ, WF2 + (size_t)L * D * DFF, M, D, DFF}; pg8::StaticOrder S; S.init(M, D, G, bx);
            pg8::EpiBf16<0> E{GB, D, nullptr, 0, 0, 1.f};
            pg8::gemm_phase<pg8::EpiBf16<0>, pg8::StaticOrder, true, true>(lds, g, S, E);
        }
        SEAM(pb + 7);
        if (IN(pb + 8)) {
            PH_IDS
            const int lane = lane_p, gw = gw_p;
            if (L + 1 < DEPTH) norm_rows<true, true>(GB, xres, xres, nw + 3 * D, nw + 4 * D, H, gw, NGW, lane);
            else norm_rows<true, false>(GB, xres, xres, nw + 3 * D, nullptr, nullptr, gw, NGW, lane);
        }
        SEAM(pb + 8);
    }
#undef IN
#undef SEAM
}

#ifndef MK_PER_PHASE
#define MK_PER_PHASE 0
#endif
extern "C" void kernel_launch(void* const* d_in, const int* in_sizes, int n_in, void* d_out, int out_size, void* d_ws, size_t ws_size, hipStream_t stream) {
    static int grid = 0;
    if (grid == 0) {
        if (n_in != 9 || in_sizes[0] != M * D || out_size != M * D || ws_size < WS_END) { fprintf(stderr, "kernel_launch: unexpected shapes (n_in %d, in0 %d, out %d, ws %zu); nothing launched\n", n_in, n_in > 0 ? in_sizes[0] : -1, out_size, ws_size); grid = -1; return; }
        int dev = 0, cus = 0, per_cu = 0;
        if (hipGetDevice(&dev) != hipSuccess || hipDeviceGetAttribute(&cus, hipDeviceAttributeMultiprocessorCount, dev) != hipSuccess) { grid = -1; return; }
        if (hipFuncSetAttribute((const void*)fwd, hipFuncAttributeMaxDynamicSharedMemorySize, LDS_BYTES) != hipSuccess) { fprintf(stderr, "kernel_launch: hipFuncSetAttribute failed\n"); grid = -1; return; }
        if (hipOccupancyMaxActiveBlocksPerMultiprocessor(&per_cu, (const void*)fwd, NTHREADS, LDS_BYTES) != hipSuccess || per_cu < 1) fprintf(stderr, "kernel_launch: occupancy query reports %d\n", per_cu);
        (void)hipGetLastError();
        grid = cus;
    }
    if (grid < 0) return;
    if (hipMemsetAsync((char*)d_ws + WS_CTL, 0, CTL_ZERO_BYTES, stream) != hipSuccess) return;
    Args a{};
    for (int i = 0; i < 9; ++i) a.in[i] = (const float*)d_in[i];
    a.out = (float*)d_out; a.ws = (unsigned char*)d_ws;
#if MK_PER_PHASE
    for (int p = 0; p < NPHASES; ++p) { a.ph_lo = p; a.ph_hi = p + 1; hipLaunchKernelGGL(fwd, dim3(grid), dim3(NTHREADS), LDS_BYTES, stream, a); }
#else
    a.ph_lo = 0; a.ph_hi = NPHASES; hipLaunchKernelGGL(fwd, dim3(grid), dim3(NTHREADS), LDS_BYTES, stream, a);
#endif
}
```

```cpp
#include <hip/hip_runtime.h>
#include <cstdio>
#include <cstdint>
namespace pg8 {
#define PG8_LAS __attribute__((address_space(3)))
typedef unsigned short bf16_t;
typedef short bf16x8 __attribute__((ext_vector_type(8)));
typedef float f32x4 __attribute__((ext_vector_type(4)));
typedef unsigned u32x4 __attribute__((ext_vector_type(4)));
constexpr int BM = 256, BK = 64, HALF = 128, HTB = HALF * BK * 2  , STAGE_BYTES = 8 * HTB, NXCD = 8, WGM = 8;

__host__ __device__ __forceinline__ int lds_byte(int r, int c) { const int st = (r >> 4) * 2 + (c >> 5), rr = r & 15, cc = c & 31, ob = rr * 64 + cc * 2; return st * 1024 + (ob ^ (((ob >> 9) & 1) << 5)); }
__host__ __device__ __forceinline__ void stage_rc(int b, int& R, int& C) { const int st = b / 1024, sb = b % 1024, swz = sb ^ (((sb >> 9) & 1) << 5); R = (st >> 1) * 16 + swz / 64; C = (st & 1) * 32 + (swz % 64) / 2; }
__host__ __device__ __forceinline__ int perm32(int rho) { const int n = rho >> 4, i = rho & 15; return 8 * (i >> 2) + 4 * n + (i & 3); }

struct Unit { int pm, pn; };
struct Gemm { const bf16_t* A; const bf16_t* Bt; int M, N, K; };

struct StaticOrder {
    int nM, nN, nwg, G, c;
    __host__ __device__ void init(int M, int N, int G_, int c_) { nM = M / BM; nN = N / BM; nwg = nM * nN; G = G_; c = c_; }
    __host__ __device__ bool next(int i, Unit& u) const {
        const long L = (long)i * G + c; if (L >= nwg) return false;
        int wgid = (int)L; { const int q = nwg / NXCD, r = nwg % NXCD, xcd = wgid % NXCD, off = wgid / NXCD; wgid = (xcd < r ? xcd * (q + 1) : r * (q + 1) + (xcd - r) * q) + off; }
        const int nig = WGM * nN, gid = wgid / nig, fm = gid * WGM, gsz = (nM - fm) < WGM ? (nM - fm) : WGM;
        u.pm = fm + ((wgid % nig) % gsz); u.pn = (wgid % nig) / gsz; return true;
    }
    __device__ __forceinline__ void a_ready(const Unit&) const {}
    __device__ __forceinline__ void done(const Unit&) const {}
};

__device__ __forceinline__ unsigned cvt_pk_bf16(float lo, float hi) { unsigned r; asm volatile("v_cvt_pk_bf16_f32 %0, %1, %2" : "=v"(r) : "v"(lo), "v"(hi)); return r; }
typedef float f32x2 __attribute__((ext_vector_type(2)));
__device__ __forceinline__ f32x2 gelu_pk(f32x2 v) {
    const f32x2 av = __builtin_elementwise_abs(v), d = av * 0.2316418882f + 1.0f;
    f32x2 t; t.x = __builtin_amdgcn_rcpf(d.x); t.y = __builtin_amdgcn_rcpf(d.y);
    f32x2 q = t * 0.5307027145f + (-0.7265760135f); q = q * t + 0.7107068705f; q = q * t + (-0.142248368f); q = q * t + 0.127414796f; q = q * t;
    const f32x2 s = (v * v) * (-0.72134752044f);
    f32x2 e; e.x = __builtin_amdgcn_exp2f(s.x); e.y = __builtin_amdgcn_exp2f(s.y);
    const f32x2 m = v * (q * e), r = v - m;
    f32x2 o; o.x = v.x < 0.f ? m.x : r.x; o.y = v.y < 0.f ? m.y : r.y; return o;
}

template <int ACT  > struct EpiBf16 {
    static constexpr bool PERM = true, AFTER_DRAIN = false; static_assert(ACT == 0 || ACT == 1, "EpiBf16: ACT is 0 (none) or 1 (gelu_pk)");
    bf16_t* O; int ldc; const float* bias; int split_cols; size_t split_stride; float scale0;
    __device__ __forceinline__ void operator()(const f32x4 (&acc)[2][2][4][2], const Unit& u, int wr, int wc, int fr, int fq) const {
        const int row0 = u.pm * BM + wr * 64 + fr; int colt = u.pn * BM; bf16_t* base = O;
        float sc = 1.f; if (split_cols) { const int t = colt / split_cols; base += (size_t)t * split_stride; colt -= t * split_cols; if (t == 0) sc = scale0; }
        const int col0 = colt + wc * 32 + 8 * fq, bcol0 = u.pn * BM + wc * 32 + 8 * fq;
        f32x4 bv[2][2];
#pragma unroll
        for (int bj = 0; bj < 2; ++bj)
#pragma unroll
            for (int n = 0; n < 2; ++n) bv[bj][n] = bias ? *(const f32x4*)(bias + bcol0 + bj * HALF + 4 * n) : (f32x4){0.f, 0.f, 0.f, 0.f};
#pragma unroll
        for (int ai = 0; ai < 2; ++ai)
#pragma unroll
            for (int m = 0; m < 4; ++m) { bf16_t* rowp = base + (size_t)(row0 + ai * HALF + m * 16) * ldc + col0;
#pragma unroll
                for (int bj = 0; bj < 2; ++bj) { f32x4 v0 = acc[ai][bj][m][0] + bv[bj][0], v1 = acc[ai][bj][m][1] + bv[bj][1];
                    if (ACT == 1) { f32x2 a = gelu_pk((f32x2){v0[0], v0[1]}), b = gelu_pk((f32x2){v0[2], v0[3]}), c = gelu_pk((f32x2){v1[0], v1[1]}), d = gelu_pk((f32x2){v1[2], v1[3]});
                        v0 = (f32x4){a.x, a.y, b.x, b.y}; v1 = (f32x4){c.x, c.y, d.x, d.y}; }
                    v0 = v0 * sc; v1 = v1 * sc; u32x4 w; w.x = cvt_pk_bf16(v0[0], v0[1]); w.y = cvt_pk_bf16(v0[2], v0[3]); w.z = cvt_pk_bf16(v1[0], v1[1]); w.w = cvt_pk_bf16(v1[2], v1[3]);
                    *(u32x4*)(rowp + bj * HALF) = w; } }
    }
};

template <class Epi, class Sched, bool ALIGN_EPI = false, bool SP2 = false>
__device__ __forceinline__ void gemm_phase(PG8_LAS unsigned char* lds, const Gemm g, const Sched& S, const Epi& E) {
    int tid_l = threadIdx.x; asm volatile("" : "+v"(tid_l));
    const int tid = tid_l, wid = __builtin_amdgcn_readfirstlane(tid >> 6), lane = tid & 63, wr = wid >> 2, wc = wid & 3, fr = lane & 15, fq = lane >> 4;
    const int K = g.K, nt = K / BK;
    unsigned voffA[2], voffB[2];
#pragma unroll
    for (int i = 0; i < 2; ++i) { int R, C; stage_rc(tid * 16 + i * 8192, R, C); const int Rb = Epi::PERM ? ((R & ~31) + perm32(R & 31)) : R;
        voffA[i] = (unsigned)(R * K + C) * 2u; voffB[i] = (unsigned)(Rb * K + C) * 2u; }
    const size_t kstep = (size_t)(BK * 2);
    const size_t hstep = (size_t)HALF * K * 2;
    const size_t tstep = 2 * hstep;
    const unsigned ldsw = (unsigned)wid * 1024u;
    const int aoff = lds_byte(wr * 64 + fr, fq * 8), boff = lds_byte(wc * 32 + fr, fq * 8);
#define PG8_SA(b, h) (((b) * 2 + (h)) * HTB)
#define PG8_SB(b, h) ((4 + (b) * 2 + (h)) * HTB)
#define PG8_STAGE(bufoff, gbase, voff) do { _Pragma("unroll") for (int _i = 0; _i < 2; ++_i) \
        __builtin_amdgcn_global_load_lds((const unsigned*)((const char*)(gbase) + (voff)[_i]), (PG8_LAS unsigned*)(lds + (bufoff) + ldsw + _i * 8192), 16, 0, 0); } while (0)
#define PG8_LDA(dst, b, h) do { _Pragma("unroll") for (int m = 0; m < 4; ++m) _Pragma("unroll") for (int k = 0; k < 2; ++k) dst[m][k] = *(const PG8_LAS bf16x8*)(lds + PG8_SA(b, h) + aoff + m * 2048 + k * 1024); } while (0)
#define PG8_LDB(dst, b, h) do { _Pragma("unroll") for (int n = 0; n < 2; ++n) _Pragma("unroll") for (int k = 0; k < 2; ++k) dst[n][k] = *(const PG8_LAS bf16x8*)(lds + PG8_SB(b, h) + boff + n * 2048 + k * 1024); } while (0)
#define PG8_MMA(ai, bj, At, Bt) do { __builtin_amdgcn_s_setprio(1); _Pragma("unroll") for (int m = 0; m < 4; ++m) _Pragma("unroll") for (int n = 0; n < 2; ++n) _Pragma("unroll") for (int k = 0; k < 2; ++k) \
        acc[ai][bj][m][n] = __builtin_amdgcn_mfma_f32_16x16x32_bf16(Bt[n][k], At[m][k], acc[ai][bj][m][n], 0, 0, 0); __builtin_amdgcn_s_setprio(0); } while (0)
#define PG8_WAIT_V(n) asm volatile("s_waitcnt vmcnt(" #n ")" ::: "memory")
#define PG8_WAIT_L(n) asm volatile("s_waitcnt lgkmcnt(" #n ")" ::: "memory")
#define PG8_BAR __builtin_amdgcn_s_barrier()
#define PG8_SCHED __builtin_amdgcn_sched_barrier(0)
    Unit cur, nxt; int ui = 0;
    if (!S.next(0, cur)) return;
    f32x4 acc[2][2][4][2];
#pragma unroll
    for (int a = 0; a < 2; ++a)
#pragma unroll
        for (int b = 0; b < 2; ++b)
#pragma unroll
            for (int m = 0; m < 4; ++m)
#pragma unroll
                for (int n = 0; n < 2; ++n) acc[a][b][m][n] = (f32x4){0.f, 0.f, 0.f, 0.f};
    bf16x8 At[4][2], B0[2][2], B1[2][2];
    const char* cA = (const char*)g.A + (size_t)cur.pm * tstep; const char* cB = (const char*)g.Bt + (size_t)cur.pn * tstep;
    S.a_ready(cur);
    if constexpr (SP2) {
        PG8_STAGE(PG8_SB(0, 0), cB, voffB); PG8_STAGE(PG8_SB(0, 1), cB + hstep, voffB); PG8_STAGE(PG8_SA(0, 0), cA, voffA); PG8_STAGE(PG8_SA(0, 1), cA + hstep, voffA);
        if (wr == 1) PG8_BAR;
        PG8_WAIT_V(2); PG8_BAR;
        PG8_STAGE(PG8_SB(1, 0), cB + kstep, voffB); PG8_STAGE(PG8_SA(1, 0), cA + kstep, voffA); PG8_STAGE(PG8_SB(1, 1), cB + hstep + kstep, voffB);
        PG8_WAIT_V(6); PG8_BAR;
    } else {
        PG8_STAGE(PG8_SB(0, 0), cB, voffB); PG8_STAGE(PG8_SA(0, 0), cA, voffA); PG8_STAGE(PG8_SB(0, 1), cB + hstep, voffB); PG8_STAGE(PG8_SA(0, 1), cA + hstep, voffA);
        if (wr == 1) PG8_BAR;
        PG8_WAIT_V(4); PG8_BAR;
        PG8_STAGE(PG8_SB(1, 0), cB + kstep, voffB); PG8_STAGE(PG8_SA(1, 0), cA + kstep, voffA); PG8_STAGE(PG8_SB(1, 1), cB + hstep + kstep, voffB);
        PG8_WAIT_V(6); PG8_BAR;
    }
    for (;;) {
        const bool has_next = S.next(ui + 1, nxt);
        const char* nA = has_next ? (const char*)g.A + (size_t)nxt.pm * tstep : cA; const char* nB = has_next ? (const char*)g.Bt + (size_t)nxt.pn * tstep : cB;
        for (int t = 0; t < nt; t += 2) {
            const bool last = (t == nt - 2);
            const char* a1 = cA + (size_t)(t + 1) * kstep;
            const char* a2 = last ? nA : cA + (size_t)(t + 2) * kstep; const char* b2 = last ? nB : cB + (size_t)(t + 2) * kstep;
            const char* a3 = a2 + kstep; const char* b3 = b2 + kstep;
            if (last && has_next) S.a_ready(nxt);
            if constexpr (SP2) {
            PG8_LDB(B0, 0, 0); PG8_LDB(B1, 0, 1); PG8_SCHED; PG8_LDA(At, 0, 0); PG8_STAGE(PG8_SA(1, 1), a1 + hstep, voffA);
            PG8_WAIT_V(8); PG8_WAIT_L(0); PG8_BAR; PG8_MMA(0, 0, At, B0); PG8_MMA(0, 1, At, B1); PG8_BAR; PG8_SCHED;
            PG8_LDA(At, 0, 1); PG8_STAGE(PG8_SB(0, 0), b2, voffB); PG8_STAGE(PG8_SB(0, 1), b2 + hstep, voffB); PG8_STAGE(PG8_SA(0, 0), a2, voffA);
            PG8_WAIT_V(8); PG8_WAIT_L(0); PG8_BAR; PG8_MMA(1, 0, At, B0); PG8_MMA(1, 1, At, B1); PG8_BAR; PG8_SCHED;
            PG8_LDB(B0, 1, 0); PG8_LDB(B1, 1, 1); PG8_SCHED; PG8_LDA(At, 1, 0); PG8_STAGE(PG8_SA(0, 1), a2 + hstep, voffA);
            PG8_WAIT_V(8); PG8_WAIT_L(0); PG8_BAR; PG8_MMA(0, 0, At, B0); PG8_MMA(0, 1, At, B1); PG8_BAR; PG8_SCHED;
            PG8_LDA(At, 1, 1); PG8_STAGE(PG8_SB(1, 0), b3, voffB); PG8_STAGE(PG8_SB(1, 1), b3 + hstep, voffB); PG8_STAGE(PG8_SA(1, 0), a3, voffA);
            PG8_WAIT_V(8); PG8_WAIT_L(0); PG8_BAR; PG8_MMA(1, 0, At, B0); PG8_MMA(1, 1, At, B1); PG8_BAR; PG8_SCHED;
            } else {
            PG8_LDB(B0, 0, 0); PG8_SCHED; PG8_LDA(At, 0, 0); PG8_STAGE(PG8_SA(1, 1), a1 + hstep, voffA);
            PG8_WAIT_L(8); PG8_BAR; PG8_WAIT_L(0); PG8_MMA(0, 0, At, B0); PG8_BAR; PG8_SCHED;
            PG8_LDB(B1, 0, 1); PG8_STAGE(PG8_SB(0, 0), b2, voffB);
            PG8_BAR; PG8_WAIT_L(0); PG8_MMA(0, 1, At, B1); PG8_BAR;
            PG8_LDA(At, 0, 1); PG8_STAGE(PG8_SA(0, 0), a2, voffA);
            PG8_BAR; PG8_WAIT_L(0); PG8_MMA(1, 0, At, B0); PG8_BAR; PG8_SCHED;
            PG8_STAGE(PG8_SB(0, 1), b2 + hstep, voffB);
            PG8_WAIT_V(6); PG8_BAR; PG8_MMA(1, 1, At, B1); PG8_BAR;
            PG8_LDB(B0, 1, 0); PG8_SCHED; PG8_LDA(At, 1, 0); PG8_STAGE(PG8_SA(0, 1), a2 + hstep, voffA);
            PG8_WAIT_L(8); PG8_BAR; PG8_WAIT_L(0); PG8_MMA(0, 0, At, B0); PG8_BAR; PG8_SCHED;
            PG8_LDB(B1, 1, 1); PG8_STAGE(PG8_SB(1, 0), b3, voffB);
            PG8_BAR; PG8_WAIT_L(0); PG8_MMA(0, 1, At, B1); PG8_BAR;
            PG8_LDA(At, 1, 1); PG8_STAGE(PG8_SA(1, 0), a3, voffA);
            PG8_BAR; PG8_WAIT_L(0); PG8_MMA(1, 0, At, B0); PG8_BAR; PG8_SCHED;
            PG8_STAGE(PG8_SB(1, 1), b3 + hstep, voffB);
            PG8_WAIT_V(6); PG8_BAR; PG8_MMA(1, 1, At, B1); PG8_BAR;
            }
        }
        if constexpr (ALIGN_EPI) { if (wr == 0) PG8_BAR; }
        if constexpr (!Epi::AFTER_DRAIN) { E(acc, cur, wr, wc, fr, fq); S.done(cur); }
        if (!has_next) break;
#pragma unroll
        for (int a = 0; a < 2; ++a)
#pragma unroll
            for (int b = 0; b < 2; ++b)
#pragma unroll
                for (int m = 0; m < 4; ++m)
#pragma unroll
                    for (int n = 0; n < 2; ++n) acc[a][b][m][n] = (f32x4){0.f, 0.f, 0.f, 0.f};
        cur = nxt; cA = nA; cB = nB; ++ui;
        if constexpr (ALIGN_EPI) { if (wr == 1) PG8_BAR; }
    }
    PG8_WAIT_V(0);
    if constexpr (!ALIGN_EPI) { if (wr == 0) PG8_BAR; }
    PG8_BAR;
    if constexpr (Epi::AFTER_DRAIN) { E.fused(acc, cur, wr, wc, fr, fq, lds, wid, lane); S.done(cur); }
#undef PG8_SA
#undef PG8_SB
#undef PG8_STAGE
#undef PG8_LDA
#undef PG8_LDB
#undef PG8_MMA
#undef PG8_WAIT_V
#undef PG8_WAIT_L
#undef PG8_BAR
#undef PG8_SCHED
}
}
namespace pg8 {
__device__ __forceinline__ float silu_f(float x) { return x * __builtin_amdgcn_rcpf(1.0f + __builtin_amdgcn_exp2f(-1.44269504f * x)); }
struct EpiSwiGLU {
    static constexpr bool PERM = true, AFTER_DRAIN = false;
    bf16_t* O; int ldc;
    __device__ __forceinline__ void operator()(const f32x4 (&acc)[2][2][4][2], const Unit& u, int wr, int wc, int fr, int fq) const {
        const int row0 = u.pm * BM + wr * 64 + fr; const int col0 = u.pn * HALF + wc * 32 + 8 * fq;
#pragma unroll
        for (int ai = 0; ai < 2; ++ai)
#pragma unroll
            for (int m = 0; m < 4; ++m) { bf16_t* rowp = O + (size_t)(row0 + ai * HALF + m * 16) * ldc + col0;
                const f32x4 g0 = acc[ai][0][m][0], g1 = acc[ai][0][m][1], u0 = acc[ai][1][m][0], u1 = acc[ai][1][m][1];
                u32x4 w; w.x = cvt_pk_bf16(silu_f(g0[0]) * u0[0], silu_f(g0[1]) * u0[1]); w.y = cvt_pk_bf16(silu_f(g0[2]) * u0[2], silu_f(g0[3]) * u0[3]);
                w.z = cvt_pk_bf16(silu_f(g1[0]) * u1[0], silu_f(g1[1]) * u1[1]); w.w = cvt_pk_bf16(silu_f(g1[2]) * u1[2], silu_f(g1[3]) * u1[3]);
                *(u32x4*)rowp = w; }
    }
};
}
namespace pg8 {
struct EpiRope {
    static constexpr bool PERM = true, AFTER_DRAIN = false;
    bf16_t* O; int ldc; const float* cosT; const float* sinT;
    __device__ __forceinline__ void operator()(const f32x4 (&acc)[2][2][4][2], const Unit& u, int wr, int wc, int fr, int fq) const {
        const int row0 = u.pm * BM + wr * 64 + fr; const int colt = u.pn * BM; const int col0 = colt + wc * 32 + 8 * fq;
        const bool rot = (((colt >> 11) % 3) < 2) && (wc == 0);
        const int dd0 = 8 * (fq & 1); const float sgn = (fq < 2) ? -1.0f : 1.0f;
#pragma unroll
        for (int ai = 0; ai < 2; ++ai)
#pragma unroll
            for (int m = 0; m < 4; ++m) { const int row = row0 + ai * HALF + m * 16; bf16_t* rowp = O + (size_t)row * ldc + col0;
                f32x4 c0 = (f32x4){1.f, 1.f, 1.f, 1.f}, c1 = c0, s0 = (f32x4){0.f, 0.f, 0.f, 0.f}, s1 = s0;
                if (rot) { const int pos = row & 4095; const f32x4* cp = (const f32x4*)(cosT + pos * 16 + dd0); const f32x4* sp = (const f32x4*)(sinT + pos * 16 + dd0);
                    c0 = cp[0]; c1 = cp[1]; s0 = sp[0] * sgn; s1 = sp[1] * sgn; }
#pragma unroll
                for (int bj = 0; bj < 2; ++bj) { f32x4 v0 = acc[ai][bj][m][0], v1 = acc[ai][bj][m][1];
                    if (rot) { f32x4 p0, p1;
#pragma unroll
                        for (int i = 0; i < 4; ++i) { p0[i] = __shfl_xor(v0[i], 32); p1[i] = __shfl_xor(v1[i], 32); }
                        v0 = v0 * c0 + p0 * s0; v1 = v1 * c1 + p1 * s1; }
                    u32x4 w; w.x = cvt_pk_bf16(v0[0], v0[1]); w.y = cvt_pk_bf16(v0[2], v0[3]); w.z = cvt_pk_bf16(v1[0], v1[1]); w.w = cvt_pk_bf16(v1[2], v1[3]);
                    *(u32x4*)(rowp + bj * HALF) = w; } }
    }
};
}
#define GAS __attribute__((address_space(1)))
#define LAS __attribute__((address_space(3)))
typedef unsigned short bf16;
typedef unsigned v4u __attribute__((ext_vector_type(4)));
typedef float f32x4 __attribute__((ext_vector_type(4)));
typedef short bf16x8 __attribute__((ext_vector_type(8)));
typedef GAS unsigned gu32;
typedef GAS unsigned long long gu64;
#define RLX_AGENT __ATOMIC_RELAXED, __HIP_MEMORY_SCOPE_AGENT
#define LDS_WAIT() asm volatile("s_waitcnt lgkmcnt(0)" ::: "memory")
#define VM_WAIT() asm volatile("s_waitcnt vmcnt(0)" ::: "memory")
__device__ __forceinline__ unsigned long long rt() { return __builtin_amdgcn_s_memrealtime(); }
__device__ __forceinline__ unsigned f2bf(float f) { unsigned u = __builtin_bit_cast(unsigned, f); return (u + 0x7fffu + ((u >> 16) & 1u)) >> 16; }
__device__ __forceinline__ unsigned pk2(float lo, float hi) { return f2bf(lo) | (f2bf(hi) << 16); }

#define XB_TMO      128
#define XB_XCNT(j)  (256  + 64 * (j))
#define XB_XSUB(j)  (1280 + 64 * (j))
#define XB_XGEN(j)  (2304 + 64 * (j))
#define XB_TOP      3328
#define XB_TOPGEN   3392
#define XCD_BAR_WORDS 3456
#define XB_SPIN_CAP (1u << 18)

__device__ __forceinline__ unsigned xb_ld(unsigned* p)              { return __hip_atomic_load(p, __ATOMIC_RELAXED, __HIP_MEMORY_SCOPE_AGENT); }
__device__ __forceinline__ unsigned xb_add(unsigned* p, unsigned v) { return __hip_atomic_fetch_add(p, v, __ATOMIC_RELAXED, __HIP_MEMORY_SCOPE_AGENT); }
__device__ __forceinline__ unsigned xb_xcc_id() { return (unsigned)__builtin_amdgcn_s_getreg((3 << 11) | 20) & 0xFu; }
#define XB_SPIN(cond, bar) do { unsigned _sp = 0; while (cond) { __builtin_amdgcn_s_sleep(1); \
    if ((++_sp & 255u) == 0u) { if (xb_ld(&(bar)[XB_TMO])) break; if (_sp > XB_SPIN_CAP) { atomicAdd(&(bar)[XB_TMO], 1u); break; } } } } while (0)

struct XcdBarrier {
    unsigned* bar; unsigned x;
    volatile LAS unsigned* st;
};

__device__ __forceinline__ XcdBarrier xcd_barrier_post(unsigned* bar, volatile LAS unsigned* st) {
    XcdBarrier b; b.bar = bar; b.x = xb_xcc_id(); b.st = st;
    if (threadIdx.x == 0) (void)xb_add(&bar[XB_XCNT(b.x)], 1u);
    return b;
}
__device__ __forceinline__ void xcd_barrier_complete(unsigned* bar, unsigned x, unsigned& nloc, unsigned& nx) {
    const unsigned G = gridDim.x * gridDim.y * gridDim.z;
    unsigned sum, cnt, mine, sp = 0u;
    for (;;) {
        sum = 0u; cnt = 0u; mine = 0u;
#pragma unroll
        for (unsigned j = 0; j < 16; ++j) { const unsigned c = xb_ld(&bar[XB_XCNT(j)]); sum += c; cnt += (c > 0u) ? 1u : 0u; mine = (j == x) ? c : mine; }
        if (sum == G) break;
        __builtin_amdgcn_s_sleep(1);
        if ((++sp & 255u) == 0u) { if (xb_ld(&bar[XB_TMO])) break; if (sp > XB_SPIN_CAP) { atomicAdd(&bar[XB_TMO], 1u); break; } }
    }
    nloc = mine > 0u ? mine : 1u; nx = cnt > 0u ? cnt : 1u;
}

__device__ __forceinline__ void xcd_barrier(const XcdBarrier& b) {
    asm volatile("s_waitcnt vmcnt(0)" ::: "memory");
    __syncthreads();
    if (threadIdx.x == 0) {
        unsigned* bar = b.bar;
        __builtin_amdgcn_s_waitcnt(0);
        unsigned nloc = b.st[0], nx = b.st[1];
        if (nloc == 0u) { xcd_barrier_complete(bar, b.x, nloc, nx); b.st[0] = nloc; b.st[1] = nx; }
        const unsigned old = xb_add(&bar[XB_XSUB(b.x)], 1u);
        const unsigned gen = old / nloc;
        if (old + 1u == (gen + 1u) * nloc) {
            __builtin_amdgcn_fence(__ATOMIC_RELEASE, "agent");
            asm volatile("s_waitcnt vmcnt(0)" ::: "memory");
            const unsigned og = xb_add(&bar[XB_TOP], 1u);
            const unsigned tg = og / nx;
            if (og + 1u == (tg + 1u) * nx) xb_add(&bar[XB_TOPGEN], 1u);
            else XB_SPIN(xb_ld(&bar[XB_TOPGEN]) == tg, bar);
            __builtin_amdgcn_fence(__ATOMIC_ACQUIRE, "agent");
            xb_add(&bar[XB_XGEN(b.x)], 1u);
            asm volatile("s_waitcnt vmcnt(0)" ::: "memory");
        } else {
            XB_SPIN(xb_ld(&bar[XB_XGEN(b.x)]) == gen, bar);
            __builtin_amdgcn_fence(__ATOMIC_ACQUIRE, "agent");
            asm volatile("s_waitcnt vmcnt(0)" ::: "memory");
        }
    }
    __syncthreads();
}

constexpr int NWAVES = 8, NTHREADS = 512;
constexpr int BATCH = 2, SEQ = 4096, D = 2048, M = BATCH * SEQ, DEPTH = 4, NH = 16, HD = 128;
constexpr int HGRN_N = 5 * D, ATTN_N = 9 * D, DFF = 5632, FFN_N = 2 * DFF;
constexpr float EPS = 1e-6f;
constexpr int NPHASES = 1 + 9 * DEPTH;
#ifndef REP_PRO
#define REP_PRO 1
#endif
#ifndef REP_INH
#define REP_INH 1
#endif
#ifndef REP_INA
#define REP_INA 1
#endif
#ifndef REP_WO
#define REP_WO 1
#endif
#ifndef REP_F1
#define REP_F1 1
#endif
#ifndef REP_F2
#define REP_F2 1
#endif
#ifndef REP_GATES
#define REP_GATES 1
#endif
#ifndef REP_SCAN
#define REP_SCAN 1
#endif
#ifndef REP_ATTN
#define REP_ATTN 1
#endif
#ifndef REP_FIN
#define REP_FIN 1
#endif
#ifndef REP_NORM
#define REP_NORM 1
#endif

constexpr size_t MiB = 1u << 20;
constexpr size_t WS_CTL = 0, CTL_ZERO_BYTES = 1 * MiB;
constexpr size_t WS_TAB = 1 * MiB;
constexpr size_t TAB_COS = 0, TAB_SIN = 262144, TAB_LB = 524288;
constexpr size_t WS_WHG = 2 * MiB;
constexpr size_t WS_WAT = 82 * MiB;
constexpr size_t WS_WO = 226 * MiB;
constexpr size_t WS_WF1 = 258 * MiB;
constexpr size_t WS_WF2 = 434 * MiB;
constexpr size_t WS_H = 522 * MiB;
constexpr size_t WS_PROJ = 554 * MiB;
constexpr size_t WS_MIX = 842 * MiB;
constexpr size_t WS_O = 942 * MiB;
constexpr size_t WS_G = 974 * MiB;
constexpr size_t WS_KH = 1006 * MiB;
constexpr size_t WS_END = 1076 * MiB;
constexpr int CW_BAR = 4096;

constexpr int RING_BYTES = 147456;
constexpr int LDSCTL_OFF = RING_BYTES, MISC_OFF = LDSCTL_OFF + 320;
constexpr int LDS_BYTES = 163840;

__device__ __forceinline__ float bf2f(unsigned short b) { return __builtin_bit_cast(float, (unsigned)b << 16); }
__device__ __forceinline__ float bflo(unsigned w) { return __builtin_bit_cast(float, w << 16); }
__device__ __forceinline__ float bfhi(unsigned w) { return __builtin_bit_cast(float, w & 0xffff0000u); }
__device__ __forceinline__ float wave_sum(float v) {
#pragma unroll
    for (int o = 1; o < 64; o <<= 1) v += __shfl_xor(v, o);
    return v;
}
__device__ __forceinline__ float sigmoid_f(float x) { return __builtin_amdgcn_rcpf(1.0f + __builtin_amdgcn_exp2f(-1.44269504f * x)); }

__device__ __forceinline__ void transpose_item(const float* W, int K, int N, bf16* WT, int k0, int n0, int drow0, LAS float* scr, int lane) {
#pragma unroll 8
    for (int i = 0; i < 32; ++i) { const int kk = 2 * i + (lane >> 5); scr[kk * 33 + (lane & 31)] = W[(size_t)(k0 + kk) * N + n0 + (lane & 31)]; }
    LDS_WAIT(); asm volatile("" ::: "memory");
    const int c = lane & 7;
#pragma unroll
    for (int j = 0; j < 4; ++j) { const int n = (lane >> 3) + 8 * j; const LAS float* s = scr + (8 * c) * 33 + n;
        v4u o; o.x = pk2(s[0 * 33], s[1 * 33]); o.y = pk2(s[2 * 33], s[3 * 33]); o.z = pk2(s[4 * 33], s[5 * 33]); o.w = pk2(s[6 * 33], s[7 * 33]);
        *(GAS v4u*)(WT + (size_t)(drow0 + n) * K + k0 + 8 * c) = o; }
    LDS_WAIT(); asm volatile("" ::: "memory");
}
__device__ __forceinline__ void transpose_matrix(const float* W, int K, int N, bf16* WT, int mode, LAS float* scr, int gw, int NGW, int lane) {
    const int nblk = N / 32, nitems = (K / 64) * nblk;
    for (int it = gw; it < nitems; it += NGW) {
        const int kb = it / nblk, nb = it - kb * nblk, n0 = 32 * nb;
        int drow0 = n0;
        if (mode == 1) { const int up = n0 >= DFF, nn = up ? n0 - DFF : n0; drow0 = (nn >> 7) * 256 + (up ? 128 : 0) + (nn & 127); }
        transpose_item(W, K, N, WT, 64 * kb, n0, drow0, scr, lane);
    }
}

template <bool RES, bool NORM2, bool XI16, bool XO16>
__device__ __forceinline__ void norm_rows(const bf16* gin, const void* x_in, void* x_out, const float* w1, const float* w2, bf16* hout, int gw, int NGW, int lane) {
    for (int m = gw; m < M; m += NGW) {
        float xv[4][8];
#pragma unroll
        for (int j = 0; j < 4; ++j) {
            if (XI16) { const v4u g = *(const GAS v4u*)((const bf16*)x_in + (size_t)m * D + 8 * (64 * j + lane));
                xv[j][0] = bflo(g.x); xv[j][1] = bfhi(g.x); xv[j][2] = bflo(g.y); xv[j][3] = bfhi(g.y); xv[j][4] = bflo(g.z); xv[j][5] = bfhi(g.z); xv[j][6] = bflo(g.w); xv[j][7] = bfhi(g.w); }
            else { const GAS f32x4* xp = (const GAS f32x4*)((const float*)x_in + (size_t)m * D + 8 * (64 * j + lane));
                const f32x4 a = xp[0], b = xp[1]; xv[j][0] = a.x; xv[j][1] = a.y; xv[j][2] = a.z; xv[j][3] = a.w; xv[j][4] = b.x; xv[j][5] = b.y; xv[j][6] = b.z; xv[j][7] = b.w; } }
        if (RES) {
            float gv[4][8]; float ss = 0.f;
#pragma unroll
            for (int j = 0; j < 4; ++j) { const v4u g = *(const GAS v4u*)(gin + (size_t)m * D + 8 * (64 * j + lane));
                gv[j][0] = bflo(g.x); gv[j][1] = bfhi(g.x); gv[j][2] = bflo(g.y); gv[j][3] = bfhi(g.y); gv[j][4] = bflo(g.z); gv[j][5] = bfhi(g.z); gv[j][6] = bflo(g.w); gv[j][7] = bfhi(g.w);
#pragma unroll
                for (int i = 0; i < 8; ++i) ss += gv[j][i] * gv[j][i]; }
            const float r1 = 1.0f / sqrtf(wave_sum(ss) * (1.0f / D) + EPS);
#pragma unroll
            for (int j = 0; j < 4; ++j) { const GAS f32x4* wp = (const GAS f32x4*)(w1 + 8 * (64 * j + lane)); const f32x4 a = wp[0], b = wp[1];
                const float wv[8] = {a.x, a.y, a.z, a.w, b.x, b.y, b.z, b.w};
#pragma unroll
                for (int i = 0; i < 8; ++i) xv[j][i] += gv[j][i] * r1 * wv[i];
                if (XO16) { v4u o; o.x = pk2(xv[j][0], xv[j][1]); o.y = pk2(xv[j][2], xv[j][3]); o.z = pk2(xv[j][4], xv[j][5]); o.w = pk2(xv[j][6], xv[j][7]);
                    *(GAS v4u*)((bf16*)x_out + (size_t)m * D + 8 * (64 * j + lane)) = o; }
                else { GAS f32x4* op = (GAS f32x4*)((float*)x_out + (size_t)m * D + 8 * (64 * j + lane));
                    op[0] = (f32x4){xv[j][0], xv[j][1], xv[j][2], xv[j][3]}; op[1] = (f32x4){xv[j][4], xv[j][5], xv[j][6], xv[j][7]}; } }
        }
        if (NORM2) {
            float ss = 0.f;
#pragma unroll
            for (int j = 0; j < 4; ++j)
#pragma unroll
                for (int i = 0; i < 8; ++i) ss += xv[j][i] * xv[j][i];
            const float r2 = 1.0f / sqrtf(wave_sum(ss) * (1.0f / D) + EPS);
#pragma unroll
            for (int j = 0; j < 4; ++j) { const GAS f32x4* wp = (const GAS f32x4*)(w2 + 8 * (64 * j + lane)); const f32x4 a = wp[0], b = wp[1];
                v4u o; o.x = pk2(xv[j][0] * r2 * a.x, xv[j][1] * r2 * a.y); o.y = pk2(xv[j][2] * r2 * a.z, xv[j][3] * r2 * a.w);
                o.z = pk2(xv[j][4] * r2 * b.x, xv[j][5] * r2 * b.y); o.w = pk2(xv[j][6] * r2 * b.z, xv[j][7] * r2 * b.w);
                *(GAS v4u*)(hout + (size_t)m * D + 8 * (64 * j + lane)) = o; }
        }
    }
}

__device__ __forceinline__ void hgrn_core_simple(LAS unsigned char* lds, const bf16* P, const float* lbt, bf16* OD, int tid) {
    const int chain = blockIdx.x;
    if (chain >= 64) return;
    const int b = chain >> 5, hh = (chain >> 1) & 15, dir = chain & 1;
    LAS float* qs = (LAS float*)lds; LAS float* ks = qs + 4096; LAS float* fs = ks + 4096; LAS float* vs = fs + 4096;
    const int v = tid >> 2, dg = tid & 3;
    float S[32];
#pragma unroll
    for (int j = 0; j < 32; ++j) S[j] = 0.f;
    const float* lb = lbt + (size_t)dir * 4 * D + hh * HD;
    bf16* od = OD + (size_t)dir * M * D;
    for (int blk = 0; blk < SEQ / 32; ++blk) {
        __syncthreads();
        for (int e = tid; e < 4096; e += NTHREADS) {
            const int tt = e >> 7, d = e & 127; const int ts = blk * 32 + tt; const int t = dir ? (SEQ - 1 - ts) : ts;
            const bf16* row = P + (size_t)(b * SEQ + t) * HGRN_N + hh * HD + d;
            const float qv = bf2f(row[0]); const float fv = bf2f(row[(1 + dir) * D]); const float iv = bf2f(row[3 * D]);
            const float lbv = lb[d]; const float fg = lbv + (1.0f - lbv) * sigmoid_f(fv);
            qs[e] = qv * sigmoid_f(qv); ks[e] = 1.0f - fg; fs[e] = fg; vs[e] = iv;
        }
        __syncthreads();
        for (int tt = 0; tt < 32; ++tt) {
            const float vt = vs[tt * 128 + v]; float o = 0.f;
            const LAS float* qr = qs + tt * 128 + dg * 32; const LAS float* kr = ks + tt * 128 + dg * 32; const LAS float* fr = fs + tt * 128 + dg * 32;
#pragma unroll
            for (int j = 0; j < 32; ++j) { S[j] = fr[j] * S[j] + kr[j] * vt; o += qr[j] * S[j]; }
            o += __shfl_xor(o, 1); o += __shfl_xor(o, 2);
            const int ts = blk * 32 + tt; const int t = dir ? (SEQ - 1 - ts) : ts;
            if (dg == 0) od[(size_t)(b * SEQ + t) * D + hh * HD + v] = (bf16)f2bf(o);
        }
    }
}
__device__ __forceinline__ void hgrn_finalize(const bf16* P, const bf16* OD, const float* gnorm, bf16* O, int gw, int NGW, int lane) {
    for (int m = gw; m < M; m += NGW) {
#pragma unroll
        for (int j = 0; j < 4; ++j) {
            const int e0 = 8 * (64 * j + lane);
            const v4u a = *(const GAS v4u*)(OD + (size_t)m * D + e0), b = *(const GAS v4u*)(OD + (size_t)M * D + (size_t)m * D + e0);
            const v4u g = *(const GAS v4u*)(P + (size_t)m * HGRN_N + 4 * D + e0);
            float s[8] = {bflo(a.x) + bflo(b.x), bfhi(a.x) + bfhi(b.x), bflo(a.y) + bflo(b.y), bfhi(a.y) + bfhi(b.y), bflo(a.z) + bflo(b.z), bfhi(a.z) + bfhi(b.z), bflo(a.w) + bflo(b.w), bfhi(a.w) + bfhi(b.w)};
            const float gv[8] = {bflo(g.x), bfhi(g.x), bflo(g.y), bfhi(g.y), bflo(g.z), bfhi(g.z), bflo(g.w), bfhi(g.w)};
            float ss = 0.f;
#pragma unroll
            for (int i = 0; i < 8; ++i) ss += s[i] * s[i];
            ss += __shfl_xor(ss, 1); ss += __shfl_xor(ss, 2); ss += __shfl_xor(ss, 4); ss += __shfl_xor(ss, 8);
            const float r = 1.0f / sqrtf(ss * (1.0f / HD) + EPS);
            const GAS f32x4* wp = (const GAS f32x4*)(gnorm + (e0 & 127)); const f32x4 wa = wp[0], wb = wp[1];
            const float wv[8] = {wa.x, wa.y, wa.z, wa.w, wb.x, wb.y, wb.z, wb.w};
            float o[8];
#pragma unroll
            for (int i = 0; i < 8; ++i) o[i] = s[i] * r * wv[i] * (gv[i] * sigmoid_f(gv[i]));
            v4u w; w.x = pk2(o[0], o[1]); w.y = pk2(o[2], o[3]); w.z = pk2(o[4], o[5]); w.w = pk2(o[6], o[7]);
            *(GAS v4u*)(O + (size_t)m * D + e0) = w;
        }
    }
}

__device__ __forceinline__ void rope_pair(float& x0, float& x1, const float* cosT, const float* sinT, int pos, int lane) {
    const float p0 = __shfl_xor(x0, 8), p1 = __shfl_xor(x1, 8);
    if (lane < 16) {
        const int dd = 2 * (lane & 7);
        const float c0 = cosT[pos * 16 + dd], c1 = cosT[pos * 16 + dd + 1], s0 = sinT[pos * 16 + dd], s1 = sinT[pos * 16 + dd + 1];
        if (lane < 8) { x0 = x0 * c0 - p0 * s0; x1 = x1 * c1 - p1 * s1; }
        else          { x0 = x0 * c0 + p0 * s0; x1 = x1 * c1 + p1 * s1; }
    }
}
__device__ __forceinline__ void attn_core_simple(const bf16* P, const float* cosT, const float* sinT, bf16* OG, float* LSE, int gw, int NGW, int lane) {
    const float scale = 0.08838834764831845f;
    for (int task = gw; task < M * NH * 3; task += NGW) {
        const int g = task % 3, rh = task / 3, hh = rh & 15, row = rh >> 4, b = row >> 12, t = row & (SEQ - 1);
        const int r = (g == 0) ? 1 : (g == 1 ? 4 : 16);
        const unsigned qq = ((const GAS unsigned*)(P + (size_t)row * ATTN_N + ((g * 3 + 0) * NH + hh) * HD))[lane];
        float q0 = bflo(qq), q1 = bfhi(qq);
        float mx = -1e30f, l = 0.f, o0 = 0.f, o1 = 0.f;
        for (int j = -64; j <= 64; ++j) {
            const int tk = t + r * j;
            if (tk < 0 || tk >= SEQ) continue;
            const bf16* krow = P + (size_t)(b * SEQ + tk) * ATTN_N + ((g * 3 + 1) * NH + hh) * HD;
            const unsigned kk = ((const GAS unsigned*)krow)[lane]; const unsigned vv = ((const GAS unsigned*)(krow + NH * HD))[lane];
            float k0 = bflo(kk), k1 = bfhi(kk);
            const float s = wave_sum(q0 * k0 + q1 * k1) * scale;
            const float mn = fmaxf(mx, s), c = __expf(mx - mn), p = __expf(s - mn);
            l = l * c + p; o0 = o0 * c + p * bflo(vv); o1 = o1 * c + p * bfhi(vv); mx = mn;
        }
        const float il = 1.0f / l;
        ((GAS unsigned*)(OG + ((size_t)g * M + row) * D + hh * HD))[lane] = pk2(o0 * il, o1 * il);
        if (lane == 0) LSE[((size_t)g * M + row) * NH + hh] = mx + __logf(l);
    }
}
__device__ __forceinline__ void attn_finalize(const bf16* OG, const float* LSE, bf16* O, int gw, int NGW, int lane) {
    for (int m = gw; m < M; m += NGW) {
#pragma unroll
        for (int j = 0; j < 4; ++j) {
            const int e0 = 8 * (64 * j + lane), hh = e0 >> 7;
            const float l0 = LSE[((size_t)0 * M + m) * NH + hh], l1 = LSE[((size_t)1 * M + m) * NH + hh], l2 = LSE[((size_t)2 * M + m) * NH + hh];
            const float mx = fmaxf(l0, fmaxf(l1, l2)); float w0 = __expf(l0 - mx), w1 = __expf(l1 - mx), w2 = __expf(l2 - mx);
            const float inv = 1.0f / (w0 + w1 + w2); w0 *= inv; w1 *= inv; w2 *= inv;
            const v4u a = *(const GAS v4u*)(OG + ((size_t)0 * M + m) * D + e0), b = *(const GAS v4u*)(OG + ((size_t)1 * M + m) * D + e0), c = *(const GAS v4u*)(OG + ((size_t)2 * M + m) * D + e0);
            v4u w;
            w.x = pk2(w0 * bflo(a.x) + w1 * bflo(b.x) + w2 * bflo(c.x), w0 * bfhi(a.x) + w1 * bfhi(b.x) + w2 * bfhi(c.x));
            w.y = pk2(w0 * bflo(a.y) + w1 * bflo(b.y) + w2 * bflo(c.y), w0 * bfhi(a.y) + w1 * bfhi(b.y) + w2 * bfhi(c.y));
            w.z = pk2(w0 * bflo(a.z) + w1 * bflo(b.z) + w2 * bflo(c.z), w0 * bfhi(a.z) + w1 * bfhi(b.z) + w2 * bfhi(c.z));
            w.w = pk2(w0 * bflo(a.w) + w1 * bflo(b.w) + w2 * bflo(c.w), w0 * bfhi(a.w) + w1 * bfhi(b.w) + w2 * bfhi(c.w));
            *(GAS v4u*)(O + (size_t)m * D + e0) = w;
        }
    }
}

typedef short s16x4 __attribute__((ext_vector_type(4)));
typedef short v4i16_t __attribute__((ext_vector_type(4)));
typedef unsigned v2u __attribute__((ext_vector_type(2)));
__device__ __forceinline__ void glds16(const void* gsrc, unsigned lds_dst) { unsigned keep;
    asm volatile("s_mov_b32 %0, m0\n\ts_mov_b32 m0, %2\n\ts_nop 0\n\tglobal_load_lds_dwordx4 %1, off\n\ts_mov_b32 m0, %0" : "=&s"(keep) : "v"(gsrc), "s"(lds_dst) : "memory"); }
__device__ __forceinline__ s16x4 tr_read(LAS const unsigned char* p) { return __builtin_bit_cast(s16x4, __builtin_amdgcn_ds_read_tr16_b64_v4i16((LAS v4i16_t*)p)); }
__device__ __forceinline__ bf16x8 cat44(s16x4 a, s16x4 b) { return (bf16x8){a[0], a[1], a[2], a[3], b[0], b[1], b[2], b[3]}; }
__device__ __forceinline__ void glds16s(const void* sbase, unsigned voff, unsigned lds_dst) { unsigned keep;
    asm volatile("s_mov_b32 %0, m0\n\ts_mov_b32 m0, %3\n\ts_nop 0\n\tglobal_load_lds_dwordx4 %1, %2\n\ts_mov_b32 m0, %0" : "=&s"(keep) : "v"(voff), "s"(sbase), "s"(lds_dst) : "memory"); }
__device__ __forceinline__ bf16x8 gload16s(const void* sbase, unsigned voff) { return *(const GAS bf16x8*)((const unsigned char*)sbase + voff); }
__device__ __forceinline__ void attn_core_mfma(LAS unsigned char* lds, const bf16* P, bf16* OG, float* LSE, int vcu, int G) {
    int tid_l = threadIdx.x; asm volatile("" : "+v"(tid_l));
    const int tid = tid_l, lane = tid & 63, w = __builtin_amdgcn_readfirstlane(tid >> 6), fr = lane & 15, q4 = lane >> 4;
    const float sc2 = 0.08838834764831845f * 1.44269504f;
    constexpr int RST = 288, K_OFF = 0, V_OFF = 73728;
#define AT_SCHED __builtin_amdgcn_sched_barrier(0)
    int prow[9], pchb[9];
#pragma unroll
    for (int i = 0; i < 9; ++i) { const int sl = (w + 8 * i) * 64 + lane; prow[i] = sl / 18; const int ch = sl - prow[i] * 18; pchb[i] = (ch < 16 ? ch : 0) * 16; }
    const int qp = (lane >> 2) & 3, p4 = lane & 3;
    const int bK = K_OFF + (16 * w + fr) * RST + q4 * 16;
    const int bV = V_OFF + (16 * w + 4 * q4 + qp) * RST + p4 * 8;
#define AT_DECODE(uid_) const int bi = (uid_) & 31, bhg = (uid_) >> 5, g = bhg % 3, bh = bhg / 3, hh = bh & 15, b = bh >> 4; \
        const int rsh = 2 * g, nbs = 5 - rsh, rho = bi >> nbs, blk = bi & ((1 << nbs) - 1), L = SEQ >> rsh, u0 = blk * 128; \
        const bf16* Qb = P + (size_t)b * SEQ * ATTN_N + ((g * 3 + 0) * NH + hh) * HD; const bf16* Kb = Qb + NH * HD; const bf16* Vb = Kb + NH * HD;
#define AT_ROWOFF(i_) ({ int uk_ = u0 - 64 + prow[i_]; uk_ = uk_ < 0 ? 0 : (uk_ >= L ? L - 1 : uk_); (unsigned)(((uk_ << rsh) + rho) * (ATTN_N * 2) + pchb[i_]); })
    bf16x8 qf[4];
    int uid = vcu;
    if (uid < 3072) { AT_DECODE(uid)
#pragma unroll
        for (int i = 0; i < 9; ++i) glds16s(Kb, AT_ROWOFF(i), (unsigned)(size_t)(lds + K_OFF + (w + 8 * i) * 1024));
        const unsigned qo = (unsigned)((((u0 + 16 * w + fr) << rsh) + rho) * (ATTN_N * 2) + 16 * q4);
#pragma unroll
        for (int ks = 0; ks < 4; ++ks) qf[ks] = gload16s(Qb, qo + 64 * ks); }
    for (; uid < 3072; uid += G) {
        AT_DECODE(uid)
        const int qtok = ((u0 + 16 * w + fr) << rsh) + rho;
        asm volatile("s_waitcnt vmcnt(0)" ::: "memory"); asm volatile("" : "+v"(qf[0]), "+v"(qf[1]), "+v"(qf[2]), "+v"(qf[3]));
        __builtin_amdgcn_s_barrier(); asm volatile("" ::: "memory");
#pragma unroll
        for (int i = 0; i < 9; ++i) glds16s(Vb, AT_ROWOFF(i), (unsigned)(size_t)(lds + V_OFF + (w + 8 * i) * 1024));
        f32x4 S[9]; bf16x8 kf[2][3][4];
#pragma unroll
        for (int kt = 0; kt < 9; ++kt) S[kt] = (f32x4){0.f, 0.f, 0.f, 0.f};
        AT_SCHED;
#pragma unroll
        for (int j = 0; j < 3; ++j)
#pragma unroll
            for (int ks = 0; ks < 4; ++ks) kf[0][j][ks] = *(const LAS bf16x8*)(lds + bK + 16 * j * RST + 64 * ks);
        AT_SCHED;
#pragma unroll
        for (int gi = 0; gi < 3; ++gi) {
            if (gi < 2) {
#pragma unroll
                for (int j = 0; j < 3; ++j)
#pragma unroll
                    for (int ks = 0; ks < 4; ++ks) kf[(gi + 1) & 1][j][ks] = *(const LAS bf16x8*)(lds + bK + 16 * (3 * (gi + 1) + j) * RST + 64 * ks);
                AT_SCHED; asm volatile("s_waitcnt lgkmcnt(12)" ::: "memory"); AT_SCHED; }
            else { AT_SCHED; asm volatile("s_waitcnt lgkmcnt(0)" ::: "memory"); AT_SCHED; }
#pragma unroll
            for (int j = 0; j < 3; ++j)
#pragma unroll
                for (int ks = 0; ks < 4; ++ks) S[3 * gi + j] = __builtin_amdgcn_mfma_f32_16x16x32_bf16(kf[gi & 1][j][ks], qf[ks], S[3 * gi + j], 0, 0, 0);
            AT_SCHED; }
        __builtin_amdgcn_s_barrier(); asm volatile("" ::: "memory");
        const int nuid = uid + G; bf16x8 qn[4];
        if (nuid < 3072) { const int uid_n = nuid;
            { const int bi = uid_n & 31, bhg = uid_n >> 5, g = bhg % 3, bh = bhg / 3, hh = bh & 15, b = bh >> 4;
              const int rsh = 2 * g, nbs = 5 - rsh, rho = bi >> nbs, blk = bi & ((1 << nbs) - 1), L = SEQ >> rsh, u0 = blk * 128;
              const bf16* Qb = P + (size_t)b * SEQ * ATTN_N + ((g * 3 + 0) * NH + hh) * HD; const bf16* Kb = Qb + NH * HD;
#pragma unroll
              for (int i = 0; i < 9; ++i) glds16s(Kb, AT_ROWOFF(i), (unsigned)(size_t)(lds + K_OFF + (w + 8 * i) * 1024));
              const unsigned qo = (unsigned)((((u0 + 16 * w + fr) << rsh) + rho) * (ATTN_N * 2) + 16 * q4);
#pragma unroll
              for (int ks = 0; ks < 4; ++ks) qn[ks] = gload16s(Qb, qo + 64 * ks); } }
        else {
#pragma unroll
            for (int ks = 0; ks < 4; ++ks) qn[ks] = qf[ks]; }
        float mx = -1e30f;
#pragma unroll
        for (int kt = 0; kt < 9; ++kt)
#pragma unroll
            for (int r = 0; r < 4; ++r) { const int rr = 4 * q4 + r; const int uk = u0 + 16 * w - 64 + 16 * kt + rr;
                const bool ok = (kt > 0 || rr >= fr) && (kt < 8 || rr <= fr) && uk >= 0 && uk < L;
                const float sv = ok ? S[kt][r] * sc2 : -1e30f; S[kt][r] = sv; mx = fmaxf(mx, sv); }
        mx = fmaxf(mx, __shfl_xor(mx, 16)); mx = fmaxf(mx, __shfl_xor(mx, 32));
        float l = 0.f;
#pragma unroll
        for (int kt = 0; kt < 9; ++kt)
#pragma unroll
            for (int r = 0; r < 4; ++r) { const float pv = __builtin_amdgcn_exp2f(S[kt][r] - mx); S[kt][r] = pv; l += pv; }
        l += __shfl_xor(l, 16); l += __shfl_xor(l, 32);
        bf16x8 pf[5];
#pragma unroll
        for (int pi = 0; pi < 5; ++pi) { const int T0 = 2 * pi, T1 = (2 * pi + 1 < 9) ? 2 * pi + 1 : 8;
            v4u pw; pw.x = pg8::cvt_pk_bf16(S[T0][0], S[T0][1]); pw.y = pg8::cvt_pk_bf16(S[T0][2], S[T0][3]);
            if (2 * pi + 1 < 9) { pw.z = pg8::cvt_pk_bf16(S[T1][0], S[T1][1]); pw.w = pg8::cvt_pk_bf16(S[T1][2], S[T1][3]); } else { pw.z = 0u; pw.w = 0u; }
            pf[pi] = __builtin_bit_cast(bf16x8, pw); }
        if (nuid < 3072) asm volatile("s_waitcnt vmcnt(13)" ::: "memory"); else asm volatile("s_waitcnt vmcnt(0)" ::: "memory");
        __builtin_amdgcn_s_barrier(); asm volatile("" ::: "memory");
        f32x4 O[8]; s16x4 vr[2][8][2];
#pragma unroll
        for (int dt = 0; dt < 8; ++dt) O[dt] = (f32x4){0.f, 0.f, 0.f, 0.f};
        AT_SCHED;
#pragma unroll
        for (int dt = 0; dt < 8; ++dt) { vr[0][dt][0] = tr_read(lds + bV + 0 * RST + 32 * dt); vr[0][dt][1] = tr_read(lds + bV + 16 * RST + 32 * dt); }
        AT_SCHED;
#pragma unroll
        for (int pi = 0; pi < 5; ++pi) {
            if (pi < 4) { const int T0 = 2 * (pi + 1), T1 = (2 * (pi + 1) + 1 < 9) ? 2 * (pi + 1) + 1 : 8;
#pragma unroll
                for (int dt = 0; dt < 4; ++dt) { vr[(pi + 1) & 1][dt][0] = tr_read(lds + bV + 16 * T0 * RST + 32 * dt); vr[(pi + 1) & 1][dt][1] = tr_read(lds + bV + 16 * T1 * RST + 32 * dt); }
                AT_SCHED; asm volatile("s_waitcnt lgkmcnt(8)" ::: "memory"); AT_SCHED;
#pragma unroll
                for (int dt = 4; dt < 8; ++dt) { vr[(pi + 1) & 1][dt][0] = tr_read(lds + bV + 16 * T0 * RST + 32 * dt); vr[(pi + 1) & 1][dt][1] = tr_read(lds + bV + 16 * T1 * RST + 32 * dt); }
                AT_SCHED; }
            else { AT_SCHED; asm volatile("s_waitcnt lgkmcnt(0)" ::: "memory"); AT_SCHED; }
#pragma unroll
            for (int dt = 0; dt < 8; ++dt) O[dt] = __builtin_amdgcn_mfma_f32_16x16x32_bf16(cat44(vr[pi & 1][dt][0], vr[pi & 1][dt][1]), pf[pi], O[dt], 0, 0, 0);
            AT_SCHED; }
        const float il = 1.0f / l;
        const bf16* ob = OG + ((size_t)g * M + (size_t)b * SEQ) * D + hh * HD; const unsigned oo = (unsigned)(qtok * (D * 2) + 8 * q4);
#pragma unroll
        for (int dt = 0; dt < 8; ++dt) { v2u o2; o2.x = pk2(O[dt][0] * il, O[dt][1] * il); o2.y = pk2(O[dt][2] * il, O[dt][3] * il);
            asm volatile("global_store_dwordx2 %0, %1, %2" :: "v"(oo + 32 * dt), "v"(o2), "s"(ob) : "memory"); }
        { const float* lb = LSE + ((size_t)g * M + (size_t)b * SEQ) * NH + hh; const float lv = mx * 0.6931471805599453f + __logf(l);
          const unsigned lo = (unsigned)(qtok * (NH * 4));
          asm volatile("global_store_dword %0, %1, %2" :: "v"(lo), "v"(lv), "s"(lb) : "memory"); }
#pragma unroll
        for (int ks = 0; ks < 4; ++ks) qf[ks] = qn[ks];
    }
    asm volatile("s_waitcnt vmcnt(0) lgkmcnt(0)" ::: "memory"); __builtin_amdgcn_s_barrier(); asm volatile("" ::: "memory");
#undef AT_SCHED
#undef AT_DECODE
#undef AT_ROWOFF
}
typedef float float2_t __attribute__((ext_vector_type(2)));
__device__ __forceinline__ void hgrn_gates(const bf16* P, const float* lbt, bf16* QT, bf16* KT, float* PREF, float* BR, int gw, int NGW, int lane) {
    const unsigned lo = 4u * (unsigned)lane;
    for (int item = gw; item < 8192; item += NGW) {
        const int cb = item & 15, half = (item >> 4) & 1, chunk = (item >> 5) & 127, dir = item >> 12;
        const int cbase = cb * 128; const size_t row0 = (size_t)chunk * 64;
        const float lb0 = lbt[(size_t)dir * 4 * D + cbase + 2 * lane], lb1 = lbt[(size_t)dir * 4 * D + cbase + 2 * lane + 1];
        const unsigned char* fcol = (const unsigned char*)(P + (1 + dir) * D + cbase); const unsigned char* qcol = (const unsigned char*)(P + cbase);
        unsigned char* qt = (unsigned char*)(QT + (size_t)dir * M * D + cbase); unsigned char* kt = (unsigned char*)(KT + (size_t)dir * M * D + cbase);
        unsigned fw[32], qw[32];
#pragma unroll
        for (int j = 0; j < 32; ++j) { const int tau = half ? 32 + j : 31 - j; const size_t t = dir ? row0 + 63 - tau : row0 + tau;
            fw[j] = *(const GAS unsigned*)(fcol + t * (HGRN_N * 2) + lo); qw[j] = *(const GAS unsigned*)(qcol + t * (HGRN_N * 2) + lo); }
        float a0 = 1.f, a1 = 1.f;
#pragma unroll
        for (int j = 0; j < 32; ++j) { const int tau = half ? 32 + j : 31 - j; const size_t t = dir ? row0 + 63 - tau : row0 + tau;
            asm volatile("" : "+v"(fw[j]), "+v"(qw[j]) :: "memory");
            const float g0 = lb0 + (1.0f - lb0) * sigmoid_f(bflo(fw[j])), g1 = lb1 + (1.0f - lb1) * sigmoid_f(bfhi(fw[j]));
            const float q0 = bflo(qw[j]), q1 = bfhi(qw[j]); const float s0 = q0 * sigmoid_f(q0), s1 = q1 * sigmoid_f(q1);
            if (half) { a0 *= g0; a1 *= g1; }
            const float i0 = __builtin_amdgcn_rcpf(fmaxf(a0, 1e-30f)), i1 = __builtin_amdgcn_rcpf(fmaxf(a1, 1e-30f));
            const float e0 = half ? a0 : i0, e1 = half ? a1 : i1, r0 = half ? i0 : a0, r1 = half ? i1 : a1;
            *(GAS unsigned*)(qt + t * (D * 2) + lo) = pk2(s0 * e0, s1 * e1);
            *(GAS unsigned*)(kt + t * (D * 2) + lo) = pk2((1.0f - g0) * r0, (1.0f - g1) * r1);
            if (!half) { a0 *= g0; a1 *= g1; }
        }
        float* dst = (half ? BR : PREF) + ((size_t)dir * (M / 64) + chunk) * D + cbase;
        *(GAS float2_t*)((unsigned char*)dst + 2u * lo) = (float2_t){a0, a1};
    }
}

__device__ __forceinline__ void hgrn_scan_mfma(LAS unsigned char* lds, const bf16* P, const bf16* QT, const bf16* KT, const float* PREF, const float* BR, bf16* OD, int vcu, int G) {
    int tid_l = threadIdx.x; asm volatile("" : "+v"(tid_l));
    const int tid = tid_l, lane = tid & 63, w = __builtin_amdgcn_readfirstlane(tid >> 6), fr = lane & 15, q4 = lane >> 4, vt = w & 1, tt = w >> 1;
    constexpr int QST = 272, KST = 288, VST = 96;
    constexpr int STG = 43008, QS = 0, KS = 17408, VS = 35840, VEC = 41984;
#define HG_SCHED __builtin_amdgcn_sched_barrier(0)
    for (int unit = vcu; unit < 256; unit += G) {
        const int chain = unit >> 2, slice = unit & 3, b = chain >> 5, hh = (chain >> 1) & 15, dir = chain & 1;
        const size_t dOff = (size_t)dir * M * D;
        const int ck0 = dir ? 63 : 0; const size_t tok00 = (size_t)b * SEQ + (size_t)ck0 * 64;
        const unsigned char* src[6]; long sstr[6]; int poff[6];
        const long rstep = (dir ? -64L : 64L);
#pragma unroll
        for (int i = 0; i < 6; ++i) {
            int img, pcl;
            if (i < 2) { img = 0; pcl = w + 8 * i; } else if (i < 4) { img = 1; pcl = w + 8 * (i - 2); }
            else if (i == 4) { img = (w < 2) ? 1 : 2; pcl = (w < 2) ? 16 + w : w - 2; }
            else { img = (w == 1) ? 3 : 0; pcl = (w == 0) ? 16 : w; }
            const int sl = pcl * 64 + lane;
            if (img == 0 || img == 1) { const int RS = img ? 18 : 17; const int row = sl / RS, ch = sl - row * RS, chs = ch < 16 ? ch : 0;
                src[i] = (const unsigned char*)((img ? KT : QT) + dOff + (tok00 + row) * D + hh * HD + chs * 8); sstr[i] = rstep * D * 2; poff[i] = (img ? KS : QS) + pcl * 1024; }
            else if (img == 2) { const int row = sl / 6, ch = sl - row * 6, chs = ch < 4 ? ch : 0;
                src[i] = (const unsigned char*)(P + (tok00 + row) * HGRN_N + 3 * D + hh * HD + slice * 32 + chs * 8); sstr[i] = rstep * HGRN_N * 2; poff[i] = VS + pcl * 1024; }
            else { src[i] = (const unsigned char*)(((lane < 32) ? PREF : BR) + ((size_t)dir * (M / 64) + (tok00 >> 6)) * D + hh * HD + 4 * (lane & 31)); sstr[i] = (dir ? -1L : 1L) * D * 4; poff[i] = VEC; } }
#ifdef PROBE_DMA2
#define HG_STAGE(step_, sb_) do { _Pragma("unroll") for (int i_ = 0; i_ < 6; ++i_) { \
            glds16(src[i_] + (long)(step_) * sstr[i_], (unsigned)(size_t)(lds + (sb_) + poff[i_])); glds16(src[i_] + (long)(step_) * sstr[i_], (unsigned)(size_t)(lds + (sb_) + poff[i_])); } } while (0)
#define HG_W01 "s_waitcnt vmcnt(12)"
#define HG_W2 "s_waitcnt vmcnt(14)"
#else
#define HG_STAGE(step_, sb_) do { _Pragma("unroll") for (int i_ = 0; i_ < 6; ++i_) \
            glds16(src[i_] + (long)(step_) * sstr[i_], (unsigned)(size_t)(lds + (sb_) + poff[i_])); } while (0)
#define HG_W01 "s_waitcnt vmcnt(6)"
#define HG_W2 "s_waitcnt vmcnt(8)"
#endif
        const int qp = (lane >> 2) & 3, p4 = lane & 3;
        const int bQ = QS + (16 * tt + fr) * QST + q4 * 16;
        const int bQ2 = QS + (16 * tt + fr) * QST + q4 * 8;
        const int bK = KS + fr * KST + q4 * 16;
        const int bKc = KS + (4 * q4 + qp) * KST + p4 * 8;
        const int bV = VS + (4 * q4 + qp) * VST + vt * 32 + p4 * 8;
        const int bP = VEC + q4 * 16;
        f32x4 S[8];
#pragma unroll
        for (int T = 0; T < 8; ++T) S[T] = (f32x4){0.f, 0.f, 0.f, 0.f};
        HG_STAGE(0, 0); HG_STAGE(1, STG);
        int sb = 0, sbn = 2 * STG;
        for (int step = 0; step < 64; ++step) {
            if (step < 2) asm volatile(HG_W01 ::: "memory"); else asm volatile(HG_W2 ::: "memory");
            __builtin_amdgcn_s_barrier(); asm volatile("" ::: "memory");
            if (step + 2 < 64) HG_STAGE(step + 2, sbn);
            else { asm volatile("s_waitcnt vmcnt(0)" ::: "memory"); }
            LAS const unsigned char* st = lds + sb;
            HG_SCHED;
            bf16x8 qf[4], kf[4][4]; s16x4 va[2][2];
#pragma unroll
            for (int ks = 0; ks < 4; ++ks) qf[ks] = *(const LAS bf16x8*)(st + bQ + 64 * ks);
#pragma unroll
            for (int ks = 0; ks < 2; ++ks)
#pragma unroll
                for (int s4 = 0; s4 < 4; ++s4) kf[ks][s4] = *(const LAS bf16x8*)(st + bK + 16 * s4 * KST + 64 * ks);
#pragma unroll
            for (int pi = 0; pi < 2; ++pi) { va[pi][0] = tr_read(st + bV + 32 * pi * VST); va[pi][1] = tr_read(st + bV + (32 * pi + 16) * VST); }
            HG_SCHED; asm volatile("s_waitcnt lgkmcnt(0)" ::: "memory"); HG_SCHED;
#pragma unroll
            for (int ks = 2; ks < 4; ++ks)
#pragma unroll
                for (int s4 = 0; s4 < 4; ++s4) kf[ks][s4] = *(const LAS bf16x8*)(st + bK + 16 * s4 * KST + 64 * ks);
            HG_SCHED;
            f32x4 Pt[4];
#pragma unroll
            for (int s4 = 0; s4 < 4; ++s4) Pt[s4] = (f32x4){0.f, 0.f, 0.f, 0.f};
#pragma unroll
            for (int ks = 0; ks < 2; ++ks)
#pragma unroll
                for (int s4 = 0; s4 < 4; ++s4) Pt[s4] = __builtin_amdgcn_mfma_f32_16x16x32_bf16(kf[ks][s4], qf[ks], Pt[s4], 0, 0, 0);
            HG_SCHED; asm volatile("s_waitcnt lgkmcnt(0)" ::: "memory"); HG_SCHED;
            f32x4 pr[8]; s16x4 qa[4], qb[4];
#pragma unroll
            for (int T = 0; T < 8; ++T) pr[T] = *(const LAS f32x4*)(st + bP + 64 * T);
#pragma unroll
            for (int ks = 0; ks < 4; ++ks) { qa[ks] = *(const LAS s16x4*)(st + bQ2 + 64 * ks); qb[ks] = *(const LAS s16x4*)(st + bQ2 + 64 * ks + 32); }
            HG_SCHED;
#pragma unroll
            for (int ks = 2; ks < 4; ++ks)
#pragma unroll
                for (int s4 = 0; s4 < 4; ++s4) Pt[s4] = __builtin_amdgcn_mfma_f32_16x16x32_bf16(kf[ks][s4], qf[ks], Pt[s4], 0, 0, 0);
            HG_SCHED;
            const int tix = 16 * tt + fr;
#pragma unroll
            for (int s4 = 0; s4 < 4; ++s4)
#pragma unroll
                for (int r = 0; r < 4; ++r) { const int six = 16 * s4 + 4 * q4 + r; const bool keep = dir ? (six >= tix) : (six <= tix); Pt[s4][r] = keep ? Pt[s4][r] : 0.f; }
            f32x4 o = (f32x4){0.f, 0.f, 0.f, 0.f};
#pragma unroll
            for (int pi = 0; pi < 2; ++pi) {
                v4u pw; pw.x = pg8::cvt_pk_bf16(Pt[2 * pi][0], Pt[2 * pi][1]); pw.y = pg8::cvt_pk_bf16(Pt[2 * pi][2], Pt[2 * pi][3]);
                pw.z = pg8::cvt_pk_bf16(Pt[2 * pi + 1][0], Pt[2 * pi + 1][1]); pw.w = pg8::cvt_pk_bf16(Pt[2 * pi + 1][2], Pt[2 * pi + 1][3]);
                o = __builtin_amdgcn_mfma_f32_16x16x32_bf16(cat44(va[pi][0], va[pi][1]), __builtin_bit_cast(bf16x8, pw), o, 0, 0, 0); }
            HG_SCHED; asm volatile("s_waitcnt lgkmcnt(0)" ::: "memory"); HG_SCHED;
#pragma unroll
            for (int T = 0; T < 8; ++T) S[T] = S[T] * pr[T];
            s16x4 kc[8][2][2]; f32x4 br[8];
#pragma unroll
            for (int T = 0; T < 4; ++T) { br[T] = *(const LAS f32x4*)(st + bP + 512 + 64 * T);
#pragma unroll
                for (int pi = 0; pi < 2; ++pi) { kc[T][pi][0] = tr_read(st + bKc + 32 * pi * KST + 32 * T); kc[T][pi][1] = tr_read(st + bKc + (32 * pi + 16) * KST + 32 * T); } }
            HG_SCHED;
#pragma unroll
            for (int ks = 0; ks < 4; ++ks) { const int T0 = 2 * ks, T1 = 2 * ks + 1;
                v4u aw; aw.x = pg8::cvt_pk_bf16(S[T0][0], S[T0][1]); aw.y = pg8::cvt_pk_bf16(S[T0][2], S[T0][3]);
                aw.z = pg8::cvt_pk_bf16(S[T1][0], S[T1][1]); aw.w = pg8::cvt_pk_bf16(S[T1][2], S[T1][3]);
                o = __builtin_amdgcn_mfma_f32_16x16x32_bf16(__builtin_bit_cast(bf16x8, aw), cat44(qa[ks], qb[ks]), o, 0, 0, 0); }
            HG_SCHED;
            { const int ck = dir ? 63 - step : step; const size_t tok = (size_t)b * SEQ + (size_t)ck * 64 + 16 * tt + fr;
              v2u o2; o2.x = pk2(o[0], o[1]); o2.y = pk2(o[2], o[3]);
              *(GAS v2u*)(OD + dOff + tok * D + hh * HD + slice * 32 + 16 * vt + 4 * q4) = o2; }
            HG_SCHED; asm volatile("s_waitcnt lgkmcnt(0)" ::: "memory"); HG_SCHED;
#pragma unroll
            for (int T = 4; T < 8; ++T) { br[T] = *(const LAS f32x4*)(st + bP + 512 + 64 * T);
#pragma unroll
                for (int pi = 0; pi < 2; ++pi) { kc[T][pi][0] = tr_read(st + bKc + 32 * pi * KST + 32 * T); kc[T][pi][1] = tr_read(st + bKc + (32 * pi + 16) * KST + 32 * T); } }
            HG_SCHED;
#pragma unroll
            for (int T = 0; T < 4; ++T) {
#pragma unroll
                for (int pi = 0; pi < 2; ++pi) S[T] = __builtin_amdgcn_mfma_f32_16x16x32_bf16(cat44(kc[T][pi][0], kc[T][pi][1]), cat44(va[pi][0], va[pi][1]), S[T], 0, 0, 0);
                S[T] = S[T] * br[T]; }
            HG_SCHED; asm volatile("s_waitcnt lgkmcnt(0)" ::: "memory"); HG_SCHED;
#pragma unroll
            for (int T = 4; T < 8; ++T) {
#pragma unroll
                for (int pi = 0; pi < 2; ++pi) S[T] = __builtin_amdgcn_mfma_f32_16x16x32_bf16(cat44(kc[T][pi][0], kc[T][pi][1]), cat44(va[pi][0], va[pi][1]), S[T], 0, 0, 0);
                S[T] = S[T] * br[T]; }
            HG_SCHED;
            const int t3 = sb; sb = (sb == 2 * STG) ? 0 : sb + STG; sbn = t3;
        }
#undef HG_STAGE
        asm volatile("s_waitcnt vmcnt(0) lgkmcnt(0)" ::: "memory"); __builtin_amdgcn_s_barrier(); asm volatile("" ::: "memory");
    }
#undef HG_SCHED
}
struct Args { const float* in[9]; float* out; unsigned char* ws; int ph_lo, ph_hi; };
__global__ void __launch_bounds__(NTHREADS, 2) fwd(Args args) {
    extern __shared__ __attribute__((aligned(16))) unsigned char lds_raw[];
    LAS unsigned char* lds = (LAS unsigned char*)lds_raw;
    volatile LAS unsigned* MISC = (volatile LAS unsigned*)(lds + MISC_OFF);
    const int G = gridDim.x; const int bx = blockIdx.x;
    const int vcu = (G % 8 == 0) ? (bx % 8) * (G / 8) + bx / 8 : bx;
    const int NGW = G * NWAVES;
    unsigned char* ws = args.ws;
    const float* x_in = args.in[0]; const float* norm_w = args.in[1]; const float* w_in_hgrn = args.in[2]; const float* lbnd = args.in[3]; const float* gnorm = args.in[4];
    const float* w_in_attn = args.in[5]; const float* w_out = args.in[6]; const float* w_ffn_in = args.in[7]; const float* w_ffn_out = args.in[8];
    float* xres = args.out;
    float* cosT = (float*)(ws + WS_TAB + TAB_COS); float* sinT = (float*)(ws + WS_TAB + TAB_SIN); float* lbT = (float*)(ws + WS_TAB + TAB_LB);
    bf16* WHG = (bf16*)(ws + WS_WHG); bf16* WAT = (bf16*)(ws + WS_WAT); bf16* WO = (bf16*)(ws + WS_WO); bf16* WF1 = (bf16*)(ws + WS_WF1); bf16* WF2 = (bf16*)(ws + WS_WF2);
    bf16* H = (bf16*)(ws + WS_H); bf16* PROJ = (bf16*)(ws + WS_PROJ); bf16* MIX = (bf16*)(ws + WS_MIX); bf16* OB = (bf16*)(ws + WS_O); bf16* GB = (bf16*)(ws + WS_G);
    float* LSE = (float*)(ws + WS_MIX + 96 * MiB);
    bf16* QT = (bf16*)(ws + WS_PROJ + 160 * MiB); bf16* KT = (bf16*)(ws + WS_PROJ + 224 * MiB); bf16* KH = (bf16*)(ws + WS_KH);
    bf16* XB = (bf16*)(ws + WS_KH);
    float* XSCR = (float*)(ws + WS_MIX); bf16* HSCR = (bf16*)(ws + WS_MIX + 64 * MiB);
    float* PREF = (float*)(ws + WS_KH + 64 * MiB); float* E63V = (float*)(ws + WS_KH + 66 * MiB);

    for (int u = threadIdx.x; u < (LDS_BYTES - LDSCTL_OFF) / 4; u += NTHREADS) ((LAS unsigned*)(lds + LDSCTL_OFF))[u] = 0u;
    __syncthreads();
    const int lo = args.ph_lo, hi = args.ph_hi;
    const bool use_bar = (hi - lo) > 1;
    XcdBarrier bar; bar.bar = (unsigned*)(ws + WS_CTL) + CW_BAR; bar.x = 0; bar.st = nullptr;
    if (use_bar) bar = xcd_barrier_post((unsigned*)(ws + WS_CTL) + CW_BAR, MISC + 8);
#ifndef MIXMAP
#define MIXMAP vcu
#endif
#define IN(k) (lo <= (k) && (k) < hi)
#define PH_IDS int tid_p = threadIdx.x; asm volatile("" : "+v"(tid_p)); const int lane_p = tid_p & 63; const int wave_p = __builtin_amdgcn_readfirstlane(tid_p >> 6); const int gw_p = vcu * NWAVES + wave_p; (void)lane_p; (void)gw_p;
#ifndef REP_BAR
#define REP_BAR 1
#endif
#define SEAM(k) do { if (IN(k) && IN((k) + 1)) for (int rb = 0; rb < REP_BAR; ++rb) xcd_barrier(bar); } while (0)

    if (IN(0)) for (int rep = 0; rep < REP_PRO; ++rep) {
        PH_IDS
        const int lane = lane_p, gw = gw_p, tid = tid_p;
        LAS float* scr = (LAS float*)(lds + wave_p * 16384);
        for (int s = 0; s < 2; ++s) transpose_matrix(w_in_hgrn + (size_t)s * D * HGRN_N, D, HGRN_N, WHG + (size_t)s * HGRN_N * D, 0, scr, gw, NGW, lane);
        for (int s = 0; s < 2; ++s) transpose_matrix(w_in_attn + (size_t)s * D * ATTN_N, D, ATTN_N, WAT + (size_t)s * ATTN_N * D, 0, scr, gw, NGW, lane);
        for (int s = 0; s < 4; ++s) transpose_matrix(w_out + (size_t)s * D * D, D, D, WO + (size_t)s * D * D, 0, scr, gw, NGW, lane);
        for (int s = 0; s < 4; ++s) transpose_matrix(w_ffn_in + (size_t)s * D * FFN_N, D, FFN_N, WF1 + (size_t)s * FFN_N * D, 1, scr, gw, NGW, lane);
        for (int s = 0; s < 4; ++s) transpose_matrix(w_ffn_out + (size_t)s * DFF * D, DFF, D, WF2 + (size_t)s * D * DFF, 0, scr, gw, NGW, lane);
        const int gt = vcu * NTHREADS + tid, NGT = G * NTHREADS;
        for (int idx = gt; idx < SEQ * 16; idx += NGT) { const int pos = idx >> 4, i = idx & 15;
            const float inv = powf(500000.0f, -(float)(2 * i) / 32.0f); const float ang = (float)pos * inv; cosT[idx] = cosf(ang); sinT[idx] = sinf(ang); }
        for (int idx = gt; idx < 2 * D; idx += NGT) { const int dir = idx >> 11, c = idx & (D - 1);
            float xl[4]; float mx = -3.0e38f;
#pragma unroll
            for (int l = 0; l < 4; ++l) { xl[l] = lbnd[(size_t)(dir * 4 + l) * D + c]; mx = fmaxf(mx, xl[l]); }
            float sum = 0.f;
#pragma unroll
            for (int l = 0; l < 4; ++l) { xl[l] = expf(xl[l] - mx); sum += xl[l]; }
            float cum = 0.f, c0 = 0.f;
#pragma unroll
            for (int l = 0; l < 4; ++l) { cum += xl[l] / sum; if (l == 0) c0 = cum; lbT[(size_t)(dir * 4 + l) * D + c] = cum - c0; } }
        norm_rows<false, true, false, false>(nullptr, x_in, nullptr, nullptr, norm_w, H, gw, NGW, lane);
    }
    SEAM(0);

    for (int L = 0; L < DEPTH; ++L) {
        const int pb = 1 + 9 * L; const bool hg = (L & 1) == 0; const int slot = L >> 1;
        const float* nw = norm_w + (size_t)L * 4 * D;
        const int NPROJ = hg ? HGRN_N : ATTN_N;
        if (IN(pb)) {
            if (hg) for (int rep = 0; rep < REP_INH; ++rep) { pg8::Gemm g{H, WHG + (size_t)slot * HGRN_N * D, M, HGRN_N, D}; pg8::StaticOrder S; S.init(M, HGRN_N, G, bx);
                pg8::EpiBf16<0> E{PROJ, HGRN_N, nullptr, 0, 0, 1.f};
                pg8::gemm_phase<pg8::EpiBf16<0>, pg8::StaticOrder, true, true>(lds, g, S, E); }
            else for (int rep = 0; rep < REP_INA; ++rep) { pg8::Gemm g{H, WAT + (size_t)slot * ATTN_N * D, M, ATTN_N, D}; pg8::StaticOrder S; S.init(M, ATTN_N, G, bx);
                pg8::EpiRope E{PROJ, ATTN_N, cosT, sinT};
                pg8::gemm_phase<pg8::EpiRope, pg8::StaticOrder, true, true>(lds, g, S, E); }
        }
        SEAM(pb);
        if (hg) {
            if (IN(pb + 1)) for (int rep = 0; rep < REP_GATES; ++rep) { PH_IDS hgrn_gates(PROJ, lbT + (size_t)L * D, QT, KT, PREF, E63V, gw_p, NGW, lane_p); }
            SEAM(pb + 1);
        }
        if (IN(pb + 2)) {
            if (hg) for (int rep = 0; rep < REP_SCAN; ++rep) hgrn_scan_mfma(lds, PROJ, QT, KT, PREF, E63V, MIX, MIXMAP, G);
            else for (int rep = 0; rep < REP_ATTN; ++rep) attn_core_mfma(lds, PROJ, MIX, LSE, MIXMAP, G);
        }
        SEAM(pb + 2);
        if (IN(pb + 3)) for (int rep = 0; rep < REP_FIN; ++rep) {
            PH_IDS
            const int lane = lane_p, gw = gw_p;
            if (hg) hgrn_finalize(PROJ, MIX, gnorm + (size_t)slot * HD, OB, gw, NGW, lane);
            else attn_finalize(MIX, LSE, OB, gw, NGW, lane);
        }
        SEAM(pb + 3);
        if (IN(pb + 4)) for (int rep = 0; rep < REP_WO; ++rep) {
            pg8::Gemm g{OB, WO + (size_t)L * D * D, M, D, D}; pg8::StaticOrder S; S.init(M, D, G, bx);
            pg8::EpiBf16<0> E{GB, D, nullptr, 0, 0, 1.f};
            pg8::gemm_phase<pg8::EpiBf16<0>, pg8::StaticOrder, true, true>(lds, g, S, E);
        }
        SEAM(pb + 4);
        if (IN(pb + 5)) for (int rep = 0; rep < REP_NORM; ++rep) { PH_IDS if (L == 0 && rep == 0) norm_rows<true, true, false, true>(GB, x_in, XB, nw + D, nw + 2 * D, H, gw_p, NGW, lane_p);
            else norm_rows<true, true, true, true>(GB, XB, rep ? (void*)XSCR : (void*)XB, nw + D, nw + 2 * D, rep ? HSCR : H, gw_p, NGW, lane_p); }
        SEAM(pb + 5);
        if (IN(pb + 6)) for (int rep = 0; rep < REP_F1; ++rep) {
            pg8::Gemm g{H, WF1 + (size_t)L * FFN_N * D, M, FFN_N, D}; pg8::StaticOrder S; S.init(M, FFN_N, G, bx);
            pg8::EpiSwiGLU E{PROJ, DFF};
            pg8::gemm_phase<pg8::EpiSwiGLU, pg8::StaticOrder, true, true>(lds, g, S, E);
        }
        SEAM(pb + 6);
        if (IN(pb + 7)) for (int rep = 0; rep < REP_F2; ++rep) {
            pg8::Gemm g{PROJ, WF2 + (size_t)L * D * DFF, M, D, DFF}; pg8::StaticOrder S; S.init(M, D, G, bx);
            pg8::EpiBf16<0> E{GB, D, nullptr, 0, 0, 1.f};
            pg8::gemm_phase<pg8::EpiBf16<0>, pg8::StaticOrder, true, true>(lds, g, S, E);
        }
        SEAM(pb + 7);
        if (IN(pb + 8)) for (int rep = 0; rep < REP_NORM; ++rep) {
            PH_IDS
            const int lane = lane_p, gw = gw_p;
            if (L + 1 < DEPTH) norm_rows<true, true, true, true>(GB, XB, rep ? (void*)XSCR : (void*)XB, nw + 3 * D, nw + 4 * D, rep ? HSCR : H, gw, NGW, lane);
            else norm_rows<true, false, true, false>(GB, XB, rep ? XSCR : xres, nw + 3 * D, nullptr, nullptr, gw, NGW, lane);
        }
        SEAM(pb + 8);
    }
#undef IN
#undef SEAM
}

#ifndef MK_PER_PHASE
#define MK_PER_PHASE 0
#endif
extern "C" void kernel_launch(void* const* d_in, const int* in_sizes, int n_in, void* d_out, int out_size, void* d_ws, size_t ws_size, hipStream_t stream) {
    static int grid = 0;
    if (grid == 0) {
        if (n_in != 9 || in_sizes[0] != M * D || out_size != M * D || ws_size < WS_END) { fprintf(stderr, "kernel_launch: unexpected shapes (n_in %d, in0 %d, out %d, ws %zu); nothing launched\n", n_in, n_in > 0 ? in_sizes[0] : -1, out_size, ws_size); grid = -1; return; }
        int dev = 0, cus = 0, per_cu = 0;
        if (hipGetDevice(&dev) != hipSuccess || hipDeviceGetAttribute(&cus, hipDeviceAttributeMultiprocessorCount, dev) != hipSuccess) { grid = -1; return; }
        if (hipFuncSetAttribute((const void*)fwd, hipFuncAttributeMaxDynamicSharedMemorySize, LDS_BYTES) != hipSuccess) { fprintf(stderr, "kernel_launch: hipFuncSetAttribute failed\n"); grid = -1; return; }
        if (hipOccupancyMaxActiveBlocksPerMultiprocessor(&per_cu, (const void*)fwd, NTHREADS, LDS_BYTES) != hipSuccess || per_cu < 1) fprintf(stderr, "kernel_launch: occupancy query reports %d\n", per_cu);
        (void)hipGetLastError();
        grid = cus;
    }
    if (grid < 0) return;
    if (hipMemsetAsync((char*)d_ws + WS_CTL, 0, CTL_ZERO_BYTES, stream) != hipSuccess) return;
    Args a{};
    for (int i = 0; i < 9; ++i) a.in[i] = (const float*)d_in[i];
    a.out = (float*)d_out; a.ws = (unsigned char*)d_ws;
#if MK_PER_PHASE
    for (int p = 0; p < NPHASES; ++p) { a.ph_lo = p; a.ph_hi = p + 1; hipLaunchKernelGGL(fwd, dim3(grid), dim3(NTHREADS), LDS_BYTES, stream, a); }
#else
    a.ph_lo = 0; a.ph_hi = NPHASES; hipLaunchKernelGGL(fwd, dim3(grid), dim3(NTHREADS), LDS_BYTES, stream, a);
#endif
}
```

```cpp
#include <hip/hip_runtime.h>
#include <cstdio>
#include <cstdint>
#ifdef EPI_NT
#define PG8_ST(v, p) __builtin_nontemporal_store((v), (p))
#else
#define PG8_ST(v, p) (*(p) = (v))
#endif
namespace pg8 {
#define PG8_LAS __attribute__((address_space(3)))
typedef unsigned short bf16_t;
typedef short bf16x8 __attribute__((ext_vector_type(8)));
typedef float f32x4 __attribute__((ext_vector_type(4)));
typedef unsigned u32x4 __attribute__((ext_vector_type(4)));
constexpr int BM = 256, BK = 64, HALF = 128, HTB = HALF * BK * 2  , STAGE_BYTES = 8 * HTB, NXCD = 8, WGM = 8;

__host__ __device__ __forceinline__ int lds_byte(int r, int c) { const int st = (r >> 4) * 2 + (c >> 5), rr = r & 15, cc = c & 31, ob = rr * 64 + cc * 2; return st * 1024 + (ob ^ (((ob >> 9) & 1) << 5)); }
__host__ __device__ __forceinline__ void stage_rc(int b, int& R, int& C) { const int st = b / 1024, sb = b % 1024, swz = sb ^ (((sb >> 9) & 1) << 5); R = (st >> 1) * 16 + swz / 64; C = (st & 1) * 32 + (swz % 64) / 2; }
__host__ __device__ __forceinline__ int perm32(int rho) { const int n = rho >> 4, i = rho & 15; return 8 * (i >> 2) + 4 * n + (i & 3); }

struct Unit { int pm, pn; };
struct Gemm { const bf16_t* A; const bf16_t* Bt; int M, N, K; };

struct StaticOrder {
    int nM, nN, nwg, G, c;
    __host__ __device__ void init(int M, int N, int G_, int c_) { nM = M / BM; nN = N / BM; nwg = nM * nN; G = G_; c = c_; }
    __host__ __device__ bool next(int i, Unit& u) const {
        const long L = (long)i * G + c; if (L >= nwg) return false;
        int wgid = (int)L; { const int q = nwg / NXCD, r = nwg % NXCD, xcd = wgid % NXCD, off = wgid / NXCD; wgid = (xcd < r ? xcd * (q + 1) : r * (q + 1) + (xcd - r) * q) + off; }
        const int nig = WGM * nN, gid = wgid / nig, fm = gid * WGM, gsz = (nM - fm) < WGM ? (nM - fm) : WGM;
        u.pm = fm + ((wgid % nig) % gsz); u.pn = (wgid % nig) / gsz; return true;
    }
    __device__ __forceinline__ void a_ready(const Unit&) const {}
    __device__ __forceinline__ void done(const Unit&) const {}
};

__device__ __forceinline__ unsigned cvt_pk_bf16(float lo, float hi) { unsigned r; asm volatile("v_cvt_pk_bf16_f32 %0, %1, %2" : "=v"(r) : "v"(lo), "v"(hi)); return r; }
typedef float f32x2 __attribute__((ext_vector_type(2)));
__device__ __forceinline__ f32x2 gelu_pk(f32x2 v) {
    const f32x2 av = __builtin_elementwise_abs(v), d = av * 0.2316418882f + 1.0f;
    f32x2 t; t.x = __builtin_amdgcn_rcpf(d.x); t.y = __builtin_amdgcn_rcpf(d.y);
    f32x2 q = t * 0.5307027145f + (-0.7265760135f); q = q * t + 0.7107068705f; q = q * t + (-0.142248368f); q = q * t + 0.127414796f; q = q * t;
    const f32x2 s = (v * v) * (-0.72134752044f);
    f32x2 e; e.x = __builtin_amdgcn_exp2f(s.x); e.y = __builtin_amdgcn_exp2f(s.y);
    const f32x2 m = v * (q * e), r = v - m;
    f32x2 o; o.x = v.x < 0.f ? m.x : r.x; o.y = v.y < 0.f ? m.y : r.y; return o;
}

template <int ACT  > struct EpiBf16 {
    static constexpr bool PERM = true, AFTER_DRAIN = false; static_assert(ACT == 0 || ACT == 1, "EpiBf16: ACT is 0 (none) or 1 (gelu_pk)");
    bf16_t* O; int ldc; const float* bias; int split_cols; size_t split_stride; float scale0;
    __device__ __forceinline__ void operator()(const f32x4 (&acc)[2][2][4][2], const Unit& u, int wr, int wc, int fr, int fq) const {
        const int row0 = u.pm * BM + wr * 64 + fr; int colt = u.pn * BM; bf16_t* base = O;
        float sc = 1.f; if (split_cols) { const int t = colt / split_cols; base += (size_t)t * split_stride; colt -= t * split_cols; if (t == 0) sc = scale0; }
        const int col0 = colt + wc * 32 + 8 * fq, bcol0 = u.pn * BM + wc * 32 + 8 * fq;
        f32x4 bv[2][2];
#pragma unroll
        for (int bj = 0; bj < 2; ++bj)
#pragma unroll
            for (int n = 0; n < 2; ++n) bv[bj][n] = bias ? *(const f32x4*)(bias + bcol0 + bj * HALF + 4 * n) : (f32x4){0.f, 0.f, 0.f, 0.f};
#pragma unroll
        for (int ai = 0; ai < 2; ++ai)
#pragma unroll
            for (int m = 0; m < 4; ++m) { bf16_t* rowp = base + (size_t)(row0 + ai * HALF + m * 16) * ldc + col0;
#pragma unroll
                for (int bj = 0; bj < 2; ++bj) { f32x4 v0 = acc[ai][bj][m][0] + bv[bj][0], v1 = acc[ai][bj][m][1] + bv[bj][1];
                    if (ACT == 1) { f32x2 a = gelu_pk((f32x2){v0[0], v0[1]}), b = gelu_pk((f32x2){v0[2], v0[3]}), c = gelu_pk((f32x2){v1[0], v1[1]}), d = gelu_pk((f32x2){v1[2], v1[3]});
                        v0 = (f32x4){a.x, a.y, b.x, b.y}; v1 = (f32x4){c.x, c.y, d.x, d.y}; }
                    v0 = v0 * sc; v1 = v1 * sc; u32x4 w; w.x = cvt_pk_bf16(v0[0], v0[1]); w.y = cvt_pk_bf16(v0[2], v0[3]); w.z = cvt_pk_bf16(v1[0], v1[1]); w.w = cvt_pk_bf16(v1[2], v1[3]);
                    PG8_ST(w, (u32x4*)(rowp + bj * HALF)); } }
    }
};

template <class Epi, class Sched, bool ALIGN_EPI = false, bool SP2 = false>
__device__ __forceinline__ void gemm_phase(PG8_LAS unsigned char* lds, const Gemm g, const Sched& S, const Epi& E) {
    int tid_l = threadIdx.x; asm volatile("" : "+v"(tid_l));
    const int tid = tid_l, wid = __builtin_amdgcn_readfirstlane(tid >> 6), lane = tid & 63, wr = wid >> 2, wc = wid & 3, fr = lane & 15, fq = lane >> 4;
    const int K = g.K, nt = K / BK;
    unsigned voffA[2], voffB[2];
#pragma unroll
    for (int i = 0; i < 2; ++i) { int R, C; stage_rc(tid * 16 + i * 8192, R, C); const int Rb = Epi::PERM ? ((R & ~31) + perm32(R & 31)) : R;
        voffA[i] = (unsigned)(R * K + C) * 2u; voffB[i] = (unsigned)(Rb * K + C) * 2u; }
    const size_t kstep = (size_t)(BK * 2);
    const size_t hstep = (size_t)HALF * K * 2;
    const size_t tstep = 2 * hstep;
    const unsigned ldsw = (unsigned)wid * 1024u;
    const int aoff = lds_byte(wr * 64 + fr, fq * 8), boff = lds_byte(wc * 32 + fr, fq * 8);
#define PG8_SA(b, h) (((b) * 2 + (h)) * HTB)
#define PG8_SB(b, h) ((4 + (b) * 2 + (h)) * HTB)
#define PG8_STAGE(bufoff, gbase, voff) do { _Pragma("unroll") for (int _i = 0; _i < 2; ++_i) \
        __builtin_amdgcn_global_load_lds((const unsigned*)((const char*)(gbase) + (voff)[_i]), (PG8_LAS unsigned*)(lds + (bufoff) + ldsw + _i * 8192), 16, 0, 0); } while (0)
#define PG8_LDA(dst, b, h) do { _Pragma("unroll") for (int m = 0; m < 4; ++m) _Pragma("unroll") for (int k = 0; k < 2; ++k) dst[m][k] = *(const PG8_LAS bf16x8*)(lds + PG8_SA(b, h) + aoff + m * 2048 + k * 1024); } while (0)
#define PG8_LDB(dst, b, h) do { _Pragma("unroll") for (int n = 0; n < 2; ++n) _Pragma("unroll") for (int k = 0; k < 2; ++k) dst[n][k] = *(const PG8_LAS bf16x8*)(lds + PG8_SB(b, h) + boff + n * 2048 + k * 1024); } while (0)
#define PG8_MMA(ai, bj, At, Bt) do { __builtin_amdgcn_s_setprio(1); _Pragma("unroll") for (int m = 0; m < 4; ++m) _Pragma("unroll") for (int n = 0; n < 2; ++n) _Pragma("unroll") for (int k = 0; k < 2; ++k) \
        acc[ai][bj][m][n] = __builtin_amdgcn_mfma_f32_16x16x32_bf16(Bt[n][k], At[m][k], acc[ai][bj][m][n], 0, 0, 0); __builtin_amdgcn_s_setprio(0); } while (0)
#define PG8_WAIT_V(n) asm volatile("s_waitcnt vmcnt(" #n ")" ::: "memory")
#define PG8_WAIT_L(n) asm volatile("s_waitcnt lgkmcnt(" #n ")" ::: "memory")
#define PG8_BAR __builtin_amdgcn_s_barrier()
#define PG8_SCHED __builtin_amdgcn_sched_barrier(0)
    Unit cur, nxt; int ui = 0;
    if (!S.next(0, cur)) return;
    f32x4 acc[2][2][4][2];
#pragma unroll
    for (int a = 0; a < 2; ++a)
#pragma unroll
        for (int b = 0; b < 2; ++b)
#pragma unroll
            for (int m = 0; m < 4; ++m)
#pragma unroll
                for (int n = 0; n < 2; ++n) acc[a][b][m][n] = (f32x4){0.f, 0.f, 0.f, 0.f};
    bf16x8 At[4][2], B0[2][2], B1[2][2];
    const char* cA = (const char*)g.A + (size_t)cur.pm * tstep; const char* cB = (const char*)g.Bt + (size_t)cur.pn * tstep;
    S.a_ready(cur);
    if constexpr (SP2) {
        PG8_STAGE(PG8_SB(0, 0), cB, voffB); PG8_STAGE(PG8_SB(0, 1), cB + hstep, voffB); PG8_STAGE(PG8_SA(0, 0), cA, voffA); PG8_STAGE(PG8_SA(0, 1), cA + hstep, voffA);
        if (wr == 1) PG8_BAR;
        PG8_WAIT_V(2); PG8_BAR;
        PG8_STAGE(PG8_SB(1, 0), cB + kstep, voffB); PG8_STAGE(PG8_SA(1, 0), cA + kstep, voffA); PG8_STAGE(PG8_SB(1, 1), cB + hstep + kstep, voffB);
        PG8_WAIT_V(6); PG8_BAR;
    } else {
        PG8_STAGE(PG8_SB(0, 0), cB, voffB); PG8_STAGE(PG8_SA(0, 0), cA, voffA); PG8_STAGE(PG8_SB(0, 1), cB + hstep, voffB); PG8_STAGE(PG8_SA(0, 1), cA + hstep, voffA);
        if (wr == 1) PG8_BAR;
        PG8_WAIT_V(4); PG8_BAR;
        PG8_STAGE(PG8_SB(1, 0), cB + kstep, voffB); PG8_STAGE(PG8_SA(1, 0), cA + kstep, voffA); PG8_STAGE(PG8_SB(1, 1), cB + hstep + kstep, voffB);
        PG8_WAIT_V(6); PG8_BAR;
    }
    for (;;) {
        const bool has_next = S.next(ui + 1, nxt);
        const char* nA = has_next ? (const char*)g.A + (size_t)nxt.pm * tstep : cA; const char* nB = has_next ? (const char*)g.Bt + (size_t)nxt.pn * tstep : cB;
        for (int t = 0; t < nt; t += 2) {
            const bool last = (t == nt - 2);
            const char* a1 = cA + (size_t)(t + 1) * kstep;
            const char* a2 = last ? nA : cA + (size_t)(t + 2) * kstep; const char* b2 = last ? nB : cB + (size_t)(t + 2) * kstep;
            const char* a3 = a2 + kstep; const char* b3 = b2 + kstep;
            if (last && has_next) S.a_ready(nxt);
            if constexpr (SP2) {
            PG8_LDB(B0, 0, 0); PG8_LDB(B1, 0, 1); PG8_SCHED; PG8_LDA(At, 0, 0); PG8_STAGE(PG8_SA(1, 1), a1 + hstep, voffA);
            PG8_WAIT_V(8); PG8_WAIT_L(0); PG8_BAR; PG8_MMA(0, 0, At, B0); PG8_MMA(0, 1, At, B1); PG8_BAR; PG8_SCHED;
            PG8_LDA(At, 0, 1); PG8_STAGE(PG8_SB(0, 0), b2, voffB); PG8_STAGE(PG8_SB(0, 1), b2 + hstep, voffB); PG8_STAGE(PG8_SA(0, 0), a2, voffA);
            PG8_WAIT_V(8); PG8_WAIT_L(0); PG8_BAR; PG8_MMA(1, 0, At, B0); PG8_MMA(1, 1, At, B1); PG8_BAR; PG8_SCHED;
            PG8_LDB(B0, 1, 0); PG8_LDB(B1, 1, 1); PG8_SCHED; PG8_LDA(At, 1, 0); PG8_STAGE(PG8_SA(0, 1), a2 + hstep, voffA);
            PG8_WAIT_V(8); PG8_WAIT_L(0); PG8_BAR; PG8_MMA(0, 0, At, B0); PG8_MMA(0, 1, At, B1); PG8_BAR; PG8_SCHED;
            PG8_LDA(At, 1, 1); PG8_STAGE(PG8_SB(1, 0), b3, voffB); PG8_STAGE(PG8_SB(1, 1), b3 + hstep, voffB); PG8_STAGE(PG8_SA(1, 0), a3, voffA);
            PG8_WAIT_V(8); PG8_WAIT_L(0); PG8_BAR; PG8_MMA(1, 0, At, B0); PG8_MMA(1, 1, At, B1); PG8_BAR; PG8_SCHED;
            } else {
            PG8_LDB(B0, 0, 0); PG8_SCHED; PG8_LDA(At, 0, 0); PG8_STAGE(PG8_SA(1, 1), a1 + hstep, voffA);
            PG8_WAIT_L(8); PG8_BAR; PG8_WAIT_L(0); PG8_MMA(0, 0, At, B0); PG8_BAR; PG8_SCHED;
            PG8_LDB(B1, 0, 1); PG8_STAGE(PG8_SB(0, 0), b2, voffB);
            PG8_BAR; PG8_WAIT_L(0); PG8_MMA(0, 1, At, B1); PG8_BAR;
            PG8_LDA(At, 0, 1); PG8_STAGE(PG8_SA(0, 0), a2, voffA);
            PG8_BAR; PG8_WAIT_L(0); PG8_MMA(1, 0, At, B0); PG8_BAR; PG8_SCHED;
            PG8_STAGE(PG8_SB(0, 1), b2 + hstep, voffB);
            PG8_WAIT_V(6); PG8_BAR; PG8_MMA(1, 1, At, B1); PG8_BAR;
            PG8_LDB(B0, 1, 0); PG8_SCHED; PG8_LDA(At, 1, 0); PG8_STAGE(PG8_SA(0, 1), a2 + hstep, voffA);
            PG8_WAIT_L(8); PG8_BAR; PG8_WAIT_L(0); PG8_MMA(0, 0, At, B0); PG8_BAR; PG8_SCHED;
            PG8_LDB(B1, 1, 1); PG8_STAGE(PG8_SB(1, 0), b3, voffB);
            PG8_BAR; PG8_WAIT_L(0); PG8_MMA(0, 1, At, B1); PG8_BAR;
            PG8_LDA(At, 1, 1); PG8_STAGE(PG8_SA(1, 0), a3, voffA);
            PG8_BAR; PG8_WAIT_L(0); PG8_MMA(1, 0, At, B0); PG8_BAR; PG8_SCHED;
            PG8_STAGE(PG8_SB(1, 1), b3 + hstep, voffB);
            PG8_WAIT_V(6); PG8_BAR; PG8_MMA(1, 1, At, B1); PG8_BAR;
            }
        }
        if constexpr (ALIGN_EPI) { if (wr == 0) PG8_BAR; }
        if constexpr (!Epi::AFTER_DRAIN) { E(acc, cur, wr, wc, fr, fq); S.done(cur); }
        if (!has_next) break;
#pragma unroll
        for (int a = 0; a < 2; ++a)
#pragma unroll
            for (int b = 0; b < 2; ++b)
#pragma unroll
                for (int m = 0; m < 4; ++m)
#pragma unroll
                    for (int n = 0; n < 2; ++n) acc[a][b][m][n] = (f32x4){0.f, 0.f, 0.f, 0.f};
        cur = nxt; cA = nA; cB = nB; ++ui;
        if constexpr (ALIGN_EPI) { if (wr == 1) PG8_BAR; }
    }
    PG8_WAIT_V(0);
    if constexpr (!ALIGN_EPI) { if (wr == 0) PG8_BAR; }
    PG8_BAR;
    if constexpr (Epi::AFTER_DRAIN) { E.fused(acc, cur, wr, wc, fr, fq, lds, wid, lane); S.done(cur); }
#undef PG8_SA
#undef PG8_SB
#undef PG8_STAGE
#undef PG8_LDA
#undef PG8_LDB
#undef PG8_MMA
#undef PG8_WAIT_V
#undef PG8_WAIT_L
#undef PG8_BAR
#undef PG8_SCHED
}
}
namespace pg8 {
__device__ __forceinline__ float silu_f(float x) { return x * __builtin_amdgcn_rcpf(1.0f + __builtin_amdgcn_exp2f(-1.44269504f * x)); }
struct EpiSwiGLU {
    static constexpr bool PERM = true, AFTER_DRAIN = false;
    bf16_t* O; int ldc;
    __device__ __forceinline__ void operator()(const f32x4 (&acc)[2][2][4][2], const Unit& u, int wr, int wc, int fr, int fq) const {
        const int row0 = u.pm * BM + wr * 64 + fr; const int col0 = u.pn * HALF + wc * 32 + 8 * fq;
#pragma unroll
        for (int ai = 0; ai < 2; ++ai)
#pragma unroll
            for (int m = 0; m < 4; ++m) { bf16_t* rowp = O + (size_t)(row0 + ai * HALF + m * 16) * ldc + col0;
                const f32x4 g0 = acc[ai][0][m][0], g1 = acc[ai][0][m][1], u0 = acc[ai][1][m][0], u1 = acc[ai][1][m][1];
                u32x4 w; w.x = cvt_pk_bf16(silu_f(g0[0]) * u0[0], silu_f(g0[1]) * u0[1]); w.y = cvt_pk_bf16(silu_f(g0[2]) * u0[2], silu_f(g0[3]) * u0[3]);
                w.z = cvt_pk_bf16(silu_f(g1[0]) * u1[0], silu_f(g1[1]) * u1[1]); w.w = cvt_pk_bf16(silu_f(g1[2]) * u1[2], silu_f(g1[3]) * u1[3]);
                PG8_ST(w, (u32x4*)rowp); }
    }
};
}
namespace pg8 {
struct EpiRope {
    static constexpr bool PERM = true, AFTER_DRAIN = false;
    bf16_t* O; int ldc; const float* cosT; const float* sinT;
    __device__ __forceinline__ void operator()(const f32x4 (&acc)[2][2][4][2], const Unit& u, int wr, int wc, int fr, int fq) const {
        const int row0 = u.pm * BM + wr * 64 + fr; const int colt = u.pn * BM; const int col0 = colt + wc * 32 + 8 * fq;
        const bool rot = (((colt >> 11) % 3) < 2) && (wc == 0);
        const int dd0 = 8 * (fq & 1); const float sgn = (fq < 2) ? -1.0f : 1.0f;
#pragma unroll
        for (int ai = 0; ai < 2; ++ai)
#pragma unroll
            for (int m = 0; m < 4; ++m) { const int row = row0 + ai * HALF + m * 16; bf16_t* rowp = O + (size_t)row * ldc + col0;
                f32x4 c0 = (f32x4){1.f, 1.f, 1.f, 1.f}, c1 = c0, s0 = (f32x4){0.f, 0.f, 0.f, 0.f}, s1 = s0;
                if (rot) { const int pos = row & 4095; const f32x4* cp = (const f32x4*)(cosT + pos * 16 + dd0); const f32x4* sp = (const f32x4*)(sinT + pos * 16 + dd0);
                    c0 = cp[0]; c1 = cp[1]; s0 = sp[0] * sgn; s1 = sp[1] * sgn; }
#pragma unroll
                for (int bj = 0; bj < 2; ++bj) { f32x4 v0 = acc[ai][bj][m][0], v1 = acc[ai][bj][m][1];
                    if (rot) { f32x4 p0, p1;
#pragma unroll
                        for (int i = 0; i < 4; ++i) { p0[i] = __shfl_xor(v0[i], 32); p1[i] = __shfl_xor(v1[i], 32); }
                        v0 = v0 * c0 + p0 * s0; v1 = v1 * c1 + p1 * s1; }
                    u32x4 w; w.x = cvt_pk_bf16(v0[0], v0[1]); w.y = cvt_pk_bf16(v0[2], v0[3]); w.z = cvt_pk_bf16(v1[0], v1[1]); w.w = cvt_pk_bf16(v1[2], v1[3]);
                    PG8_ST(w, (u32x4*)(rowp + bj * HALF)); } }
    }
};
}
#define GAS __attribute__((address_space(1)))
#define LAS __attribute__((address_space(3)))
typedef unsigned short bf16;
typedef unsigned v4u __attribute__((ext_vector_type(4)));
typedef float f32x4 __attribute__((ext_vector_type(4)));
typedef short bf16x8 __attribute__((ext_vector_type(8)));
typedef GAS unsigned gu32;
typedef GAS unsigned long long gu64;
#define RLX_AGENT __ATOMIC_RELAXED, __HIP_MEMORY_SCOPE_AGENT
#define LDS_WAIT() asm volatile("s_waitcnt lgkmcnt(0)" ::: "memory")
#define VM_WAIT() asm volatile("s_waitcnt vmcnt(0)" ::: "memory")
__device__ __forceinline__ unsigned long long rt() { return __builtin_amdgcn_s_memrealtime(); }
__device__ __forceinline__ unsigned f2bf(float f) { unsigned u = __builtin_bit_cast(unsigned, f); return (u + 0x7fffu + ((u >> 16) & 1u)) >> 16; }
__device__ __forceinline__ unsigned pk2(float lo, float hi) { return f2bf(lo) | (f2bf(hi) << 16); }

#define XB_TMO      128
#define XB_XCNT(j)  (256  + 64 * (j))
#define XB_XSUB(j)  (1280 + 64 * (j))
#define XB_XGEN(j)  (2304 + 64 * (j))
#define XB_TOP      3328
#define XB_TOPGEN   3392
#define XCD_BAR_WORDS 3456
#define XB_SPIN_CAP (1u << 18)

__device__ __forceinline__ unsigned xb_ld(unsigned* p)              { return __hip_atomic_load(p, __ATOMIC_RELAXED, __HIP_MEMORY_SCOPE_AGENT); }
__device__ __forceinline__ unsigned xb_add(unsigned* p, unsigned v) { return __hip_atomic_fetch_add(p, v, __ATOMIC_RELAXED, __HIP_MEMORY_SCOPE_AGENT); }
__device__ __forceinline__ unsigned xb_xcc_id() { return (unsigned)__builtin_amdgcn_s_getreg((3 << 11) | 20) & 0xFu; }
#define XB_SPIN(cond, bar) do { unsigned _sp = 0; while (cond) { __builtin_amdgcn_s_sleep(1); \
    if ((++_sp & 255u) == 0u) { if (xb_ld(&(bar)[XB_TMO])) break; if (_sp > XB_SPIN_CAP) { atomicAdd(&(bar)[XB_TMO], 1u); break; } } } } while (0)

struct XcdBarrier {
    unsigned* bar; unsigned x;
    volatile LAS unsigned* st;
};

__device__ __forceinline__ XcdBarrier xcd_barrier_post(unsigned* bar, volatile LAS unsigned* st) {
    XcdBarrier b; b.bar = bar; b.x = xb_xcc_id(); b.st = st;
    if (threadIdx.x == 0) (void)xb_add(&bar[XB_XCNT(b.x)], 1u);
    return b;
}
__device__ __forceinline__ void xcd_barrier_complete(unsigned* bar, unsigned x, unsigned& nloc, unsigned& nx) {
    const unsigned G = gridDim.x * gridDim.y * gridDim.z;
    unsigned sum, cnt, mine, sp = 0u;
    for (;;) {
        sum = 0u; cnt = 0u; mine = 0u;
#pragma unroll
        for (unsigned j = 0; j < 16; ++j) { const unsigned c = xb_ld(&bar[XB_XCNT(j)]); sum += c; cnt += (c > 0u) ? 1u : 0u; mine = (j == x) ? c : mine; }
        if (sum == G) break;
        __builtin_amdgcn_s_sleep(1);
        if ((++sp & 255u) == 0u) { if (xb_ld(&bar[XB_TMO])) break; if (sp > XB_SPIN_CAP) { atomicAdd(&bar[XB_TMO], 1u); break; } }
    }
    nloc = mine > 0u ? mine : 1u; nx = cnt > 0u ? cnt : 1u;
}

__device__ __forceinline__ void xcd_barrier(const XcdBarrier& b) {
    asm volatile("s_waitcnt vmcnt(0)" ::: "memory");
    __syncthreads();
    if (threadIdx.x == 0) {
        unsigned* bar = b.bar;
        __builtin_amdgcn_s_waitcnt(0);
        unsigned nloc = b.st[0], nx = b.st[1];
        if (nloc == 0u) { xcd_barrier_complete(bar, b.x, nloc, nx); b.st[0] = nloc; b.st[1] = nx; }
        const unsigned old = xb_add(&bar[XB_XSUB(b.x)], 1u);
        const unsigned gen = old / nloc;
        if (old + 1u == (gen + 1u) * nloc) {
            __builtin_amdgcn_fence(__ATOMIC_RELEASE, "agent");
            asm volatile("s_waitcnt vmcnt(0)" ::: "memory");
            const unsigned og = xb_add(&bar[XB_TOP], 1u);
            const unsigned tg = og / nx;
            if (og + 1u == (tg + 1u) * nx) xb_add(&bar[XB_TOPGEN], 1u);
            else XB_SPIN(xb_ld(&bar[XB_TOPGEN]) == tg, bar);
            __builtin_amdgcn_fence(__ATOMIC_ACQUIRE, "agent");
            xb_add(&bar[XB_XGEN(b.x)], 1u);
            asm volatile("s_waitcnt vmcnt(0)" ::: "memory");
        } else {
            XB_SPIN(xb_ld(&bar[XB_XGEN(b.x)]) == gen, bar);
            __builtin_amdgcn_fence(__ATOMIC_ACQUIRE, "agent");
            asm volatile("s_waitcnt vmcnt(0)" ::: "memory");
        }
    }
    __syncthreads();
}

constexpr int NWAVES = 8, NTHREADS = 512;
constexpr int BATCH = 2, SEQ = 4096, D = 2048, M = BATCH * SEQ, DEPTH = 4, NH = 16, HD = 128;
constexpr int HGRN_N = 5 * D, ATTN_N = 9 * D, DFF = 5632, FFN_N = 2 * DFF;
constexpr float EPS = 1e-6f;
constexpr int NPHASES = 1 + 9 * DEPTH;
#ifndef REP_PRO
#define REP_PRO 1
#endif
#ifndef REP_INH
#define REP_INH 1
#endif
#ifndef REP_INA_COLD
#define REP_INA_COLD 0
#endif
#ifndef REP_INA
#define REP_INA 1
#endif
#ifndef REP_WO
#define REP_WO 1
#endif
#ifndef REP_F1
#define REP_F1 1
#endif
#ifndef REP_F2
#define REP_F2 1
#endif
#ifndef REP_GATES
#define REP_GATES 1
#endif
#ifndef REP_SCAN
#define REP_SCAN 1
#endif
#ifndef REP_ATTN
#define REP_ATTN 1
#endif
#ifndef REP_FIN
#define REP_FIN 1
#endif
#ifndef REP_NORM
#define REP_NORM 1
#endif

constexpr size_t MiB = 1u << 20;
constexpr size_t WS_CTL = 0, CTL_ZERO_BYTES = 1 * MiB;
constexpr size_t WS_TAB = 1 * MiB;
constexpr size_t TAB_COS = 0, TAB_SIN = 262144, TAB_LB = 524288;
constexpr size_t WS_WHG = 2 * MiB;
constexpr size_t WS_WAT = 82 * MiB;
constexpr size_t WS_WO = 226 * MiB;
constexpr size_t WS_WF1 = 258 * MiB;
constexpr size_t WS_WF2 = 434 * MiB;
constexpr size_t WS_H = 522 * MiB;
constexpr size_t WS_PROJ = 554 * MiB;
constexpr size_t WS_MIX = 842 * MiB;
constexpr size_t WS_O = 942 * MiB;
constexpr size_t WS_G = 974 * MiB;
constexpr size_t WS_KH = 1006 * MiB;
constexpr size_t WS_END = 1076 * MiB;
constexpr int CW_BAR = 4096;

constexpr int RING_BYTES = 147456;
constexpr int LDSCTL_OFF = RING_BYTES, MISC_OFF = LDSCTL_OFF + 320;
constexpr int LDS_BYTES = 163840;

__device__ __forceinline__ float bf2f(unsigned short b) { return __builtin_bit_cast(float, (unsigned)b << 16); }
__device__ __forceinline__ float bflo(unsigned w) { return __builtin_bit_cast(float, w << 16); }
__device__ __forceinline__ float bfhi(unsigned w) { return __builtin_bit_cast(float, w & 0xffff0000u); }
__device__ __forceinline__ float wave_sum(float v) {
#pragma unroll
    for (int o = 1; o < 64; o <<= 1) v += __shfl_xor(v, o);
    return v;
}
__device__ __forceinline__ float sigmoid_f(float x) { return __builtin_amdgcn_rcpf(1.0f + __builtin_amdgcn_exp2f(-1.44269504f * x)); }

__device__ __forceinline__ void transpose_item(const float* W, int K, int N, bf16* WT, int k0, int n0, int drow0, LAS float* scr, int lane) {
    float ld[32];
#pragma unroll
    for (int i = 0; i < 32; ++i) { const int kk = 2 * i + (lane >> 5); ld[i] = W[(size_t)(k0 + kk) * N + n0 + (lane & 31)]; }
#pragma unroll
    for (int i = 0; i < 32; ++i) { const int kk = 2 * i + (lane >> 5); scr[kk * 33 + (lane & 31)] = ld[i]; }
    LDS_WAIT(); asm volatile("" ::: "memory");
    const int c = lane & 7;
#pragma unroll
    for (int j = 0; j < 4; ++j) { const int n = (lane >> 3) + 8 * j; const LAS float* s = scr + (8 * c) * 33 + n;
        v4u o; o.x = pk2(s[0 * 33], s[1 * 33]); o.y = pk2(s[2 * 33], s[3 * 33]); o.z = pk2(s[4 * 33], s[5 * 33]); o.w = pk2(s[6 * 33], s[7 * 33]);
        *(GAS v4u*)(WT + (size_t)(drow0 + n) * K + k0 + 8 * c) = o; }
    LDS_WAIT(); asm volatile("" ::: "memory");
}
__device__ __forceinline__ void transpose_matrix(const float* W, int K, int N, bf16* WT, int mode, LAS float* scr, int gw, int NGW, int lane) {
    const int nblk = N / 32, nitems = (K / 64) * nblk;
    for (int it = gw; it < nitems; it += NGW) {
        const int kb = it / nblk, nb = it - kb * nblk, n0 = 32 * nb;
        int drow0 = n0;
        if (mode == 1) { const int up = n0 >= DFF, nn = up ? n0 - DFF : n0; drow0 = (nn >> 7) * 256 + (up ? 128 : 0) + (nn & 127); }
        transpose_item(W, K, N, WT, 64 * kb, n0, drow0, scr, lane);
    }
}

template <bool RES, bool NORM2, bool XI16, bool XO16>
__device__ __forceinline__ void norm_rows(const bf16* gin, const void* x_in, void* x_out, const float* w1, const float* w2, bf16* hout, int gw, int NGW, int lane) {
    for (int m = gw; m < M; m += NGW) {
        float xv[4][8];
#pragma unroll
        for (int j = 0; j < 4; ++j) {
            if (XI16) { const v4u g = *(const GAS v4u*)((const bf16*)x_in + (size_t)m * D + 8 * (64 * j + lane));
                xv[j][0] = bflo(g.x); xv[j][1] = bfhi(g.x); xv[j][2] = bflo(g.y); xv[j][3] = bfhi(g.y); xv[j][4] = bflo(g.z); xv[j][5] = bfhi(g.z); xv[j][6] = bflo(g.w); xv[j][7] = bfhi(g.w); }
            else { const GAS f32x4* xp = (const GAS f32x4*)((const float*)x_in + (size_t)m * D + 8 * (64 * j + lane));
                const f32x4 a = xp[0], b = xp[1]; xv[j][0] = a.x; xv[j][1] = a.y; xv[j][2] = a.z; xv[j][3] = a.w; xv[j][4] = b.x; xv[j][5] = b.y; xv[j][6] = b.z; xv[j][7] = b.w; } }
        if (RES) {
            float gv[4][8]; float ss = 0.f;
#pragma unroll
            for (int j = 0; j < 4; ++j) { const v4u g = *(const GAS v4u*)(gin + (size_t)m * D + 8 * (64 * j + lane));
                gv[j][0] = bflo(g.x); gv[j][1] = bfhi(g.x); gv[j][2] = bflo(g.y); gv[j][3] = bfhi(g.y); gv[j][4] = bflo(g.z); gv[j][5] = bfhi(g.z); gv[j][6] = bflo(g.w); gv[j][7] = bfhi(g.w);
#pragma unroll
                for (int i = 0; i < 8; ++i) ss += gv[j][i] * gv[j][i]; }
            const float r1 = 1.0f / sqrtf(wave_sum(ss) * (1.0f / D) + EPS);
#pragma unroll
            for (int j = 0; j < 4; ++j) { const GAS f32x4* wp = (const GAS f32x4*)(w1 + 8 * (64 * j + lane)); const f32x4 a = wp[0], b = wp[1];
                const float wv[8] = {a.x, a.y, a.z, a.w, b.x, b.y, b.z, b.w};
#pragma unroll
                for (int i = 0; i < 8; ++i) xv[j][i] += gv[j][i] * r1 * wv[i];
                if (XO16) { v4u o; o.x = pk2(xv[j][0], xv[j][1]); o.y = pk2(xv[j][2], xv[j][3]); o.z = pk2(xv[j][4], xv[j][5]); o.w = pk2(xv[j][6], xv[j][7]);
                    *(GAS v4u*)((bf16*)x_out + (size_t)m * D + 8 * (64 * j + lane)) = o; }
                else { GAS f32x4* op = (GAS f32x4*)((float*)x_out + (size_t)m * D + 8 * (64 * j + lane));
                    op[0] = (f32x4){xv[j][0], xv[j][1], xv[j][2], xv[j][3]}; op[1] = (f32x4){xv[j][4], xv[j][5], xv[j][6], xv[j][7]}; } }
        }
        if (NORM2) {
            float ss = 0.f;
#pragma unroll
            for (int j = 0; j < 4; ++j)
#pragma unroll
                for (int i = 0; i < 8; ++i) ss += xv[j][i] * xv[j][i];
            const float r2 = 1.0f / sqrtf(wave_sum(ss) * (1.0f / D) + EPS);
#pragma unroll
            for (int j = 0; j < 4; ++j) { const GAS f32x4* wp = (const GAS f32x4*)(w2 + 8 * (64 * j + lane)); const f32x4 a = wp[0], b = wp[1];
                v4u o; o.x = pk2(xv[j][0] * r2 * a.x, xv[j][1] * r2 * a.y); o.y = pk2(xv[j][2] * r2 * a.z, xv[j][3] * r2 * a.w);
                o.z = pk2(xv[j][4] * r2 * b.x, xv[j][5] * r2 * b.y); o.w = pk2(xv[j][6] * r2 * b.z, xv[j][7] * r2 * b.w);
                *(GAS v4u*)(hout + (size_t)m * D + 8 * (64 * j + lane)) = o; }
        }
    }
}

__device__ __forceinline__ void hgrn_core_simple(LAS unsigned char* lds, const bf16* P, const float* lbt, bf16* OD, int tid) {
    const int chain = blockIdx.x;
    if (chain >= 64) return;
    const int b = chain >> 5, hh = (chain >> 1) & 15, dir = chain & 1;
    LAS float* qs = (LAS float*)lds; LAS float* ks = qs + 4096; LAS float* fs = ks + 4096; LAS float* vs = fs + 4096;
    const int v = tid >> 2, dg = tid & 3;
    float S[32];
#pragma unroll
    for (int j = 0; j < 32; ++j) S[j] = 0.f;
    const float* lb = lbt + (size_t)dir * 4 * D + hh * HD;
    bf16* od = OD + (size_t)dir * M * D;
    for (int blk = 0; blk < SEQ / 32; ++blk) {
        __syncthreads();
        for (int e = tid; e < 4096; e += NTHREADS) {
            const int tt = e >> 7, d = e & 127; const int ts = blk * 32 + tt; const int t = dir ? (SEQ - 1 - ts) : ts;
            const bf16* row = P + (size_t)(b * SEQ + t) * HGRN_N + hh * HD + d;
            const float qv = bf2f(row[0]); const float fv = bf2f(row[(1 + dir) * D]); const float iv = bf2f(row[3 * D]);
            const float lbv = lb[d]; const float fg = lbv + (1.0f - lbv) * sigmoid_f(fv);
            qs[e] = qv * sigmoid_f(qv); ks[e] = 1.0f - fg; fs[e] = fg; vs[e] = iv;
        }
        __syncthreads();
        for (int tt = 0; tt < 32; ++tt) {
            const float vt = vs[tt * 128 + v]; float o = 0.f;
            const LAS float* qr = qs + tt * 128 + dg * 32; const LAS float* kr = ks + tt * 128 + dg * 32; const LAS float* fr = fs + tt * 128 + dg * 32;
#pragma unroll
            for (int j = 0; j < 32; ++j) { S[j] = fr[j] * S[j] + kr[j] * vt; o += qr[j] * S[j]; }
            o += __shfl_xor(o, 1); o += __shfl_xor(o, 2);
            const int ts = blk * 32 + tt; const int t = dir ? (SEQ - 1 - ts) : ts;
            if (dg == 0) od[(size_t)(b * SEQ + t) * D + hh * HD + v] = (bf16)f2bf(o);
        }
    }
}
__device__ __forceinline__ void hgrn_finalize(const bf16* P, const bf16* OD, const float* gnorm, bf16* O, int gw, int NGW, int lane) {
    for (int m = gw; m < M; m += NGW) {
#pragma unroll
        for (int j = 0; j < 4; ++j) {
            const int e0 = 8 * (64 * j + lane);
            const v4u a = *(const GAS v4u*)(OD + (size_t)m * D + e0), b = *(const GAS v4u*)(OD + (size_t)M * D + (size_t)m * D + e0);
            const v4u g = *(const GAS v4u*)(P + (size_t)m * HGRN_N + 4 * D + e0);
            float s[8] = {bflo(a.x) + bflo(b.x), bfhi(a.x) + bfhi(b.x), bflo(a.y) + bflo(b.y), bfhi(a.y) + bfhi(b.y), bflo(a.z) + bflo(b.z), bfhi(a.z) + bfhi(b.z), bflo(a.w) + bflo(b.w), bfhi(a.w) + bfhi(b.w)};
            const float gv[8] = {bflo(g.x), bfhi(g.x), bflo(g.y), bfhi(g.y), bflo(g.z), bfhi(g.z), bflo(g.w), bfhi(g.w)};
            float ss = 0.f;
#pragma unroll
            for (int i = 0; i < 8; ++i) ss += s[i] * s[i];
            ss += __shfl_xor(ss, 1); ss += __shfl_xor(ss, 2); ss += __shfl_xor(ss, 4); ss += __shfl_xor(ss, 8);
            const float r = 1.0f / sqrtf(ss * (1.0f / HD) + EPS);
            const GAS f32x4* wp = (const GAS f32x4*)(gnorm + (e0 & 127)); const f32x4 wa = wp[0], wb = wp[1];
            const float wv[8] = {wa.x, wa.y, wa.z, wa.w, wb.x, wb.y, wb.z, wb.w};
            float o[8];
#pragma unroll
            for (int i = 0; i < 8; ++i) o[i] = s[i] * r * wv[i] * (gv[i] * sigmoid_f(gv[i]));
            v4u w; w.x = pk2(o[0], o[1]); w.y = pk2(o[2], o[3]); w.z = pk2(o[4], o[5]); w.w = pk2(o[6], o[7]);
            *(GAS v4u*)(O + (size_t)m * D + e0) = w;
        }
    }
}

__device__ __forceinline__ void rope_pair(float& x0, float& x1, const float* cosT, const float* sinT, int pos, int lane) {
    const float p0 = __shfl_xor(x0, 8), p1 = __shfl_xor(x1, 8);
    if (lane < 16) {
        const int dd = 2 * (lane & 7);
        const float c0 = cosT[pos * 16 + dd], c1 = cosT[pos * 16 + dd + 1], s0 = sinT[pos * 16 + dd], s1 = sinT[pos * 16 + dd + 1];
        if (lane < 8) { x0 = x0 * c0 - p0 * s0; x1 = x1 * c1 - p1 * s1; }
        else          { x0 = x0 * c0 + p0 * s0; x1 = x1 * c1 + p1 * s1; }
    }
}
__device__ __forceinline__ void attn_core_simple(const bf16* P, const float* cosT, const float* sinT, bf16* OG, float* LSE, int gw, int NGW, int lane) {
    const float scale = 0.08838834764831845f;
    for (int task = gw; task < M * NH * 3; task += NGW) {
        const int g = task % 3, rh = task / 3, hh = rh & 15, row = rh >> 4, b = row >> 12, t = row & (SEQ - 1);
        const int r = (g == 0) ? 1 : (g == 1 ? 4 : 16);
        const unsigned qq = ((const GAS unsigned*)(P + (size_t)row * ATTN_N + ((g * 3 + 0) * NH + hh) * HD))[lane];
        float q0 = bflo(qq), q1 = bfhi(qq);
        float mx = -1e30f, l = 0.f, o0 = 0.f, o1 = 0.f;
        for (int j = -64; j <= 64; ++j) {
            const int tk = t + r * j;
            if (tk < 0 || tk >= SEQ) continue;
            const bf16* krow = P + (size_t)(b * SEQ + tk) * ATTN_N + ((g * 3 + 1) * NH + hh) * HD;
            const unsigned kk = ((const GAS unsigned*)krow)[lane]; const unsigned vv = ((const GAS unsigned*)(krow + NH * HD))[lane];
            float k0 = bflo(kk), k1 = bfhi(kk);
            const float s = wave_sum(q0 * k0 + q1 * k1) * scale;
            const float mn = fmaxf(mx, s), c = __expf(mx - mn), p = __expf(s - mn);
            l = l * c + p; o0 = o0 * c + p * bflo(vv); o1 = o1 * c + p * bfhi(vv); mx = mn;
        }
        const float il = 1.0f / l;
        ((GAS unsigned*)(OG + ((size_t)g * M + row) * D + hh * HD))[lane] = pk2(o0 * il, o1 * il);
        if (lane == 0) LSE[((size_t)g * M + row) * NH + hh] = mx + __logf(l);
    }
}
__device__ __forceinline__ void attn_finalize(const bf16* OG, const float* LSE, bf16* O, int gw, int NGW, int lane) {
    for (int m = gw; m < M; m += NGW) {
#pragma unroll
        for (int j = 0; j < 4; ++j) {
            const int e0 = 8 * (64 * j + lane), hh = e0 >> 7;
            const float l0 = LSE[((size_t)0 * M + m) * NH + hh], l1 = LSE[((size_t)1 * M + m) * NH + hh], l2 = LSE[((size_t)2 * M + m) * NH + hh];
            const float mx = fmaxf(l0, fmaxf(l1, l2)); float w0 = __expf(l0 - mx), w1 = __expf(l1 - mx), w2 = __expf(l2 - mx);
            const float inv = 1.0f / (w0 + w1 + w2); w0 *= inv; w1 *= inv; w2 *= inv;
            const v4u a = *(const GAS v4u*)(OG + ((size_t)0 * M + m) * D + e0), b = *(const GAS v4u*)(OG + ((size_t)1 * M + m) * D + e0), c = *(const GAS v4u*)(OG + ((size_t)2 * M + m) * D + e0);
            v4u w;
            w.x = pk2(w0 * bflo(a.x) + w1 * bflo(b.x) + w2 * bflo(c.x), w0 * bfhi(a.x) + w1 * bfhi(b.x) + w2 * bfhi(c.x));
            w.y = pk2(w0 * bflo(a.y) + w1 * bflo(b.y) + w2 * bflo(c.y), w0 * bfhi(a.y) + w1 * bfhi(b.y) + w2 * bfhi(c.y));
            w.z = pk2(w0 * bflo(a.z) + w1 * bflo(b.z) + w2 * bflo(c.z), w0 * bfhi(a.z) + w1 * bfhi(b.z) + w2 * bfhi(c.z));
            w.w = pk2(w0 * bflo(a.w) + w1 * bflo(b.w) + w2 * bflo(c.w), w0 * bfhi(a.w) + w1 * bfhi(b.w) + w2 * bfhi(c.w));
            *(GAS v4u*)(O + (size_t)m * D + e0) = w;
        }
    }
}

typedef short s16x4 __attribute__((ext_vector_type(4)));
typedef short v4i16_t __attribute__((ext_vector_type(4)));
typedef unsigned v2u __attribute__((ext_vector_type(2)));
__device__ __forceinline__ void glds16(const void* gsrc, unsigned lds_dst) { unsigned keep;
    asm volatile("s_mov_b32 %0, m0\n\ts_mov_b32 m0, %2\n\ts_nop 0\n\tglobal_load_lds_dwordx4 %1, off\n\ts_mov_b32 m0, %0" : "=&s"(keep) : "v"(gsrc), "s"(lds_dst) : "memory"); }
__device__ __forceinline__ s16x4 tr_read(LAS const unsigned char* p) { return __builtin_bit_cast(s16x4, __builtin_amdgcn_ds_read_tr16_b64_v4i16((LAS v4i16_t*)p)); }
__device__ __forceinline__ bf16x8 cat44(s16x4 a, s16x4 b) { return (bf16x8){a[0], a[1], a[2], a[3], b[0], b[1], b[2], b[3]}; }
#ifdef PROBE_ADMA2
#define AT_VW "s_waitcnt vmcnt(22)"
#else
#define AT_VW "s_waitcnt vmcnt(13)"
#endif
__device__ __forceinline__ void glds16s_1(const void* sbase, unsigned voff, unsigned lds_dst) { unsigned keep;
    asm volatile("s_mov_b32 %0, m0\n\ts_mov_b32 m0, %3\n\ts_nop 0\n\tglobal_load_lds_dwordx4 %1, %2\n\ts_mov_b32 m0, %0" : "=&s"(keep) : "v"(voff), "s"(sbase), "s"(lds_dst) : "memory"); }
__device__ __forceinline__ void glds16s(const void* sbase, unsigned voff, unsigned lds_dst) { glds16s_1(sbase, voff, lds_dst);
#ifdef PROBE_ADMA2
    glds16s_1(sbase, voff, lds_dst);
#endif
}
__device__ __forceinline__ bf16x8 gload16s(const void* sbase, unsigned voff) { return *(const GAS bf16x8*)((const unsigned char*)sbase + voff); }
__device__ __forceinline__ void attn_core_mfma(LAS unsigned char* lds, const bf16* P, bf16* OG, float* LSE, int vcu, int G) {
    int tid_l = threadIdx.x; asm volatile("" : "+v"(tid_l));
    const int tid = tid_l, lane = tid & 63, w = __builtin_amdgcn_readfirstlane(tid >> 6), fr = lane & 15, q4 = lane >> 4;
    const float sc2 = 0.08838834764831845f * 1.44269504f;
    constexpr int RST = 288, K_OFF = 0, V_OFF = 73728;
#define AT_SCHED __builtin_amdgcn_sched_barrier(0)
    int prow[9], pchb[9];
#pragma unroll
    for (int i = 0; i < 9; ++i) { const int sl = (w + 8 * i) * 64 + lane; prow[i] = sl / 18; const int ch = sl - prow[i] * 18; pchb[i] = (ch < 16 ? ch : 0) * 16; }
    const int qp = (lane >> 2) & 3, p4 = lane & 3;
    const int bK = K_OFF + (16 * w + fr) * RST + q4 * 16;
    const int bV = V_OFF + (16 * w + 4 * q4 + qp) * RST + p4 * 8;
#define AT_DECODE(uid_) const int bi = (uid_) & 31, bhg = (uid_) >> 5, g = bhg % 3, bh = bhg / 3, hh = bh & 15, b = bh >> 4; \
        const int rsh = 2 * g, nbs = 5 - rsh, rho = bi >> nbs, blk = bi & ((1 << nbs) - 1), L = SEQ >> rsh, u0 = blk * 128; \
        const bf16* Qb = P + (size_t)b * SEQ * ATTN_N + ((g * 3 + 0) * NH + hh) * HD; const bf16* Kb = Qb + NH * HD; const bf16* Vb = Kb + NH * HD;
#define AT_ROWOFF(i_) ({ int uk_ = u0 - 64 + prow[i_]; uk_ = uk_ < 0 ? 0 : (uk_ >= L ? L - 1 : uk_); (unsigned)(((uk_ << rsh) + rho) * (ATTN_N * 2) + pchb[i_]); })
    bf16x8 qf[4];
    int uid = vcu;
    if (uid < 3072) { AT_DECODE(uid)
#pragma unroll
        for (int i = 0; i < 9; ++i) glds16s(Kb, AT_ROWOFF(i), (unsigned)(size_t)(lds + K_OFF + (w + 8 * i) * 1024));
        const unsigned qo = (unsigned)((((u0 + 16 * w + fr) << rsh) + rho) * (ATTN_N * 2) + 16 * q4);
#pragma unroll
        for (int ks = 0; ks < 4; ++ks) qf[ks] = gload16s(Qb, qo + 64 * ks); }
    for (; uid < 3072; uid += G) {
        AT_DECODE(uid)
        const int qtok = ((u0 + 16 * w + fr) << rsh) + rho;
        asm volatile("s_waitcnt vmcnt(0)" ::: "memory"); asm volatile("" : "+v"(qf[0]), "+v"(qf[1]), "+v"(qf[2]), "+v"(qf[3]));
        __builtin_amdgcn_s_barrier(); asm volatile("" ::: "memory");
#pragma unroll
        for (int i = 0; i < 9; ++i) glds16s(Vb, AT_ROWOFF(i), (unsigned)(size_t)(lds + V_OFF + (w + 8 * i) * 1024));
        f32x4 S[9]; bf16x8 kf[2][3][4];
#pragma unroll
        for (int kt = 0; kt < 9; ++kt) S[kt] = (f32x4){0.f, 0.f, 0.f, 0.f};
        AT_SCHED;
#pragma unroll
        for (int j = 0; j < 3; ++j)
#pragma unroll
            for (int ks = 0; ks < 4; ++ks) kf[0][j][ks] = *(const LAS bf16x8*)(lds + bK + 16 * j * RST + 64 * ks);
        AT_SCHED;
#pragma unroll
        for (int gi = 0; gi < 3; ++gi) {
            if (gi < 2) {
#pragma unroll
                for (int j = 0; j < 3; ++j)
#pragma unroll
                    for (int ks = 0; ks < 4; ++ks) kf[(gi + 1) & 1][j][ks] = *(const LAS bf16x8*)(lds + bK + 16 * (3 * (gi + 1) + j) * RST + 64 * ks);
                AT_SCHED; asm volatile("s_waitcnt lgkmcnt(12)" ::: "memory"); AT_SCHED; }
            else { AT_SCHED; asm volatile("s_waitcnt lgkmcnt(0)" ::: "memory"); AT_SCHED; }
#pragma unroll
            for (int j = 0; j < 3; ++j)
#pragma unroll
                for (int ks = 0; ks < 4; ++ks) S[3 * gi + j] = __builtin_amdgcn_mfma_f32_16x16x32_bf16(kf[gi & 1][j][ks], qf[ks], S[3 * gi + j], 0, 0, 0);
            AT_SCHED; }
        __builtin_amdgcn_s_barrier(); asm volatile("" ::: "memory");
        const int nuid = uid + G; bf16x8 qn[4];
        if (nuid < 3072) { const int uid_n = nuid;
            { const int bi = uid_n & 31, bhg = uid_n >> 5, g = bhg % 3, bh = bhg / 3, hh = bh & 15, b = bh >> 4;
              const int rsh = 2 * g, nbs = 5 - rsh, rho = bi >> nbs, blk = bi & ((1 << nbs) - 1), L = SEQ >> rsh, u0 = blk * 128;
              const bf16* Qb = P + (size_t)b * SEQ * ATTN_N + ((g * 3 + 0) * NH + hh) * HD; const bf16* Kb = Qb + NH * HD;
#pragma unroll
              for (int i = 0; i < 9; ++i) glds16s(Kb, AT_ROWOFF(i), (unsigned)(size_t)(lds + K_OFF + (w + 8 * i) * 1024));
              const unsigned qo = (unsigned)((((u0 + 16 * w + fr) << rsh) + rho) * (ATTN_N * 2) + 16 * q4);
#pragma unroll
              for (int ks = 0; ks < 4; ++ks) qn[ks] = gload16s(Qb, qo + 64 * ks); } }
        else {
#pragma unroll
            for (int ks = 0; ks < 4; ++ks) qn[ks] = qf[ks]; }
        float mx = -1e30f;
#pragma unroll
        for (int kt = 0; kt < 9; ++kt)
#pragma unroll
            for (int r = 0; r < 4; ++r) { const int rr = 4 * q4 + r; const int uk = u0 + 16 * w - 64 + 16 * kt + rr;
                const bool ok = (kt > 0 || rr >= fr) && (kt < 8 || rr <= fr) && uk >= 0 && uk < L;
                const float sv = ok ? S[kt][r] * sc2 : -1e30f; S[kt][r] = sv; mx = fmaxf(mx, sv); }
        mx = fmaxf(mx, __shfl_xor(mx, 16)); mx = fmaxf(mx, __shfl_xor(mx, 32));
        float l = 0.f;
#pragma unroll
        for (int kt = 0; kt < 9; ++kt)
#pragma unroll
            for (int r = 0; r < 4; ++r) { const float pv = __builtin_amdgcn_exp2f(S[kt][r] - mx); S[kt][r] = pv; l += pv; }
        l += __shfl_xor(l, 16); l += __shfl_xor(l, 32);
        bf16x8 pf[5];
#pragma unroll
        for (int pi = 0; pi < 5; ++pi) { const int T0 = 2 * pi, T1 = (2 * pi + 1 < 9) ? 2 * pi + 1 : 8;
            v4u pw; pw.x = pg8::cvt_pk_bf16(S[T0][0], S[T0][1]); pw.y = pg8::cvt_pk_bf16(S[T0][2], S[T0][3]);
            if (2 * pi + 1 < 9) { pw.z = pg8::cvt_pk_bf16(S[T1][0], S[T1][1]); pw.w = pg8::cvt_pk_bf16(S[T1][2], S[T1][3]); } else { pw.z = 0u; pw.w = 0u; }
            pf[pi] = __builtin_bit_cast(bf16x8, pw); }
        if (nuid < 3072) asm volatile(AT_VW ::: "memory"); else asm volatile("s_waitcnt vmcnt(0)" ::: "memory");
        __builtin_amdgcn_s_barrier(); asm volatile("" ::: "memory");
        f32x4 O[8]; s16x4 vr[2][8][2];
#pragma unroll
        for (int dt = 0; dt < 8; ++dt) O[dt] = (f32x4){0.f, 0.f, 0.f, 0.f};
        AT_SCHED;
#pragma unroll
        for (int dt = 0; dt < 8; ++dt) { vr[0][dt][0] = tr_read(lds + bV + 0 * RST + 32 * dt); vr[0][dt][1] = tr_read(lds + bV + 16 * RST + 32 * dt); }
        AT_SCHED;
#pragma unroll
        for (int pi = 0; pi < 5; ++pi) {
            if (pi < 4) { const int T0 = 2 * (pi + 1), T1 = (2 * (pi + 1) + 1 < 9) ? 2 * (pi + 1) + 1 : 8;
#pragma unroll
                for (int dt = 0; dt < 4; ++dt) { vr[(pi + 1) & 1][dt][0] = tr_read(lds + bV + 16 * T0 * RST + 32 * dt); vr[(pi + 1) & 1][dt][1] = tr_read(lds + bV + 16 * T1 * RST + 32 * dt); }
                AT_SCHED; asm volatile("s_waitcnt lgkmcnt(8)" ::: "memory"); AT_SCHED;
#pragma unroll
                for (int dt = 4; dt < 8; ++dt) { vr[(pi + 1) & 1][dt][0] = tr_read(lds + bV + 16 * T0 * RST + 32 * dt); vr[(pi + 1) & 1][dt][1] = tr_read(lds + bV + 16 * T1 * RST + 32 * dt); }
                AT_SCHED; }
            else { AT_SCHED; asm volatile("s_waitcnt lgkmcnt(0)" ::: "memory"); AT_SCHED; }
#pragma unroll
            for (int dt = 0; dt < 8; ++dt) O[dt] = __builtin_amdgcn_mfma_f32_16x16x32_bf16(cat44(vr[pi & 1][dt][0], vr[pi & 1][dt][1]), pf[pi], O[dt], 0, 0, 0);
            AT_SCHED; }
        const float il = 1.0f / l;
        const bf16* ob = OG + ((size_t)g * M + (size_t)b * SEQ) * D + hh * HD; const unsigned oo = (unsigned)(qtok * (D * 2) + 8 * q4);
#pragma unroll
        for (int dt = 0; dt < 8; ++dt) { v2u o2; o2.x = pk2(O[dt][0] * il, O[dt][1] * il); o2.y = pk2(O[dt][2] * il, O[dt][3] * il);
            asm volatile("global_store_dwordx2 %0, %1, %2" :: "v"(oo + 32 * dt), "v"(o2), "s"(ob) : "memory"); }
        { const float* lb = LSE + ((size_t)g * M + (size_t)b * SEQ) * NH + hh; const float lv = mx * 0.6931471805599453f + __logf(l);
          const unsigned lo = (unsigned)(qtok * (NH * 4));
          asm volatile("global_store_dword %0, %1, %2" :: "v"(lo), "v"(lv), "s"(lb) : "memory"); }
#pragma unroll
        for (int ks = 0; ks < 4; ++ks) qf[ks] = qn[ks];
    }
    asm volatile("s_waitcnt vmcnt(0) lgkmcnt(0)" ::: "memory"); __builtin_amdgcn_s_barrier(); asm volatile("" ::: "memory");
#undef AT_SCHED
#undef AT_DECODE
#undef AT_ROWOFF
}
typedef float float2_t __attribute__((ext_vector_type(2)));
__device__ __forceinline__ void hgrn_gates(const bf16* P, const float* lbt, bf16* QT, bf16* KT, float* PREF, float* BR, int gw, int NGW, int lane) {
    const unsigned lo = 4u * (unsigned)lane;
    for (int item = gw; item < 8192; item += NGW) {
        const int cb = item & 15, half = (item >> 4) & 1, chunk = (item >> 5) & 127, dir = item >> 12;
        const int cbase = cb * 128; const size_t row0 = (size_t)chunk * 64;
        const float lb0 = lbt[(size_t)dir * 4 * D + cbase + 2 * lane], lb1 = lbt[(size_t)dir * 4 * D + cbase + 2 * lane + 1];
        const unsigned char* fcol = (const unsigned char*)(P + (1 + dir) * D + cbase); const unsigned char* qcol = (const unsigned char*)(P + cbase);
        unsigned char* qt = (unsigned char*)(QT + (size_t)dir * M * D + cbase); unsigned char* kt = (unsigned char*)(KT + (size_t)dir * M * D + cbase);
        unsigned fw[32], qw[32];
#pragma unroll
        for (int j = 0; j < 32; ++j) { const int tau = half ? 32 + j : 31 - j; const size_t t = dir ? row0 + 63 - tau : row0 + tau;
            fw[j] = *(const GAS unsigned*)(fcol + t * (HGRN_N * 2) + lo); qw[j] = *(const GAS unsigned*)(qcol + t * (HGRN_N * 2) + lo); }
        float a0 = 1.f, a1 = 1.f;
#pragma unroll
        for (int j = 0; j < 32; ++j) { const int tau = half ? 32 + j : 31 - j; const size_t t = dir ? row0 + 63 - tau : row0 + tau;
            asm volatile("" : "+v"(fw[j]), "+v"(qw[j]) :: "memory");
            const float g0 = lb0 + (1.0f - lb0) * sigmoid_f(bflo(fw[j])), g1 = lb1 + (1.0f - lb1) * sigmoid_f(bfhi(fw[j]));
            const float q0 = bflo(qw[j]), q1 = bfhi(qw[j]); const float s0 = q0 * sigmoid_f(q0), s1 = q1 * sigmoid_f(q1);
            if (half) { a0 *= g0; a1 *= g1; }
            const float i0 = __builtin_amdgcn_rcpf(fmaxf(a0, 1e-30f)), i1 = __builtin_amdgcn_rcpf(fmaxf(a1, 1e-30f));
            const float e0 = half ? a0 : i0, e1 = half ? a1 : i1, r0 = half ? i0 : a0, r1 = half ? i1 : a1;
            *(GAS unsigned*)(qt + t * (D * 2) + lo) = pk2(s0 * e0, s1 * e1);
            *(GAS unsigned*)(kt + t * (D * 2) + lo) = pk2((1.0f - g0) * r0, (1.0f - g1) * r1);
            if (!half) { a0 *= g0; a1 *= g1; }
        }
        float* dst = (half ? BR : PREF) + ((size_t)dir * (M / 64) + chunk) * D + cbase;
        *(GAS float2_t*)((unsigned char*)dst + 2u * lo) = (float2_t){a0, a1};
    }
}

__device__ __forceinline__ void hgrn_scan_mfma(LAS unsigned char* lds, const bf16* P, const bf16* QT, const bf16* KT, const float* PREF, const float* BR, bf16* OD, int vcu, int G) {
    int tid_l = threadIdx.x; asm volatile("" : "+v"(tid_l));
    const int tid = tid_l, lane = tid & 63, w = __builtin_amdgcn_readfirstlane(tid >> 6), fr = lane & 15, q4 = lane >> 4, vt = w & 1, tt = w >> 1;
    constexpr int QST = 272, KST = 288, VST = 96;
    constexpr int STG = 43008, QS = 0, KS = 17408, VS = 35840, VEC = 41984;
#define HG_SCHED __builtin_amdgcn_sched_barrier(0)
    for (int unit = vcu; unit < 256; unit += G) {
        const int chain = unit >> 2, slice = unit & 3, b = chain >> 5, hh = (chain >> 1) & 15, dir = chain & 1;
        const size_t dOff = (size_t)dir * M * D;
        const int ck0 = dir ? 63 : 0; const size_t tok00 = (size_t)b * SEQ + (size_t)ck0 * 64;
        const unsigned char* src[6]; long sstr[6]; int poff[6];
        const long rstep = (dir ? -64L : 64L);
#pragma unroll
        for (int i = 0; i < 6; ++i) {
            int img, pcl;
            if (i < 2) { img = 0; pcl = w + 8 * i; } else if (i < 4) { img = 1; pcl = w + 8 * (i - 2); }
            else if (i == 4) { img = (w < 2) ? 1 : 2; pcl = (w < 2) ? 16 + w : w - 2; }
            else { img = (w == 1) ? 3 : 0; pcl = (w == 0) ? 16 : w; }
            const int sl = pcl * 64 + lane;
            if (img == 0 || img == 1) { const int RS = img ? 18 : 17; const int row = sl / RS, ch = sl - row * RS, chs = ch < 16 ? ch : 0;
                src[i] = (const unsigned char*)((img ? KT : QT) + dOff + (tok00 + row) * D + hh * HD + chs * 8); sstr[i] = rstep * D * 2; poff[i] = (img ? KS : QS) + pcl * 1024; }
            else if (img == 2) { const int row = sl / 6, ch = sl - row * 6, chs = ch < 4 ? ch : 0;
                src[i] = (const unsigned char*)(P + (tok00 + row) * HGRN_N + 3 * D + hh * HD + slice * 32 + chs * 8); sstr[i] = rstep * HGRN_N * 2; poff[i] = VS + pcl * 1024; }
            else { src[i] = (const unsigned char*)(((lane < 32) ? PREF : BR) + ((size_t)dir * (M / 64) + (tok00 >> 6)) * D + hh * HD + 4 * (lane & 31)); sstr[i] = (dir ? -1L : 1L) * D * 4; poff[i] = VEC; } }
#ifdef PROBE_DMA2
#define HG_STAGE(step_, sb_) do { _Pragma("unroll") for (int i_ = 0; i_ < 6; ++i_) { \
            glds16(src[i_] + (long)(step_) * sstr[i_], (unsigned)(size_t)(lds + (sb_) + poff[i_])); glds16(src[i_] + (long)(step_) * sstr[i_], (unsigned)(size_t)(lds + (sb_) + poff[i_])); } } while (0)
#define HG_W01 "s_waitcnt vmcnt(12)"
#define HG_W2 "s_waitcnt vmcnt(14)"
#else
#define HG_STAGE(step_, sb_) do { _Pragma("unroll") for (int i_ = 0; i_ < 6; ++i_) \
            glds16(src[i_] + (long)(step_) * sstr[i_], (unsigned)(size_t)(lds + (sb_) + poff[i_])); } while (0)
#define HG_W01 "s_waitcnt vmcnt(6)"
#define HG_W2 "s_waitcnt vmcnt(8)"
#endif
        const int qp = (lane >> 2) & 3, p4 = lane & 3;
        const int bQ = QS + (16 * tt + fr) * QST + q4 * 16;
        const int bQ2 = QS + (16 * tt + fr) * QST + q4 * 8;
        const int bK = KS + fr * KST + q4 * 16;
        const int bKc = KS + (4 * q4 + qp) * KST + p4 * 8;
        const int bV = VS + (4 * q4 + qp) * VST + vt * 32 + p4 * 8;
        const int bP = VEC + q4 * 16;
        f32x4 S[8];
#pragma unroll
        for (int T = 0; T < 8; ++T) S[T] = (f32x4){0.f, 0.f, 0.f, 0.f};
        HG_STAGE(0, 0); HG_STAGE(1, STG);
        int sb = 0, sbn = 2 * STG;
        for (int step = 0; step < 64; ++step) {
            if (step < 2) asm volatile(HG_W01 ::: "memory"); else asm volatile(HG_W2 ::: "memory");
            __builtin_amdgcn_s_barrier(); asm volatile("" ::: "memory");
            if (step + 2 < 64) HG_STAGE(step + 2, sbn);
            else { asm volatile("s_waitcnt vmcnt(0)" ::: "memory"); }
            LAS const unsigned char* st = lds + sb;
            HG_SCHED;
            bf16x8 qf[4], kf[4][4]; s16x4 va[2][2];
#pragma unroll
            for (int ks = 0; ks < 4; ++ks) qf[ks] = *(const LAS bf16x8*)(st + bQ + 64 * ks);
#pragma unroll
            for (int ks = 0; ks < 2; ++ks)
#pragma unroll
                for (int s4 = 0; s4 < 4; ++s4) kf[ks][s4] = *(const LAS bf16x8*)(st + bK + 16 * s4 * KST + 64 * ks);
#pragma unroll
            for (int pi = 0; pi < 2; ++pi) { va[pi][0] = tr_read(st + bV + 32 * pi * VST); va[pi][1] = tr_read(st + bV + (32 * pi + 16) * VST); }
            HG_SCHED; asm volatile("s_waitcnt lgkmcnt(0)" ::: "memory"); HG_SCHED;
#pragma unroll
            for (int ks = 2; ks < 4; ++ks)
#pragma unroll
                for (int s4 = 0; s4 < 4; ++s4) kf[ks][s4] = *(const LAS bf16x8*)(st + bK + 16 * s4 * KST + 64 * ks);
            HG_SCHED;
            f32x4 Pt[4];
#pragma unroll
            for (int s4 = 0; s4 < 4; ++s4) Pt[s4] = (f32x4){0.f, 0.f, 0.f, 0.f};
#pragma unroll
            for (int ks = 0; ks < 2; ++ks)
#pragma unroll
                for (int s4 = 0; s4 < 4; ++s4) Pt[s4] = __builtin_amdgcn_mfma_f32_16x16x32_bf16(kf[ks][s4], qf[ks], Pt[s4], 0, 0, 0);
            HG_SCHED; asm volatile("s_waitcnt lgkmcnt(0)" ::: "memory"); HG_SCHED;
            f32x4 pr[8]; s16x4 qa[4], qb[4];
#pragma unroll
            for (int T = 0; T < 8; ++T) pr[T] = *(const LAS f32x4*)(st + bP + 64 * T);
#pragma unroll
            for (int ks = 0; ks < 4; ++ks) { qa[ks] = *(const LAS s16x4*)(st + bQ2 + 64 * ks); qb[ks] = *(const LAS s16x4*)(st + bQ2 + 64 * ks + 32); }
            HG_SCHED;
#pragma unroll
            for (int ks = 2; ks < 4; ++ks)
#pragma unroll
                for (int s4 = 0; s4 < 4; ++s4) Pt[s4] = __builtin_amdgcn_mfma_f32_16x16x32_bf16(kf[ks][s4], qf[ks], Pt[s4], 0, 0, 0);
            HG_SCHED;
            const int tix = 16 * tt + fr;
#pragma unroll
            for (int s4 = 0; s4 < 4; ++s4)
#pragma unroll
                for (int r = 0; r < 4; ++r) { const int six = 16 * s4 + 4 * q4 + r; const bool keep = dir ? (six >= tix) : (six <= tix); Pt[s4][r] = keep ? Pt[s4][r] : 0.f; }
            f32x4 o = (f32x4){0.f, 0.f, 0.f, 0.f};
#pragma unroll
            for (int pi = 0; pi < 2; ++pi) {
                v4u pw; pw.x = pg8::cvt_pk_bf16(Pt[2 * pi][0], Pt[2 * pi][1]); pw.y = pg8::cvt_pk_bf16(Pt[2 * pi][2], Pt[2 * pi][3]);
                pw.z = pg8::cvt_pk_bf16(Pt[2 * pi + 1][0], Pt[2 * pi + 1][1]); pw.w = pg8::cvt_pk_bf16(Pt[2 * pi + 1][2], Pt[2 * pi + 1][3]);
                o = __builtin_amdgcn_mfma_f32_16x16x32_bf16(cat44(va[pi][0], va[pi][1]), __builtin_bit_cast(bf16x8, pw), o, 0, 0, 0); }
            HG_SCHED; asm volatile("s_waitcnt lgkmcnt(0)" ::: "memory"); HG_SCHED;
#pragma unroll
            for (int T = 0; T < 8; ++T) S[T] = S[T] * pr[T];
            s16x4 kc[8][2][2]; f32x4 br[8];
#pragma unroll
            for (int T = 0; T < 4; ++T) { br[T] = *(const LAS f32x4*)(st + bP + 512 + 64 * T);
#pragma unroll
                for (int pi = 0; pi < 2; ++pi) { kc[T][pi][0] = tr_read(st + bKc + 32 * pi * KST + 32 * T); kc[T][pi][1] = tr_read(st + bKc + (32 * pi + 16) * KST + 32 * T); } }
            HG_SCHED;
#pragma unroll
            for (int ks = 0; ks < 4; ++ks) { const int T0 = 2 * ks, T1 = 2 * ks + 1;
                v4u aw; aw.x = pg8::cvt_pk_bf16(S[T0][0], S[T0][1]); aw.y = pg8::cvt_pk_bf16(S[T0][2], S[T0][3]);
                aw.z = pg8::cvt_pk_bf16(S[T1][0], S[T1][1]); aw.w = pg8::cvt_pk_bf16(S[T1][2], S[T1][3]);
                o = __builtin_amdgcn_mfma_f32_16x16x32_bf16(__builtin_bit_cast(bf16x8, aw), cat44(qa[ks], qb[ks]), o, 0, 0, 0); }
            HG_SCHED;
            { const int ck = dir ? 63 - step : step; const size_t tok = (size_t)b * SEQ + (size_t)ck * 64 + 16 * tt + fr;
              v2u o2; o2.x = pk2(o[0], o[1]); o2.y = pk2(o[2], o[3]);
              *(GAS v2u*)(OD + dOff + tok * D + hh * HD + slice * 32 + 16 * vt + 4 * q4) = o2; }
            HG_SCHED; asm volatile("s_waitcnt lgkmcnt(0)" ::: "memory"); HG_SCHED;
#pragma unroll
            for (int T = 4; T < 8; ++T) { br[T] = *(const LAS f32x4*)(st + bP + 512 + 64 * T);
#pragma unroll
                for (int pi = 0; pi < 2; ++pi) { kc[T][pi][0] = tr_read(st + bKc + 32 * pi * KST + 32 * T); kc[T][pi][1] = tr_read(st + bKc + (32 * pi + 16) * KST + 32 * T); } }
            HG_SCHED;
#pragma unroll
            for (int T = 0; T < 4; ++T) {
#pragma unroll
                for (int pi = 0; pi < 2; ++pi) S[T] = __builtin_amdgcn_mfma_f32_16x16x32_bf16(cat44(kc[T][pi][0], kc[T][pi][1]), cat44(va[pi][0], va[pi][1]), S[T], 0, 0, 0);
                S[T] = S[T] * br[T]; }
            HG_SCHED; asm volatile("s_waitcnt lgkmcnt(0)" ::: "memory"); HG_SCHED;
#pragma unroll
            for (int T = 4; T < 8; ++T) {
#pragma unroll
                for (int pi = 0; pi < 2; ++pi) S[T] = __builtin_amdgcn_mfma_f32_16x16x32_bf16(cat44(kc[T][pi][0], kc[T][pi][1]), cat44(va[pi][0], va[pi][1]), S[T], 0, 0, 0);
                S[T] = S[T] * br[T]; }
            HG_SCHED;
            const int t3 = sb; sb = (sb == 2 * STG) ? 0 : sb + STG; sbn = t3;
        }
#undef HG_STAGE
        asm volatile("s_waitcnt vmcnt(0) lgkmcnt(0)" ::: "memory"); __builtin_amdgcn_s_barrier(); asm volatile("" ::: "memory");
    }
#undef HG_SCHED
}
struct Args { const float* in[9]; float* out; unsigned char* ws; int ph_lo, ph_hi; };
__global__ void __launch_bounds__(NTHREADS, 2) fwd(Args args) {
    extern __shared__ __attribute__((aligned(16))) unsigned char lds_raw[];
    LAS unsigned char* lds = (LAS unsigned char*)lds_raw;
    volatile LAS unsigned* MISC = (volatile LAS unsigned*)(lds + MISC_OFF);
    const int G = gridDim.x; const int bx = blockIdx.x;
    const int vcu = (G % 8 == 0) ? (bx % 8) * (G / 8) + bx / 8 : bx;
    const int NGW = G * NWAVES;
    unsigned char* ws = args.ws;
    const float* x_in = args.in[0]; const float* norm_w = args.in[1]; const float* w_in_hgrn = args.in[2]; const float* lbnd = args.in[3]; const float* gnorm = args.in[4];
    const float* w_in_attn = args.in[5]; const float* w_out = args.in[6]; const float* w_ffn_in = args.in[7]; const float* w_ffn_out = args.in[8];
    float* xres = args.out;
    float* cosT = (float*)(ws + WS_TAB + TAB_COS); float* sinT = (float*)(ws + WS_TAB + TAB_SIN); float* lbT = (float*)(ws + WS_TAB + TAB_LB);
    bf16* WHG = (bf16*)(ws + WS_WHG); bf16* WAT = (bf16*)(ws + WS_WAT); bf16* WO = (bf16*)(ws + WS_WO); bf16* WF1 = (bf16*)(ws + WS_WF1); bf16* WF2 = (bf16*)(ws + WS_WF2);
    bf16* H = (bf16*)(ws + WS_H); bf16* PROJ = (bf16*)(ws + WS_PROJ); bf16* MIX = (bf16*)(ws + WS_MIX); bf16* OB = (bf16*)(ws + WS_O); bf16* GB = (bf16*)(ws + WS_G);
    float* LSE = (float*)(ws + WS_MIX + 96 * MiB);
    bf16* QT = (bf16*)(ws + WS_PROJ + 160 * MiB); bf16* KT = (bf16*)(ws + WS_PROJ + 224 * MiB); bf16* KH = (bf16*)(ws + WS_KH);
    bf16* XB = (bf16*)(ws + WS_KH);
    float* XSCR = (float*)(ws + WS_MIX); bf16* HSCR = (bf16*)(ws + WS_MIX + 64 * MiB);
    float* PREF = (float*)(ws + WS_KH + 64 * MiB); float* E63V = (float*)(ws + WS_KH + 66 * MiB);

    for (int u = threadIdx.x; u < (LDS_BYTES - LDSCTL_OFF) / 4; u += NTHREADS) ((LAS unsigned*)(lds + LDSCTL_OFF))[u] = 0u;
    __syncthreads();
    const int lo = args.ph_lo, hi = args.ph_hi;
    const int FF1_REM = ((M / 256) * (FFN_N / 256)) % G;
    const bool TAILCVT = FF1_REM != 0 && (hi - lo) == NPHASES && REP_F1 == 1;
    const bool use_bar = (hi - lo) > 1;
    XcdBarrier bar; bar.bar = (unsigned*)(ws + WS_CTL) + CW_BAR; bar.x = 0; bar.st = nullptr;
    if (use_bar) bar = xcd_barrier_post((unsigned*)(ws + WS_CTL) + CW_BAR, MISC + 8);
#ifndef TAIL_ALL
#define TAIL_ALL 0
#endif
#ifndef TAIL_F2
#define TAIL_F2 1
#endif
#ifndef MIXMAP
#define MIXMAP vcu
#endif
#define IN(k) (lo <= (k) && (k) < hi)
#define PH_IDS int tid_p = threadIdx.x; asm volatile("" : "+v"(tid_p)); const int lane_p = tid_p & 63; const int wave_p = __builtin_amdgcn_readfirstlane(tid_p >> 6); const int gw_p = vcu * NWAVES + wave_p; (void)lane_p; (void)gw_p;
#ifndef REP_BAR
#define REP_BAR 1
#endif
#define SEAM(k) do { if (IN(k) && IN((k) + 1)) for (int rb = 0; rb < REP_BAR; ++rb) xcd_barrier(bar); } while (0)

    if (IN(0)) for (int rep = 0; rep < REP_PRO; ++rep) {
        PH_IDS
        const int lane = lane_p, gw = gw_p, tid = tid_p;
        LAS float* scr = (LAS float*)(lds + wave_p * 16384);
        for (int s = 0; s < ((TAILCVT && TAIL_ALL) ? 1 : 2); ++s) transpose_matrix(w_in_hgrn + (size_t)s * D * HGRN_N, D, HGRN_N, WHG + (size_t)s * HGRN_N * D, 0, scr, gw, NGW, lane);
        for (int s = 0; s < ((TAILCVT && TAIL_ALL) ? 0 : 2); ++s) transpose_matrix(w_in_attn + (size_t)s * D * ATTN_N, D, ATTN_N, WAT + (size_t)s * ATTN_N * D, 0, scr, gw, NGW, lane);
        for (int s = 0; s < ((TAILCVT && TAIL_ALL) ? 1 : 4); ++s) transpose_matrix(w_out + (size_t)s * D * D, D, D, WO + (size_t)s * D * D, 0, scr, gw, NGW, lane);
        for (int s = 0; s < (TAILCVT ? 1 : 4); ++s) transpose_matrix(w_ffn_in + (size_t)s * D * FFN_N, D, FFN_N, WF1 + (size_t)s * FFN_N * D, 1, scr, gw, NGW, lane);
        for (int s = 0; s < ((TAILCVT && TAIL_F2) ? 1 : 4); ++s) transpose_matrix(w_ffn_out + (size_t)s * DFF * D, DFF, D, WF2 + (size_t)s * D * DFF, 0, scr, gw, NGW, lane);
        const int gt = vcu * NTHREADS + tid, NGT = G * NTHREADS;
        for (int idx = gt; idx < SEQ * 16; idx += NGT) { const int pos = idx >> 4, i = idx & 15;
            const float inv = powf(500000.0f, -(float)(2 * i) / 32.0f); const float ang = (float)pos * inv; cosT[idx] = cosf(ang); sinT[idx] = sinf(ang); }
        for (int idx = gt; idx < 2 * D; idx += NGT) { const int dir = idx >> 11, c = idx & (D - 1);
            float xl[4]; float mx = -3.0e38f;
#pragma unroll
            for (int l = 0; l < 4; ++l) { xl[l] = lbnd[(size_t)(dir * 4 + l) * D + c]; mx = fmaxf(mx, xl[l]); }
            float sum = 0.f;
#pragma unroll
            for (int l = 0; l < 4; ++l) { xl[l] = expf(xl[l] - mx); sum += xl[l]; }
            float cum = 0.f, c0 = 0.f;
#pragma unroll
            for (int l = 0; l < 4; ++l) { cum += xl[l] / sum; if (l == 0) c0 = cum; lbT[(size_t)(dir * 4 + l) * D + c] = cum - c0; } }
        norm_rows<false, true, false, false>(nullptr, x_in, nullptr, nullptr, norm_w, H, gw, NGW, lane);
    }
    SEAM(0);

    for (int L = 0; L < DEPTH; ++L) {
        const int pb = 1 + 9 * L; const bool hg = (L & 1) == 0; const int slot = L >> 1;
        const float* nw = norm_w + (size_t)L * 4 * D;
        const int NPROJ = hg ? HGRN_N : ATTN_N;
        if (IN(pb)) {
            if (hg) for (int rep = 0; rep < REP_INH; ++rep) { pg8::Gemm g{H, WHG + (size_t)slot * HGRN_N * D, M, HGRN_N, D}; pg8::StaticOrder S; S.init(M, HGRN_N, G, bx);
                pg8::EpiBf16<0> E{PROJ, HGRN_N, nullptr, 0, 0, 1.f};
                pg8::gemm_phase<pg8::EpiBf16<0>, pg8::StaticOrder, true, true>(lds, g, S, E); }
            else for (int rep = 0; rep < REP_INA; ++rep) { pg8::Gemm g{H, WAT + (size_t)((REP_INA_COLD && rep + 1 < REP_INA) ? (slot ^ 1) : slot) * ATTN_N * D, M, ATTN_N, D}; pg8::StaticOrder S; S.init(M, ATTN_N, G, bx);
                pg8::EpiRope E{PROJ, ATTN_N, cosT, sinT};
                pg8::gemm_phase<pg8::EpiRope, pg8::StaticOrder, true, true>(lds, g, S, E); }
        }
        SEAM(pb);
        if (hg) {
            if (IN(pb + 1)) for (int rep = 0; rep < REP_GATES; ++rep) { PH_IDS hgrn_gates(PROJ, lbT + (size_t)L * D, QT, KT, PREF, E63V, gw_p, NGW, lane_p); }
            SEAM(pb + 1);
        }
        if (IN(pb + 2)) {
            if (hg) for (int rep = 0; rep < REP_SCAN; ++rep) hgrn_scan_mfma(lds, PROJ, QT, KT, PREF, E63V, MIX, MIXMAP, G);
            else for (int rep = 0; rep < REP_ATTN; ++rep) attn_core_mfma(lds, PROJ, MIX, LSE, MIXMAP, G);
        }
        SEAM(pb + 2);
        if (IN(pb + 3)) for (int rep = 0; rep < REP_FIN; ++rep) {
            PH_IDS
            const int lane = lane_p, gw = gw_p;
            if (hg) hgrn_finalize(PROJ, MIX, gnorm + (size_t)slot * HD, OB, gw, NGW, lane);
            else attn_finalize(MIX, LSE, OB, gw, NGW, lane);
        }
        SEAM(pb + 3);
        if (IN(pb + 4)) for (int rep = 0; rep < REP_WO; ++rep) {
            pg8::Gemm g{OB, WO + (size_t)L * D * D, M, D, D}; pg8::StaticOrder S; S.init(M, D, G, bx);
            pg8::EpiBf16<0> E{GB, D, nullptr, 0, 0, 1.f};
            pg8::gemm_phase<pg8::EpiBf16<0>, pg8::StaticOrder, true, true>(lds, g, S, E);
        }
        SEAM(pb + 4);
        if (IN(pb + 5)) for (int rep = 0; rep < REP_NORM; ++rep) { PH_IDS if (L == 0 && rep == 0) norm_rows<true, true, false, true>(GB, x_in, XB, nw + D, nw + 2 * D, H, gw_p, NGW, lane_p);
            else norm_rows<true, true, true, true>(GB, XB, rep ? (void*)XSCR : (void*)XB, nw + D, nw + 2 * D, rep ? HSCR : H, gw_p, NGW, lane_p); }
        SEAM(pb + 5);
        if (IN(pb + 6)) for (int rep = 0; rep < REP_F1; ++rep) {
            pg8::Gemm g{H, WF1 + (size_t)L * FFN_N * D, M, FFN_N, D}; pg8::StaticOrder S; S.init(M, FFN_N, G, bx);
            pg8::EpiSwiGLU E{PROJ, DFF};
            pg8::gemm_phase<pg8::EpiSwiGLU, pg8::StaticOrder, true, true>(lds, g, S, E);
            if (TAILCVT && L + 1 < DEPTH && bx >= FF1_REM) {
                PH_IDS
                LAS float* scr = (LAS float*)(lds + wave_p * 16384); const int gw2 = (bx - FF1_REM) * NWAVES + wave_p, ngw2 = (G - FF1_REM) * NWAVES;
                transpose_matrix(w_ffn_in + (size_t)(L + 1) * D * FFN_N, D, FFN_N, WF1 + (size_t)(L + 1) * FFN_N * D, 1, scr, gw2, ngw2, lane_p);
                if (TAIL_ALL) { const int L1 = L + 1, slot1 = L1 >> 1;
                    if (L1 & 1) transpose_matrix(w_in_attn + (size_t)slot1 * D * ATTN_N, D, ATTN_N, WAT + (size_t)slot1 * ATTN_N * D, 0, scr, gw2, ngw2, lane_p);
                    else transpose_matrix(w_in_hgrn + (size_t)slot1 * D * HGRN_N, D, HGRN_N, WHG + (size_t)slot1 * HGRN_N * D, 0, scr, gw2, ngw2, lane_p);
                    transpose_matrix(w_out + (size_t)L1 * D * D, D, D, WO + (size_t)L1 * D * D, 0, scr, gw2, ngw2, lane_p); }
                if (TAIL_F2) transpose_matrix(w_ffn_out + (size_t)(L + 1) * DFF * D, DFF, D, WF2 + (size_t)(L + 1) * D * DFF, 0, scr, gw2, ngw2, lane_p);
            }
        }
        SEAM(pb + 6);
        if (IN(pb + 7)) for (int rep = 0; rep < REP_F2; ++rep) {
            pg8::Gemm g{PROJ, WF2 + (size_t)L * D * DFF, M, D, DFF}; pg8::StaticOrder S; S.init(M, D, G, bx);
            pg8::EpiBf16<0> E{GB, D, nullptr, 0, 0, 1.f};
            pg8::gemm_phase<pg8::EpiBf16<0>, pg8::StaticOrder, true, true>(lds, g, S, E);
        }
        SEAM(pb + 7);
        if (IN(pb + 8)) for (int rep = 0; rep < REP_NORM; ++rep) {
            PH_IDS
            const int lane = lane_p, gw = gw_p;
            if (L + 1 < DEPTH) norm_rows<true, true, true, true>(GB, XB, rep ? (void*)XSCR : (void*)XB, nw + 3 * D, nw + 4 * D, rep ? HSCR : H, gw, NGW, lane);
            else norm_rows<true, false, true, false>(GB, XB, rep ? XSCR : xres, nw + 3 * D, nullptr, nullptr, gw, NGW, lane);
        }
        SEAM(pb + 8);
    }
#undef IN
#undef SEAM
}

#ifndef MK_PER_PHASE
#define MK_PER_PHASE 0
#endif
extern "C" void kernel_launch(void* const* d_in, const int* in_sizes, int n_in, void* d_out, int out_size, void* d_ws, size_t ws_size, hipStream_t stream) {
    static int grid = 0;
    if (grid == 0) {
        if (n_in != 9 || in_sizes[0] != M * D || out_size != M * D || ws_size < WS_END) { fprintf(stderr, "kernel_launch: unexpected shapes (n_in %d, in0 %d, out %d, ws %zu); nothing launched\n", n_in, n_in > 0 ? in_sizes[0] : -1, out_size, ws_size); grid = -1; return; }
        int dev = 0, cus = 0, per_cu = 0;
        if (hipGetDevice(&dev) != hipSuccess || hipDeviceGetAttribute(&cus, hipDeviceAttributeMultiprocessorCount, dev) != hipSuccess) { grid = -1; return; }
        if (hipFuncSetAttribute((const void*)fwd, hipFuncAttributeMaxDynamicSharedMemorySize, LDS_BYTES) != hipSuccess) { fprintf(stderr, "kernel_launch: hipFuncSetAttribute failed\n"); grid = -1; return; }
        if (hipOccupancyMaxActiveBlocksPerMultiprocessor(&per_cu, (const void*)fwd, NTHREADS, LDS_BYTES) != hipSuccess || per_cu < 1) fprintf(stderr, "kernel_launch: occupancy query reports %d\n", per_cu);
        (void)hipGetLastError();
        grid = cus;
    }
    if (grid < 0) return;
    if (hipMemsetAsync((char*)d_ws + WS_CTL, 0, CTL_ZERO_BYTES, stream) != hipSuccess) return;
    Args a{};
    for (int i = 0; i < 9; ++i) a.in[i] = (const float*)d_in[i];
    a.out = (float*)d_out; a.ws = (unsigned char*)d_ws;
#if MK_PER_PHASE
    for (int p = 0; p < NPHASES; ++p) { a.ph_lo = p; a.ph_hi = p + 1; hipLaunchKernelGGL(fwd, dim3(grid), dim3(NTHREADS), LDS_BYTES, stream, a); }
#else
    a.ph_lo = 0; a.ph_hi = NPHASES; hipLaunchKernelGGL(fwd, dim3(grid), dim3(NTHREADS), LDS_BYTES, stream, a);
#endif
}
```

```cpp
#include <hip/hip_runtime.h>
#include <cstdio>
#include <cstdint>
#ifdef EPI_NT
#define PG8_ST(v, p) __builtin_nontemporal_store((v), (p))
#else
#define PG8_ST(v, p) (*(p) = (v))
#endif
namespace pg8 {
#define PG8_LAS __attribute__((address_space(3)))
typedef unsigned short bf16_t;
typedef short bf16x8 __attribute__((ext_vector_type(8)));
typedef float f32x4 __attribute__((ext_vector_type(4)));
typedef unsigned u32x4 __attribute__((ext_vector_type(4)));
constexpr int BM = 256, BK = 64, HALF = 128, HTB = HALF * BK * 2  , STAGE_BYTES = 8 * HTB, NXCD = 8, WGM = 8;

__host__ __device__ __forceinline__ int lds_byte(int r, int c) { const int st = (r >> 4) * 2 + (c >> 5), rr = r & 15, cc = c & 31, ob = rr * 64 + cc * 2; return st * 1024 + (ob ^ (((ob >> 9) & 1) << 5)); }
__host__ __device__ __forceinline__ void stage_rc(int b, int& R, int& C) { const int st = b / 1024, sb = b % 1024, swz = sb ^ (((sb >> 9) & 1) << 5); R = (st >> 1) * 16 + swz / 64; C = (st & 1) * 32 + (swz % 64) / 2; }
__host__ __device__ __forceinline__ int perm32(int rho) { const int n = rho >> 4, i = rho & 15; return 8 * (i >> 2) + 4 * n + (i & 3); }

struct Unit { int pm, pn; };
struct Gemm { const bf16_t* A; const bf16_t* Bt; int M, N, K; };

struct StaticOrder {
    int nM, nN, nwg, G, c;
    __host__ __device__ void init(int M, int N, int G_, int c_) { nM = M / BM; nN = N / BM; nwg = nM * nN; G = G_; c = c_; }
    __host__ __device__ bool next(int i, Unit& u) const {
        const long L = (long)i * G + c; if (L >= nwg) return false;
        int wgid = (int)L; { const int q = nwg / NXCD, r = nwg % NXCD, xcd = wgid % NXCD, off = wgid / NXCD; wgid = (xcd < r ? xcd * (q + 1) : r * (q + 1) + (xcd - r) * q) + off; }
        const int nig = WGM * nN, gid = wgid / nig, fm = gid * WGM, gsz = (nM - fm) < WGM ? (nM - fm) : WGM;
        u.pm = fm + ((wgid % nig) % gsz); u.pn = (wgid % nig) / gsz; return true;
    }
    __device__ __forceinline__ void a_ready(const Unit&) const {}
    __device__ __forceinline__ void done(const Unit&) const {}
};

__device__ __forceinline__ unsigned cvt_pk_bf16(float lo, float hi) { unsigned r; asm volatile("v_cvt_pk_bf16_f32 %0, %1, %2" : "=v"(r) : "v"(lo), "v"(hi)); return r; }
typedef float f32x2 __attribute__((ext_vector_type(2)));
__device__ __forceinline__ f32x2 gelu_pk(f32x2 v) {
    const f32x2 av = __builtin_elementwise_abs(v), d = av * 0.2316418882f + 1.0f;
    f32x2 t; t.x = __builtin_amdgcn_rcpf(d.x); t.y = __builtin_amdgcn_rcpf(d.y);
    f32x2 q = t * 0.5307027145f + (-0.7265760135f); q = q * t + 0.7107068705f; q = q * t + (-0.142248368f); q = q * t + 0.127414796f; q = q * t;
    const f32x2 s = (v * v) * (-0.72134752044f);
    f32x2 e; e.x = __builtin_amdgcn_exp2f(s.x); e.y = __builtin_amdgcn_exp2f(s.y);
    const f32x2 m = v * (q * e), r = v - m;
    f32x2 o; o.x = v.x < 0.f ? m.x : r.x; o.y = v.y < 0.f ? m.y : r.y; return o;
}

template <int ACT  > struct EpiBf16 {
    static constexpr bool PERM = true, AFTER_DRAIN = false; static_assert(ACT == 0 || ACT == 1, "EpiBf16: ACT is 0 (none) or 1 (gelu_pk)");
    bf16_t* O; int ldc; const float* bias; int split_cols; size_t split_stride; float scale0;
    __device__ __forceinline__ void operator()(const f32x4 (&acc)[2][2][4][2], const Unit& u, int wr, int wc, int fr, int fq) const {
        const int row0 = u.pm * BM + wr * 64 + fr; int colt = u.pn * BM; bf16_t* base = O;
        float sc = 1.f; if (split_cols) { const int t = colt / split_cols; base += (size_t)t * split_stride; colt -= t * split_cols; if (t == 0) sc = scale0; }
        const int col0 = colt + wc * 32 + 8 * fq, bcol0 = u.pn * BM + wc * 32 + 8 * fq;
        f32x4 bv[2][2];
#pragma unroll
        for (int bj = 0; bj < 2; ++bj)
#pragma unroll
            for (int n = 0; n < 2; ++n) bv[bj][n] = bias ? *(const f32x4*)(bias + bcol0 + bj * HALF + 4 * n) : (f32x4){0.f, 0.f, 0.f, 0.f};
#pragma unroll
        for (int ai = 0; ai < 2; ++ai)
#pragma unroll
            for (int m = 0; m < 4; ++m) { bf16_t* rowp = base + (size_t)(row0 + ai * HALF + m * 16) * ldc + col0;
#pragma unroll
                for (int bj = 0; bj < 2; ++bj) { f32x4 v0 = acc[ai][bj][m][0] + bv[bj][0], v1 = acc[ai][bj][m][1] + bv[bj][1];
                    if (ACT == 1) { f32x2 a = gelu_pk((f32x2){v0[0], v0[1]}), b = gelu_pk((f32x2){v0[2], v0[3]}), c = gelu_pk((f32x2){v1[0], v1[1]}), d = gelu_pk((f32x2){v1[2], v1[3]});
                        v0 = (f32x4){a.x, a.y, b.x, b.y}; v1 = (f32x4){c.x, c.y, d.x, d.y}; }
                    v0 = v0 * sc; v1 = v1 * sc; u32x4 w; w.x = cvt_pk_bf16(v0[0], v0[1]); w.y = cvt_pk_bf16(v0[2], v0[3]); w.z = cvt_pk_bf16(v1[0], v1[1]); w.w = cvt_pk_bf16(v1[2], v1[3]);
                    PG8_ST(w, (u32x4*)(rowp + bj * HALF)); } }
    }
};

template <class Epi, class Sched, bool ALIGN_EPI = false, bool SP2 = false>
__device__ __forceinline__ void gemm_phase(PG8_LAS unsigned char* lds, const Gemm g, const Sched& S, const Epi& E) {
    int tid_l = threadIdx.x; asm volatile("" : "+v"(tid_l));
    const int tid = tid_l, wid = __builtin_amdgcn_readfirstlane(tid >> 6), lane = tid & 63, wr = wid >> 2, wc = wid & 3, fr = lane & 15, fq = lane >> 4;
    const int K = g.K, nt = K / BK;
    unsigned voffA[2], voffB[2];
#pragma unroll
    for (int i = 0; i < 2; ++i) { int R, C; stage_rc(tid * 16 + i * 8192, R, C); const int Rb = Epi::PERM ? ((R & ~31) + perm32(R & 31)) : R;
        voffA[i] = (unsigned)(R * K + C) * 2u; voffB[i] = (unsigned)(Rb * K + C) * 2u; }
    const size_t kstep = (size_t)(BK * 2);
    const size_t hstep = (size_t)HALF * K * 2;
    const size_t tstep = 2 * hstep;
    const unsigned ldsw = (unsigned)wid * 1024u;
    const int aoff = lds_byte(wr * 64 + fr, fq * 8), boff = lds_byte(wc * 32 + fr, fq * 8);
#define PG8_SA(b, h) (((b) * 2 + (h)) * HTB)
#define PG8_SB(b, h) ((4 + (b) * 2 + (h)) * HTB)
#define PG8_STAGE(bufoff, gbase, voff) do { _Pragma("unroll") for (int _i = 0; _i < 2; ++_i) \
        __builtin_amdgcn_global_load_lds((const unsigned*)((const char*)(gbase) + (voff)[_i]), (PG8_LAS unsigned*)(lds + (bufoff) + ldsw + _i * 8192), 16, 0, 0); } while (0)
#define PG8_LDA(dst, b, h) do { _Pragma("unroll") for (int m = 0; m < 4; ++m) _Pragma("unroll") for (int k = 0; k < 2; ++k) dst[m][k] = *(const PG8_LAS bf16x8*)(lds + PG8_SA(b, h) + aoff + m * 2048 + k * 1024); } while (0)
#define PG8_LDB(dst, b, h) do { _Pragma("unroll") for (int n = 0; n < 2; ++n) _Pragma("unroll") for (int k = 0; k < 2; ++k) dst[n][k] = *(const PG8_LAS bf16x8*)(lds + PG8_SB(b, h) + boff + n * 2048 + k * 1024); } while (0)
#define PG8_MMA(ai, bj, At, Bt) do { __builtin_amdgcn_s_setprio(1); _Pragma("unroll") for (int m = 0; m < 4; ++m) _Pragma("unroll") for (int n = 0; n < 2; ++n) _Pragma("unroll") for (int k = 0; k < 2; ++k) \
        acc[ai][bj][m][n] = __builtin_amdgcn_mfma_f32_16x16x32_bf16(Bt[n][k], At[m][k], acc[ai][bj][m][n], 0, 0, 0); __builtin_amdgcn_s_setprio(0); } while (0)
#define PG8_WAIT_V(n) asm volatile("s_waitcnt vmcnt(" #n ")" ::: "memory")
#define PG8_WAIT_L(n) asm volatile("s_waitcnt lgkmcnt(" #n ")" ::: "memory")
#define PG8_BAR __builtin_amdgcn_s_barrier()
#define PG8_SCHED __builtin_amdgcn_sched_barrier(0)
    Unit cur, nxt; int ui = 0;
    if (!S.next(0, cur)) return;
    f32x4 acc[2][2][4][2];
#pragma unroll
    for (int a = 0; a < 2; ++a)
#pragma unroll
        for (int b = 0; b < 2; ++b)
#pragma unroll
            for (int m = 0; m < 4; ++m)
#pragma unroll
                for (int n = 0; n < 2; ++n) acc[a][b][m][n] = (f32x4){0.f, 0.f, 0.f, 0.f};
    bf16x8 At[4][2], B0[2][2], B1[2][2];
    const char* cA = (const char*)g.A + (size_t)cur.pm * tstep; const char* cB = (const char*)g.Bt + (size_t)cur.pn * tstep;
    S.a_ready(cur);
    if constexpr (SP2) {
        PG8_STAGE(PG8_SB(0, 0), cB, voffB); PG8_STAGE(PG8_SB(0, 1), cB + hstep, voffB); PG8_STAGE(PG8_SA(0, 0), cA, voffA); PG8_STAGE(PG8_SA(0, 1), cA + hstep, voffA);
        if (wr == 1) PG8_BAR;
        PG8_WAIT_V(2); PG8_BAR;
        PG8_STAGE(PG8_SB(1, 0), cB + kstep, voffB); PG8_STAGE(PG8_SA(1, 0), cA + kstep, voffA); PG8_STAGE(PG8_SB(1, 1), cB + hstep + kstep, voffB);
        PG8_WAIT_V(6); PG8_BAR;
    } else {
        PG8_STAGE(PG8_SB(0, 0), cB, voffB); PG8_STAGE(PG8_SA(0, 0), cA, voffA); PG8_STAGE(PG8_SB(0, 1), cB + hstep, voffB); PG8_STAGE(PG8_SA(0, 1), cA + hstep, voffA);
        if (wr == 1) PG8_BAR;
        PG8_WAIT_V(4); PG8_BAR;
        PG8_STAGE(PG8_SB(1, 0), cB + kstep, voffB); PG8_STAGE(PG8_SA(1, 0), cA + kstep, voffA); PG8_STAGE(PG8_SB(1, 1), cB + hstep + kstep, voffB);
        PG8_WAIT_V(6); PG8_BAR;
    }
    for (;;) {
        const bool has_next = S.next(ui + 1, nxt);
        const char* nA = has_next ? (const char*)g.A + (size_t)nxt.pm * tstep : cA; const char* nB = has_next ? (const char*)g.Bt + (size_t)nxt.pn * tstep : cB;
        for (int t = 0; t < nt; t += 2) {
            const bool last = (t == nt - 2);
            const char* a1 = cA + (size_t)(t + 1) * kstep;
            const char* a2 = last ? nA : cA + (size_t)(t + 2) * kstep; const char* b2 = last ? nB : cB + (size_t)(t + 2) * kstep;
            const char* a3 = a2 + kstep; const char* b3 = b2 + kstep;
            if (last && has_next) S.a_ready(nxt);
            if constexpr (SP2) {
            PG8_LDB(B0, 0, 0); PG8_LDB(B1, 0, 1); PG8_SCHED; PG8_LDA(At, 0, 0); PG8_STAGE(PG8_SA(1, 1), a1 + hstep, voffA);
            PG8_WAIT_V(8); PG8_WAIT_L(0); PG8_BAR; PG8_MMA(0, 0, At, B0); PG8_MMA(0, 1, At, B1); PG8_BAR; PG8_SCHED;
            PG8_LDA(At, 0, 1); PG8_STAGE(PG8_SB(0, 0), b2, voffB); PG8_STAGE(PG8_SB(0, 1), b2 + hstep, voffB); PG8_STAGE(PG8_SA(0, 0), a2, voffA);
            PG8_WAIT_V(8); PG8_WAIT_L(0); PG8_BAR; PG8_MMA(1, 0, At, B0); PG8_MMA(1, 1, At, B1); PG8_BAR; PG8_SCHED;
            PG8_LDB(B0, 1, 0); PG8_LDB(B1, 1, 1); PG8_SCHED; PG8_LDA(At, 1, 0); PG8_STAGE(PG8_SA(0, 1), a2 + hstep, voffA);
            PG8_WAIT_V(8); PG8_WAIT_L(0); PG8_BAR; PG8_MMA(0, 0, At, B0); PG8_MMA(0, 1, At, B1); PG8_BAR; PG8_SCHED;
            PG8_LDA(At, 1, 1); PG8_STAGE(PG8_SB(1, 0), b3, voffB); PG8_STAGE(PG8_SB(1, 1), b3 + hstep, voffB); PG8_STAGE(PG8_SA(1, 0), a3, voffA);
            PG8_WAIT_V(8); PG8_WAIT_L(0); PG8_BAR; PG8_MMA(1, 0, At, B0); PG8_MMA(1, 1, At, B1); PG8_BAR; PG8_SCHED;
            } else {
            PG8_LDB(B0, 0, 0); PG8_SCHED; PG8_LDA(At, 0, 0); PG8_STAGE(PG8_SA(1, 1), a1 + hstep, voffA);
            PG8_WAIT_L(8); PG8_BAR; PG8_WAIT_L(0); PG8_MMA(0, 0, At, B0); PG8_BAR; PG8_SCHED;
            PG8_LDB(B1, 0, 1); PG8_STAGE(PG8_SB(0, 0), b2, voffB);
            PG8_BAR; PG8_WAIT_L(0); PG8_MMA(0, 1, At, B1); PG8_BAR;
            PG8_LDA(At, 0, 1); PG8_STAGE(PG8_SA(0, 0), a2, voffA);
            PG8_BAR; PG8_WAIT_L(0); PG8_MMA(1, 0, At, B0); PG8_BAR; PG8_SCHED;
            PG8_STAGE(PG8_SB(0, 1), b2 + hstep, voffB);
            PG8_WAIT_V(6); PG8_BAR; PG8_MMA(1, 1, At, B1); PG8_BAR;
            PG8_LDB(B0, 1, 0); PG8_SCHED; PG8_LDA(At, 1, 0); PG8_STAGE(PG8_SA(0, 1), a2 + hstep, voffA);
            PG8_WAIT_L(8); PG8_BAR; PG8_WAIT_L(0); PG8_MMA(0, 0, At, B0); PG8_BAR; PG8_SCHED;
            PG8_LDB(B1, 1, 1); PG8_STAGE(PG8_SB(1, 0), b3, voffB);
            PG8_BAR; PG8_WAIT_L(0); PG8_MMA(0, 1, At, B1); PG8_BAR;
            PG8_LDA(At, 1, 1); PG8_STAGE(PG8_SA(1, 0), a3, voffA);
            PG8_BAR; PG8_WAIT_L(0); PG8_MMA(1, 0, At, B0); PG8_BAR; PG8_SCHED;
            PG8_STAGE(PG8_SB(1, 1), b3 + hstep, voffB);
            PG8_WAIT_V(6); PG8_BAR; PG8_MMA(1, 1, At, B1); PG8_BAR;
            }
        }
        if constexpr (ALIGN_EPI) { if (wr == 0) PG8_BAR; }
        if constexpr (!Epi::AFTER_DRAIN) { E(acc, cur, wr, wc, fr, fq); S.done(cur); }
        if (!has_next) break;
#pragma unroll
        for (int a = 0; a < 2; ++a)
#pragma unroll
            for (int b = 0; b < 2; ++b)
#pragma unroll
                for (int m = 0; m < 4; ++m)
#pragma unroll
                    for (int n = 0; n < 2; ++n) acc[a][b][m][n] = (f32x4){0.f, 0.f, 0.f, 0.f};
        cur = nxt; cA = nA; cB = nB; ++ui;
        if constexpr (ALIGN_EPI) { if (wr == 1) PG8_BAR; }
    }
    PG8_WAIT_V(0);
    if constexpr (!ALIGN_EPI) { if (wr == 0) PG8_BAR; }
    PG8_BAR;
    if constexpr (Epi::AFTER_DRAIN) { E.fused(acc, cur, wr, wc, fr, fq, lds, wid, lane); S.done(cur); }
#undef PG8_SA
#undef PG8_SB
#undef PG8_STAGE
#undef PG8_LDA
#undef PG8_LDB
#undef PG8_MMA
#undef PG8_WAIT_V
#undef PG8_WAIT_L
#undef PG8_BAR
#undef PG8_SCHED
}
}
namespace pg8 {
__device__ __forceinline__ float silu_f(float x) { return x * __builtin_amdgcn_rcpf(1.0f + __builtin_amdgcn_exp2f(-1.44269504f * x)); }
struct EpiSwiGLU {
    static constexpr bool PERM = true, AFTER_DRAIN = false;
    bf16_t* O; int ldc;
    __device__ __forceinline__ void operator()(const f32x4 (&acc)[2][2][4][2], const Unit& u, int wr, int wc, int fr, int fq) const {
        const int row0 = u.pm * BM + wr * 64 + fr; const int col0 = u.pn * HALF + wc * 32 + 8 * fq;
#pragma unroll
        for (int ai = 0; ai < 2; ++ai)
#pragma unroll
            for (int m = 0; m < 4; ++m) { bf16_t* rowp = O + (size_t)(row0 + ai * HALF + m * 16) * ldc + col0;
                const f32x4 g0 = acc[ai][0][m][0], g1 = acc[ai][0][m][1], u0 = acc[ai][1][m][0], u1 = acc[ai][1][m][1];
                u32x4 w; w.x = cvt_pk_bf16(silu_f(g0[0]) * u0[0], silu_f(g0[1]) * u0[1]); w.y = cvt_pk_bf16(silu_f(g0[2]) * u0[2], silu_f(g0[3]) * u0[3]);
                w.z = cvt_pk_bf16(silu_f(g1[0]) * u1[0], silu_f(g1[1]) * u1[1]); w.w = cvt_pk_bf16(silu_f(g1[2]) * u1[2], silu_f(g1[3]) * u1[3]);
                PG8_ST(w, (u32x4*)rowp); }
    }
};
}
#ifdef ROPE_NT
#define PG8_ST_ROPE(v, p) __builtin_nontemporal_store((v), (p))
#else
#define PG8_ST_ROPE(v, p) (*(p) = (v))
#endif
namespace pg8 {
struct EpiRope {
    static constexpr bool PERM = true, AFTER_DRAIN = false;
    bf16_t* O; int ldc; const float* cosT; const float* sinT;
    __device__ __forceinline__ void operator()(const f32x4 (&acc)[2][2][4][2], const Unit& u, int wr, int wc, int fr, int fq) const {
        const int row0 = u.pm * BM + wr * 64 + fr; const int colt = u.pn * BM; const int col0 = colt + wc * 32 + 8 * fq;
        const bool rot = (((colt >> 11) % 3) < 2) && (wc == 0);
        const int dd0 = 8 * (fq & 1); const float sgn = (fq < 2) ? -1.0f : 1.0f;
#pragma unroll
        for (int ai = 0; ai < 2; ++ai)
#pragma unroll
            for (int m = 0; m < 4; ++m) { const int row = row0 + ai * HALF + m * 16; bf16_t* rowp = O + (size_t)row * ldc + col0;
                f32x4 c0 = (f32x4){1.f, 1.f, 1.f, 1.f}, c1 = c0, s0 = (f32x4){0.f, 0.f, 0.f, 0.f}, s1 = s0;
                if (rot) { const int pos = row & 4095; const f32x4* cp = (const f32x4*)(cosT + pos * 16 + dd0); const f32x4* sp = (const f32x4*)(sinT + pos * 16 + dd0);
                    c0 = cp[0]; c1 = cp[1]; s0 = sp[0] * sgn; s1 = sp[1] * sgn; }
#pragma unroll
                for (int bj = 0; bj < 2; ++bj) { f32x4 v0 = acc[ai][bj][m][0], v1 = acc[ai][bj][m][1];
                    if (rot) { f32x4 p0, p1;
#pragma unroll
                        for (int i = 0; i < 4; ++i) { p0[i] = __shfl_xor(v0[i], 32); p1[i] = __shfl_xor(v1[i], 32); }
                        v0 = v0 * c0 + p0 * s0; v1 = v1 * c1 + p1 * s1; }
                    u32x4 w; w.x = cvt_pk_bf16(v0[0], v0[1]); w.y = cvt_pk_bf16(v0[2], v0[3]); w.z = cvt_pk_bf16(v1[0], v1[1]); w.w = cvt_pk_bf16(v1[2], v1[3]);
                    PG8_ST_ROPE(w, (u32x4*)(rowp + bj * HALF)); } }
    }
};
}
#define GAS __attribute__((address_space(1)))
#define LAS __attribute__((address_space(3)))
typedef unsigned short bf16;
typedef unsigned v4u __attribute__((ext_vector_type(4)));
typedef float f32x4 __attribute__((ext_vector_type(4)));
typedef short bf16x8 __attribute__((ext_vector_type(8)));
typedef GAS unsigned gu32;
typedef GAS unsigned long long gu64;
#define RLX_AGENT __ATOMIC_RELAXED, __HIP_MEMORY_SCOPE_AGENT
#define LDS_WAIT() asm volatile("s_waitcnt lgkmcnt(0)" ::: "memory")
#define VM_WAIT() asm volatile("s_waitcnt vmcnt(0)" ::: "memory")
__device__ __forceinline__ unsigned long long rt() { return __builtin_amdgcn_s_memrealtime(); }
__device__ __forceinline__ unsigned f2bf(float f) { unsigned u = __builtin_bit_cast(unsigned, f); return (u + 0x7fffu + ((u >> 16) & 1u)) >> 16; }
__device__ __forceinline__ unsigned pk2(float lo, float hi) { return f2bf(lo) | (f2bf(hi) << 16); }

#define XB_TMO      128
#define XB_XCNT(j)  (256  + 64 * (j))
#define XB_XSUB(j)  (1280 + 64 * (j))
#define XB_XGEN(j)  (2304 + 64 * (j))
#define XB_TOP      3328
#define XB_TOPGEN   3392
#define XCD_BAR_WORDS 3456
#define XB_SPIN_CAP (1u << 18)

__device__ __forceinline__ unsigned xb_ld(unsigned* p)              { return __hip_atomic_load(p, __ATOMIC_RELAXED, __HIP_MEMORY_SCOPE_AGENT); }
__device__ __forceinline__ unsigned xb_add(unsigned* p, unsigned v) { return __hip_atomic_fetch_add(p, v, __ATOMIC_RELAXED, __HIP_MEMORY_SCOPE_AGENT); }
__device__ __forceinline__ unsigned xb_xcc_id() { return (unsigned)__builtin_amdgcn_s_getreg((3 << 11) | 20) & 0xFu; }
#define XB_SPIN(cond, bar) do { unsigned _sp = 0; while (cond) { __builtin_amdgcn_s_sleep(1); \
    if ((++_sp & 255u) == 0u) { if (xb_ld(&(bar)[XB_TMO])) break; if (_sp > XB_SPIN_CAP) { atomicAdd(&(bar)[XB_TMO], 1u); break; } } } } while (0)

struct XcdBarrier {
    unsigned* bar; unsigned x;
    volatile LAS unsigned* st;
};

__device__ __forceinline__ XcdBarrier xcd_barrier_post(unsigned* bar, volatile LAS unsigned* st) {
    XcdBarrier b; b.bar = bar; b.x = xb_xcc_id(); b.st = st;
    if (threadIdx.x == 0) (void)xb_add(&bar[XB_XCNT(b.x)], 1u);
    return b;
}
__device__ __forceinline__ void xcd_barrier_complete(unsigned* bar, unsigned x, unsigned& nloc, unsigned& nx) {
    const unsigned G = gridDim.x * gridDim.y * gridDim.z;
    unsigned sum, cnt, mine, sp = 0u;
    for (;;) {
        sum = 0u; cnt = 0u; mine = 0u;
#pragma unroll
        for (unsigned j = 0; j < 16; ++j) { const unsigned c = xb_ld(&bar[XB_XCNT(j)]); sum += c; cnt += (c > 0u) ? 1u : 0u; mine = (j == x) ? c : mine; }
        if (sum == G) break;
        __builtin_amdgcn_s_sleep(1);
        if ((++sp & 255u) == 0u) { if (xb_ld(&bar[XB_TMO])) break; if (sp > XB_SPIN_CAP) { atomicAdd(&bar[XB_TMO], 1u); break; } }
    }
    nloc = mine > 0u ? mine : 1u; nx = cnt > 0u ? cnt : 1u;
}

__device__ __forceinline__ void xcd_barrier(const XcdBarrier& b) {
    asm volatile("s_waitcnt vmcnt(0)" ::: "memory");
    __syncthreads();
    if (threadIdx.x == 0) {
        unsigned* bar = b.bar;
        __builtin_amdgcn_s_waitcnt(0);
        unsigned nloc = b.st[0], nx = b.st[1];
        if (nloc == 0u) { xcd_barrier_complete(bar, b.x, nloc, nx); b.st[0] = nloc; b.st[1] = nx; }
        const unsigned old = xb_add(&bar[XB_XSUB(b.x)], 1u);
        const unsigned gen = old / nloc;
        if (old + 1u == (gen + 1u) * nloc) {
            __builtin_amdgcn_fence(__ATOMIC_RELEASE, "agent");
            asm volatile("s_waitcnt vmcnt(0)" ::: "memory");
            const unsigned og = xb_add(&bar[XB_TOP], 1u);
            const unsigned tg = og / nx;
            if (og + 1u == (tg + 1u) * nx) xb_add(&bar[XB_TOPGEN], 1u);
            else XB_SPIN(xb_ld(&bar[XB_TOPGEN]) == tg, bar);
            __builtin_amdgcn_fence(__ATOMIC_ACQUIRE, "agent");
            xb_add(&bar[XB_XGEN(b.x)], 1u);
            asm volatile("s_waitcnt vmcnt(0)" ::: "memory");
        } else {
            XB_SPIN(xb_ld(&bar[XB_XGEN(b.x)]) == gen, bar);
            __builtin_amdgcn_fence(__ATOMIC_ACQUIRE, "agent");
            asm volatile("s_waitcnt vmcnt(0)" ::: "memory");
        }
    }
    __syncthreads();
}

constexpr int NWAVES = 8, NTHREADS = 512;
constexpr int BATCH = 2, SEQ = 4096, D = 2048, M = BATCH * SEQ, DEPTH = 4, NH = 16, HD = 128;
constexpr int HGRN_N = 5 * D, ATTN_N = 9 * D, DFF = 5632, FFN_N = 2 * DFF;
constexpr float EPS = 1e-6f;
constexpr int NPHASES = 1 + 9 * DEPTH;
#ifndef REP_PRO
#define REP_PRO 1
#endif
#ifndef REP_INH
#define REP_INH 1
#endif
#ifndef REP_INA_COLD
#define REP_INA_COLD 0
#endif
#ifndef REP_INA
#define REP_INA 1
#endif
#ifndef REP_WO
#define REP_WO 1
#endif
#ifndef REP_F1
#define REP_F1 1
#endif
#ifndef REP_F2
#define REP_F2 1
#endif
#ifndef REP_GATES
#define REP_GATES 1
#endif
#ifndef REP_SCAN
#define REP_SCAN 1
#endif
#ifndef REP_ATTN
#define REP_ATTN 1
#endif
#ifndef REP_FIN
#define REP_FIN 1
#endif
#ifndef REP_NORM
#define REP_NORM 1
#endif

constexpr size_t MiB = 1u << 20;
constexpr size_t WS_CTL = 0, CTL_ZERO_BYTES = 1 * MiB;
constexpr size_t WS_TAB = 1 * MiB;
constexpr size_t TAB_COS = 0, TAB_SIN = 262144, TAB_LB = 524288;
constexpr size_t WS_WHG = 2 * MiB;
constexpr size_t WS_WAT = 82 * MiB;
constexpr size_t WS_WO = 226 * MiB;
constexpr size_t WS_WF1 = 258 * MiB;
constexpr size_t WS_WF2 = 434 * MiB;
constexpr size_t WS_H = 522 * MiB;
constexpr size_t WS_PROJ = 554 * MiB;
constexpr size_t WS_MIX = 842 * MiB;
constexpr size_t WS_O = 942 * MiB;
constexpr size_t WS_G = 974 * MiB;
constexpr size_t WS_KH = 1006 * MiB;
constexpr size_t WS_END = 1076 * MiB;
constexpr int CW_BAR = 4096;

constexpr int RING_BYTES = 147456;
constexpr int LDSCTL_OFF = RING_BYTES, MISC_OFF = LDSCTL_OFF + 320;
constexpr int LDS_BYTES = 163840;

__device__ __forceinline__ float bf2f(unsigned short b) { return __builtin_bit_cast(float, (unsigned)b << 16); }
__device__ __forceinline__ float bflo(unsigned w) { return __builtin_bit_cast(float, w << 16); }
__device__ __forceinline__ float bfhi(unsigned w) { return __builtin_bit_cast(float, w & 0xffff0000u); }
__device__ __forceinline__ float wave_sum(float v) {
#pragma unroll
    for (int o = 1; o < 64; o <<= 1) v += __shfl_xor(v, o);
    return v;
}
__device__ __forceinline__ float sigmoid_f(float x) { return __builtin_amdgcn_rcpf(1.0f + __builtin_amdgcn_exp2f(-1.44269504f * x)); }

__device__ __forceinline__ void transpose_item(const float* W, int K, int N, bf16* WT, int k0, int n0, int drow0, LAS float* scr, int lane) {
    float ld[32];
#pragma unroll
    for (int i = 0; i < 32; ++i) { const int kk = 2 * i + (lane >> 5); ld[i] = W[(size_t)(k0 + kk) * N + n0 + (lane & 31)]; }
#pragma unroll
    for (int i = 0; i < 32; ++i) { const int kk = 2 * i + (lane >> 5); scr[kk * 33 + (lane & 31)] = ld[i]; }
    LDS_WAIT(); asm volatile("" ::: "memory");
    const int c = lane & 7;
#pragma unroll
    for (int j = 0; j < 4; ++j) { const int n = (lane >> 3) + 8 * j; const LAS float* s = scr + (8 * c) * 33 + n;
        v4u o; o.x = pk2(s[0 * 33], s[1 * 33]); o.y = pk2(s[2 * 33], s[3 * 33]); o.z = pk2(s[4 * 33], s[5 * 33]); o.w = pk2(s[6 * 33], s[7 * 33]);
        *(GAS v4u*)(WT + (size_t)(drow0 + n) * K + k0 + 8 * c) = o; }
    LDS_WAIT(); asm volatile("" ::: "memory");
}
__device__ __forceinline__ void transpose_matrix(const float* W, int K, int N, bf16* WT, int mode, LAS float* scr, int gw, int NGW, int lane) {
    const int nblk = N / 32, nitems = (K / 64) * nblk;
    for (int it = gw; it < nitems; it += NGW) {
        const int kb = it / nblk, nb = it - kb * nblk, n0 = 32 * nb;
        int drow0 = n0;
        if (mode == 1) { const int up = n0 >= DFF, nn = up ? n0 - DFF : n0; drow0 = (nn >> 7) * 256 + (up ? 128 : 0) + (nn & 127); }
        transpose_item(W, K, N, WT, 64 * kb, n0, drow0, scr, lane);
    }
}

template <bool RES, bool NORM2, bool XI16, bool XO16>
__device__ __forceinline__ void norm_rows(const bf16* gin, const void* x_in, void* x_out, const float* w1, const float* w2, bf16* hout, int gw, int NGW, int lane) {
    for (int m = gw; m < M; m += NGW) {
        float xv[4][8];
#pragma unroll
        for (int j = 0; j < 4; ++j) {
            if (XI16) { const v4u g = *(const GAS v4u*)((const bf16*)x_in + (size_t)m * D + 8 * (64 * j + lane));
                xv[j][0] = bflo(g.x); xv[j][1] = bfhi(g.x); xv[j][2] = bflo(g.y); xv[j][3] = bfhi(g.y); xv[j][4] = bflo(g.z); xv[j][5] = bfhi(g.z); xv[j][6] = bflo(g.w); xv[j][7] = bfhi(g.w); }
            else { const GAS f32x4* xp = (const GAS f32x4*)((const float*)x_in + (size_t)m * D + 8 * (64 * j + lane));
                const f32x4 a = xp[0], b = xp[1]; xv[j][0] = a.x; xv[j][1] = a.y; xv[j][2] = a.z; xv[j][3] = a.w; xv[j][4] = b.x; xv[j][5] = b.y; xv[j][6] = b.z; xv[j][7] = b.w; } }
        if (RES) {
            float gv[4][8]; float ss = 0.f;
#pragma unroll
            for (int j = 0; j < 4; ++j) { const v4u g = *(const GAS v4u*)(gin + (size_t)m * D + 8 * (64 * j + lane));
                gv[j][0] = bflo(g.x); gv[j][1] = bfhi(g.x); gv[j][2] = bflo(g.y); gv[j][3] = bfhi(g.y); gv[j][4] = bflo(g.z); gv[j][5] = bfhi(g.z); gv[j][6] = bflo(g.w); gv[j][7] = bfhi(g.w);
#pragma unroll
                for (int i = 0; i < 8; ++i) ss += gv[j][i] * gv[j][i]; }
            const float r1 = 1.0f / sqrtf(wave_sum(ss) * (1.0f / D) + EPS);
#pragma unroll
            for (int j = 0; j < 4; ++j) { const GAS f32x4* wp = (const GAS f32x4*)(w1 + 8 * (64 * j + lane)); const f32x4 a = wp[0], b = wp[1];
                const float wv[8] = {a.x, a.y, a.z, a.w, b.x, b.y, b.z, b.w};
#pragma unroll
                for (int i = 0; i < 8; ++i) xv[j][i] += gv[j][i] * r1 * wv[i];
                if (XO16) { v4u o; o.x = pk2(xv[j][0], xv[j][1]); o.y = pk2(xv[j][2], xv[j][3]); o.z = pk2(xv[j][4], xv[j][5]); o.w = pk2(xv[j][6], xv[j][7]);
                    *(GAS v4u*)((bf16*)x_out + (size_t)m * D + 8 * (64 * j + lane)) = o; }
                else { GAS f32x4* op = (GAS f32x4*)((float*)x_out + (size_t)m * D + 8 * (64 * j + lane));
                    op[0] = (f32x4){xv[j][0], xv[j][1], xv[j][2], xv[j][3]}; op[1] = (f32x4){xv[j][4], xv[j][5], xv[j][6], xv[j][7]}; } }
        }
        if (NORM2) {
            float ss = 0.f;
#pragma unroll
            for (int j = 0; j < 4; ++j)
#pragma unroll
                for (int i = 0; i < 8; ++i) ss += xv[j][i] * xv[j][i];
            const float r2 = 1.0f / sqrtf(wave_sum(ss) * (1.0f / D) + EPS);
#pragma unroll
            for (int j = 0; j < 4; ++j) { const GAS f32x4* wp = (const GAS f32x4*)(w2 + 8 * (64 * j + lane)); const f32x4 a = wp[0], b = wp[1];
                v4u o; o.x = pk2(xv[j][0] * r2 * a.x, xv[j][1] * r2 * a.y); o.y = pk2(xv[j][2] * r2 * a.z, xv[j][3] * r2 * a.w);
                o.z = pk2(xv[j][4] * r2 * b.x, xv[j][5] * r2 * b.y); o.w = pk2(xv[j][6] * r2 * b.z, xv[j][7] * r2 * b.w);
                *(GAS v4u*)(hout + (size_t)m * D + 8 * (64 * j + lane)) = o; }
        }
    }
}

__device__ __forceinline__ void hgrn_core_simple(LAS unsigned char* lds, const bf16* P, const float* lbt, bf16* OD, int tid) {
    const int chain = blockIdx.x;
    if (chain >= 64) return;
    const int b = chain >> 5, hh = (chain >> 1) & 15, dir = chain & 1;
    LAS float* qs = (LAS float*)lds; LAS float* ks = qs + 4096; LAS float* fs = ks + 4096; LAS float* vs = fs + 4096;
    const int v = tid >> 2, dg = tid & 3;
    float S[32];
#pragma unroll
    for (int j = 0; j < 32; ++j) S[j] = 0.f;
    const float* lb = lbt + (size_t)dir * 4 * D + hh * HD;
    bf16* od = OD + (size_t)dir * M * D;
    for (int blk = 0; blk < SEQ / 32; ++blk) {
        __syncthreads();
        for (int e = tid; e < 4096; e += NTHREADS) {
            const int tt = e >> 7, d = e & 127; const int ts = blk * 32 + tt; const int t = dir ? (SEQ - 1 - ts) : ts;
            const bf16* row = P + (size_t)(b * SEQ + t) * HGRN_N + hh * HD + d;
            const float qv = bf2f(row[0]); const float fv = bf2f(row[(1 + dir) * D]); const float iv = bf2f(row[3 * D]);
            const float lbv = lb[d]; const float fg = lbv + (1.0f - lbv) * sigmoid_f(fv);
            qs[e] = qv * sigmoid_f(qv); ks[e] = 1.0f - fg; fs[e] = fg; vs[e] = iv;
        }
        __syncthreads();
        for (int tt = 0; tt < 32; ++tt) {
            const float vt = vs[tt * 128 + v]; float o = 0.f;
            const LAS float* qr = qs + tt * 128 + dg * 32; const LAS float* kr = ks + tt * 128 + dg * 32; const LAS float* fr = fs + tt * 128 + dg * 32;
#pragma unroll
            for (int j = 0; j < 32; ++j) { S[j] = fr[j] * S[j] + kr[j] * vt; o += qr[j] * S[j]; }
            o += __shfl_xor(o, 1); o += __shfl_xor(o, 2);
            const int ts = blk * 32 + tt; const int t = dir ? (SEQ - 1 - ts) : ts;
            if (dg == 0) od[(size_t)(b * SEQ + t) * D + hh * HD + v] = (bf16)f2bf(o);
        }
    }
}
__device__ __forceinline__ void hgrn_finalize(const bf16* P, const bf16* OD, const float* gnorm, bf16* O, int gw, int NGW, int lane) {
    for (int m = gw; m < M; m += NGW) {
#pragma unroll
        for (int j = 0; j < 4; ++j) {
            const int e0 = 8 * (64 * j + lane);
            const v4u a = *(const GAS v4u*)(OD + (size_t)m * D + e0), b = *(const GAS v4u*)(OD + (size_t)M * D + (size_t)m * D + e0);
            const v4u g = *(const GAS v4u*)(P + (size_t)m * HGRN_N + 4 * D + e0);
            float s[8] = {bflo(a.x) + bflo(b.x), bfhi(a.x) + bfhi(b.x), bflo(a.y) + bflo(b.y), bfhi(a.y) + bfhi(b.y), bflo(a.z) + bflo(b.z), bfhi(a.z) + bfhi(b.z), bflo(a.w) + bflo(b.w), bfhi(a.w) + bfhi(b.w)};
            const float gv[8] = {bflo(g.x), bfhi(g.x), bflo(g.y), bfhi(g.y), bflo(g.z), bfhi(g.z), bflo(g.w), bfhi(g.w)};
            float ss = 0.f;
#pragma unroll
            for (int i = 0; i < 8; ++i) ss += s[i] * s[i];
            ss += __shfl_xor(ss, 1); ss += __shfl_xor(ss, 2); ss += __shfl_xor(ss, 4); ss += __shfl_xor(ss, 8);
            const float r = 1.0f / sqrtf(ss * (1.0f / HD) + EPS);
            const GAS f32x4* wp = (const GAS f32x4*)(gnorm + (e0 & 127)); const f32x4 wa = wp[0], wb = wp[1];
            const float wv[8] = {wa.x, wa.y, wa.z, wa.w, wb.x, wb.y, wb.z, wb.w};
            float o[8];
#pragma unroll
            for (int i = 0; i < 8; ++i) o[i] = s[i] * r * wv[i] * (gv[i] * sigmoid_f(gv[i]));
            v4u w; w.x = pk2(o[0], o[1]); w.y = pk2(o[2], o[3]); w.z = pk2(o[4], o[5]); w.w = pk2(o[6], o[7]);
            *(GAS v4u*)(O + (size_t)m * D + e0) = w;
        }
    }
}

__device__ __forceinline__ void rope_pair(float& x0, float& x1, const float* cosT, const float* sinT, int pos, int lane) {
    const float p0 = __shfl_xor(x0, 8), p1 = __shfl_xor(x1, 8);
    if (lane < 16) {
        const int dd = 2 * (lane & 7);
        const float c0 = cosT[pos * 16 + dd], c1 = cosT[pos * 16 + dd + 1], s0 = sinT[pos * 16 + dd], s1 = sinT[pos * 16 + dd + 1];
        if (lane < 8) { x0 = x0 * c0 - p0 * s0; x1 = x1 * c1 - p1 * s1; }
        else          { x0 = x0 * c0 + p0 * s0; x1 = x1 * c1 + p1 * s1; }
    }
}
__device__ __forceinline__ void attn_core_simple(const bf16* P, const float* cosT, const float* sinT, bf16* OG, float* LSE, int gw, int NGW, int lane) {
    const float scale = 0.08838834764831845f;
    for (int task = gw; task < M * NH * 3; task += NGW) {
        const int g = task % 3, rh = task / 3, hh = rh & 15, row = rh >> 4, b = row >> 12, t = row & (SEQ - 1);
        const int r = (g == 0) ? 1 : (g == 1 ? 4 : 16);
        const unsigned qq = ((const GAS unsigned*)(P + (size_t)row * ATTN_N + ((g * 3 + 0) * NH + hh) * HD))[lane];
        float q0 = bflo(qq), q1 = bfhi(qq);
        float mx = -1e30f, l = 0.f, o0 = 0.f, o1 = 0.f;
        for (int j = -64; j <= 64; ++j) {
            const int tk = t + r * j;
            if (tk < 0 || tk >= SEQ) continue;
            const bf16* krow = P + (size_t)(b * SEQ + tk) * ATTN_N + ((g * 3 + 1) * NH + hh) * HD;
            const unsigned kk = ((const GAS unsigned*)krow)[lane]; const unsigned vv = ((const GAS unsigned*)(krow + NH * HD))[lane];
            float k0 = bflo(kk), k1 = bfhi(kk);
            const float s = wave_sum(q0 * k0 + q1 * k1) * scale;
            const float mn = fmaxf(mx, s), c = __expf(mx - mn), p = __expf(s - mn);
            l = l * c + p; o0 = o0 * c + p * bflo(vv); o1 = o1 * c + p * bfhi(vv); mx = mn;
        }
        const float il = 1.0f / l;
        ((GAS unsigned*)(OG + ((size_t)g * M + row) * D + hh * HD))[lane] = pk2(o0 * il, o1 * il);
        if (lane == 0) LSE[((size_t)g * M + row) * NH + hh] = mx + __logf(l);
    }
}
__device__ __forceinline__ void attn_finalize(const bf16* OG, const float* LSE, bf16* O, int gw, int NGW, int lane) {
    for (int m = gw; m < M; m += NGW) {
#pragma unroll
        for (int j = 0; j < 4; ++j) {
            const int e0 = 8 * (64 * j + lane), hh = e0 >> 7;
            const float l0 = LSE[((size_t)0 * M + m) * NH + hh], l1 = LSE[((size_t)1 * M + m) * NH + hh], l2 = LSE[((size_t)2 * M + m) * NH + hh];
            const float mx = fmaxf(l0, fmaxf(l1, l2)); float w0 = __expf(l0 - mx), w1 = __expf(l1 - mx), w2 = __expf(l2 - mx);
            const float inv = 1.0f / (w0 + w1 + w2); w0 *= inv; w1 *= inv; w2 *= inv;
            const v4u a = *(const GAS v4u*)(OG + ((size_t)0 * M + m) * D + e0), b = *(const GAS v4u*)(OG + ((size_t)1 * M + m) * D + e0), c = *(const GAS v4u*)(OG + ((size_t)2 * M + m) * D + e0);
            v4u w;
            w.x = pk2(w0 * bflo(a.x) + w1 * bflo(b.x) + w2 * bflo(c.x), w0 * bfhi(a.x) + w1 * bfhi(b.x) + w2 * bfhi(c.x));
            w.y = pk2(w0 * bflo(a.y) + w1 * bflo(b.y) + w2 * bflo(c.y), w0 * bfhi(a.y) + w1 * bfhi(b.y) + w2 * bfhi(c.y));
            w.z = pk2(w0 * bflo(a.z) + w1 * bflo(b.z) + w2 * bflo(c.z), w0 * bfhi(a.z) + w1 * bfhi(b.z) + w2 * bfhi(c.z));
            w.w = pk2(w0 * bflo(a.w) + w1 * bflo(b.w) + w2 * bflo(c.w), w0 * bfhi(a.w) + w1 * bfhi(b.w) + w2 * bfhi(c.w));
            *(GAS v4u*)(O + (size_t)m * D + e0) = w;
        }
    }
}

typedef short s16x4 __attribute__((ext_vector_type(4)));
typedef short v4i16_t __attribute__((ext_vector_type(4)));
typedef unsigned v2u __attribute__((ext_vector_type(2)));
__device__ __forceinline__ void glds16(const void* gsrc, unsigned lds_dst) { unsigned keep;
    asm volatile("s_mov_b32 %0, m0\n\ts_mov_b32 m0, %2\n\ts_nop 0\n\tglobal_load_lds_dwordx4 %1, off\n\ts_mov_b32 m0, %0" : "=&s"(keep) : "v"(gsrc), "s"(lds_dst) : "memory"); }
__device__ __forceinline__ s16x4 tr_read(LAS const unsigned char* p) { return __builtin_bit_cast(s16x4, __builtin_amdgcn_ds_read_tr16_b64_v4i16((LAS v4i16_t*)p)); }
__device__ __forceinline__ bf16x8 cat44(s16x4 a, s16x4 b) { return (bf16x8){a[0], a[1], a[2], a[3], b[0], b[1], b[2], b[3]}; }
#ifdef PROBE_ADMA2
#define AT_VW "s_waitcnt vmcnt(22)"
#else
#define AT_VW "s_waitcnt vmcnt(13)"
#endif
__device__ __forceinline__ void glds16s_1(const void* sbase, unsigned voff, unsigned lds_dst) { unsigned keep;
    asm volatile("s_mov_b32 %0, m0\n\ts_mov_b32 m0, %3\n\ts_nop 0\n\tglobal_load_lds_dwordx4 %1, %2\n\ts_mov_b32 m0, %0" : "=&s"(keep) : "v"(voff), "s"(sbase), "s"(lds_dst) : "memory"); }
__device__ __forceinline__ void glds16s(const void* sbase, unsigned voff, unsigned lds_dst) { glds16s_1(sbase, voff, lds_dst);
#ifdef PROBE_ADMA2
    glds16s_1(sbase, voff, lds_dst);
#endif
}
__device__ __forceinline__ bf16x8 gload16s(const void* sbase, unsigned voff) { return *(const GAS bf16x8*)((const unsigned char*)sbase + voff); }
__device__ __forceinline__ void attn_core_mfma(LAS unsigned char* lds, const bf16* P, bf16* OG, float* LSE, int vcu, int G) {
    int tid_l = threadIdx.x; asm volatile("" : "+v"(tid_l));
    const int tid = tid_l, lane = tid & 63, w = __builtin_amdgcn_readfirstlane(tid >> 6), fr = lane & 15, q4 = lane >> 4;
    const float sc2 = 0.08838834764831845f * 1.44269504f;
    constexpr int RST = 288, K_OFF = 0, V_OFF = 73728;
#define AT_SCHED __builtin_amdgcn_sched_barrier(0)
    int prow[9], pchb[9];
#pragma unroll
    for (int i = 0; i < 9; ++i) { const int sl = (w + 8 * i) * 64 + lane; prow[i] = sl / 18; const int ch = sl - prow[i] * 18; pchb[i] = (ch < 16 ? ch : 0) * 16; }
    const int qp = (lane >> 2) & 3, p4 = lane & 3;
    const int bK = K_OFF + (16 * w + fr) * RST + q4 * 16;
    const int bV = V_OFF + (16 * w + 4 * q4 + qp) * RST + p4 * 8;
#define AT_DECODE(uid_) const int bi = (uid_) & 31, bhg = (uid_) >> 5, g = bhg % 3, bh = bhg / 3, hh = bh & 15, b = bh >> 4; \
        const int rsh = 2 * g, nbs = 5 - rsh, rho = bi >> nbs, blk = bi & ((1 << nbs) - 1), L = SEQ >> rsh, u0 = blk * 128; \
        const bf16* Qb = P + (size_t)b * SEQ * ATTN_N + ((g * 3 + 0) * NH + hh) * HD; const bf16* Kb = Qb + NH * HD; const bf16* Vb = Kb + NH * HD;
#define AT_ROWOFF(i_) ({ int uk_ = u0 - 64 + prow[i_]; uk_ = uk_ < 0 ? 0 : (uk_ >= L ? L - 1 : uk_); (unsigned)(((uk_ << rsh) + rho) * (ATTN_N * 2) + pchb[i_]); })
    bf16x8 qf[4];
    int uid = vcu;
    if (uid < 3072) { AT_DECODE(uid)
#pragma unroll
        for (int i = 0; i < 9; ++i) glds16s(Kb, AT_ROWOFF(i), (unsigned)(size_t)(lds + K_OFF + (w + 8 * i) * 1024));
        const unsigned qo = (unsigned)((((u0 + 16 * w + fr) << rsh) + rho) * (ATTN_N * 2) + 16 * q4);
#pragma unroll
        for (int ks = 0; ks < 4; ++ks) qf[ks] = gload16s(Qb, qo + 64 * ks); }
    for (; uid < 3072; uid += G) {
        AT_DECODE(uid)
        const int qtok = ((u0 + 16 * w + fr) << rsh) + rho;
        asm volatile("s_waitcnt vmcnt(0)" ::: "memory"); asm volatile("" : "+v"(qf[0]), "+v"(qf[1]), "+v"(qf[2]), "+v"(qf[3]));
        __builtin_amdgcn_s_barrier(); asm volatile("" ::: "memory");
#pragma unroll
        for (int i = 0; i < 9; ++i) glds16s(Vb, AT_ROWOFF(i), (unsigned)(size_t)(lds + V_OFF + (w + 8 * i) * 1024));
        f32x4 S[9]; bf16x8 kf[2][3][4];
#pragma unroll
        for (int kt = 0; kt < 9; ++kt) S[kt] = (f32x4){0.f, 0.f, 0.f, 0.f};
        AT_SCHED;
#pragma unroll
        for (int j = 0; j < 3; ++j)
#pragma unroll
            for (int ks = 0; ks < 4; ++ks) kf[0][j][ks] = *(const LAS bf16x8*)(lds + bK + 16 * j * RST + 64 * ks);
        AT_SCHED;
#pragma unroll
        for (int gi = 0; gi < 3; ++gi) {
            if (gi < 2) {
#pragma unroll
                for (int j = 0; j < 3; ++j)
#pragma unroll
                    for (int ks = 0; ks < 4; ++ks) kf[(gi + 1) & 1][j][ks] = *(const LAS bf16x8*)(lds + bK + 16 * (3 * (gi + 1) + j) * RST + 64 * ks);
                AT_SCHED; asm volatile("s_waitcnt lgkmcnt(12)" ::: "memory"); AT_SCHED; }
            else { AT_SCHED; asm volatile("s_waitcnt lgkmcnt(0)" ::: "memory"); AT_SCHED; }
#pragma unroll
            for (int j = 0; j < 3; ++j)
#pragma unroll
                for (int ks = 0; ks < 4; ++ks) S[3 * gi + j] = __builtin_amdgcn_mfma_f32_16x16x32_bf16(kf[gi & 1][j][ks], qf[ks], S[3 * gi + j], 0, 0, 0);
            AT_SCHED; }
        __builtin_amdgcn_s_barrier(); asm volatile("" ::: "memory");
        const int nuid = uid + G; bf16x8 qn[4];
        if (nuid < 3072) { const int uid_n = nuid;
            { const int bi = uid_n & 31, bhg = uid_n >> 5, g = bhg % 3, bh = bhg / 3, hh = bh & 15, b = bh >> 4;
              const int rsh = 2 * g, nbs = 5 - rsh, rho = bi >> nbs, blk = bi & ((1 << nbs) - 1), L = SEQ >> rsh, u0 = blk * 128;
              const bf16* Qb = P + (size_t)b * SEQ * ATTN_N + ((g * 3 + 0) * NH + hh) * HD; const bf16* Kb = Qb + NH * HD;
#pragma unroll
              for (int i = 0; i < 9; ++i) glds16s(Kb, AT_ROWOFF(i), (unsigned)(size_t)(lds + K_OFF + (w + 8 * i) * 1024));
              const unsigned qo = (unsigned)((((u0 + 16 * w + fr) << rsh) + rho) * (ATTN_N * 2) + 16 * q4);
#pragma unroll
              for (int ks = 0; ks < 4; ++ks) qn[ks] = gload16s(Qb, qo + 64 * ks); } }
        else {
#pragma unroll
            for (int ks = 0; ks < 4; ++ks) qn[ks] = qf[ks]; }
        float mx = -1e30f;
#pragma unroll
        for (int kt = 0; kt < 9; ++kt)
#pragma unroll
            for (int r = 0; r < 4; ++r) { const int rr = 4 * q4 + r; const int uk = u0 + 16 * w - 64 + 16 * kt + rr;
                const bool ok = (kt > 0 || rr >= fr) && (kt < 8 || rr <= fr) && uk >= 0 && uk < L;
                const float sv = ok ? S[kt][r] * sc2 : -1e30f; S[kt][r] = sv; mx = fmaxf(mx, sv); }
        mx = fmaxf(mx, __shfl_xor(mx, 16)); mx = fmaxf(mx, __shfl_xor(mx, 32));
        float l = 0.f;
#pragma unroll
        for (int kt = 0; kt < 9; ++kt)
#pragma unroll
            for (int r = 0; r < 4; ++r) { const float pv = __builtin_amdgcn_exp2f(S[kt][r] - mx); S[kt][r] = pv; l += pv; }
        l += __shfl_xor(l, 16); l += __shfl_xor(l, 32);
        bf16x8 pf[5];
#pragma unroll
        for (int pi = 0; pi < 5; ++pi) { const int T0 = 2 * pi, T1 = (2 * pi + 1 < 9) ? 2 * pi + 1 : 8;
            v4u pw; pw.x = pg8::cvt_pk_bf16(S[T0][0], S[T0][1]); pw.y = pg8::cvt_pk_bf16(S[T0][2], S[T0][3]);
            if (2 * pi + 1 < 9) { pw.z = pg8::cvt_pk_bf16(S[T1][0], S[T1][1]); pw.w = pg8::cvt_pk_bf16(S[T1][2], S[T1][3]); } else { pw.z = 0u; pw.w = 0u; }
            pf[pi] = __builtin_bit_cast(bf16x8, pw); }
        if (nuid < 3072) asm volatile(AT_VW ::: "memory"); else asm volatile("s_waitcnt vmcnt(0)" ::: "memory");
        __builtin_amdgcn_s_barrier(); asm volatile("" ::: "memory");
        f32x4 O[8]; s16x4 vr[2][8][2];
#pragma unroll
        for (int dt = 0; dt < 8; ++dt) O[dt] = (f32x4){0.f, 0.f, 0.f, 0.f};
        AT_SCHED;
#pragma unroll
        for (int dt = 0; dt < 8; ++dt) { vr[0][dt][0] = tr_read(lds + bV + 0 * RST + 32 * dt); vr[0][dt][1] = tr_read(lds + bV + 16 * RST + 32 * dt); }
        AT_SCHED;
#pragma unroll
        for (int pi = 0; pi < 5; ++pi) {
            if (pi < 4) { const int T0 = 2 * (pi + 1), T1 = (2 * (pi + 1) + 1 < 9) ? 2 * (pi + 1) + 1 : 8;
#pragma unroll
                for (int dt = 0; dt < 4; ++dt) { vr[(pi + 1) & 1][dt][0] = tr_read(lds + bV + 16 * T0 * RST + 32 * dt); vr[(pi + 1) & 1][dt][1] = tr_read(lds + bV + 16 * T1 * RST + 32 * dt); }
                AT_SCHED; asm volatile("s_waitcnt lgkmcnt(8)" ::: "memory"); AT_SCHED;
#pragma unroll
                for (int dt = 4; dt < 8; ++dt) { vr[(pi + 1) & 1][dt][0] = tr_read(lds + bV + 16 * T0 * RST + 32 * dt); vr[(pi + 1) & 1][dt][1] = tr_read(lds + bV + 16 * T1 * RST + 32 * dt); }
                AT_SCHED; }
            else { AT_SCHED; asm volatile("s_waitcnt lgkmcnt(0)" ::: "memory"); AT_SCHED; }
#pragma unroll
            for (int dt = 0; dt < 8; ++dt) O[dt] = __builtin_amdgcn_mfma_f32_16x16x32_bf16(cat44(vr[pi & 1][dt][0], vr[pi & 1][dt][1]), pf[pi], O[dt], 0, 0, 0);
            AT_SCHED; }
        const float il = 1.0f / l;
        const bf16* ob = OG + ((size_t)g * M + (size_t)b * SEQ) * D + hh * HD; const unsigned oo = (unsigned)(qtok * (D * 2) + 8 * q4);
#pragma unroll
        for (int dt = 0; dt < 8; ++dt) { v2u o2; o2.x = pk2(O[dt][0] * il, O[dt][1] * il); o2.y = pk2(O[dt][2] * il, O[dt][3] * il);
            asm volatile("global_store_dwordx2 %0, %1, %2" :: "v"(oo + 32 * dt), "v"(o2), "s"(ob) : "memory"); }
        { const float* lb = LSE + ((size_t)g * M + (size_t)b * SEQ) * NH + hh; const float lv = mx * 0.6931471805599453f + __logf(l);
          const unsigned lo = (unsigned)(qtok * (NH * 4));
          asm volatile("global_store_dword %0, %1, %2" :: "v"(lo), "v"(lv), "s"(lb) : "memory"); }
#pragma unroll
        for (int ks = 0; ks < 4; ++ks) qf[ks] = qn[ks];
    }
    asm volatile("s_waitcnt vmcnt(0) lgkmcnt(0)" ::: "memory"); __builtin_amdgcn_s_barrier(); asm volatile("" ::: "memory");
#undef AT_SCHED
#undef AT_DECODE
#undef AT_ROWOFF
}
typedef float float2_t __attribute__((ext_vector_type(2)));
__device__ __forceinline__ void hgrn_gates(const bf16* P, const float* lbt, bf16* QT, bf16* KT, float* PREF, float* BR, int gw, int NGW, int lane) {
    const unsigned lo = 4u * (unsigned)lane;
    for (int item = gw; item < 8192; item += NGW) {
        const int cb = item & 15, half = (item >> 4) & 1, chunk = (item >> 5) & 127, dir = item >> 12;
        const int cbase = cb * 128; const size_t row0 = (size_t)chunk * 64;
        const float lb0 = lbt[(size_t)dir * 4 * D + cbase + 2 * lane], lb1 = lbt[(size_t)dir * 4 * D + cbase + 2 * lane + 1];
        const unsigned char* fcol = (const unsigned char*)(P + (1 + dir) * D + cbase); const unsigned char* qcol = (const unsigned char*)(P + cbase);
        unsigned char* qt = (unsigned char*)(QT + (size_t)dir * M * D + cbase); unsigned char* kt = (unsigned char*)(KT + (size_t)dir * M * D + cbase);
        unsigned fw[32], qw[32];
#pragma unroll
        for (int j = 0; j < 32; ++j) { const int tau = half ? 32 + j : 31 - j; const size_t t = dir ? row0 + 63 - tau : row0 + tau;
            fw[j] = *(const GAS unsigned*)(fcol + t * (HGRN_N * 2) + lo); qw[j] = *(const GAS unsigned*)(qcol + t * (HGRN_N * 2) + lo); }
        float a0 = 1.f, a1 = 1.f;
#pragma unroll
        for (int j = 0; j < 32; ++j) { const int tau = half ? 32 + j : 31 - j; const size_t t = dir ? row0 + 63 - tau : row0 + tau;
            asm volatile("" : "+v"(fw[j]), "+v"(qw[j]) :: "memory");
            const float g0 = lb0 + (1.0f - lb0) * sigmoid_f(bflo(fw[j])), g1 = lb1 + (1.0f - lb1) * sigmoid_f(bfhi(fw[j]));
            const float q0 = bflo(qw[j]), q1 = bfhi(qw[j]); const float s0 = q0 * sigmoid_f(q0), s1 = q1 * sigmoid_f(q1);
            if (half) { a0 *= g0; a1 *= g1; }
            const float i0 = __builtin_amdgcn_rcpf(fmaxf(a0, 1e-30f)), i1 = __builtin_amdgcn_rcpf(fmaxf(a1, 1e-30f));
            const float e0 = half ? a0 : i0, e1 = half ? a1 : i1, r0 = half ? i0 : a0, r1 = half ? i1 : a1;
            *(GAS unsigned*)(qt + t * (D * 2) + lo) = pk2(s0 * e0, s1 * e1);
            *(GAS unsigned*)(kt + t * (D * 2) + lo) = pk2((1.0f - g0) * r0, (1.0f - g1) * r1);
            if (!half) { a0 *= g0; a1 *= g1; }
        }
        float* dst = (half ? BR : PREF) + ((size_t)dir * (M / 64) + chunk) * D + cbase;
        *(GAS float2_t*)((unsigned char*)dst + 2u * lo) = (float2_t){a0, a1};
    }
}

__device__ __forceinline__ void hgrn_scan_mfma(LAS unsigned char* lds, const bf16* P, const bf16* QT, const bf16* KT, const float* PREF, const float* BR, bf16* OD, int vcu, int G) {
    int tid_l = threadIdx.x; asm volatile("" : "+v"(tid_l));
    const int tid = tid_l, lane = tid & 63, w = __builtin_amdgcn_readfirstlane(tid >> 6), fr = lane & 15, q4 = lane >> 4;
    constexpr int QST = 272, KST = 288, VST = 96;
    constexpr int STG = 43008, QS = 0, KS = 17408, VS = 35840, VEC = 41984;
#define HG_SCHED __builtin_amdgcn_sched_barrier(0)
    for (int unit = vcu; unit < 256; unit += G) {
        const int chain = unit >> 2, slice = unit & 3, b = chain >> 5, hh = (chain >> 1) & 15, dir = chain & 1;
        const size_t dOff = (size_t)dir * M * D;
        const int ck0 = dir ? 63 : 0; const size_t tok00 = (size_t)b * SEQ + (size_t)ck0 * 64;
        if (w >= 4) {
            const int lw = w - 4;
            const unsigned char* src[11]; long sstr[11]; int poff[11];
            const long rstep = (dir ? -64L : 64L);
#pragma unroll
            for (int i = 0; i < 11; ++i) {
                int img, pcl;
                if (i < 4) { img = 0; pcl = lw + 4 * i; } else if (i < 8) { img = 1; pcl = lw + 4 * (i - 4); } else if (i == 8) { img = 2; pcl = lw; }
                else if (i == 9) { img = (lw < 2) ? 2 : (lw == 2 ? 0 : 1); pcl = (lw < 2) ? 4 + lw : 16; }
                else { img = (lw == 0) ? 1 : (lw == 1 ? 3 : 0); pcl = (lw == 0) ? 17 : lw; }
                const int sl = pcl * 64 + lane;
                if (img == 0 || img == 1) { const int RS = img ? 18 : 17; const int row = sl / RS, ch = sl - row * RS, chs = ch < 16 ? ch : 0;
                    src[i] = (const unsigned char*)((img ? KT : QT) + dOff + (tok00 + row) * D + hh * HD + chs * 8); sstr[i] = rstep * D * 2; poff[i] = (img ? KS : QS) + pcl * 1024; }
                else if (img == 2) { const int row = sl / 6, ch = sl - row * 6, chs = ch < 4 ? ch : 0;
                    src[i] = (const unsigned char*)(P + (tok00 + row) * HGRN_N + 3 * D + hh * HD + slice * 32 + chs * 8); sstr[i] = rstep * HGRN_N * 2; poff[i] = VS + pcl * 1024; }
                else { src[i] = (const unsigned char*)(((lane < 32) ? PREF : BR) + ((size_t)dir * (M / 64) + (tok00 >> 6)) * D + hh * HD + 4 * (lane & 31)); sstr[i] = (dir ? -1L : 1L) * D * 4; poff[i] = VEC; } }
#define HG_STAGE(step_, sb_) do { _Pragma("unroll") for (int i_ = 0; i_ < 11; ++i_) \
                glds16(src[i_] + (long)(step_) * sstr[i_], (unsigned)(size_t)(lds + (sb_) + poff[i_])); } while (0)
            HG_STAGE(0, 0); HG_STAGE(1, STG);
            int sbn = 2 * STG;
            for (int step = 0; step < 64; ++step) {
                if (step < 63) asm volatile("s_waitcnt vmcnt(11)" ::: "memory"); else asm volatile("s_waitcnt vmcnt(0)" ::: "memory");
                __builtin_amdgcn_s_barrier(); asm volatile("" ::: "memory");
                if (step + 2 < 64) HG_STAGE(step + 2, sbn);
                sbn = (sbn == 2 * STG) ? 0 : sbn + STG;
            }
#undef HG_STAGE
        } else {
            const int tt = w, qp = (lane >> 2) & 3, p4 = lane & 3;
            const int bQ = QS + (16 * tt + fr) * QST + q4 * 16;
            const int bQ2 = QS + (16 * tt + fr) * QST + q4 * 8;
            const int bK = KS + fr * KST + q4 * 16;
            const int bKc = KS + (4 * q4 + qp) * KST + p4 * 8;
            const int bV = VS + (4 * q4 + qp) * VST + p4 * 8;
            const int bP = VEC + q4 * 16;
            f32x4 S[8][2];
#pragma unroll
            for (int T = 0; T < 8; ++T) { S[T][0] = (f32x4){0.f, 0.f, 0.f, 0.f}; S[T][1] = (f32x4){0.f, 0.f, 0.f, 0.f}; }
            int sb = 0;
            for (int step = 0; step < 64; ++step) {
                __builtin_amdgcn_s_barrier(); asm volatile("" ::: "memory");
                LAS const unsigned char* st = lds + sb;
                HG_SCHED;
                bf16x8 qf[4], kf[2][4]; s16x4 va[2][2][2];
#pragma unroll
                for (int ks = 0; ks < 4; ++ks) qf[ks] = *(const LAS bf16x8*)(st + bQ + 64 * ks);
#pragma unroll
                for (int s4 = 0; s4 < 4; ++s4) kf[0][s4] = *(const LAS bf16x8*)(st + bK + 16 * s4 * KST);
#pragma unroll
                for (int vt = 0; vt < 2; ++vt)
#pragma unroll
                    for (int pi = 0; pi < 2; ++pi) { va[vt][pi][0] = tr_read(st + bV + 32 * pi * VST + 32 * vt); va[vt][pi][1] = tr_read(st + bV + (32 * pi + 16) * VST + 32 * vt); }
                HG_SCHED;
                f32x4 Pt[4];
#pragma unroll
                for (int s4 = 0; s4 < 4; ++s4) Pt[s4] = (f32x4){0.f, 0.f, 0.f, 0.f};
#pragma unroll
                for (int ks = 0; ks < 4; ++ks) {
                    if (ks < 3) {
#pragma unroll
                        for (int s4 = 0; s4 < 4; ++s4) kf[(ks + 1) & 1][s4] = *(const LAS bf16x8*)(st + bK + 16 * s4 * KST + 64 * (ks + 1));
                        HG_SCHED; asm volatile("s_waitcnt lgkmcnt(4)" ::: "memory"); HG_SCHED; }
                    else { HG_SCHED; asm volatile("s_waitcnt lgkmcnt(0)" ::: "memory"); HG_SCHED; }
#pragma unroll
                    for (int s4 = 0; s4 < 4; ++s4) Pt[s4] = __builtin_amdgcn_mfma_f32_16x16x32_bf16(kf[ks & 1][s4], qf[ks], Pt[s4], 0, 0, 0);
                    HG_SCHED; }
                f32x4 pr[8]; s16x4 qa[4], qb[4];
#pragma unroll
                for (int T = 0; T < 8; ++T) pr[T] = *(const LAS f32x4*)(st + bP + 64 * T);
#pragma unroll
                for (int ks = 0; ks < 4; ++ks) { qa[ks] = *(const LAS s16x4*)(st + bQ2 + 64 * ks); qb[ks] = *(const LAS s16x4*)(st + bQ2 + 64 * ks + 32); }
                HG_SCHED;
                const int tix = 16 * tt + fr;
#pragma unroll
                for (int s4 = 0; s4 < 4; ++s4)
#pragma unroll
                    for (int r = 0; r < 4; ++r) { const int six = 16 * s4 + 4 * q4 + r; const bool keep = dir ? (six >= tix) : (six <= tix); Pt[s4][r] = keep ? Pt[s4][r] : 0.f; }
                f32x4 o[2]; o[0] = (f32x4){0.f, 0.f, 0.f, 0.f}; o[1] = (f32x4){0.f, 0.f, 0.f, 0.f};
#pragma unroll
                for (int pi = 0; pi < 2; ++pi) {
                    v4u pw; pw.x = pg8::cvt_pk_bf16(Pt[2 * pi][0], Pt[2 * pi][1]); pw.y = pg8::cvt_pk_bf16(Pt[2 * pi][2], Pt[2 * pi][3]);
                    pw.z = pg8::cvt_pk_bf16(Pt[2 * pi + 1][0], Pt[2 * pi + 1][1]); pw.w = pg8::cvt_pk_bf16(Pt[2 * pi + 1][2], Pt[2 * pi + 1][3]);
#pragma unroll
                    for (int vt = 0; vt < 2; ++vt) o[vt] = __builtin_amdgcn_mfma_f32_16x16x32_bf16(cat44(va[vt][pi][0], va[vt][pi][1]), __builtin_bit_cast(bf16x8, pw), o[vt], 0, 0, 0); }
                HG_SCHED; asm volatile("s_waitcnt lgkmcnt(0)" ::: "memory"); HG_SCHED;
#pragma unroll
                for (int T = 0; T < 8; ++T) { S[T][0] = S[T][0] * pr[T]; S[T][1] = S[T][1] * pr[T]; }
                HG_SCHED;
                s16x4 kc[2][2][2][2]; f32x4 br[2][2];
#pragma unroll
                for (int j = 0; j < 2; ++j) { br[0][j] = *(const LAS f32x4*)(st + bP + 512 + 64 * j);
#pragma unroll
                    for (int pi = 0; pi < 2; ++pi) { kc[0][j][pi][0] = tr_read(st + bKc + 32 * pi * KST + 32 * j); kc[0][j][pi][1] = tr_read(st + bKc + (32 * pi + 16) * KST + 32 * j); } }
                HG_SCHED;
#pragma unroll
                for (int ks = 0; ks < 4; ++ks) { const int T0 = 2 * ks, T1 = 2 * ks + 1; const bf16x8 qq = cat44(qa[ks], qb[ks]);
#pragma unroll
                    for (int vt = 0; vt < 2; ++vt) {
                        v4u aw; aw.x = pg8::cvt_pk_bf16(S[T0][vt][0], S[T0][vt][1]); aw.y = pg8::cvt_pk_bf16(S[T0][vt][2], S[T0][vt][3]);
                        aw.z = pg8::cvt_pk_bf16(S[T1][vt][0], S[T1][vt][1]); aw.w = pg8::cvt_pk_bf16(S[T1][vt][2], S[T1][vt][3]);
                        o[vt] = __builtin_amdgcn_mfma_f32_16x16x32_bf16(__builtin_bit_cast(bf16x8, aw), qq, o[vt], 0, 0, 0); } }
                HG_SCHED;
                { const int ck = dir ? 63 - step : step; const size_t tok = (size_t)b * SEQ + (size_t)ck * 64 + 16 * tt + fr;
#pragma unroll
                  for (int vt = 0; vt < 2; ++vt) { v2u o2; o2.x = pk2(o[vt][0], o[vt][1]); o2.y = pk2(o[vt][2], o[vt][3]);
                    *(GAS v2u*)(OD + dOff + tok * D + hh * HD + slice * 32 + 16 * vt + 4 * q4) = o2; } }
                HG_SCHED;
#pragma unroll
                for (int rd = 0; rd < 4; ++rd) {
                    if (rd < 3) {
#pragma unroll
                        for (int j = 0; j < 2; ++j) { const int T = 2 * (rd + 1) + j; br[(rd + 1) & 1][j] = *(const LAS f32x4*)(st + bP + 512 + 64 * T);
#pragma unroll
                            for (int pi = 0; pi < 2; ++pi) { kc[(rd + 1) & 1][j][pi][0] = tr_read(st + bKc + 32 * pi * KST + 32 * T); kc[(rd + 1) & 1][j][pi][1] = tr_read(st + bKc + (32 * pi + 16) * KST + 32 * T); } }
                        HG_SCHED; asm volatile("s_waitcnt lgkmcnt(10)" ::: "memory"); HG_SCHED; }
                    else { HG_SCHED; asm volatile("s_waitcnt lgkmcnt(0)" ::: "memory"); HG_SCHED; }
#pragma unroll
                    for (int j = 0; j < 2; ++j) { const int T = 2 * rd + j;
#pragma unroll
                        for (int vt = 0; vt < 2; ++vt) {
#pragma unroll
                            for (int pi = 0; pi < 2; ++pi) S[T][vt] = __builtin_amdgcn_mfma_f32_16x16x32_bf16(cat44(kc[rd & 1][j][pi][0], kc[rd & 1][j][pi][1]), cat44(va[vt][pi][0], va[vt][pi][1]), S[T][vt], 0, 0, 0);
                            S[T][vt] = S[T][vt] * br[rd & 1][j]; } }
                    HG_SCHED; }
                sb = (sb == 2 * STG) ? 0 : sb + STG;
            }
        }
        asm volatile("s_waitcnt vmcnt(0) lgkmcnt(0)" ::: "memory"); __builtin_amdgcn_s_barrier(); asm volatile("" ::: "memory");
    }
#undef HG_SCHED
}
struct Args { const float* in[9]; float* out; unsigned char* ws; int ph_lo, ph_hi; };
__global__ void __launch_bounds__(NTHREADS, 2) fwd(Args args) {
    extern __shared__ __attribute__((aligned(16))) unsigned char lds_raw[];
    LAS unsigned char* lds = (LAS unsigned char*)lds_raw;
    volatile LAS unsigned* MISC = (volatile LAS unsigned*)(lds + MISC_OFF);
    const int G = gridDim.x; const int bx = blockIdx.x;
    const int vcu = (G % 8 == 0) ? (bx % 8) * (G / 8) + bx / 8 : bx;
    const int NGW = G * NWAVES;
    unsigned char* ws = args.ws;
    const float* x_in = args.in[0]; const float* norm_w = args.in[1]; const float* w_in_hgrn = args.in[2]; const float* lbnd = args.in[3]; const float* gnorm = args.in[4];
    const float* w_in_attn = args.in[5]; const float* w_out = args.in[6]; const float* w_ffn_in = args.in[7]; const float* w_ffn_out = args.in[8];
    float* xres = args.out;
    float* cosT = (float*)(ws + WS_TAB + TAB_COS); float* sinT = (float*)(ws + WS_TAB + TAB_SIN); float* lbT = (float*)(ws + WS_TAB + TAB_LB);
    bf16* WHG = (bf16*)(ws + WS_WHG); bf16* WAT = (bf16*)(ws + WS_WAT); bf16* WO = (bf16*)(ws + WS_WO); bf16* WF1 = (bf16*)(ws + WS_WF1); bf16* WF2 = (bf16*)(ws + WS_WF2);
    bf16* H = (bf16*)(ws + WS_H); bf16* PROJ = (bf16*)(ws + WS_PROJ); bf16* MIX = (bf16*)(ws + WS_MIX); bf16* OB = (bf16*)(ws + WS_O); bf16* GB = (bf16*)(ws + WS_G);
    float* LSE = (float*)(ws + WS_MIX + 96 * MiB);
    bf16* QT = (bf16*)(ws + WS_PROJ + 160 * MiB); bf16* KT = (bf16*)(ws + WS_PROJ + 224 * MiB); bf16* KH = (bf16*)(ws + WS_KH);
    bf16* XB = (bf16*)(ws + WS_KH);
    float* XSCR = (float*)(ws + WS_MIX); bf16* HSCR = (bf16*)(ws + WS_MIX + 64 * MiB);
    float* PREF = (float*)(ws + WS_KH + 64 * MiB); float* E63V = (float*)(ws + WS_KH + 66 * MiB);

    for (int u = threadIdx.x; u < (LDS_BYTES - LDSCTL_OFF) / 4; u += NTHREADS) ((LAS unsigned*)(lds + LDSCTL_OFF))[u] = 0u;
    __syncthreads();
    const int lo = args.ph_lo, hi = args.ph_hi;
    const int FF1_REM = ((M / 256) * (FFN_N / 256)) % G;
    const bool TAILCVT = FF1_REM != 0 && (hi - lo) == NPHASES && REP_F1 == 1;
    const bool use_bar = (hi - lo) > 1;
    XcdBarrier bar; bar.bar = (unsigned*)(ws + WS_CTL) + CW_BAR; bar.x = 0; bar.st = nullptr;
    if (use_bar) bar = xcd_barrier_post((unsigned*)(ws + WS_CTL) + CW_BAR, MISC + 8);
#ifndef TAIL_ALL
#define TAIL_ALL 0
#endif
#ifndef INP_ALIGN
#define INP_ALIGN true
#endif
#ifndef TAIL_WO
#define TAIL_WO 0
#endif
#ifndef TAIL_F2
#define TAIL_F2 1
#endif
#ifndef MIXMAP
#define MIXMAP vcu
#endif
#define IN(k) (lo <= (k) && (k) < hi)
#define PH_IDS int tid_p = threadIdx.x; asm volatile("" : "+v"(tid_p)); const int lane_p = tid_p & 63; const int wave_p = __builtin_amdgcn_readfirstlane(tid_p >> 6); const int gw_p = vcu * NWAVES + wave_p; (void)lane_p; (void)gw_p;
#ifndef REP_BAR
#define REP_BAR 1
#endif
#define SEAM(k) do { if (IN(k) && IN((k) + 1)) for (int rb = 0; rb < REP_BAR; ++rb) xcd_barrier(bar); } while (0)

    if (IN(0)) for (int rep = 0; rep < REP_PRO; ++rep) {
        PH_IDS
        const int lane = lane_p, gw = gw_p, tid = tid_p;
        LAS float* scr = (LAS float*)(lds + wave_p * 16384);
        for (int s = 0; s < ((TAILCVT && TAIL_ALL) ? 1 : 2); ++s) transpose_matrix(w_in_hgrn + (size_t)s * D * HGRN_N, D, HGRN_N, WHG + (size_t)s * HGRN_N * D, 0, scr, gw, NGW, lane);
        for (int s = 0; s < ((TAILCVT && TAIL_ALL) ? 0 : 2); ++s) transpose_matrix(w_in_attn + (size_t)s * D * ATTN_N, D, ATTN_N, WAT + (size_t)s * ATTN_N * D, 0, scr, gw, NGW, lane);
        for (int s = 0; s < ((TAILCVT && (TAIL_ALL || TAIL_WO)) ? 1 : 4); ++s) transpose_matrix(w_out + (size_t)s * D * D, D, D, WO + (size_t)s * D * D, 0, scr, gw, NGW, lane);
        for (int s = 0; s < (TAILCVT ? 1 : 4); ++s) transpose_matrix(w_ffn_in + (size_t)s * D * FFN_N, D, FFN_N, WF1 + (size_t)s * FFN_N * D, 1, scr, gw, NGW, lane);
        for (int s = 0; s < ((TAILCVT && TAIL_F2) ? 1 : 4); ++s) transpose_matrix(w_ffn_out + (size_t)s * DFF * D, DFF, D, WF2 + (size_t)s * D * DFF, 0, scr, gw, NGW, lane);
        const int gt = vcu * NTHREADS + tid, NGT = G * NTHREADS;
        for (int idx = gt; idx < SEQ * 16; idx += NGT) { const int pos = idx >> 4, i = idx & 15;
            const float inv = powf(500000.0f, -(float)(2 * i) / 32.0f); const float ang = (float)pos * inv; cosT[idx] = cosf(ang); sinT[idx] = sinf(ang); }
        for (int idx = gt; idx < 2 * D; idx += NGT) { const int dir = idx >> 11, c = idx & (D - 1);
            float xl[4]; float mx = -3.0e38f;
#pragma unroll
            for (int l = 0; l < 4; ++l) { xl[l] = lbnd[(size_t)(dir * 4 + l) * D + c]; mx = fmaxf(mx, xl[l]); }
            float sum = 0.f;
#pragma unroll
            for (int l = 0; l < 4; ++l) { xl[l] = expf(xl[l] - mx); sum += xl[l]; }
            float cum = 0.f, c0 = 0.f;
#pragma unroll
            for (int l = 0; l < 4; ++l) { cum += xl[l] / sum; if (l == 0) c0 = cum; lbT[(size_t)(dir * 4 + l) * D + c] = cum - c0; } }
        norm_rows<false, true, false, false>(nullptr, x_in, nullptr, nullptr, norm_w, H, gw, NGW, lane);
    }
    SEAM(0);

    for (int L = 0; L < DEPTH; ++L) {
        const int pb = 1 + 9 * L; const bool hg = (L & 1) == 0; const int slot = L >> 1;
        const float* nw = norm_w + (size_t)L * 4 * D;
        const int NPROJ = hg ? HGRN_N : ATTN_N;
        if (IN(pb)) {
#ifdef STAGGER_US
            { const unsigned long long t0 = __builtin_amdgcn_s_memrealtime(); const unsigned long long dl = (unsigned long long)((bx >> 3) & 3) * (STAGGER_US * 100);
              while (__builtin_amdgcn_s_memrealtime() - t0 < dl) __builtin_amdgcn_s_sleep(8); }
#endif
            if (hg) for (int rep = 0; rep < REP_INH; ++rep) { pg8::Gemm g{H, WHG + (size_t)slot * HGRN_N * D, M, HGRN_N, D}; pg8::StaticOrder S; S.init(M, HGRN_N, G, bx);
                pg8::EpiBf16<0> E{PROJ, HGRN_N, nullptr, 0, 0, 1.f};
                pg8::gemm_phase<pg8::EpiBf16<0>, pg8::StaticOrder, INP_ALIGN, true>(lds, g, S, E); }
            else for (int rep = 0; rep < REP_INA; ++rep) { pg8::Gemm g{H, WAT + (size_t)((REP_INA_COLD && rep + 1 < REP_INA) ? (slot ^ 1) : slot) * ATTN_N * D, M, ATTN_N, D}; pg8::StaticOrder S; S.init(M, ATTN_N, G, bx);
                pg8::EpiRope E{PROJ, ATTN_N, cosT, sinT};
                pg8::gemm_phase<pg8::EpiRope, pg8::StaticOrder, INP_ALIGN, true>(lds, g, S, E); }
        }
        SEAM(pb);
        if (hg) {
            if (IN(pb + 1)) for (int rep = 0; rep < REP_GATES; ++rep) { PH_IDS hgrn_gates(PROJ, lbT + (size_t)L * D, QT, KT, PREF, E63V, gw_p, NGW, lane_p); }
            SEAM(pb + 1);
        }
        if (IN(pb + 2)) {
            if (hg) for (int rep = 0; rep < REP_SCAN; ++rep) hgrn_scan_mfma(lds, PROJ, QT, KT, PREF, E63V, MIX, MIXMAP, G);
            else for (int rep = 0; rep < REP_ATTN; ++rep) attn_core_mfma(lds, PROJ, MIX, LSE, MIXMAP, G);
        }
        SEAM(pb + 2);
        if (IN(pb + 3)) for (int rep = 0; rep < REP_FIN; ++rep) {
            PH_IDS
            const int lane = lane_p, gw = gw_p;
            if (hg) hgrn_finalize(PROJ, MIX, gnorm + (size_t)slot * HD, OB, gw, NGW, lane);
            else attn_finalize(MIX, LSE, OB, gw, NGW, lane);
        }
        SEAM(pb + 3);
        if (IN(pb + 4)) for (int rep = 0; rep < REP_WO; ++rep) {
            pg8::Gemm g{OB, WO + (size_t)L * D * D, M, D, D}; pg8::StaticOrder S; S.init(M, D, G, bx);
            pg8::EpiBf16<0> E{GB, D, nullptr, 0, 0, 1.f};
            pg8::gemm_phase<pg8::EpiBf16<0>, pg8::StaticOrder, true, true>(lds, g, S, E);
        }
        SEAM(pb + 4);
        if (IN(pb + 5)) for (int rep = 0; rep < REP_NORM; ++rep) { PH_IDS if (L == 0 && rep == 0) norm_rows<true, true, false, true>(GB, x_in, XB, nw + D, nw + 2 * D, H, gw_p, NGW, lane_p);
            else norm_rows<true, true, true, true>(GB, XB, rep ? (void*)XSCR : (void*)XB, nw + D, nw + 2 * D, rep ? HSCR : H, gw_p, NGW, lane_p); }
        SEAM(pb + 5);
        if (IN(pb + 6)) for (int rep = 0; rep < REP_F1; ++rep) {
            pg8::Gemm g{H, WF1 + (size_t)L * FFN_N * D, M, FFN_N, D}; pg8::StaticOrder S; S.init(M, FFN_N, G, bx);
            pg8::EpiSwiGLU E{PROJ, DFF};
            pg8::gemm_phase<pg8::EpiSwiGLU, pg8::StaticOrder, true, true>(lds, g, S, E);
            if (TAILCVT && L + 1 < DEPTH && bx >= FF1_REM) {
                PH_IDS
                LAS float* scr = (LAS float*)(lds + wave_p * 16384); const int gw2 = (bx - FF1_REM) * NWAVES + wave_p, ngw2 = (G - FF1_REM) * NWAVES;
                transpose_matrix(w_ffn_in + (size_t)(L + 1) * D * FFN_N, D, FFN_N, WF1 + (size_t)(L + 1) * FFN_N * D, 1, scr, gw2, ngw2, lane_p);
                if (TAIL_ALL) { const int L1 = L + 1, slot1 = L1 >> 1;
                    if (L1 & 1) transpose_matrix(w_in_attn + (size_t)slot1 * D * ATTN_N, D, ATTN_N, WAT + (size_t)slot1 * ATTN_N * D, 0, scr, gw2, ngw2, lane_p);
                    else transpose_matrix(w_in_hgrn + (size_t)slot1 * D * HGRN_N, D, HGRN_N, WHG + (size_t)slot1 * HGRN_N * D, 0, scr, gw2, ngw2, lane_p);
                    transpose_matrix(w_out + (size_t)L1 * D * D, D, D, WO + (size_t)L1 * D * D, 0, scr, gw2, ngw2, lane_p); }
                if (TAIL_F2) transpose_matrix(w_ffn_out + (size_t)(L + 1) * DFF * D, DFF, D, WF2 + (size_t)(L + 1) * D * DFF, 0, scr, gw2, ngw2, lane_p);
                if (TAIL_WO && !TAIL_ALL) transpose_matrix(w_out + (size_t)(L + 1) * D * D, D, D, WO + (size_t)(L + 1) * D * D, 0, scr, gw2, ngw2, lane_p);
            }
        }
        SEAM(pb + 6);
        if (IN(pb + 7)) for (int rep = 0; rep < REP_F2; ++rep) {
            pg8::Gemm g{PROJ, WF2 + (size_t)L * D * DFF, M, D, DFF}; pg8::StaticOrder S; S.init(M, D, G, bx);
            pg8::EpiBf16<0> E{GB, D, nullptr, 0, 0, 1.f};
            pg8::gemm_phase<pg8::EpiBf16<0>, pg8::StaticOrder, true, true>(lds, g, S, E);
        }
        SEAM(pb + 7);
        if (IN(pb + 8)) for (int rep = 0; rep < REP_NORM; ++rep) {
            PH_IDS
            const int lane = lane_p, gw = gw_p;
            if (L + 1 < DEPTH) norm_rows<true, true, true, true>(GB, XB, rep ? (void*)XSCR : (void*)XB, nw + 3 * D, nw + 4 * D, rep ? HSCR : H, gw, NGW, lane);
            else norm_rows<true, false, true, false>(GB, XB, rep ? XSCR : xres, nw + 3 * D, nullptr, nullptr, gw, NGW, lane);
        }
        SEAM(pb + 8);
    }
#undef IN
#undef SEAM
}

#ifndef MK_PER_PHASE
#define MK_PER_PHASE 0
#endif
extern "C" void kernel_launch(void* const* d_in, const int* in_sizes, int n_in, void* d_out, int out_size, void* d_ws, size_t ws_size, hipStream_t stream) {
    static int grid = 0;
    if (grid == 0) {
        if (n_in != 9 || in_sizes[0] != M * D || out_size != M * D || ws_size < WS_END) { fprintf(stderr, "kernel_launch: unexpected shapes (n_in %d, in0 %d, out %d, ws %zu); nothing launched\n", n_in, n_in > 0 ? in_sizes[0] : -1, out_size, ws_size); grid = -1; return; }
        int dev = 0, cus = 0, per_cu = 0;
        if (hipGetDevice(&dev) != hipSuccess || hipDeviceGetAttribute(&cus, hipDeviceAttributeMultiprocessorCount, dev) != hipSuccess) { grid = -1; return; }
        if (hipFuncSetAttribute((const void*)fwd, hipFuncAttributeMaxDynamicSharedMemorySize, LDS_BYTES) != hipSuccess) { fprintf(stderr, "kernel_launch: hipFuncSetAttribute failed\n"); grid = -1; return; }
        if (hipOccupancyMaxActiveBlocksPerMultiprocessor(&per_cu, (const void*)fwd, NTHREADS, LDS_BYTES) != hipSuccess || per_cu < 1) fprintf(stderr, "kernel_launch: occupancy query reports %d\n", per_cu);
        (void)hipGetLastError();
        grid = cus;
    }
    if (grid < 0) return;
    if (hipMemsetAsync((char*)d_ws + WS_CTL, 0, CTL_ZERO_BYTES, stream) != hipSuccess) return;
    Args a{};
    for (int i = 0; i < 9; ++i) a.in[i] = (const float*)d_in[i];
    a.out = (float*)d_out; a.ws = (unsigned char*)d_ws;
#if MK_PER_PHASE
    for (int p = 0; p < NPHASES; ++p) { a.ph_lo = p; a.ph_hi = p + 1; hipLaunchKernelGGL(fwd, dim3(grid), dim3(NTHREADS), LDS_BYTES, stream, a); }
#else
    a.ph_lo = 0; a.ph_hi = NPHASES; hipLaunchKernelGGL(fwd, dim3(grid), dim3(NTHREADS), LDS_BYTES, stream, a);
#endif
}
```

```cpp
#include <hip/hip_runtime.h>
#include <cstdio>
#include <cstdint>
#ifdef EPI_NT
#define PG8_ST(v, p) __builtin_nontemporal_store((v), (p))
#else
#define PG8_ST(v, p) (*(p) = (v))
#endif
namespace pg8 {
#define PG8_LAS __attribute__((address_space(3)))
typedef unsigned short bf16_t;
typedef short bf16x8 __attribute__((ext_vector_type(8)));
typedef float f32x4 __attribute__((ext_vector_type(4)));
typedef unsigned u32x4 __attribute__((ext_vector_type(4)));
constexpr int BM = 256, BK = 64, HALF = 128, HTB = HALF * BK * 2  , STAGE_BYTES = 8 * HTB, NXCD = 8, WGM = 8;

__host__ __device__ __forceinline__ int lds_byte(int r, int c) { const int st = (r >> 4) * 2 + (c >> 5), rr = r & 15, cc = c & 31, ob = rr * 64 + cc * 2; return st * 1024 + (ob ^ (((ob >> 9) & 1) << 5)); }
__host__ __device__ __forceinline__ void stage_rc(int b, int& R, int& C) { const int st = b / 1024, sb = b % 1024, swz = sb ^ (((sb >> 9) & 1) << 5); R = (st >> 1) * 16 + swz / 64; C = (st & 1) * 32 + (swz % 64) / 2; }
__host__ __device__ __forceinline__ int perm32(int rho) { const int n = rho >> 4, i = rho & 15; return 8 * (i >> 2) + 4 * n + (i & 3); }

struct Unit { int pm, pn; };
struct Gemm { const bf16_t* A; const bf16_t* Bt; int M, N, K; };

struct StaticOrder {
    int nM, nN, nwg, G, c;
    __host__ __device__ void init(int M, int N, int G_, int c_) { nM = M / BM; nN = N / BM; nwg = nM * nN; G = G_; c = c_; }
    __host__ __device__ bool next(int i, Unit& u) const {
        const long L = (long)i * G + c; if (L >= nwg) return false;
        int wgid = (int)L; { const int q = nwg / NXCD, r = nwg % NXCD, xcd = wgid % NXCD, off = wgid / NXCD; wgid = (xcd < r ? xcd * (q + 1) : r * (q + 1) + (xcd - r) * q) + off; }
        const int nig = WGM * nN, gid = wgid / nig, fm = gid * WGM, gsz = (nM - fm) < WGM ? (nM - fm) : WGM;
        u.pm = fm + ((wgid % nig) % gsz); u.pn = (wgid % nig) / gsz; return true;
    }
    __device__ __forceinline__ void a_ready(const Unit&) const {}
    __device__ __forceinline__ void done(const Unit&) const {}
};

__device__ __forceinline__ unsigned cvt_pk_bf16(float lo, float hi) { unsigned r; asm volatile("v_cvt_pk_bf16_f32 %0, %1, %2" : "=v"(r) : "v"(lo), "v"(hi)); return r; }
typedef float f32x2 __attribute__((ext_vector_type(2)));
__device__ __forceinline__ f32x2 gelu_pk(f32x2 v) {
    const f32x2 av = __builtin_elementwise_abs(v), d = av * 0.2316418882f + 1.0f;
    f32x2 t; t.x = __builtin_amdgcn_rcpf(d.x); t.y = __builtin_amdgcn_rcpf(d.y);
    f32x2 q = t * 0.5307027145f + (-0.7265760135f); q = q * t + 0.7107068705f; q = q * t + (-0.142248368f); q = q * t + 0.127414796f; q = q * t;
    const f32x2 s = (v * v) * (-0.72134752044f);
    f32x2 e; e.x = __builtin_amdgcn_exp2f(s.x); e.y = __builtin_amdgcn_exp2f(s.y);
    const f32x2 m = v * (q * e), r = v - m;
    f32x2 o; o.x = v.x < 0.f ? m.x : r.x; o.y = v.y < 0.f ? m.y : r.y; return o;
}

template <int ACT  > struct EpiBf16 {
    static constexpr bool PERM = true, AFTER_DRAIN = false; static_assert(ACT == 0 || ACT == 1, "EpiBf16: ACT is 0 (none) or 1 (gelu_pk)");
    bf16_t* O; int ldc; const float* bias; int split_cols; size_t split_stride; float scale0;
    __device__ __forceinline__ void operator()(const f32x4 (&acc)[2][2][4][2], const Unit& u, int wr, int wc, int fr, int fq) const {
        const int row0 = u.pm * BM + wr * 64 + fr; int colt = u.pn * BM; bf16_t* base = O;
        float sc = 1.f; if (split_cols) { const int t = colt / split_cols; base += (size_t)t * split_stride; colt -= t * split_cols; if (t == 0) sc = scale0; }
        const int col0 = colt + wc * 32 + 8 * fq, bcol0 = u.pn * BM + wc * 32 + 8 * fq;
        f32x4 bv[2][2];
#pragma unroll
        for (int bj = 0; bj < 2; ++bj)
#pragma unroll
            for (int n = 0; n < 2; ++n) bv[bj][n] = bias ? *(const f32x4*)(bias + bcol0 + bj * HALF + 4 * n) : (f32x4){0.f, 0.f, 0.f, 0.f};
#pragma unroll
        for (int ai = 0; ai < 2; ++ai)
#pragma unroll
            for (int m = 0; m < 4; ++m) { bf16_t* rowp = base + (size_t)(row0 + ai * HALF + m * 16) * ldc + col0;
#pragma unroll
                for (int bj = 0; bj < 2; ++bj) { f32x4 v0 = acc[ai][bj][m][0] + bv[bj][0], v1 = acc[ai][bj][m][1] + bv[bj][1];
                    if (ACT == 1) { f32x2 a = gelu_pk((f32x2){v0[0], v0[1]}), b = gelu_pk((f32x2){v0[2], v0[3]}), c = gelu_pk((f32x2){v1[0], v1[1]}), d = gelu_pk((f32x2){v1[2], v1[3]});
                        v0 = (f32x4){a.x, a.y, b.x, b.y}; v1 = (f32x4){c.x, c.y, d.x, d.y}; }
                    v0 = v0 * sc; v1 = v1 * sc; u32x4 w; w.x = cvt_pk_bf16(v0[0], v0[1]); w.y = cvt_pk_bf16(v0[2], v0[3]); w.z = cvt_pk_bf16(v1[0], v1[1]); w.w = cvt_pk_bf16(v1[2], v1[3]);
                    PG8_ST(w, (u32x4*)(rowp + bj * HALF)); } }
    }
};

template <class Epi, class Sched, bool ALIGN_EPI = false, bool SP2 = false>
__device__ __forceinline__ void gemm_phase(PG8_LAS unsigned char* lds, const Gemm g, const Sched& S, const Epi& E) {
    int tid_l = threadIdx.x; asm volatile("" : "+v"(tid_l));
    const int tid = tid_l, wid = __builtin_amdgcn_readfirstlane(tid >> 6), lane = tid & 63, wr = wid >> 2, wc = wid & 3, fr = lane & 15, fq = lane >> 4;
    const int K = g.K, nt = K / BK;
    unsigned voffA[2], voffB[2];
#pragma unroll
    for (int i = 0; i < 2; ++i) { int R, C; stage_rc(tid * 16 + i * 8192, R, C); const int Rb = Epi::PERM ? ((R & ~31) + perm32(R & 31)) : R;
        voffA[i] = (unsigned)(R * K + C) * 2u; voffB[i] = (unsigned)(Rb * K + C) * 2u; }
    const size_t kstep = (size_t)(BK * 2);
    const size_t hstep = (size_t)HALF * K * 2;
    const size_t tstep = 2 * hstep;
    const unsigned ldsw = (unsigned)wid * 1024u;
    const int aoff = lds_byte(wr * 64 + fr, fq * 8), boff = lds_byte(wc * 32 + fr, fq * 8);
#define PG8_SA(b, h) (((b) * 2 + (h)) * HTB)
#define PG8_SB(b, h) ((4 + (b) * 2 + (h)) * HTB)
#define PG8_STAGE(bufoff, gbase, voff) do { _Pragma("unroll") for (int _i = 0; _i < 2; ++_i) \
        __builtin_amdgcn_global_load_lds((const unsigned*)((const char*)(gbase) + (voff)[_i]), (PG8_LAS unsigned*)(lds + (bufoff) + ldsw + _i * 8192), 16, 0, 0); } while (0)
#define PG8_LDA(dst, b, h) do { _Pragma("unroll") for (int m = 0; m < 4; ++m) _Pragma("unroll") for (int k = 0; k < 2; ++k) dst[m][k] = *(const PG8_LAS bf16x8*)(lds + PG8_SA(b, h) + aoff + m * 2048 + k * 1024); } while (0)
#define PG8_LDB(dst, b, h) do { _Pragma("unroll") for (int n = 0; n < 2; ++n) _Pragma("unroll") for (int k = 0; k < 2; ++k) dst[n][k] = *(const PG8_LAS bf16x8*)(lds + PG8_SB(b, h) + boff + n * 2048 + k * 1024); } while (0)
#define PG8_MMA(ai, bj, At, Bt) do { __builtin_amdgcn_s_setprio(1); _Pragma("unroll") for (int m = 0; m < 4; ++m) _Pragma("unroll") for (int n = 0; n < 2; ++n) _Pragma("unroll") for (int k = 0; k < 2; ++k) \
        acc[ai][bj][m][n] = __builtin_amdgcn_mfma_f32_16x16x32_bf16(Bt[n][k], At[m][k], acc[ai][bj][m][n], 0, 0, 0); __builtin_amdgcn_s_setprio(0); } while (0)
#define PG8_WAIT_V(n) asm volatile("s_waitcnt vmcnt(" #n ")" ::: "memory")
#define PG8_WAIT_L(n) asm volatile("s_waitcnt lgkmcnt(" #n ")" ::: "memory")
#define PG8_BAR __builtin_amdgcn_s_barrier()
#define PG8_SCHED __builtin_amdgcn_sched_barrier(0)
    Unit cur, nxt; int ui = 0;
    if (!S.next(0, cur)) return;
    f32x4 acc[2][2][4][2];
#pragma unroll
    for (int a = 0; a < 2; ++a)
#pragma unroll
        for (int b = 0; b < 2; ++b)
#pragma unroll
            for (int m = 0; m < 4; ++m)
#pragma unroll
                for (int n = 0; n < 2; ++n) acc[a][b][m][n] = (f32x4){0.f, 0.f, 0.f, 0.f};
    bf16x8 At[4][2], B0[2][2], B1[2][2];
    const char* cA = (const char*)g.A + (size_t)cur.pm * tstep; const char* cB = (const char*)g.Bt + (size_t)cur.pn * tstep;
    S.a_ready(cur);
    if constexpr (SP2) {
        PG8_STAGE(PG8_SB(0, 0), cB, voffB); PG8_STAGE(PG8_SB(0, 1), cB + hstep, voffB); PG8_STAGE(PG8_SA(0, 0), cA, voffA); PG8_STAGE(PG8_SA(0, 1), cA + hstep, voffA);
        if (wr == 1) PG8_BAR;
        PG8_WAIT_V(2); PG8_BAR;
        PG8_STAGE(PG8_SB(1, 0), cB + kstep, voffB); PG8_STAGE(PG8_SA(1, 0), cA + kstep, voffA); PG8_STAGE(PG8_SB(1, 1), cB + hstep + kstep, voffB);
        PG8_WAIT_V(6); PG8_BAR;
    } else {
        PG8_STAGE(PG8_SB(0, 0), cB, voffB); PG8_STAGE(PG8_SA(0, 0), cA, voffA); PG8_STAGE(PG8_SB(0, 1), cB + hstep, voffB); PG8_STAGE(PG8_SA(0, 1), cA + hstep, voffA);
        if (wr == 1) PG8_BAR;
        PG8_WAIT_V(4); PG8_BAR;
        PG8_STAGE(PG8_SB(1, 0), cB + kstep, voffB); PG8_STAGE(PG8_SA(1, 0), cA + kstep, voffA); PG8_STAGE(PG8_SB(1, 1), cB + hstep + kstep, voffB);
        PG8_WAIT_V(6); PG8_BAR;
    }
    for (;;) {
        const bool has_next = S.next(ui + 1, nxt);
        const char* nA = has_next ? (const char*)g.A + (size_t)nxt.pm * tstep : cA; const char* nB = has_next ? (const char*)g.Bt + (size_t)nxt.pn * tstep : cB;
        for (int t = 0; t < nt; t += 2) {
            const bool last = (t == nt - 2);
            const char* a1 = cA + (size_t)(t + 1) * kstep;
            const char* a2 = last ? nA : cA + (size_t)(t + 2) * kstep; const char* b2 = last ? nB : cB + (size_t)(t + 2) * kstep;
            const char* a3 = a2 + kstep; const char* b3 = b2 + kstep;
            if (last && has_next) S.a_ready(nxt);
            if constexpr (SP2) {
            PG8_LDB(B0, 0, 0); PG8_LDB(B1, 0, 1); PG8_SCHED; PG8_LDA(At, 0, 0); PG8_STAGE(PG8_SA(1, 1), a1 + hstep, voffA);
            PG8_WAIT_V(8); PG8_WAIT_L(0); PG8_BAR; PG8_MMA(0, 0, At, B0); PG8_MMA(0, 1, At, B1); PG8_BAR; PG8_SCHED;
            PG8_LDA(At, 0, 1); PG8_STAGE(PG8_SB(0, 0), b2, voffB); PG8_STAGE(PG8_SB(0, 1), b2 + hstep, voffB); PG8_STAGE(PG8_SA(0, 0), a2, voffA);
            PG8_WAIT_V(8); PG8_WAIT_L(0); PG8_BAR; PG8_MMA(1, 0, At, B0); PG8_MMA(1, 1, At, B1); PG8_BAR; PG8_SCHED;
            PG8_LDB(B0, 1, 0); PG8_LDB(B1, 1, 1); PG8_SCHED; PG8_LDA(At, 1, 0); PG8_STAGE(PG8_SA(0, 1), a2 + hstep, voffA);
            PG8_WAIT_V(8); PG8_WAIT_L(0); PG8_BAR; PG8_MMA(0, 0, At, B0); PG8_MMA(0, 1, At, B1); PG8_BAR; PG8_SCHED;
            PG8_LDA(At, 1, 1); PG8_STAGE(PG8_SB(1, 0), b3, voffB); PG8_STAGE(PG8_SB(1, 1), b3 + hstep, voffB); PG8_STAGE(PG8_SA(1, 0), a3, voffA);
            PG8_WAIT_V(8); PG8_WAIT_L(0); PG8_BAR; PG8_MMA(1, 0, At, B0); PG8_MMA(1, 1, At, B1); PG8_BAR; PG8_SCHED;
            } else {
            PG8_LDB(B0, 0, 0); PG8_SCHED; PG8_LDA(At, 0, 0); PG8_STAGE(PG8_SA(1, 1), a1 + hstep, voffA);
            PG8_WAIT_L(8); PG8_BAR; PG8_WAIT_L(0); PG8_MMA(0, 0, At, B0); PG8_BAR; PG8_SCHED;
            PG8_LDB(B1, 0, 1); PG8_STAGE(PG8_SB(0, 0), b2, voffB);
            PG8_BAR; PG8_WAIT_L(0); PG8_MMA(0, 1, At, B1); PG8_BAR;
            PG8_LDA(At, 0, 1); PG8_STAGE(PG8_SA(0, 0), a2, voffA);
            PG8_BAR; PG8_WAIT_L(0); PG8_MMA(1, 0, At, B0); PG8_BAR; PG8_SCHED;
            PG8_STAGE(PG8_SB(0, 1), b2 + hstep, voffB);
            PG8_WAIT_V(6); PG8_BAR; PG8_MMA(1, 1, At, B1); PG8_BAR;
            PG8_LDB(B0, 1, 0); PG8_SCHED; PG8_LDA(At, 1, 0); PG8_STAGE(PG8_SA(0, 1), a2 + hstep, voffA);
            PG8_WAIT_L(8); PG8_BAR; PG8_WAIT_L(0); PG8_MMA(0, 0, At, B0); PG8_BAR; PG8_SCHED;
            PG8_LDB(B1, 1, 1); PG8_STAGE(PG8_SB(1, 0), b3, voffB);
            PG8_BAR; PG8_WAIT_L(0); PG8_MMA(0, 1, At, B1); PG8_BAR;
            PG8_LDA(At, 1, 1); PG8_STAGE(PG8_SA(1, 0), a3, voffA);
            PG8_BAR; PG8_WAIT_L(0); PG8_MMA(1, 0, At, B0); PG8_BAR; PG8_SCHED;
            PG8_STAGE(PG8_SB(1, 1), b3 + hstep, voffB);
            PG8_WAIT_V(6); PG8_BAR; PG8_MMA(1, 1, At, B1); PG8_BAR;
            }
        }
        if constexpr (ALIGN_EPI) { if (wr == 0) PG8_BAR; }
        if constexpr (!Epi::AFTER_DRAIN) { E(acc, cur, wr, wc, fr, fq); S.done(cur); }
        if (!has_next) break;
#pragma unroll
        for (int a = 0; a < 2; ++a)
#pragma unroll
            for (int b = 0; b < 2; ++b)
#pragma unroll
                for (int m = 0; m < 4; ++m)
#pragma unroll
                    for (int n = 0; n < 2; ++n) acc[a][b][m][n] = (f32x4){0.f, 0.f, 0.f, 0.f};
        cur = nxt; cA = nA; cB = nB; ++ui;
        if constexpr (ALIGN_EPI) { if (wr == 1) PG8_BAR; }
    }
    PG8_WAIT_V(0);
    if constexpr (!ALIGN_EPI) { if (wr == 0) PG8_BAR; }
    PG8_BAR;
    if constexpr (Epi::AFTER_DRAIN) { E.fused(acc, cur, wr, wc, fr, fq, lds, wid, lane); S.done(cur); }
#undef PG8_SA
#undef PG8_SB
#undef PG8_STAGE
#undef PG8_LDA
#undef PG8_LDB
#undef PG8_MMA
#undef PG8_WAIT_V
#undef PG8_WAIT_L
#undef PG8_BAR
#undef PG8_SCHED
}
}
namespace pg8 {
__device__ __forceinline__ float silu_f(float x) { return x * __builtin_amdgcn_rcpf(1.0f + __builtin_amdgcn_exp2f(-1.44269504f * x)); }
struct EpiSwiGLU {
    static constexpr bool PERM = true, AFTER_DRAIN = false;
    bf16_t* O; int ldc;
    __device__ __forceinline__ void operator()(const f32x4 (&acc)[2][2][4][2], const Unit& u, int wr, int wc, int fr, int fq) const {
        const int row0 = u.pm * BM + wr * 64 + fr; const int col0 = u.pn * HALF + wc * 32 + 8 * fq;
#pragma unroll
        for (int ai = 0; ai < 2; ++ai)
#pragma unroll
            for (int m = 0; m < 4; ++m) { bf16_t* rowp = O + (size_t)(row0 + ai * HALF + m * 16) * ldc + col0;
                const f32x4 g0 = acc[ai][0][m][0], g1 = acc[ai][0][m][1], u0 = acc[ai][1][m][0], u1 = acc[ai][1][m][1];
                u32x4 w; w.x = cvt_pk_bf16(silu_f(g0[0]) * u0[0], silu_f(g0[1]) * u0[1]); w.y = cvt_pk_bf16(silu_f(g0[2]) * u0[2], silu_f(g0[3]) * u0[3]);
                w.z = cvt_pk_bf16(silu_f(g1[0]) * u1[0], silu_f(g1[1]) * u1[1]); w.w = cvt_pk_bf16(silu_f(g1[2]) * u1[2], silu_f(g1[3]) * u1[3]);
                PG8_ST(w, (u32x4*)rowp); }
    }
};
}
#ifdef ROPE_NT
#define PG8_ST_ROPE(v, p) __builtin_nontemporal_store((v), (p))
#else
#define PG8_ST_ROPE(v, p) (*(p) = (v))
#endif
namespace pg8 {
struct EpiRope {
    static constexpr bool PERM = true, AFTER_DRAIN = false;
    bf16_t* O; int ldc; const float* cosT; const float* sinT;
    __device__ __forceinline__ void operator()(const f32x4 (&acc)[2][2][4][2], const Unit& u, int wr, int wc, int fr, int fq) const {
        const int row0 = u.pm * BM + wr * 64 + fr; const int colt = u.pn * BM; const int col0 = colt + wc * 32 + 8 * fq;
        const bool rot = (((colt >> 11) % 3) < 2) && (wc == 0);
        const int dd0 = 8 * (fq & 1); const float sgn = (fq < 2) ? -1.0f : 1.0f;
#pragma unroll
        for (int ai = 0; ai < 2; ++ai)
#pragma unroll
            for (int m = 0; m < 4; ++m) { const int row = row0 + ai * HALF + m * 16; bf16_t* rowp = O + (size_t)row * ldc + col0;
                f32x4 c0 = (f32x4){1.f, 1.f, 1.f, 1.f}, c1 = c0, s0 = (f32x4){0.f, 0.f, 0.f, 0.f}, s1 = s0;
                if (rot) { const int pos = row & 4095; const f32x4* cp = (const f32x4*)(cosT + pos * 16 + dd0); const f32x4* sp = (const f32x4*)(sinT + pos * 16 + dd0);
                    c0 = cp[0]; c1 = cp[1]; s0 = sp[0] * sgn; s1 = sp[1] * sgn; }
#pragma unroll
                for (int bj = 0; bj < 2; ++bj) { f32x4 v0 = acc[ai][bj][m][0], v1 = acc[ai][bj][m][1];
                    if (rot) { f32x4 p0, p1;
#pragma unroll
                        for (int i = 0; i < 4; ++i) { p0[i] = __shfl_xor(v0[i], 32); p1[i] = __shfl_xor(v1[i], 32); }
                        v0 = v0 * c0 + p0 * s0; v1 = v1 * c1 + p1 * s1; }
                    u32x4 w; w.x = cvt_pk_bf16(v0[0], v0[1]); w.y = cvt_pk_bf16(v0[2], v0[3]); w.z = cvt_pk_bf16(v1[0], v1[1]); w.w = cvt_pk_bf16(v1[2], v1[3]);
                    PG8_ST_ROPE(w, (u32x4*)(rowp + bj * HALF)); } }
    }
};
}
#define GAS __attribute__((address_space(1)))
#define LAS __attribute__((address_space(3)))
typedef unsigned short bf16;
typedef unsigned v4u __attribute__((ext_vector_type(4)));
typedef float f32x4 __attribute__((ext_vector_type(4)));
typedef short bf16x8 __attribute__((ext_vector_type(8)));
typedef GAS unsigned gu32;
typedef GAS unsigned long long gu64;
#define RLX_AGENT __ATOMIC_RELAXED, __HIP_MEMORY_SCOPE_AGENT
#define LDS_WAIT() asm volatile("s_waitcnt lgkmcnt(0)" ::: "memory")
#define VM_WAIT() asm volatile("s_waitcnt vmcnt(0)" ::: "memory")
__device__ __forceinline__ unsigned long long rt() { return __builtin_amdgcn_s_memrealtime(); }
__device__ __forceinline__ unsigned f2bf(float f) { unsigned u = __builtin_bit_cast(unsigned, f); return (u + 0x7fffu + ((u >> 16) & 1u)) >> 16; }
__device__ __forceinline__ unsigned pk2(float lo, float hi) { return f2bf(lo) | (f2bf(hi) << 16); }

#define XB_TMO      128
#define XB_XCNT(j)  (256  + 64 * (j))
#define XB_XSUB(j)  (1280 + 64 * (j))
#define XB_XGEN(j)  (2304 + 64 * (j))
#define XB_TOP      3328
#define XB_TOPGEN   3392
#define XCD_BAR_WORDS 3456
#define XB_SPIN_CAP (1u << 18)

__device__ __forceinline__ unsigned xb_ld(unsigned* p)              { return __hip_atomic_load(p, __ATOMIC_RELAXED, __HIP_MEMORY_SCOPE_AGENT); }
__device__ __forceinline__ unsigned xb_add(unsigned* p, unsigned v) { return __hip_atomic_fetch_add(p, v, __ATOMIC_RELAXED, __HIP_MEMORY_SCOPE_AGENT); }
__device__ __forceinline__ unsigned xb_xcc_id() { return (unsigned)__builtin_amdgcn_s_getreg((3 << 11) | 20) & 0xFu; }
#define XB_SPIN(cond, bar) do { unsigned _sp = 0; while (cond) { __builtin_amdgcn_s_sleep(1); \
    if ((++_sp & 255u) == 0u) { if (xb_ld(&(bar)[XB_TMO])) break; if (_sp > XB_SPIN_CAP) { atomicAdd(&(bar)[XB_TMO], 1u); break; } } } } while (0)

struct XcdBarrier {
    unsigned* bar; unsigned x;
    volatile LAS unsigned* st;
};

__device__ __forceinline__ XcdBarrier xcd_barrier_post(unsigned* bar, volatile LAS unsigned* st) {
    XcdBarrier b; b.bar = bar; b.x = xb_xcc_id(); b.st = st;
    if (threadIdx.x == 0) (void)xb_add(&bar[XB_XCNT(b.x)], 1u);
    return b;
}
__device__ __forceinline__ void xcd_barrier_complete(unsigned* bar, unsigned x, unsigned& nloc, unsigned& nx) {
    const unsigned G = gridDim.x * gridDim.y * gridDim.z;
    unsigned sum, cnt, mine, sp = 0u;
    for (;;) {
        sum = 0u; cnt = 0u; mine = 0u;
#pragma unroll
        for (unsigned j = 0; j < 16; ++j) { const unsigned c = xb_ld(&bar[XB_XCNT(j)]); sum += c; cnt += (c > 0u) ? 1u : 0u; mine = (j == x) ? c : mine; }
        if (sum == G) break;
        __builtin_amdgcn_s_sleep(1);
        if ((++sp & 255u) == 0u) { if (xb_ld(&bar[XB_TMO])) break; if (sp > XB_SPIN_CAP) { atomicAdd(&bar[XB_TMO], 1u); break; } }
    }
    nloc = mine > 0u ? mine : 1u; nx = cnt > 0u ? cnt : 1u;
}

__device__ __forceinline__ void xcd_barrier(const XcdBarrier& b) {
    asm volatile("s_waitcnt vmcnt(0)" ::: "memory");
    __syncthreads();
    if (threadIdx.x == 0) {
        unsigned* bar = b.bar;
        __builtin_amdgcn_s_waitcnt(0);
        unsigned nloc = b.st[0], nx = b.st[1];
        if (nloc == 0u) { xcd_barrier_complete(bar, b.x, nloc, nx); b.st[0] = nloc; b.st[1] = nx; }
        const unsigned old = xb_add(&bar[XB_XSUB(b.x)], 1u);
        const unsigned gen = old / nloc;
        if (old + 1u == (gen + 1u) * nloc) {
            __builtin_amdgcn_fence(__ATOMIC_RELEASE, "agent");
            asm volatile("s_waitcnt vmcnt(0)" ::: "memory");
            const unsigned og = xb_add(&bar[XB_TOP], 1u);
            const unsigned tg = og / nx;
            if (og + 1u == (tg + 1u) * nx) xb_add(&bar[XB_TOPGEN], 1u);
            else XB_SPIN(xb_ld(&bar[XB_TOPGEN]) == tg, bar);
            __builtin_amdgcn_fence(__ATOMIC_ACQUIRE, "agent");
            xb_add(&bar[XB_XGEN(b.x)], 1u);
            asm volatile("s_waitcnt vmcnt(0)" ::: "memory");
        } else {
            XB_SPIN(xb_ld(&bar[XB_XGEN(b.x)]) == gen, bar);
            __builtin_amdgcn_fence(__ATOMIC_ACQUIRE, "agent");
            asm volatile("s_waitcnt vmcnt(0)" ::: "memory");
        }
    }
    __syncthreads();
}

constexpr int NWAVES = 8, NTHREADS = 512;
constexpr int BATCH = 2, SEQ = 4096, D = 2048, M = BATCH * SEQ, DEPTH = 4, NH = 16, HD = 128;
constexpr int HGRN_N = 5 * D, ATTN_N = 9 * D, DFF = 5632, FFN_N = 2 * DFF;
constexpr float EPS = 1e-6f;
constexpr int NPHASES = 1 + 9 * DEPTH;
#ifndef REP_PRO
#define REP_PRO 1
#endif
#ifndef REP_INH
#define REP_INH 1
#endif
#ifndef REP_INA_COLD
#define REP_INA_COLD 0
#endif
#ifndef REP_INA
#define REP_INA 1
#endif
#ifndef REP_WO
#define REP_WO 1
#endif
#ifndef REP_F1
#define REP_F1 1
#endif
#ifndef REP_F2
#define REP_F2 1
#endif
#ifndef REP_GATES
#define REP_GATES 1
#endif
#ifndef REP_SCAN
#define REP_SCAN 1
#endif
#ifndef REP_ATTN
#define REP_ATTN 1
#endif
#ifndef REP_FIN
#define REP_FIN 1
#endif
#ifndef REP_NORM
#define REP_NORM 1
#endif

constexpr size_t MiB = 1u << 20;
constexpr size_t WS_CTL = 0, CTL_ZERO_BYTES = 1 * MiB;
constexpr size_t WS_TAB = 1 * MiB;
constexpr size_t TAB_COS = 0, TAB_SIN = 262144, TAB_LB = 524288;
constexpr size_t WS_WHG = 2 * MiB;
constexpr size_t WS_WAT = 82 * MiB;
constexpr size_t WS_WO = 226 * MiB;
constexpr size_t WS_WF1 = 258 * MiB;
constexpr size_t WS_WF2 = 434 * MiB;
constexpr size_t WS_H = 522 * MiB;
constexpr size_t WS_PROJ = 554 * MiB;
constexpr size_t WS_MIX = 842 * MiB;
constexpr size_t WS_O = 942 * MiB;
constexpr size_t WS_G = 974 * MiB;
constexpr size_t WS_KH = 1006 * MiB;
constexpr size_t WS_END = 1076 * MiB;
constexpr int CW_BAR = 4096;

constexpr int RING_BYTES = 147456;
constexpr int LDSCTL_OFF = RING_BYTES, MISC_OFF = LDSCTL_OFF + 320;
constexpr int LDS_BYTES = 163840;

__device__ __forceinline__ float bf2f(unsigned short b) { return __builtin_bit_cast(float, (unsigned)b << 16); }
__device__ __forceinline__ float bflo(unsigned w) { return __builtin_bit_cast(float, w << 16); }
__device__ __forceinline__ float bfhi(unsigned w) { return __builtin_bit_cast(float, w & 0xffff0000u); }
__device__ __forceinline__ float wave_sum(float v) {
#pragma unroll
    for (int o = 1; o < 64; o <<= 1) v += __shfl_xor(v, o);
    return v;
}
__device__ __forceinline__ float sigmoid_f(float x) { return __builtin_amdgcn_rcpf(1.0f + __builtin_amdgcn_exp2f(-1.44269504f * x)); }

__device__ __forceinline__ void transpose_item(const float* W, int K, int N, bf16* WT, int k0, int n0, int drow0, LAS float* scr, int lane) {
    float ld[32];
#pragma unroll
    for (int i = 0; i < 32; ++i) { const int kk = 2 * i + (lane >> 5); ld[i] = W[(size_t)(k0 + kk) * N + n0 + (lane & 31)]; }
#pragma unroll
    for (int i = 0; i < 32; ++i) { const int kk = 2 * i + (lane >> 5); scr[kk * 33 + (lane & 31)] = ld[i]; }
    LDS_WAIT(); asm volatile("" ::: "memory");
    const int c = lane & 7;
#pragma unroll
    for (int j = 0; j < 4; ++j) { const int n = (lane >> 3) + 8 * j; const LAS float* s = scr + (8 * c) * 33 + n;
        v4u o; o.x = pk2(s[0 * 33], s[1 * 33]); o.y = pk2(s[2 * 33], s[3 * 33]); o.z = pk2(s[4 * 33], s[5 * 33]); o.w = pk2(s[6 * 33], s[7 * 33]);
        *(GAS v4u*)(WT + (size_t)(drow0 + n) * K + k0 + 8 * c) = o; }
    LDS_WAIT(); asm volatile("" ::: "memory");
}
__device__ __forceinline__ void transpose_matrix(const float* W, int K, int N, bf16* WT, int mode, LAS float* scr, int gw, int NGW, int lane) {
    const int nblk = N / 32, nitems = (K / 64) * nblk;
    for (int it = gw; it < nitems; it += NGW) {
        const int kb = it / nblk, nb = it - kb * nblk, n0 = 32 * nb;
        int drow0 = n0;
        if (mode == 1) { const int up = n0 >= DFF, nn = up ? n0 - DFF : n0; drow0 = (nn >> 7) * 256 + (up ? 128 : 0) + (nn & 127); }
        transpose_item(W, K, N, WT, 64 * kb, n0, drow0, scr, lane);
    }
}

template <bool RES, bool NORM2, bool XI16, bool XO16>
__device__ __forceinline__ void norm_rows(const bf16* gin, const void* x_in, void* x_out, const float* w1, const float* w2, bf16* hout, int gw, int NGW, int lane) {
    for (int m = gw; m < M; m += NGW) {
        float xv[4][8];
#pragma unroll
        for (int j = 0; j < 4; ++j) {
            if (XI16) { const v4u g = *(const GAS v4u*)((const bf16*)x_in + (size_t)m * D + 8 * (64 * j + lane));
                xv[j][0] = bflo(g.x); xv[j][1] = bfhi(g.x); xv[j][2] = bflo(g.y); xv[j][3] = bfhi(g.y); xv[j][4] = bflo(g.z); xv[j][5] = bfhi(g.z); xv[j][6] = bflo(g.w); xv[j][7] = bfhi(g.w); }
            else { const GAS f32x4* xp = (const GAS f32x4*)((const float*)x_in + (size_t)m * D + 8 * (64 * j + lane));
                const f32x4 a = xp[0], b = xp[1]; xv[j][0] = a.x; xv[j][1] = a.y; xv[j][2] = a.z; xv[j][3] = a.w; xv[j][4] = b.x; xv[j][5] = b.y; xv[j][6] = b.z; xv[j][7] = b.w; } }
        if (RES) {
            float gv[4][8]; float ss = 0.f;
#pragma unroll
            for (int j = 0; j < 4; ++j) { const v4u g = *(const GAS v4u*)(gin + (size_t)m * D + 8 * (64 * j + lane));
                gv[j][0] = bflo(g.x); gv[j][1] = bfhi(g.x); gv[j][2] = bflo(g.y); gv[j][3] = bfhi(g.y); gv[j][4] = bflo(g.z); gv[j][5] = bfhi(g.z); gv[j][6] = bflo(g.w); gv[j][7] = bfhi(g.w);
#pragma unroll
                for (int i = 0; i < 8; ++i) ss += gv[j][i] * gv[j][i]; }
            const float r1 = 1.0f / sqrtf(wave_sum(ss) * (1.0f / D) + EPS);
#pragma unroll
            for (int j = 0; j < 4; ++j) { const GAS f32x4* wp = (const GAS f32x4*)(w1 + 8 * (64 * j + lane)); const f32x4 a = wp[0], b = wp[1];
                const float wv[8] = {a.x, a.y, a.z, a.w, b.x, b.y, b.z, b.w};
#pragma unroll
                for (int i = 0; i < 8; ++i) xv[j][i] += gv[j][i] * r1 * wv[i];
                if (XO16) { v4u o; o.x = pk2(xv[j][0], xv[j][1]); o.y = pk2(xv[j][2], xv[j][3]); o.z = pk2(xv[j][4], xv[j][5]); o.w = pk2(xv[j][6], xv[j][7]);
                    *(GAS v4u*)((bf16*)x_out + (size_t)m * D + 8 * (64 * j + lane)) = o; }
                else { GAS f32x4* op = (GAS f32x4*)((float*)x_out + (size_t)m * D + 8 * (64 * j + lane));
                    op[0] = (f32x4){xv[j][0], xv[j][1], xv[j][2], xv[j][3]}; op[1] = (f32x4){xv[j][4], xv[j][5], xv[j][6], xv[j][7]}; } }
        }
        if (NORM2) {
            float ss = 0.f;
#pragma unroll
            for (int j = 0; j < 4; ++j)
#pragma unroll
                for (int i = 0; i < 8; ++i) ss += xv[j][i] * xv[j][i];
            const float r2 = 1.0f / sqrtf(wave_sum(ss) * (1.0f / D) + EPS);
#pragma unroll
            for (int j = 0; j < 4; ++j) { const GAS f32x4* wp = (const GAS f32x4*)(w2 + 8 * (64 * j + lane)); const f32x4 a = wp[0], b = wp[1];
                v4u o; o.x = pk2(xv[j][0] * r2 * a.x, xv[j][1] * r2 * a.y); o.y = pk2(xv[j][2] * r2 * a.z, xv[j][3] * r2 * a.w);
                o.z = pk2(xv[j][4] * r2 * b.x, xv[j][5] * r2 * b.y); o.w = pk2(xv[j][6] * r2 * b.z, xv[j][7] * r2 * b.w);
                *(GAS v4u*)(hout + (size_t)m * D + 8 * (64 * j + lane)) = o; }
        }
    }
}

__device__ __forceinline__ void hgrn_core_simple(LAS unsigned char* lds, const bf16* P, const float* lbt, bf16* OD, int tid) {
    const int chain = blockIdx.x;
    if (chain >= 64) return;
    const int b = chain >> 5, hh = (chain >> 1) & 15, dir = chain & 1;
    LAS float* qs = (LAS float*)lds; LAS float* ks = qs + 4096; LAS float* fs = ks + 4096; LAS float* vs = fs + 4096;
    const int v = tid >> 2, dg = tid & 3;
    float S[32];
#pragma unroll
    for (int j = 0; j < 32; ++j) S[j] = 0.f;
    const float* lb = lbt + (size_t)dir * 4 * D + hh * HD;
    bf16* od = OD + (size_t)dir * M * D;
    for (int blk = 0; blk < SEQ / 32; ++blk) {
        __syncthreads();
        for (int e = tid; e < 4096; e += NTHREADS) {
            const int tt = e >> 7, d = e & 127; const int ts = blk * 32 + tt; const int t = dir ? (SEQ - 1 - ts) : ts;
            const bf16* row = P + (size_t)(b * SEQ + t) * HGRN_N + hh * HD + d;
            const float qv = bf2f(row[0]); const float fv = bf2f(row[(1 + dir) * D]); const float iv = bf2f(row[3 * D]);
            const float lbv = lb[d]; const float fg = lbv + (1.0f - lbv) * sigmoid_f(fv);
            qs[e] = qv * sigmoid_f(qv); ks[e] = 1.0f - fg; fs[e] = fg; vs[e] = iv;
        }
        __syncthreads();
        for (int tt = 0; tt < 32; ++tt) {
            const float vt = vs[tt * 128 + v]; float o = 0.f;
            const LAS float* qr = qs + tt * 128 + dg * 32; const LAS float* kr = ks + tt * 128 + dg * 32; const LAS float* fr = fs + tt * 128 + dg * 32;
#pragma unroll
            for (int j = 0; j < 32; ++j) { S[j] = fr[j] * S[j] + kr[j] * vt; o += qr[j] * S[j]; }
            o += __shfl_xor(o, 1); o += __shfl_xor(o, 2);
            const int ts = blk * 32 + tt; const int t = dir ? (SEQ - 1 - ts) : ts;
            if (dg == 0) od[(size_t)(b * SEQ + t) * D + hh * HD + v] = (bf16)f2bf(o);
        }
    }
}
__device__ __forceinline__ void hgrn_finalize(const bf16* P, const bf16* OD, const float* gnorm, bf16* O, int gw, int NGW, int lane) {
    for (int m = gw; m < M; m += NGW) {
#pragma unroll
        for (int j = 0; j < 4; ++j) {
            const int e0 = 8 * (64 * j + lane);
            const v4u a = *(const GAS v4u*)(OD + (size_t)m * D + e0), b = *(const GAS v4u*)(OD + (size_t)M * D + (size_t)m * D + e0);
            const v4u g = *(const GAS v4u*)(P + (size_t)m * HGRN_N + 4 * D + e0);
            float s[8] = {bflo(a.x) + bflo(b.x), bfhi(a.x) + bfhi(b.x), bflo(a.y) + bflo(b.y), bfhi(a.y) + bfhi(b.y), bflo(a.z) + bflo(b.z), bfhi(a.z) + bfhi(b.z), bflo(a.w) + bflo(b.w), bfhi(a.w) + bfhi(b.w)};
            const float gv[8] = {bflo(g.x), bfhi(g.x), bflo(g.y), bfhi(g.y), bflo(g.z), bfhi(g.z), bflo(g.w), bfhi(g.w)};
            float ss = 0.f;
#pragma unroll
            for (int i = 0; i < 8; ++i) ss += s[i] * s[i];
            ss += __shfl_xor(ss, 1); ss += __shfl_xor(ss, 2); ss += __shfl_xor(ss, 4); ss += __shfl_xor(ss, 8);
            const float r = 1.0f / sqrtf(ss * (1.0f / HD) + EPS);
            const GAS f32x4* wp = (const GAS f32x4*)(gnorm + (e0 & 127)); const f32x4 wa = wp[0], wb = wp[1];
            const float wv[8] = {wa.x, wa.y, wa.z, wa.w, wb.x, wb.y, wb.z, wb.w};
            float o[8];
#pragma unroll
            for (int i = 0; i < 8; ++i) o[i] = s[i] * r * wv[i] * (gv[i] * sigmoid_f(gv[i]));
            v4u w; w.x = pk2(o[0], o[1]); w.y = pk2(o[2], o[3]); w.z = pk2(o[4], o[5]); w.w = pk2(o[6], o[7]);
            *(GAS v4u*)(O + (size_t)m * D + e0) = w;
        }
    }
}

__device__ __forceinline__ void rope_pair(float& x0, float& x1, const float* cosT, const float* sinT, int pos, int lane) {
    const float p0 = __shfl_xor(x0, 8), p1 = __shfl_xor(x1, 8);
    if (lane < 16) {
        const int dd = 2 * (lane & 7);
        const float c0 = cosT[pos * 16 + dd], c1 = cosT[pos * 16 + dd + 1], s0 = sinT[pos * 16 + dd], s1 = sinT[pos * 16 + dd + 1];
        if (lane < 8) { x0 = x0 * c0 - p0 * s0; x1 = x1 * c1 - p1 * s1; }
        else          { x0 = x0 * c0 + p0 * s0; x1 = x1 * c1 + p1 * s1; }
    }
}
__device__ __forceinline__ void attn_core_simple(const bf16* P, const float* cosT, const float* sinT, bf16* OG, float* LSE, int gw, int NGW, int lane) {
    const float scale = 0.08838834764831845f;
    for (int task = gw; task < M * NH * 3; task += NGW) {
        const int g = task % 3, rh = task / 3, hh = rh & 15, row = rh >> 4, b = row >> 12, t = row & (SEQ - 1);
        const int r = (g == 0) ? 1 : (g == 1 ? 4 : 16);
        const unsigned qq = ((const GAS unsigned*)(P + (size_t)row * ATTN_N + ((g * 3 + 0) * NH + hh) * HD))[lane];
        float q0 = bflo(qq), q1 = bfhi(qq);
        float mx = -1e30f, l = 0.f, o0 = 0.f, o1 = 0.f;
        for (int j = -64; j <= 64; ++j) {
            const int tk = t + r * j;
            if (tk < 0 || tk >= SEQ) continue;
            const bf16* krow = P + (size_t)(b * SEQ + tk) * ATTN_N + ((g * 3 + 1) * NH + hh) * HD;
            const unsigned kk = ((const GAS unsigned*)krow)[lane]; const unsigned vv = ((const GAS unsigned*)(krow + NH * HD))[lane];
            float k0 = bflo(kk), k1 = bfhi(kk);
            const float s = wave_sum(q0 * k0 + q1 * k1) * scale;
            const float mn = fmaxf(mx, s), c = __expf(mx - mn), p = __expf(s - mn);
            l = l * c + p; o0 = o0 * c + p * bflo(vv); o1 = o1 * c + p * bfhi(vv); mx = mn;
        }
        const float il = 1.0f / l;
        ((GAS unsigned*)(OG + ((size_t)g * M + row) * D + hh * HD))[lane] = pk2(o0 * il, o1 * il);
        if (lane == 0) LSE[((size_t)g * M + row) * NH + hh] = mx + __logf(l);
    }
}
__device__ __forceinline__ void attn_finalize(const bf16* OG, const float* LSE, bf16* O, int gw, int NGW, int lane) {
    for (int m = gw; m < M; m += NGW) {
#pragma unroll
        for (int j = 0; j < 4; ++j) {
            const int e0 = 8 * (64 * j + lane), hh = e0 >> 7;
            const float l0 = LSE[((size_t)0 * M + m) * NH + hh], l1 = LSE[((size_t)1 * M + m) * NH + hh], l2 = LSE[((size_t)2 * M + m) * NH + hh];
            const float mx = fmaxf(l0, fmaxf(l1, l2)); float w0 = __expf(l0 - mx), w1 = __expf(l1 - mx), w2 = __expf(l2 - mx);
            const float inv = 1.0f / (w0 + w1 + w2); w0 *= inv; w1 *= inv; w2 *= inv;
            const v4u a = *(const GAS v4u*)(OG + ((size_t)0 * M + m) * D + e0), b = *(const GAS v4u*)(OG + ((size_t)1 * M + m) * D + e0), c = *(const GAS v4u*)(OG + ((size_t)2 * M + m) * D + e0);
            v4u w;
            w.x = pk2(w0 * bflo(a.x) + w1 * bflo(b.x) + w2 * bflo(c.x), w0 * bfhi(a.x) + w1 * bfhi(b.x) + w2 * bfhi(c.x));
            w.y = pk2(w0 * bflo(a.y) + w1 * bflo(b.y) + w2 * bflo(c.y), w0 * bfhi(a.y) + w1 * bfhi(b.y) + w2 * bfhi(c.y));
            w.z = pk2(w0 * bflo(a.z) + w1 * bflo(b.z) + w2 * bflo(c.z), w0 * bfhi(a.z) + w1 * bfhi(b.z) + w2 * bfhi(c.z));
            w.w = pk2(w0 * bflo(a.w) + w1 * bflo(b.w) + w2 * bflo(c.w), w0 * bfhi(a.w) + w1 * bfhi(b.w) + w2 * bfhi(c.w));
            *(GAS v4u*)(O + (size_t)m * D + e0) = w;
        }
    }
}

typedef short s16x4 __attribute__((ext_vector_type(4)));
typedef short v4i16_t __attribute__((ext_vector_type(4)));
typedef unsigned v2u __attribute__((ext_vector_type(2)));
__device__ __forceinline__ void glds16(const void* gsrc, unsigned lds_dst) { unsigned keep;
    asm volatile("s_mov_b32 %0, m0\n\ts_mov_b32 m0, %2\n\ts_nop 0\n\tglobal_load_lds_dwordx4 %1, off\n\ts_mov_b32 m0, %0" : "=&s"(keep) : "v"(gsrc), "s"(lds_dst) : "memory"); }
__device__ __forceinline__ s16x4 tr_read(LAS const unsigned char* p) { return __builtin_bit_cast(s16x4, __builtin_amdgcn_ds_read_tr16_b64_v4i16((LAS v4i16_t*)p)); }
__device__ __forceinline__ bf16x8 cat44(s16x4 a, s16x4 b) { return (bf16x8){a[0], a[1], a[2], a[3], b[0], b[1], b[2], b[3]}; }
#ifdef PROBE_ADMA2
#define AT_VW "s_waitcnt vmcnt(22)"
#else
#define AT_VW "s_waitcnt vmcnt(13)"
#endif
__device__ __forceinline__ void glds16s_1(const void* sbase, unsigned voff, unsigned lds_dst) { unsigned keep;
    asm volatile("s_mov_b32 %0, m0\n\ts_mov_b32 m0, %3\n\ts_nop 0\n\tglobal_load_lds_dwordx4 %1, %2\n\ts_mov_b32 m0, %0" : "=&s"(keep) : "v"(voff), "s"(sbase), "s"(lds_dst) : "memory"); }
__device__ __forceinline__ void glds16s(const void* sbase, unsigned voff, unsigned lds_dst) { glds16s_1(sbase, voff, lds_dst);
#ifdef PROBE_ADMA2
    glds16s_1(sbase, voff, lds_dst);
#endif
}
__device__ __forceinline__ bf16x8 gload16s(const void* sbase, unsigned voff) { return *(const GAS bf16x8*)((const unsigned char*)sbase + voff); }
__device__ __forceinline__ void attn_core_mfma(LAS unsigned char* lds, const bf16* P, bf16* OG, float* LSE, int vcu, int G) {
    int tid_l = threadIdx.x; asm volatile("" : "+v"(tid_l));
    const int tid = tid_l, lane = tid & 63, w = __builtin_amdgcn_readfirstlane(tid >> 6), fr = lane & 15, q4 = lane >> 4;
    const float sc2 = 0.08838834764831845f * 1.44269504f;
    constexpr int RST = 288, K_OFF = 0, V_OFF = 73728;
    const bool ucons = (3072 % G) == 0; const int USTEP = ucons ? 1 : G, UID0 = ucons ? vcu * (3072 / G) : vcu;
    const int NUN = ucons ? 3072 / G : (vcu < 3072 ? (3072 - vcu + G - 1) / G : 0);
#define AT_SCHED __builtin_amdgcn_sched_barrier(0)
#define AT_DECODE(uid_) const int bi = (uid_) & 31, bhg = (uid_) >> 5, g = bhg % 3, bh = bhg / 3, hh = bh & 15, b = bh >> 4; \
        const int rsh = 2 * g, nbs = 5 - rsh, rho = bi >> nbs, blk = bi & ((1 << nbs) - 1), L = SEQ >> rsh, u0 = blk * 128; \
        const bf16* Qb = P + (size_t)b * SEQ * ATTN_N + ((g * 3 + 0) * NH + hh) * HD; const bf16* Kb = Qb + NH * HD; const bf16* Vb = Kb + NH * HD; \
        (void)L; (void)Qb; (void)Kb; (void)Vb; (void)u0; (void)rho;
    if (w >= 4) {
        const int lw = w - 4;
        int prow[18], pchb[18];
#pragma unroll
        for (int i = 0; i < 18; ++i) { const int sl = (lw + 4 * i) * 64 + lane; prow[i] = sl / 18; const int ch = sl - prow[i] * 18; pchb[i] = (ch < 16 ? ch : 0) * 16; }
#define AT_ROWOFF(i_) ({ int uk_ = u0 - 64 + prow[i_]; uk_ = uk_ < 0 ? 0 : (uk_ >= L ? L - 1 : uk_); (unsigned)(((uk_ << rsh) + rho) * (ATTN_N * 2) + pchb[i_]); })
#define AT_ISSUE(base_, off_) do { _Pragma("unroll") for (int i_ = 0; i_ < 18; ++i_) glds16s(base_, AT_ROWOFF(i_), (unsigned)(size_t)(lds + (off_) + (lw + 4 * i_) * 1024)); } while (0)
        int uid = UID0;
        if (uid < 3072) { AT_DECODE(uid) AT_ISSUE(Kb, K_OFF); AT_ISSUE(Vb, V_OFF); }
        for (int un = 0; un < NUN; ++un, uid += USTEP) {
            const int nuid = (un + 1 < NUN) ? uid + USTEP : 3072;
            asm volatile("s_waitcnt vmcnt(18)" ::: "memory");
            __builtin_amdgcn_s_barrier(); asm volatile("" ::: "memory");
            __builtin_amdgcn_s_barrier(); asm volatile("" ::: "memory");
            if (nuid < 3072) { AT_DECODE(nuid) AT_ISSUE(Kb, K_OFF); asm volatile("s_waitcnt vmcnt(18)" ::: "memory"); }
            else asm volatile("s_waitcnt vmcnt(0)" ::: "memory");
            __builtin_amdgcn_s_barrier(); asm volatile("" ::: "memory");
            __builtin_amdgcn_s_barrier(); asm volatile("" ::: "memory");
            if (nuid < 3072) { AT_DECODE(nuid) AT_ISSUE(Vb, V_OFF); }
        }
#undef AT_ROWOFF
#undef AT_ISSUE
    } else {
        const int cw = w, qp = (lane >> 2) & 3, p4 = lane & 3;
        const int bK = K_OFF + (32 * cw + fr) * RST + q4 * 16;
        const int bV = V_OFF + (32 * cw + 4 * q4 + qp) * RST + p4 * 8;
        bf16x8 qf[2][4];
        int uid = UID0;
        if (uid < 3072) { AT_DECODE(uid)
#pragma unroll
            for (int qi = 0; qi < 2; ++qi) { const unsigned qo = (unsigned)((((u0 + 32 * cw + 16 * qi + fr) << rsh) + rho) * (ATTN_N * 2) + 16 * q4);
#pragma unroll
                for (int ks = 0; ks < 4; ++ks) qf[qi][ks] = gload16s(Qb, qo + 64 * ks); } }
        for (int un = 0; un < NUN; ++un, uid += USTEP) {
            AT_DECODE(uid)
            const int nuid = (un + 1 < NUN) ? uid + USTEP : 3072;
            __builtin_amdgcn_s_barrier(); asm volatile("" ::: "memory");
            f32x4 S[2][9]; bf16x8 kf[2][2][4];
#pragma unroll
            for (int qi = 0; qi < 2; ++qi)
#pragma unroll
                for (int kt = 0; kt < 9; ++kt) S[qi][kt] = (f32x4){0.f, 0.f, 0.f, 0.f};
            AT_SCHED;
#pragma unroll
            for (int jj = 0; jj < 2; ++jj)
#pragma unroll
                for (int ks = 0; ks < 4; ++ks) kf[0][jj][ks] = *(const LAS bf16x8*)(lds + bK + 16 * jj * RST + 64 * ks);
            AT_SCHED;
#pragma unroll
            for (int gi = 0; gi < 5; ++gi) {
                if (gi < 4) {
#pragma unroll
                    for (int jj = 0; jj < 2; ++jj)
#pragma unroll
                        for (int ks = 0; ks < 4; ++ks) kf[(gi + 1) & 1][jj][ks] = *(const LAS bf16x8*)(lds + bK + 16 * (2 * (gi + 1) + jj) * RST + 64 * ks);
                    AT_SCHED; asm volatile("s_waitcnt lgkmcnt(8)" ::: "memory"); AT_SCHED; }
                else { AT_SCHED; asm volatile("s_waitcnt lgkmcnt(0)" ::: "memory"); AT_SCHED; }
#pragma unroll
                for (int jj = 0; jj < 2; ++jj) { const int j = 2 * gi + jj;
#pragma unroll
                    for (int ks = 0; ks < 4; ++ks) {
                        if (j <= 8) S[0][j] = __builtin_amdgcn_mfma_f32_16x16x32_bf16(kf[gi & 1][jj][ks], qf[0][ks], S[0][j], 0, 0, 0);
                        if (j >= 1) S[1][j - 1] = __builtin_amdgcn_mfma_f32_16x16x32_bf16(kf[gi & 1][jj][ks], qf[1][ks], S[1][j - 1], 0, 0, 0); } }
                AT_SCHED; }
            __builtin_amdgcn_s_barrier(); asm volatile("" ::: "memory");
            bf16x8 qn[2][4];
            if (nuid < 3072) {
                const int bi_n = nuid & 31, bhg_n = nuid >> 5, g_n = bhg_n % 3, bh_n = bhg_n / 3, hh_n = bh_n & 15, b_n = bh_n >> 4;
                const int rsh_n = 2 * g_n, nbs_n = 5 - rsh_n, rho_n = bi_n >> nbs_n, blk_n = bi_n & ((1 << nbs_n) - 1), u0_n = blk_n * 128;
                const bf16* Qb_n = P + (size_t)b_n * SEQ * ATTN_N + ((g_n * 3 + 0) * NH + hh_n) * HD;
#pragma unroll
                for (int qi = 0; qi < 2; ++qi) { const unsigned qo = (unsigned)((((u0_n + 32 * cw + 16 * qi + fr) << rsh_n) + rho_n) * (ATTN_N * 2) + 16 * q4);
#pragma unroll
                    for (int ks = 0; ks < 4; ++ks) qn[qi][ks] = gload16s(Qb_n, qo + 64 * ks); } }
            else {
#pragma unroll
                for (int qi = 0; qi < 2; ++qi)
#pragma unroll
                    for (int ks = 0; ks < 4; ++ks) qn[qi][ks] = qf[qi][ks]; }
            float mxs[2], ls[2]; bf16x8 pf[2][5];
#pragma unroll
            for (int qi = 0; qi < 2; ++qi) {
                float mx = -1e30f;
#pragma unroll
                for (int kt = 0; kt < 9; ++kt)
#pragma unroll
                    for (int r = 0; r < 4; ++r) { const int rr = 4 * q4 + r; const int uk = u0 + 32 * cw + 16 * qi - 64 + 16 * kt + rr;
                        const bool ok = (kt > 0 || rr >= fr) && (kt < 8 || rr <= fr) && uk >= 0 && uk < L;
                        const float sv = ok ? S[qi][kt][r] * sc2 : -1e30f; S[qi][kt][r] = sv; mx = fmaxf(mx, sv); }
                mx = fmaxf(mx, __shfl_xor(mx, 16)); mx = fmaxf(mx, __shfl_xor(mx, 32));
                float l = 0.f;
#pragma unroll
                for (int kt = 0; kt < 9; ++kt)
#pragma unroll
                    for (int r = 0; r < 4; ++r) { const float pv = __builtin_amdgcn_exp2f(S[qi][kt][r] - mx); S[qi][kt][r] = pv; l += pv; }
                l += __shfl_xor(l, 16); l += __shfl_xor(l, 32);
                mxs[qi] = mx; ls[qi] = l;
#pragma unroll
                for (int pi = 0; pi < 5; ++pi) { const int ka = 2 * pi - qi, kb = 2 * pi + 1 - qi; v4u pw;
                    if (ka >= 0 && ka <= 8) { pw.x = pg8::cvt_pk_bf16(S[qi][ka][0], S[qi][ka][1]); pw.y = pg8::cvt_pk_bf16(S[qi][ka][2], S[qi][ka][3]); } else { pw.x = 0u; pw.y = 0u; }
                    if (kb >= 0 && kb <= 8) { pw.z = pg8::cvt_pk_bf16(S[qi][kb][0], S[qi][kb][1]); pw.w = pg8::cvt_pk_bf16(S[qi][kb][2], S[qi][kb][3]); } else { pw.z = 0u; pw.w = 0u; }
                    pf[qi][pi] = __builtin_bit_cast(bf16x8, pw); } }
            __builtin_amdgcn_s_barrier(); asm volatile("" ::: "memory");
            f32x4 O[2][8]; s16x4 vr[2][8][2];
#pragma unroll
            for (int qi = 0; qi < 2; ++qi)
#pragma unroll
                for (int dt = 0; dt < 8; ++dt) O[qi][dt] = (f32x4){0.f, 0.f, 0.f, 0.f};
            AT_SCHED;
#pragma unroll
            for (int dt = 0; dt < 8; ++dt) { vr[0][dt][0] = tr_read(lds + bV + 32 * dt); vr[0][dt][1] = tr_read(lds + bV + 16 * RST + 32 * dt); }
            AT_SCHED;
#pragma unroll
            for (int pi = 0; pi < 5; ++pi) {
                if (pi < 4) {
#pragma unroll
                    for (int dt = 0; dt < 4; ++dt) { vr[(pi + 1) & 1][dt][0] = tr_read(lds + bV + 32 * (pi + 1) * RST + 32 * dt); vr[(pi + 1) & 1][dt][1] = tr_read(lds + bV + (32 * (pi + 1) + 16) * RST + 32 * dt); }
                    AT_SCHED; asm volatile("s_waitcnt lgkmcnt(8)" ::: "memory"); AT_SCHED;
#pragma unroll
                    for (int dt = 4; dt < 8; ++dt) { vr[(pi + 1) & 1][dt][0] = tr_read(lds + bV + 32 * (pi + 1) * RST + 32 * dt); vr[(pi + 1) & 1][dt][1] = tr_read(lds + bV + (32 * (pi + 1) + 16) * RST + 32 * dt); }
                    AT_SCHED; }
                else { AT_SCHED; asm volatile("s_waitcnt lgkmcnt(0)" ::: "memory"); AT_SCHED; }
#pragma unroll
                for (int dt = 0; dt < 8; ++dt) { const bf16x8 vf = cat44(vr[pi & 1][dt][0], vr[pi & 1][dt][1]);
                    O[0][dt] = __builtin_amdgcn_mfma_f32_16x16x32_bf16(vf, pf[0][pi], O[0][dt], 0, 0, 0);
                    O[1][dt] = __builtin_amdgcn_mfma_f32_16x16x32_bf16(vf, pf[1][pi], O[1][dt], 0, 0, 0); }
                AT_SCHED; }
            __builtin_amdgcn_s_barrier(); asm volatile("" ::: "memory");
#pragma unroll
            for (int qi = 0; qi < 2; ++qi) { const float il = 1.0f / ls[qi]; const int qtok = ((u0 + 32 * cw + 16 * qi + fr) << rsh) + rho;
                const size_t orow = (size_t)g * M + (size_t)b * SEQ + qtok; bf16* op = OG + orow * D + hh * HD + 4 * q4;
#pragma unroll
                for (int dt = 0; dt < 8; ++dt) { v2u o2; o2.x = pk2(O[qi][dt][0] * il, O[qi][dt][1] * il); o2.y = pk2(O[qi][dt][2] * il, O[qi][dt][3] * il); *(GAS v2u*)(op + 16 * dt) = o2; }
                if (q4 == 0) *(GAS float*)(LSE + orow * NH + hh) = mxs[qi] * 0.6931471805599453f + __logf(ls[qi]); }
#pragma unroll
            for (int qi = 0; qi < 2; ++qi)
#pragma unroll
                for (int ks = 0; ks < 4; ++ks) qf[qi][ks] = qn[qi][ks];
        }
    }
    asm volatile("s_waitcnt vmcnt(0) lgkmcnt(0)" ::: "memory"); __builtin_amdgcn_s_barrier(); asm volatile("" ::: "memory");
#undef AT_SCHED
#undef AT_DECODE
}
typedef float float2_t __attribute__((ext_vector_type(2)));
__device__ __forceinline__ void hgrn_gates(const bf16* P, const float* lbt, bf16* QT, bf16* KT, float* PREF, float* BR, int gw, int NGW, int lane) {
    const unsigned lo = 4u * (unsigned)lane;
    for (int item = gw; item < 8192; item += NGW) {
        const int cb = item & 15, half = (item >> 4) & 1, chunk = (item >> 5) & 127, dir = item >> 12;
        const int cbase = cb * 128; const size_t row0 = (size_t)chunk * 64;
        const float lb0 = lbt[(size_t)dir * 4 * D + cbase + 2 * lane], lb1 = lbt[(size_t)dir * 4 * D + cbase + 2 * lane + 1];
        const unsigned char* fcol = (const unsigned char*)(P + (1 + dir) * D + cbase); const unsigned char* qcol = (const unsigned char*)(P + cbase);
        unsigned char* qt = (unsigned char*)(QT + (size_t)dir * M * D + cbase); unsigned char* kt = (unsigned char*)(KT + (size_t)dir * M * D + cbase);
        unsigned fw[32], qw[32];
#pragma unroll
        for (int j = 0; j < 32; ++j) { const int tau = half ? 32 + j : 31 - j; const size_t t = dir ? row0 + 63 - tau : row0 + tau;
            fw[j] = *(const GAS unsigned*)(fcol + t * (HGRN_N * 2) + lo); qw[j] = *(const GAS unsigned*)(qcol + t * (HGRN_N * 2) + lo); }
        float a0 = 1.f, a1 = 1.f;
#pragma unroll
        for (int j = 0; j < 32; ++j) { const int tau = half ? 32 + j : 31 - j; const size_t t = dir ? row0 + 63 - tau : row0 + tau;
            asm volatile("" : "+v"(fw[j]), "+v"(qw[j]) :: "memory");
            const float g0 = lb0 + (1.0f - lb0) * sigmoid_f(bflo(fw[j])), g1 = lb1 + (1.0f - lb1) * sigmoid_f(bfhi(fw[j]));
            const float q0 = bflo(qw[j]), q1 = bfhi(qw[j]); const float s0 = q0 * sigmoid_f(q0), s1 = q1 * sigmoid_f(q1);
            if (half) { a0 *= g0; a1 *= g1; }
            const float i0 = __builtin_amdgcn_rcpf(fmaxf(a0, 1e-30f)), i1 = __builtin_amdgcn_rcpf(fmaxf(a1, 1e-30f));
            const float e0 = half ? a0 : i0, e1 = half ? a1 : i1, r0 = half ? i0 : a0, r1 = half ? i1 : a1;
            *(GAS unsigned*)(qt + t * (D * 2) + lo) = pk2(s0 * e0, s1 * e1);
            *(GAS unsigned*)(kt + t * (D * 2) + lo) = pk2((1.0f - g0) * r0, (1.0f - g1) * r1);
            if (!half) { a0 *= g0; a1 *= g1; }
        }
        float* dst = (half ? BR : PREF) + ((size_t)dir * (M / 64) + chunk) * D + cbase;
        *(GAS float2_t*)((unsigned char*)dst + 2u * lo) = (float2_t){a0, a1};
    }
}

__device__ __forceinline__ void hgrn_scan_mfma(LAS unsigned char* lds, const bf16* P, const bf16* QT, const bf16* KT, const float* PREF, const float* BR, bf16* OD, int vcu, int G) {
    int tid_l = threadIdx.x; asm volatile("" : "+v"(tid_l));
    const int tid = tid_l, lane = tid & 63, w = __builtin_amdgcn_readfirstlane(tid >> 6), fr = lane & 15, q4 = lane >> 4;
    constexpr int QST = 272, KST = 288, VST = 96;
    constexpr int STG = 43008, QS = 0, KS = 17408, VS = 35840, VEC = 41984;
#define HG_SCHED __builtin_amdgcn_sched_barrier(0)
    for (int unit = vcu; unit < 256; unit += G) {
        const int chain = unit >> 2, slice = unit & 3, b = chain >> 5, hh = (chain >> 1) & 15, dir = chain & 1;
        const size_t dOff = (size_t)dir * M * D;
        const int ck0 = dir ? 63 : 0; const size_t tok00 = (size_t)b * SEQ + (size_t)ck0 * 64;
        if (w >= 4) {
            const int lw = w - 4;
            const unsigned char* src[11]; long sstr[11]; int poff[11];
            const long rstep = (dir ? -64L : 64L);
#pragma unroll
            for (int i = 0; i < 11; ++i) {
                int img, pcl;
                if (i < 4) { img = 0; pcl = lw + 4 * i; } else if (i < 8) { img = 1; pcl = lw + 4 * (i - 4); } else if (i == 8) { img = 2; pcl = lw; }
                else if (i == 9) { img = (lw < 2) ? 2 : (lw == 2 ? 0 : 1); pcl = (lw < 2) ? 4 + lw : 16; }
                else { img = (lw == 0) ? 1 : (lw == 1 ? 3 : 0); pcl = (lw == 0) ? 17 : lw; }
                const int sl = pcl * 64 + lane;
                if (img == 0 || img == 1) { const int RS = img ? 18 : 17; const int row = sl / RS, ch = sl - row * RS, chs = ch < 16 ? ch : 0;
                    src[i] = (const unsigned char*)((img ? KT : QT) + dOff + (tok00 + row) * D + hh * HD + chs * 8); sstr[i] = rstep * D * 2; poff[i] = (img ? KS : QS) + pcl * 1024; }
                else if (img == 2) { const int row = sl / 6, ch = sl - row * 6, chs = ch < 4 ? ch : 0;
                    src[i] = (const unsigned char*)(P + (tok00 + row) * HGRN_N + 3 * D + hh * HD + slice * 32 + chs * 8); sstr[i] = rstep * HGRN_N * 2; poff[i] = VS + pcl * 1024; }
                else { src[i] = (const unsigned char*)(((lane < 32) ? PREF : BR) + ((size_t)dir * (M / 64) + (tok00 >> 6)) * D + hh * HD + 4 * (lane & 31)); sstr[i] = (dir ? -1L : 1L) * D * 4; poff[i] = VEC; } }
#define HG_STAGE(step_, sb_) do { _Pragma("unroll") for (int i_ = 0; i_ < 11; ++i_) \
                glds16(src[i_] + (long)(step_) * sstr[i_], (unsigned)(size_t)(lds + (sb_) + poff[i_])); } while (0)
            HG_STAGE(0, 0); HG_STAGE(1, STG);
            int sbn = 2 * STG;
            for (int step = 0; step < 64; ++step) {
                if (step < 63) asm volatile("s_waitcnt vmcnt(11)" ::: "memory"); else asm volatile("s_waitcnt vmcnt(0)" ::: "memory");
                __builtin_amdgcn_s_barrier(); asm volatile("" ::: "memory");
                if (step + 2 < 64) HG_STAGE(step + 2, sbn);
                sbn = (sbn == 2 * STG) ? 0 : sbn + STG;
            }
#undef HG_STAGE
        } else {
            const int tt = w, qp = (lane >> 2) & 3, p4 = lane & 3;
            const int bQ = QS + (16 * tt + fr) * QST + q4 * 16;
            const int bQ2 = QS + (16 * tt + fr) * QST + q4 * 8;
            const int bK = KS + fr * KST + q4 * 16;
            const int bKc = KS + (4 * q4 + qp) * KST + p4 * 8;
            const int bV = VS + (4 * q4 + qp) * VST + p4 * 8;
            const int bP = VEC + q4 * 16;
            f32x4 S[8][2];
#pragma unroll
            for (int T = 0; T < 8; ++T) { S[T][0] = (f32x4){0.f, 0.f, 0.f, 0.f}; S[T][1] = (f32x4){0.f, 0.f, 0.f, 0.f}; }
            int sb = 0;
            for (int step = 0; step < 64; ++step) {
                __builtin_amdgcn_s_barrier(); asm volatile("" ::: "memory");
                LAS const unsigned char* st = lds + sb;
                HG_SCHED;
                bf16x8 qf[4], kf[2][4]; s16x4 va[2][2][2];
#pragma unroll
                for (int ks = 0; ks < 4; ++ks) qf[ks] = *(const LAS bf16x8*)(st + bQ + 64 * ks);
#pragma unroll
                for (int s4 = 0; s4 < 4; ++s4) kf[0][s4] = *(const LAS bf16x8*)(st + bK + 16 * s4 * KST);
#pragma unroll
                for (int vt = 0; vt < 2; ++vt)
#pragma unroll
                    for (int pi = 0; pi < 2; ++pi) { va[vt][pi][0] = tr_read(st + bV + 32 * pi * VST + 32 * vt); va[vt][pi][1] = tr_read(st + bV + (32 * pi + 16) * VST + 32 * vt); }
                HG_SCHED;
                f32x4 Pt[4];
#pragma unroll
                for (int s4 = 0; s4 < 4; ++s4) Pt[s4] = (f32x4){0.f, 0.f, 0.f, 0.f};
#pragma unroll
                for (int ks = 0; ks < 4; ++ks) {
                    if (ks < 3) {
#pragma unroll
                        for (int s4 = 0; s4 < 4; ++s4) kf[(ks + 1) & 1][s4] = *(const LAS bf16x8*)(st + bK + 16 * s4 * KST + 64 * (ks + 1));
                        HG_SCHED; asm volatile("s_waitcnt lgkmcnt(4)" ::: "memory"); HG_SCHED; }
                    else { HG_SCHED; asm volatile("s_waitcnt lgkmcnt(0)" ::: "memory"); HG_SCHED; }
#pragma unroll
                    for (int s4 = 0; s4 < 4; ++s4) Pt[s4] = __builtin_amdgcn_mfma_f32_16x16x32_bf16(kf[ks & 1][s4], qf[ks], Pt[s4], 0, 0, 0);
                    HG_SCHED; }
                f32x4 pr[8]; s16x4 qa[4], qb[4];
#pragma unroll
                for (int T = 0; T < 8; ++T) pr[T] = *(const LAS f32x4*)(st + bP + 64 * T);
#pragma unroll
                for (int ks = 0; ks < 4; ++ks) { qa[ks] = *(const LAS s16x4*)(st + bQ2 + 64 * ks); qb[ks] = *(const LAS s16x4*)(st + bQ2 + 64 * ks + 32); }
                HG_SCHED;
                const int tix = 16 * tt + fr;
#pragma unroll
                for (int s4 = 0; s4 < 4; ++s4)
#pragma unroll
                    for (int r = 0; r < 4; ++r) { const int six = 16 * s4 + 4 * q4 + r; const bool keep = dir ? (six >= tix) : (six <= tix); Pt[s4][r] = keep ? Pt[s4][r] : 0.f; }
                f32x4 o[2]; o[0] = (f32x4){0.f, 0.f, 0.f, 0.f}; o[1] = (f32x4){0.f, 0.f, 0.f, 0.f};
#pragma unroll
                for (int pi = 0; pi < 2; ++pi) {
                    v4u pw; pw.x = pg8::cvt_pk_bf16(Pt[2 * pi][0], Pt[2 * pi][1]); pw.y = pg8::cvt_pk_bf16(Pt[2 * pi][2], Pt[2 * pi][3]);
                    pw.z = pg8::cvt_pk_bf16(Pt[2 * pi + 1][0], Pt[2 * pi + 1][1]); pw.w = pg8::cvt_pk_bf16(Pt[2 * pi + 1][2], Pt[2 * pi + 1][3]);
#pragma unroll
                    for (int vt = 0; vt < 2; ++vt) o[vt] = __builtin_amdgcn_mfma_f32_16x16x32_bf16(cat44(va[vt][pi][0], va[vt][pi][1]), __builtin_bit_cast(bf16x8, pw), o[vt], 0, 0, 0); }
                HG_SCHED; asm volatile("s_waitcnt lgkmcnt(0)" ::: "memory"); HG_SCHED;
#pragma unroll
                for (int T = 0; T < 8; ++T) { S[T][0] = S[T][0] * pr[T]; S[T][1] = S[T][1] * pr[T]; }
                HG_SCHED;
                s16x4 kc[2][2][2][2]; f32x4 br[2][2];
#pragma unroll
                for (int j = 0; j < 2; ++j) { br[0][j] = *(const LAS f32x4*)(st + bP + 512 + 64 * j);
#pragma unroll
                    for (int pi = 0; pi < 2; ++pi) { kc[0][j][pi][0] = tr_read(st + bKc + 32 * pi * KST + 32 * j); kc[0][j][pi][1] = tr_read(st + bKc + (32 * pi + 16) * KST + 32 * j); } }
                HG_SCHED;
#pragma unroll
                for (int ks = 0; ks < 4; ++ks) { const int T0 = 2 * ks, T1 = 2 * ks + 1; const bf16x8 qq = cat44(qa[ks], qb[ks]);
#pragma unroll
                    for (int vt = 0; vt < 2; ++vt) {
                        v4u aw; aw.x = pg8::cvt_pk_bf16(S[T0][vt][0], S[T0][vt][1]); aw.y = pg8::cvt_pk_bf16(S[T0][vt][2], S[T0][vt][3]);
                        aw.z = pg8::cvt_pk_bf16(S[T1][vt][0], S[T1][vt][1]); aw.w = pg8::cvt_pk_bf16(S[T1][vt][2], S[T1][vt][3]);
                        o[vt] = __builtin_amdgcn_mfma_f32_16x16x32_bf16(__builtin_bit_cast(bf16x8, aw), qq, o[vt], 0, 0, 0); } }
                HG_SCHED;
                { const int ck = dir ? 63 - step : step; const size_t tok = (size_t)b * SEQ + (size_t)ck * 64 + 16 * tt + fr;
#pragma unroll
                  for (int vt = 0; vt < 2; ++vt) { v2u o2; o2.x = pk2(o[vt][0], o[vt][1]); o2.y = pk2(o[vt][2], o[vt][3]);
                    *(GAS v2u*)(OD + dOff + tok * D + hh * HD + slice * 32 + 16 * vt + 4 * q4) = o2; } }
                HG_SCHED;
#pragma unroll
                for (int rd = 0; rd < 4; ++rd) {
                    if (rd < 3) {
#pragma unroll
                        for (int j = 0; j < 2; ++j) { const int T = 2 * (rd + 1) + j; br[(rd + 1) & 1][j] = *(const LAS f32x4*)(st + bP + 512 + 64 * T);
#pragma unroll
                            for (int pi = 0; pi < 2; ++pi) { kc[(rd + 1) & 1][j][pi][0] = tr_read(st + bKc + 32 * pi * KST + 32 * T); kc[(rd + 1) & 1][j][pi][1] = tr_read(st + bKc + (32 * pi + 16) * KST + 32 * T); } }
                        HG_SCHED; asm volatile("s_waitcnt lgkmcnt(10)" ::: "memory"); HG_SCHED; }
                    else { HG_SCHED; asm volatile("s_waitcnt lgkmcnt(0)" ::: "memory"); HG_SCHED; }
#pragma unroll
                    for (int j = 0; j < 2; ++j) { const int T = 2 * rd + j;
#pragma unroll
                        for (int vt = 0; vt < 2; ++vt) {
#pragma unroll
                            for (int pi = 0; pi < 2; ++pi) S[T][vt] = __builtin_amdgcn_mfma_f32_16x16x32_bf16(cat44(kc[rd & 1][j][pi][0], kc[rd & 1][j][pi][1]), cat44(va[vt][pi][0], va[vt][pi][1]), S[T][vt], 0, 0, 0);
                            S[T][vt] = S[T][vt] * br[rd & 1][j]; } }
                    HG_SCHED; }
                sb = (sb == 2 * STG) ? 0 : sb + STG;
            }
        }
        asm volatile("s_waitcnt vmcnt(0) lgkmcnt(0)" ::: "memory"); __builtin_amdgcn_s_barrier(); asm volatile("" ::: "memory");
    }
#undef HG_SCHED
}
struct Args { const float* in[9]; float* out; unsigned char* ws; int ph_lo, ph_hi; };
__global__ void __launch_bounds__(NTHREADS, 2) fwd(Args args) {
    extern __shared__ __attribute__((aligned(16))) unsigned char lds_raw[];
    LAS unsigned char* lds = (LAS unsigned char*)lds_raw;
    volatile LAS unsigned* MISC = (volatile LAS unsigned*)(lds + MISC_OFF);
    const int G = gridDim.x; const int bx = blockIdx.x;
    const int vcu = (G % 8 == 0) ? (bx % 8) * (G / 8) + bx / 8 : bx;
    const int NGW = G * NWAVES;
    unsigned char* ws = args.ws;
    const float* x_in = args.in[0]; const float* norm_w = args.in[1]; const float* w_in_hgrn = args.in[2]; const float* lbnd = args.in[3]; const float* gnorm = args.in[4];
    const float* w_in_attn = args.in[5]; const float* w_out = args.in[6]; const float* w_ffn_in = args.in[7]; const float* w_ffn_out = args.in[8];
    float* xres = args.out;
    float* cosT = (float*)(ws + WS_TAB + TAB_COS); float* sinT = (float*)(ws + WS_TAB + TAB_SIN); float* lbT = (float*)(ws + WS_TAB + TAB_LB);
    bf16* WHG = (bf16*)(ws + WS_WHG); bf16* WAT = (bf16*)(ws + WS_WAT); bf16* WO = (bf16*)(ws + WS_WO); bf16* WF1 = (bf16*)(ws + WS_WF1); bf16* WF2 = (bf16*)(ws + WS_WF2);
    bf16* H = (bf16*)(ws + WS_H); bf16* PROJ = (bf16*)(ws + WS_PROJ); bf16* MIX = (bf16*)(ws + WS_MIX); bf16* OB = (bf16*)(ws + WS_O); bf16* GB = (bf16*)(ws + WS_G);
    float* LSE = (float*)(ws + WS_MIX + 96 * MiB);
    bf16* QT = (bf16*)(ws + WS_PROJ + 160 * MiB); bf16* KT = (bf16*)(ws + WS_PROJ + 224 * MiB); bf16* KH = (bf16*)(ws + WS_KH);
    bf16* XB = (bf16*)(ws + WS_KH);
    float* XSCR = (float*)(ws + WS_MIX); bf16* HSCR = (bf16*)(ws + WS_MIX + 64 * MiB);
    float* PREF = (float*)(ws + WS_KH + 64 * MiB); float* E63V = (float*)(ws + WS_KH + 66 * MiB);

    for (int u = threadIdx.x; u < (LDS_BYTES - LDSCTL_OFF) / 4; u += NTHREADS) ((LAS unsigned*)(lds + LDSCTL_OFF))[u] = 0u;
    __syncthreads();
    const int lo = args.ph_lo, hi = args.ph_hi;
    const int FF1_REM = ((M / 256) * (FFN_N / 256)) % G;
    const bool TAILCVT = FF1_REM != 0 && (hi - lo) == NPHASES && REP_F1 == 1;
    const bool use_bar = (hi - lo) > 1;
    XcdBarrier bar; bar.bar = (unsigned*)(ws + WS_CTL) + CW_BAR; bar.x = 0; bar.st = nullptr;
    if (use_bar) bar = xcd_barrier_post((unsigned*)(ws + WS_CTL) + CW_BAR, MISC + 8);
#ifndef TAIL_ALL
#define TAIL_ALL 0
#endif
#ifndef INP_ALIGN
#define INP_ALIGN true
#endif
#ifndef TAIL_WO
#define TAIL_WO 0
#endif
#ifndef TAIL_F2
#define TAIL_F2 1
#endif
#ifndef MIXMAP
#define MIXMAP vcu
#endif
#define IN(k) (lo <= (k) && (k) < hi)
#define PH_IDS int tid_p = threadIdx.x; asm volatile("" : "+v"(tid_p)); const int lane_p = tid_p & 63; const int wave_p = __builtin_amdgcn_readfirstlane(tid_p >> 6); const int gw_p = vcu * NWAVES + wave_p; (void)lane_p; (void)gw_p;
#ifndef REP_BAR
#define REP_BAR 1
#endif
#define SEAM(k) do { if (IN(k) && IN((k) + 1)) for (int rb = 0; rb < REP_BAR; ++rb) xcd_barrier(bar); } while (0)

    if (IN(0)) for (int rep = 0; rep < REP_PRO; ++rep) {
        PH_IDS
        const int lane = lane_p, gw = gw_p, tid = tid_p;
        LAS float* scr = (LAS float*)(lds + wave_p * 16384);
        for (int s = 0; s < ((TAILCVT && TAIL_ALL) ? 1 : 2); ++s) transpose_matrix(w_in_hgrn + (size_t)s * D * HGRN_N, D, HGRN_N, WHG + (size_t)s * HGRN_N * D, 0, scr, gw, NGW, lane);
        for (int s = 0; s < ((TAILCVT && TAIL_ALL) ? 0 : 2); ++s) transpose_matrix(w_in_attn + (size_t)s * D * ATTN_N, D, ATTN_N, WAT + (size_t)s * ATTN_N * D, 0, scr, gw, NGW, lane);
        for (int s = 0; s < ((TAILCVT && (TAIL_ALL || TAIL_WO)) ? 1 : 4); ++s) transpose_matrix(w_out + (size_t)s * D * D, D, D, WO + (size_t)s * D * D, 0, scr, gw, NGW, lane);
        for (int s = 0; s < (TAILCVT ? 1 : 4); ++s) transpose_matrix(w_ffn_in + (size_t)s * D * FFN_N, D, FFN_N, WF1 + (size_t)s * FFN_N * D, 1, scr, gw, NGW, lane);
        for (int s = 0; s < ((TAILCVT && TAIL_F2) ? 1 : 4); ++s) transpose_matrix(w_ffn_out + (size_t)s * DFF * D, DFF, D, WF2 + (size_t)s * D * DFF, 0, scr, gw, NGW, lane);
        const int gt = vcu * NTHREADS + tid, NGT = G * NTHREADS;
        for (int idx = gt; idx < SEQ * 16; idx += NGT) { const int pos = idx >> 4, i = idx & 15;
            const float inv = powf(500000.0f, -(float)(2 * i) / 32.0f); const float ang = (float)pos * inv; cosT[idx] = cosf(ang); sinT[idx] = sinf(ang); }
        for (int idx = gt; idx < 2 * D; idx += NGT) { const int dir = idx >> 11, c = idx & (D - 1);
            float xl[4]; float mx = -3.0e38f;
#pragma unroll
            for (int l = 0; l < 4; ++l) { xl[l] = lbnd[(size_t)(dir * 4 + l) * D + c]; mx = fmaxf(mx, xl[l]); }
            float sum = 0.f;
#pragma unroll
            for (int l = 0; l < 4; ++l) { xl[l] = expf(xl[l] - mx); sum += xl[l]; }
            float cum = 0.f, c0 = 0.f;
#pragma unroll
            for (int l = 0; l < 4; ++l) { cum += xl[l] / sum; if (l == 0) c0 = cum; lbT[(size_t)(dir * 4 + l) * D + c] = cum - c0; } }
        norm_rows<false, true, false, false>(nullptr, x_in, nullptr, nullptr, norm_w, H, gw, NGW, lane);
    }
    SEAM(0);

    for (int L = 0; L < DEPTH; ++L) {
        const int pb = 1 + 9 * L; const bool hg = (L & 1) == 0; const int slot = L >> 1;
        const float* nw = norm_w + (size_t)L * 4 * D;
        const int NPROJ = hg ? HGRN_N : ATTN_N;
        if (IN(pb)) {
#ifdef STAGGER_US
            { const unsigned long long t0 = __builtin_amdgcn_s_memrealtime(); const unsigned long long dl = (unsigned long long)((bx >> 3) & 3) * (STAGGER_US * 100);
              while (__builtin_amdgcn_s_memrealtime() - t0 < dl) __builtin_amdgcn_s_sleep(8); }
#endif
            if (hg) for (int rep = 0; rep < REP_INH; ++rep) { pg8::Gemm g{H, WHG + (size_t)slot * HGRN_N * D, M, HGRN_N, D}; pg8::StaticOrder S; S.init(M, HGRN_N, G, bx);
                pg8::EpiBf16<0> E{PROJ, HGRN_N, nullptr, 0, 0, 1.f};
                pg8::gemm_phase<pg8::EpiBf16<0>, pg8::StaticOrder, INP_ALIGN, true>(lds, g, S, E); }
            else for (int rep = 0; rep < REP_INA; ++rep) { pg8::Gemm g{H, WAT + (size_t)((REP_INA_COLD && rep + 1 < REP_INA) ? (slot ^ 1) : slot) * ATTN_N * D, M, ATTN_N, D}; pg8::StaticOrder S; S.init(M, ATTN_N, G, bx);
                pg8::EpiRope E{PROJ, ATTN_N, cosT, sinT};
                pg8::gemm_phase<pg8::EpiRope, pg8::StaticOrder, INP_ALIGN, true>(lds, g, S, E); }
        }
        SEAM(pb);
        if (hg) {
            if (IN(pb + 1)) for (int rep = 0; rep < REP_GATES; ++rep) { PH_IDS hgrn_gates(PROJ, lbT + (size_t)L * D, QT, KT, PREF, E63V, gw_p, NGW, lane_p); }
            SEAM(pb + 1);
        }
        if (IN(pb + 2)) {
            if (hg) for (int rep = 0; rep < REP_SCAN; ++rep) hgrn_scan_mfma(lds, PROJ, QT, KT, PREF, E63V, MIX, MIXMAP, G);
            else for (int rep = 0; rep < REP_ATTN; ++rep) attn_core_mfma(lds, PROJ, MIX, LSE, MIXMAP, G);
        }
        SEAM(pb + 2);
        if (IN(pb + 3)) for (int rep = 0; rep < REP_FIN; ++rep) {
            PH_IDS
            const int lane = lane_p, gw = gw_p;
            if (hg) hgrn_finalize(PROJ, MIX, gnorm + (size_t)slot * HD, OB, gw, NGW, lane);
            else attn_finalize(MIX, LSE, OB, gw, NGW, lane);
        }
        SEAM(pb + 3);
        if (IN(pb + 4)) for (int rep = 0; rep < REP_WO; ++rep) {
            pg8::Gemm g{OB, WO + (size_t)L * D * D, M, D, D}; pg8::StaticOrder S; S.init(M, D, G, bx);
            pg8::EpiBf16<0> E{GB, D, nullptr, 0, 0, 1.f};
            pg8::gemm_phase<pg8::EpiBf16<0>, pg8::StaticOrder, true, true>(lds, g, S, E);
        }
        SEAM(pb + 4);
        if (IN(pb + 5)) for (int rep = 0; rep < REP_NORM; ++rep) { PH_IDS if (L == 0 && rep == 0) norm_rows<true, true, false, true>(GB, x_in, XB, nw + D, nw + 2 * D, H, gw_p, NGW, lane_p);
            else norm_rows<true, true, true, true>(GB, XB, rep ? (void*)XSCR : (void*)XB, nw + D, nw + 2 * D, rep ? HSCR : H, gw_p, NGW, lane_p); }
        SEAM(pb + 5);
        if (IN(pb + 6)) for (int rep = 0; rep < REP_F1; ++rep) {
            pg8::Gemm g{H, WF1 + (size_t)L * FFN_N * D, M, FFN_N, D}; pg8::StaticOrder S; S.init(M, FFN_N, G, bx);
            pg8::EpiSwiGLU E{PROJ, DFF};
            pg8::gemm_phase<pg8::EpiSwiGLU, pg8::StaticOrder, true, true>(lds, g, S, E);
            if (TAILCVT && L + 1 < DEPTH && bx >= FF1_REM) {
                PH_IDS
                LAS float* scr = (LAS float*)(lds + wave_p * 16384); const int gw2 = (bx - FF1_REM) * NWAVES + wave_p, ngw2 = (G - FF1_REM) * NWAVES;
                transpose_matrix(w_ffn_in + (size_t)(L + 1) * D * FFN_N, D, FFN_N, WF1 + (size_t)(L + 1) * FFN_N * D, 1, scr, gw2, ngw2, lane_p);
                if (TAIL_ALL) { const int L1 = L + 1, slot1 = L1 >> 1;
                    if (L1 & 1) transpose_matrix(w_in_attn + (size_t)slot1 * D * ATTN_N, D, ATTN_N, WAT + (size_t)slot1 * ATTN_N * D, 0, scr, gw2, ngw2, lane_p);
                    else transpose_matrix(w_in_hgrn + (size_t)slot1 * D * HGRN_N, D, HGRN_N, WHG + (size_t)slot1 * HGRN_N * D, 0, scr, gw2, ngw2, lane_p);
                    transpose_matrix(w_out + (size_t)L1 * D * D, D, D, WO + (size_t)L1 * D * D, 0, scr, gw2, ngw2, lane_p); }
                if (TAIL_F2) transpose_matrix(w_ffn_out + (size_t)(L + 1) * DFF * D, DFF, D, WF2 + (size_t)(L + 1) * D * DFF, 0, scr, gw2, ngw2, lane_p);
                if (TAIL_WO && !TAIL_ALL) transpose_matrix(w_out + (size_t)(L + 1) * D * D, D, D, WO + (size_t)(L + 1) * D * D, 0, scr, gw2, ngw2, lane_p);
            }
        }
        SEAM(pb + 6);
        if (IN(pb + 7)) for (int rep = 0; rep < REP_F2; ++rep) {
            pg8::Gemm g{PROJ, WF2 + (size_t)L * D * DFF, M, D, DFF}; pg8::StaticOrder S; S.init(M, D, G, bx);
            pg8::EpiBf16<0> E{GB, D, nullptr, 0, 0, 1.f};
            pg8::gemm_phase<pg8::EpiBf16<0>, pg8::StaticOrder, true, true>(lds, g, S, E);
        }
        SEAM(pb + 7);
        if (IN(pb + 8)) for (int rep = 0; rep < REP_NORM; ++rep) {
            PH_IDS
            const int lane = lane_p, gw = gw_p;
            if (L + 1 < DEPTH) norm_rows<true, true, true, true>(GB, XB, rep ? (void*)XSCR : (void*)XB, nw + 3 * D, nw + 4 * D, rep ? HSCR : H, gw, NGW, lane);
            else norm_rows<true, false, true, false>(GB, XB, rep ? XSCR : xres, nw + 3 * D, nullptr, nullptr, gw, NGW, lane);
        }
        SEAM(pb + 8);
    }
#undef IN
#undef SEAM
}

#ifndef MK_PER_PHASE
#define MK_PER_PHASE 0
#endif
extern "C" void kernel_launch(void* const* d_in, const int* in_sizes, int n_in, void* d_out, int out_size, void* d_ws, size_t ws_size, hipStream_t stream) {
    static int grid = 0;
    if (grid == 0) {
        if (n_in != 9 || in_sizes[0] != M * D || out_size != M * D || ws_size < WS_END) { fprintf(stderr, "kernel_launch: unexpected shapes (n_in %d, in0 %d, out %d, ws %zu); nothing launched\n", n_in, n_in > 0 ? in_sizes[0] : -1, out_size, ws_size); grid = -1; return; }
        int dev = 0, cus = 0, per_cu = 0;
        if (hipGetDevice(&dev) != hipSuccess || hipDeviceGetAttribute(&cus, hipDeviceAttributeMultiprocessorCount, dev) != hipSuccess) { grid = -1; return; }
        if (hipFuncSetAttribute((const void*)fwd, hipFuncAttributeMaxDynamicSharedMemorySize, LDS_BYTES) != hipSuccess) { fprintf(stderr, "kernel_launch: hipFuncSetAttribute failed\n"); grid = -1; return; }
        if (hipOccupancyMaxActiveBlocksPerMultiprocessor(&per_cu, (const void*)fwd, NTHREADS, LDS_BYTES) != hipSuccess || per_cu < 1) fprintf(stderr, "kernel_launch: occupancy query reports %d\n", per_cu);
        (void)hipGetLastError();
        grid = cus;
    }
    if (grid < 0) return;
    if (hipMemsetAsync((char*)d_ws + WS_CTL, 0, CTL_ZERO_BYTES, stream) != hipSuccess) return;
    Args a{};
    for (int i = 0; i < 9; ++i) a.in[i] = (const float*)d_in[i];
    a.out = (float*)d_out; a.ws = (unsigned char*)d_ws;
#if MK_PER_PHASE
    for (int p = 0; p < NPHASES; ++p) { a.ph_lo = p; a.ph_hi = p + 1; hipLaunchKernelGGL(fwd, dim3(grid), dim3(NTHREADS), LDS_BYTES, stream, a); }
#else
    a.ph_lo = 0; a.ph_hi = NPHASES; hipLaunchKernelGGL(fwd, dim3(grid), dim3(NTHREADS), LDS_BYTES, stream, a);
#endif
}
```

```cpp
#include <hip/hip_runtime.h>
#include <cstdio>
#include <cstdint>
#ifdef EPI_NT
#define PG8_ST(v, p) __builtin_nontemporal_store((v), (p))
#else
#define PG8_ST(v, p) (*(p) = (v))
#endif
namespace pg8 {
#define PG8_LAS __attribute__((address_space(3)))
typedef unsigned short bf16_t;
typedef short bf16x8 __attribute__((ext_vector_type(8)));
typedef float f32x4 __attribute__((ext_vector_type(4)));
typedef unsigned u32x4 __attribute__((ext_vector_type(4)));
constexpr int BM = 256, BK = 64, HALF = 128, HTB = HALF * BK * 2  , STAGE_BYTES = 8 * HTB, NXCD = 8, WGM = 8;

__host__ __device__ __forceinline__ int lds_byte(int r, int c) { const int st = (r >> 4) * 2 + (c >> 5), rr = r & 15, cc = c & 31, ob = rr * 64 + cc * 2; return st * 1024 + (ob ^ (((ob >> 9) & 1) << 5)); }
__host__ __device__ __forceinline__ void stage_rc(int b, int& R, int& C) { const int st = b / 1024, sb = b % 1024, swz = sb ^ (((sb >> 9) & 1) << 5); R = (st >> 1) * 16 + swz / 64; C = (st & 1) * 32 + (swz % 64) / 2; }
__host__ __device__ __forceinline__ int perm32(int rho) { const int n = rho >> 4, i = rho & 15; return 8 * (i >> 2) + 4 * n + (i & 3); }

struct Unit { int pm, pn; };
struct Gemm { const bf16_t* A; const bf16_t* Bt; int M, N, K; };

struct StaticOrder {
    int nM, nN, nwg, G, c;
    __host__ __device__ void init(int M, int N, int G_, int c_) { nM = M / BM; nN = N / BM; nwg = nM * nN; G = G_; c = c_; }
    __host__ __device__ bool next(int i, Unit& u) const {
        const long L = (long)i * G + c; if (L >= nwg) return false;
        int wgid = (int)L; { const int q = nwg / NXCD, r = nwg % NXCD, xcd = wgid % NXCD, off = wgid / NXCD; wgid = (xcd < r ? xcd * (q + 1) : r * (q + 1) + (xcd - r) * q) + off; }
        const int nig = WGM * nN, gid = wgid / nig, fm = gid * WGM, gsz = (nM - fm) < WGM ? (nM - fm) : WGM;
        u.pm = fm + ((wgid % nig) % gsz); u.pn = (wgid % nig) / gsz; return true;
    }
    __device__ __forceinline__ void a_ready(const Unit&) const {}
    __device__ __forceinline__ void done(const Unit&) const {}
};

__device__ __forceinline__ unsigned cvt_pk_bf16(float lo, float hi) { unsigned r; asm volatile("v_cvt_pk_bf16_f32 %0, %1, %2" : "=v"(r) : "v"(lo), "v"(hi)); return r; }
typedef float f32x2 __attribute__((ext_vector_type(2)));
__device__ __forceinline__ f32x2 gelu_pk(f32x2 v) {
    const f32x2 av = __builtin_elementwise_abs(v), d = av * 0.2316418882f + 1.0f;
    f32x2 t; t.x = __builtin_amdgcn_rcpf(d.x); t.y = __builtin_amdgcn_rcpf(d.y);
    f32x2 q = t * 0.5307027145f + (-0.7265760135f); q = q * t + 0.7107068705f; q = q * t + (-0.142248368f); q = q * t + 0.127414796f; q = q * t;
    const f32x2 s = (v * v) * (-0.72134752044f);
    f32x2 e; e.x = __builtin_amdgcn_exp2f(s.x); e.y = __builtin_amdgcn_exp2f(s.y);
    const f32x2 m = v * (q * e), r = v - m;
    f32x2 o; o.x = v.x < 0.f ? m.x : r.x; o.y = v.y < 0.f ? m.y : r.y; return o;
}

template <int ACT  > struct EpiBf16 {
    static constexpr bool PERM = true, AFTER_DRAIN = false; static_assert(ACT == 0 || ACT == 1, "EpiBf16: ACT is 0 (none) or 1 (gelu_pk)");
    bf16_t* O; int ldc; const float* bias; int split_cols; size_t split_stride; float scale0;
    __device__ __forceinline__ void operator()(const f32x4 (&acc)[2][2][4][2], const Unit& u, int wr, int wc, int fr, int fq) const {
        const int row0 = u.pm * BM + wr * 64 + fr; int colt = u.pn * BM; bf16_t* base = O;
        float sc = 1.f; if (split_cols) { const int t = colt / split_cols; base += (size_t)t * split_stride; colt -= t * split_cols; if (t == 0) sc = scale0; }
        const int col0 = colt + wc * 32 + 8 * fq, bcol0 = u.pn * BM + wc * 32 + 8 * fq;
        f32x4 bv[2][2];
#pragma unroll
        for (int bj = 0; bj < 2; ++bj)
#pragma unroll
            for (int n = 0; n < 2; ++n) bv[bj][n] = bias ? *(const f32x4*)(bias + bcol0 + bj * HALF + 4 * n) : (f32x4){0.f, 0.f, 0.f, 0.f};
#pragma unroll
        for (int ai = 0; ai < 2; ++ai)
#pragma unroll
            for (int m = 0; m < 4; ++m) { bf16_t* rowp = base + (size_t)(row0 + ai * HALF + m * 16) * ldc + col0;
#pragma unroll
                for (int bj = 0; bj < 2; ++bj) { f32x4 v0 = acc[ai][bj][m][0] + bv[bj][0], v1 = acc[ai][bj][m][1] + bv[bj][1];
                    if (ACT == 1) { f32x2 a = gelu_pk((f32x2){v0[0], v0[1]}), b = gelu_pk((f32x2){v0[2], v0[3]}), c = gelu_pk((f32x2){v1[0], v1[1]}), d = gelu_pk((f32x2){v1[2], v1[3]});
                        v0 = (f32x4){a.x, a.y, b.x, b.y}; v1 = (f32x4){c.x, c.y, d.x, d.y}; }
                    v0 = v0 * sc; v1 = v1 * sc; u32x4 w; w.x = cvt_pk_bf16(v0[0], v0[1]); w.y = cvt_pk_bf16(v0[2], v0[3]); w.z = cvt_pk_bf16(v1[0], v1[1]); w.w = cvt_pk_bf16(v1[2], v1[3]);
                    PG8_ST(w, (u32x4*)(rowp + bj * HALF)); } }
    }
};

template <class Epi, class Sched, bool ALIGN_EPI = false, bool SP2 = false>
__device__ __forceinline__ void gemm_phase(PG8_LAS unsigned char* lds, const Gemm g, const Sched& S, const Epi& E) {
    int tid_l = threadIdx.x; asm volatile("" : "+v"(tid_l));
    const int tid = tid_l, wid = __builtin_amdgcn_readfirstlane(tid >> 6), lane = tid & 63, wr = wid >> 2, wc = wid & 3, fr = lane & 15, fq = lane >> 4;
    const int K = g.K, nt = K / BK;
    unsigned voffA[2], voffB[2];
#pragma unroll
    for (int i = 0; i < 2; ++i) { int R, C; stage_rc(tid * 16 + i * 8192, R, C); const int Rb = Epi::PERM ? ((R & ~31) + perm32(R & 31)) : R;
        voffA[i] = (unsigned)(R * K + C) * 2u; voffB[i] = (unsigned)(Rb * K + C) * 2u; }
    const size_t kstep = (size_t)(BK * 2);
    const size_t hstep = (size_t)HALF * K * 2;
    const size_t tstep = 2 * hstep;
    const unsigned ldsw = (unsigned)wid * 1024u;
    const int aoff = lds_byte(wr * 64 + fr, fq * 8), boff = lds_byte(wc * 32 + fr, fq * 8);
#define PG8_SA(b, h) (((b) * 2 + (h)) * HTB)
#define PG8_SB(b, h) ((4 + (b) * 2 + (h)) * HTB)
#define PG8_STAGE(bufoff, gbase, voff) do { _Pragma("unroll") for (int _i = 0; _i < 2; ++_i) \
        __builtin_amdgcn_global_load_lds((const unsigned*)((const char*)(gbase) + (voff)[_i]), (PG8_LAS unsigned*)(lds + (bufoff) + ldsw + _i * 8192), 16, 0, 0); } while (0)
#define PG8_LDA(dst, b, h) do { _Pragma("unroll") for (int m = 0; m < 4; ++m) _Pragma("unroll") for (int k = 0; k < 2; ++k) dst[m][k] = *(const PG8_LAS bf16x8*)(lds + PG8_SA(b, h) + aoff + m * 2048 + k * 1024); } while (0)
#define PG8_LDB(dst, b, h) do { _Pragma("unroll") for (int n = 0; n < 2; ++n) _Pragma("unroll") for (int k = 0; k < 2; ++k) dst[n][k] = *(const PG8_LAS bf16x8*)(lds + PG8_SB(b, h) + boff + n * 2048 + k * 1024); } while (0)
#define PG8_MMA(ai, bj, At, Bt) do { __builtin_amdgcn_s_setprio(1); _Pragma("unroll") for (int m = 0; m < 4; ++m) _Pragma("unroll") for (int n = 0; n < 2; ++n) _Pragma("unroll") for (int k = 0; k < 2; ++k) \
        acc[ai][bj][m][n] = __builtin_amdgcn_mfma_f32_16x16x32_bf16(Bt[n][k], At[m][k], acc[ai][bj][m][n], 0, 0, 0); __builtin_amdgcn_s_setprio(0); } while (0)
#define PG8_WAIT_V(n) asm volatile("s_waitcnt vmcnt(" #n ")" ::: "memory")
#define PG8_WAIT_L(n) asm volatile("s_waitcnt lgkmcnt(" #n ")" ::: "memory")
#define PG8_BAR __builtin_amdgcn_s_barrier()
#define PG8_SCHED __builtin_amdgcn_sched_barrier(0)
    Unit cur, nxt; int ui = 0;
    if (!S.next(0, cur)) return;
    f32x4 acc[2][2][4][2];
#pragma unroll
    for (int a = 0; a < 2; ++a)
#pragma unroll
        for (int b = 0; b < 2; ++b)
#pragma unroll
            for (int m = 0; m < 4; ++m)
#pragma unroll
                for (int n = 0; n < 2; ++n) acc[a][b][m][n] = (f32x4){0.f, 0.f, 0.f, 0.f};
    bf16x8 At[4][2], B0[2][2], B1[2][2];
    const char* cA = (const char*)g.A + (size_t)cur.pm * tstep; const char* cB = (const char*)g.Bt + (size_t)cur.pn * tstep;
    S.a_ready(cur);
    if constexpr (SP2) {
        PG8_STAGE(PG8_SB(0, 0), cB, voffB); PG8_STAGE(PG8_SB(0, 1), cB + hstep, voffB); PG8_STAGE(PG8_SA(0, 0), cA, voffA); PG8_STAGE(PG8_SA(0, 1), cA + hstep, voffA);
        if (wr == 1) PG8_BAR;
        PG8_WAIT_V(2); PG8_BAR;
        PG8_STAGE(PG8_SB(1, 0), cB + kstep, voffB); PG8_STAGE(PG8_SA(1, 0), cA + kstep, voffA); PG8_STAGE(PG8_SB(1, 1), cB + hstep + kstep, voffB);
        PG8_WAIT_V(6); PG8_BAR;
    } else {
        PG8_STAGE(PG8_SB(0, 0), cB, voffB); PG8_STAGE(PG8_SA(0, 0), cA, voffA); PG8_STAGE(PG8_SB(0, 1), cB + hstep, voffB); PG8_STAGE(PG8_SA(0, 1), cA + hstep, voffA);
        if (wr == 1) PG8_BAR;
        PG8_WAIT_V(4); PG8_BAR;
        PG8_STAGE(PG8_SB(1, 0), cB + kstep, voffB); PG8_STAGE(PG8_SA(1, 0), cA + kstep, voffA); PG8_STAGE(PG8_SB(1, 1), cB + hstep + kstep, voffB);
        PG8_WAIT_V(6); PG8_BAR;
    }
    for (;;) {
        const bool has_next = S.next(ui + 1, nxt);
        const char* nA = has_next ? (const char*)g.A + (size_t)nxt.pm * tstep : cA; const char* nB = has_next ? (const char*)g.Bt + (size_t)nxt.pn * tstep : cB;
        for (int t = 0; t < nt; t += 2) {
            const bool last = (t == nt - 2);
            const char* a1 = cA + (size_t)(t + 1) * kstep;
            const char* a2 = last ? nA : cA + (size_t)(t + 2) * kstep; const char* b2 = last ? nB : cB + (size_t)(t + 2) * kstep;
            const char* a3 = a2 + kstep; const char* b3 = b2 + kstep;
            if (last && has_next) S.a_ready(nxt);
            if constexpr (SP2) {
            PG8_LDB(B0, 0, 0); PG8_LDB(B1, 0, 1); PG8_SCHED; PG8_LDA(At, 0, 0); PG8_STAGE(PG8_SA(1, 1), a1 + hstep, voffA);
            PG8_WAIT_V(8); PG8_WAIT_L(0); PG8_BAR; PG8_MMA(0, 0, At, B0); PG8_MMA(0, 1, At, B1); PG8_BAR; PG8_SCHED;
            PG8_LDA(At, 0, 1); PG8_STAGE(PG8_SB(0, 0), b2, voffB); PG8_STAGE(PG8_SB(0, 1), b2 + hstep, voffB); PG8_STAGE(PG8_SA(0, 0), a2, voffA);
            PG8_WAIT_V(8); PG8_WAIT_L(0); PG8_BAR; PG8_MMA(1, 0, At, B0); PG8_MMA(1, 1, At, B1); PG8_BAR; PG8_SCHED;
            PG8_LDB(B0, 1, 0); PG8_LDB(B1, 1, 1); PG8_SCHED; PG8_LDA(At, 1, 0); PG8_STAGE(PG8_SA(0, 1), a2 + hstep, voffA);
            PG8_WAIT_V(8); PG8_WAIT_L(0); PG8_BAR; PG8_MMA(0, 0, At, B0); PG8_MMA(0, 1, At, B1); PG8_BAR; PG8_SCHED;
            PG8_LDA(At, 1, 1); PG8_STAGE(PG8_SB(1, 0), b3, voffB); PG8_STAGE(PG8_SB(1, 1), b3 + hstep, voffB); PG8_STAGE(PG8_SA(1, 0), a3, voffA);
            PG8_WAIT_V(8); PG8_WAIT_L(0); PG8_BAR; PG8_MMA(1, 0, At, B0); PG8_MMA(1, 1, At, B1); PG8_BAR; PG8_SCHED;
            } else {
            PG8_LDB(B0, 0, 0); PG8_SCHED; PG8_LDA(At, 0, 0); PG8_STAGE(PG8_SA(1, 1), a1 + hstep, voffA);
            PG8_WAIT_L(8); PG8_BAR; PG8_WAIT_L(0); PG8_MMA(0, 0, At, B0); PG8_BAR; PG8_SCHED;
            PG8_LDB(B1, 0, 1); PG8_STAGE(PG8_SB(0, 0), b2, voffB);
            PG8_BAR; PG8_WAIT_L(0); PG8_MMA(0, 1, At, B1); PG8_BAR;
            PG8_LDA(At, 0, 1); PG8_STAGE(PG8_SA(0, 0), a2, voffA);
            PG8_BAR; PG8_WAIT_L(0); PG8_MMA(1, 0, At, B0); PG8_BAR; PG8_SCHED;
            PG8_STAGE(PG8_SB(0, 1), b2 + hstep, voffB);
            PG8_WAIT_V(6); PG8_BAR; PG8_MMA(1, 1, At, B1); PG8_BAR;
            PG8_LDB(B0, 1, 0); PG8_SCHED; PG8_LDA(At, 1, 0); PG8_STAGE(PG8_SA(0, 1), a2 + hstep, voffA);
            PG8_WAIT_L(8); PG8_BAR; PG8_WAIT_L(0); PG8_MMA(0, 0, At, B0); PG8_BAR; PG8_SCHED;
            PG8_LDB(B1, 1, 1); PG8_STAGE(PG8_SB(1, 0), b3, voffB);
            PG8_BAR; PG8_WAIT_L(0); PG8_MMA(0, 1, At, B1); PG8_BAR;
            PG8_LDA(At, 1, 1); PG8_STAGE(PG8_SA(1, 0), a3, voffA);
            PG8_BAR; PG8_WAIT_L(0); PG8_MMA(1, 0, At, B0); PG8_BAR; PG8_SCHED;
            PG8_STAGE(PG8_SB(1, 1), b3 + hstep, voffB);
            PG8_WAIT_V(6); PG8_BAR; PG8_MMA(1, 1, At, B1); PG8_BAR;
            }
        }
        if constexpr (ALIGN_EPI) { if (wr == 0) PG8_BAR; }
        if constexpr (!Epi::AFTER_DRAIN) { E(acc, cur, wr, wc, fr, fq); S.done(cur); }
        if (!has_next) break;
#pragma unroll
        for (int a = 0; a < 2; ++a)
#pragma unroll
            for (int b = 0; b < 2; ++b)
#pragma unroll
                for (int m = 0; m < 4; ++m)
#pragma unroll
                    for (int n = 0; n < 2; ++n) acc[a][b][m][n] = (f32x4){0.f, 0.f, 0.f, 0.f};
        cur = nxt; cA = nA; cB = nB; ++ui;
        if constexpr (ALIGN_EPI) { if (wr == 1) PG8_BAR; }
    }
    PG8_WAIT_V(0);
    if constexpr (!ALIGN_EPI) { if (wr == 0) PG8_BAR; }
    PG8_BAR;
    if constexpr (Epi::AFTER_DRAIN) { E.fused(acc, cur, wr, wc, fr, fq, lds, wid, lane); S.done(cur); }
#undef PG8_SA
#undef PG8_SB
#undef PG8_STAGE
#undef PG8_LDA
#undef PG8_LDB
#undef PG8_MMA
#undef PG8_WAIT_V
#undef PG8_WAIT_L
#undef PG8_BAR
#undef PG8_SCHED
}
}
namespace pg8 {
__device__ __forceinline__ float silu_f(float x) { return x * __builtin_amdgcn_rcpf(1.0f + __builtin_amdgcn_exp2f(-1.44269504f * x)); }
struct EpiSwiGLU {
    static constexpr bool PERM = true, AFTER_DRAIN = false;
    bf16_t* O; int ldc;
    __device__ __forceinline__ void operator()(const f32x4 (&acc)[2][2][4][2], const Unit& u, int wr, int wc, int fr, int fq) const {
        const int row0 = u.pm * BM + wr * 64 + fr; const int col0 = u.pn * HALF + wc * 32 + 8 * fq;
#pragma unroll
        for (int ai = 0; ai < 2; ++ai)
#pragma unroll
            for (int m = 0; m < 4; ++m) { bf16_t* rowp = O + (size_t)(row0 + ai * HALF + m * 16) * ldc + col0;
                const f32x4 g0 = acc[ai][0][m][0], g1 = acc[ai][0][m][1], u0 = acc[ai][1][m][0], u1 = acc[ai][1][m][1];
                u32x4 w; w.x = cvt_pk_bf16(silu_f(g0[0]) * u0[0], silu_f(g0[1]) * u0[1]); w.y = cvt_pk_bf16(silu_f(g0[2]) * u0[2], silu_f(g0[3]) * u0[3]);
                w.z = cvt_pk_bf16(silu_f(g1[0]) * u1[0], silu_f(g1[1]) * u1[1]); w.w = cvt_pk_bf16(silu_f(g1[2]) * u1[2], silu_f(g1[3]) * u1[3]);
                PG8_ST(w, (u32x4*)rowp); }
    }
};
}
#ifdef ROPE_NT
#define PG8_ST_ROPE(v, p) __builtin_nontemporal_store((v), (p))
#else
#define PG8_ST_ROPE(v, p) (*(p) = (v))
#endif
namespace pg8 {
struct EpiRope {
    static constexpr bool PERM = true, AFTER_DRAIN = false;
    bf16_t* O; int ldc; const float* cosT; const float* sinT;
    __device__ __forceinline__ void operator()(const f32x4 (&acc)[2][2][4][2], const Unit& u, int wr, int wc, int fr, int fq) const {
        const int row0 = u.pm * BM + wr * 64 + fr; const int colt = u.pn * BM; const int col0 = colt + wc * 32 + 8 * fq;
        const bool rot = (((colt >> 11) % 3) < 2) && (wc == 0);
        const int dd0 = 8 * (fq & 1); const float sgn = (fq < 2) ? -1.0f : 1.0f;
#pragma unroll
        for (int ai = 0; ai < 2; ++ai)
#pragma unroll
            for (int m = 0; m < 4; ++m) { const int row = row0 + ai * HALF + m * 16; bf16_t* rowp = O + (size_t)row * ldc + col0;
                f32x4 c0 = (f32x4){1.f, 1.f, 1.f, 1.f}, c1 = c0, s0 = (f32x4){0.f, 0.f, 0.f, 0.f}, s1 = s0;
                if (rot) { const int pos = row & 4095; const f32x4* cp = (const f32x4*)(cosT + pos * 16 + dd0); const f32x4* sp = (const f32x4*)(sinT + pos * 16 + dd0);
                    c0 = cp[0]; c1 = cp[1]; s0 = sp[0] * sgn; s1 = sp[1] * sgn; }
#pragma unroll
                for (int bj = 0; bj < 2; ++bj) { f32x4 v0 = acc[ai][bj][m][0], v1 = acc[ai][bj][m][1];
                    if (rot) { f32x4 p0, p1;
#pragma unroll
                        for (int i = 0; i < 4; ++i) { p0[i] = __shfl_xor(v0[i], 32); p1[i] = __shfl_xor(v1[i], 32); }
                        v0 = v0 * c0 + p0 * s0; v1 = v1 * c1 + p1 * s1; }
                    u32x4 w; w.x = cvt_pk_bf16(v0[0], v0[1]); w.y = cvt_pk_bf16(v0[2], v0[3]); w.z = cvt_pk_bf16(v1[0], v1[1]); w.w = cvt_pk_bf16(v1[2], v1[3]);
                    PG8_ST_ROPE(w, (u32x4*)(rowp + bj * HALF)); } }
    }
};
}
#define GAS __attribute__((address_space(1)))
#define LAS __attribute__((address_space(3)))
typedef unsigned short bf16;
typedef unsigned v4u __attribute__((ext_vector_type(4)));
typedef float f32x4 __attribute__((ext_vector_type(4)));
typedef short bf16x8 __attribute__((ext_vector_type(8)));
typedef GAS unsigned gu32;
typedef GAS unsigned long long gu64;
#define RLX_AGENT __ATOMIC_RELAXED, __HIP_MEMORY_SCOPE_AGENT
#define LDS_WAIT() asm volatile("s_waitcnt lgkmcnt(0)" ::: "memory")
#define VM_WAIT() asm volatile("s_waitcnt vmcnt(0)" ::: "memory")
__device__ __forceinline__ unsigned long long rt() { return __builtin_amdgcn_s_memrealtime(); }
__device__ __forceinline__ unsigned f2bf(float f) { unsigned u = __builtin_bit_cast(unsigned, f); return (u + 0x7fffu + ((u >> 16) & 1u)) >> 16; }
__device__ __forceinline__ unsigned pk2(float lo, float hi) { return f2bf(lo) | (f2bf(hi) << 16); }

#define XB_TMO      128
#define XB_XCNT(j)  (256  + 64 * (j))
#define XB_XSUB(j)  (1280 + 64 * (j))
#define XB_XGEN(j)  (2304 + 64 * (j))
#define XB_TOP      3328
#define XB_TOPGEN   3392
#define XCD_BAR_WORDS 3456
#define XB_SPIN_CAP (1u << 18)

__device__ __forceinline__ unsigned xb_ld(unsigned* p)              { return __hip_atomic_load(p, __ATOMIC_RELAXED, __HIP_MEMORY_SCOPE_AGENT); }
__device__ __forceinline__ unsigned xb_add(unsigned* p, unsigned v) { return __hip_atomic_fetch_add(p, v, __ATOMIC_RELAXED, __HIP_MEMORY_SCOPE_AGENT); }
__device__ __forceinline__ unsigned xb_xcc_id() { return (unsigned)__builtin_amdgcn_s_getreg((3 << 11) | 20) & 0xFu; }
#define XB_SPIN(cond, bar) do { unsigned _sp = 0; while (cond) { __builtin_amdgcn_s_sleep(1); \
    if ((++_sp & 255u) == 0u) { if (xb_ld(&(bar)[XB_TMO])) break; if (_sp > XB_SPIN_CAP) { atomicAdd(&(bar)[XB_TMO], 1u); break; } } } } while (0)

struct XcdBarrier {
    unsigned* bar; unsigned x;
    volatile LAS unsigned* st;
};

__device__ __forceinline__ XcdBarrier xcd_barrier_post(unsigned* bar, volatile LAS unsigned* st) {
    XcdBarrier b; b.bar = bar; b.x = xb_xcc_id(); b.st = st;
    if (threadIdx.x == 0) (void)xb_add(&bar[XB_XCNT(b.x)], 1u);
    return b;
}
__device__ __forceinline__ void xcd_barrier_complete(unsigned* bar, unsigned x, unsigned& nloc, unsigned& nx) {
    const unsigned G = gridDim.x * gridDim.y * gridDim.z;
    unsigned sum, cnt, mine, sp = 0u;
    for (;;) {
        sum = 0u; cnt = 0u; mine = 0u;
#pragma unroll
        for (unsigned j = 0; j < 16; ++j) { const unsigned c = xb_ld(&bar[XB_XCNT(j)]); sum += c; cnt += (c > 0u) ? 1u : 0u; mine = (j == x) ? c : mine; }
        if (sum == G) break;
        __builtin_amdgcn_s_sleep(1);
        if ((++sp & 255u) == 0u) { if (xb_ld(&bar[XB_TMO])) break; if (sp > XB_SPIN_CAP) { atomicAdd(&bar[XB_TMO], 1u); break; } }
    }
    nloc = mine > 0u ? mine : 1u; nx = cnt > 0u ? cnt : 1u;
}

__device__ __forceinline__ void xcd_barrier(const XcdBarrier& b) {
    asm volatile("s_waitcnt vmcnt(0)" ::: "memory");
    __syncthreads();
    if (threadIdx.x == 0) {
        unsigned* bar = b.bar;
        __builtin_amdgcn_s_waitcnt(0);
        unsigned nloc = b.st[0], nx = b.st[1];
        if (nloc == 0u) { xcd_barrier_complete(bar, b.x, nloc, nx); b.st[0] = nloc; b.st[1] = nx; }
        const unsigned old = xb_add(&bar[XB_XSUB(b.x)], 1u);
        const unsigned gen = old / nloc;
        if (old + 1u == (gen + 1u) * nloc) {
            __builtin_amdgcn_fence(__ATOMIC_RELEASE, "agent");
            asm volatile("s_waitcnt vmcnt(0)" ::: "memory");
            const unsigned og = xb_add(&bar[XB_TOP], 1u);
            const unsigned tg = og / nx;
            if (og + 1u == (tg + 1u) * nx) xb_add(&bar[XB_TOPGEN], 1u);
            else XB_SPIN(xb_ld(&bar[XB_TOPGEN]) == tg, bar);
            __builtin_amdgcn_fence(__ATOMIC_ACQUIRE, "agent");
            xb_add(&bar[XB_XGEN(b.x)], 1u);
            asm volatile("s_waitcnt vmcnt(0)" ::: "memory");
        } else {
            XB_SPIN(xb_ld(&bar[XB_XGEN(b.x)]) == gen, bar);
            __builtin_amdgcn_fence(__ATOMIC_ACQUIRE, "agent");
            asm volatile("s_waitcnt vmcnt(0)" ::: "memory");
        }
    }
    __syncthreads();
}

constexpr int NWAVES = 8, NTHREADS = 512;
constexpr int BATCH = 2, SEQ = 4096, D = 2048, M = BATCH * SEQ, DEPTH = 4, NH = 16, HD = 128;
constexpr int HGRN_N = 5 * D, ATTN_N = 9 * D, DFF = 5632, FFN_N = 2 * DFF;
constexpr float EPS = 1e-6f;
constexpr int NPHASES = 1 + 9 * DEPTH;
#ifndef REP_PRO
#define REP_PRO 1
#endif
#ifndef REP_INH
#define REP_INH 1
#endif
#ifndef REP_INA_COLD
#define REP_INA_COLD 0
#endif
#ifndef REP_INA
#define REP_INA 1
#endif
#ifndef REP_WO
#define REP_WO 1
#endif
#ifndef REP_F1
#define REP_F1 1
#endif
#ifndef REP_F2
#define REP_F2 1
#endif
#ifndef REP_GATES
#define REP_GATES 1
#endif
#ifndef REP_SCAN
#define REP_SCAN 1
#endif
#ifndef REP_ATTN
#define REP_ATTN 1
#endif
#ifndef REP_FIN
#define REP_FIN 1
#endif
#ifndef REP_NORM
#define REP_NORM 1
#endif

constexpr size_t MiB = 1u << 20;
constexpr size_t WS_CTL = 0, CTL_ZERO_BYTES = 1 * MiB;
constexpr size_t WS_TAB = 1 * MiB;
constexpr size_t TAB_COS = 0, TAB_SIN = 262144, TAB_LB = 524288;
constexpr size_t WS_WHG = 2 * MiB;
constexpr size_t WS_WAT = 82 * MiB;
constexpr size_t WS_WO = 226 * MiB;
constexpr size_t WS_WF1 = 258 * MiB;
constexpr size_t WS_WF2 = 434 * MiB;
constexpr size_t WS_H = 522 * MiB;
constexpr size_t WS_PROJ = 554 * MiB;
constexpr size_t WS_MIX = 842 * MiB;
constexpr size_t WS_O = 942 * MiB;
constexpr size_t WS_G = 974 * MiB;
constexpr size_t WS_KH = 1006 * MiB;
constexpr size_t WS_END = 1076 * MiB;
constexpr int CW_BAR = 4096;

constexpr int RING_BYTES = 147456;
constexpr int LDSCTL_OFF = RING_BYTES, MISC_OFF = LDSCTL_OFF + 320;
constexpr int LDS_BYTES = 163840;

__device__ __forceinline__ float bf2f(unsigned short b) { return __builtin_bit_cast(float, (unsigned)b << 16); }
__device__ __forceinline__ float bflo(unsigned w) { return __builtin_bit_cast(float, w << 16); }
__device__ __forceinline__ float bfhi(unsigned w) { return __builtin_bit_cast(float, w & 0xffff0000u); }
__device__ __forceinline__ float wave_sum(float v) {
#pragma unroll
    for (int o = 1; o < 64; o <<= 1) v += __shfl_xor(v, o);
    return v;
}
__device__ __forceinline__ float sigmoid_f(float x) { return __builtin_amdgcn_rcpf(1.0f + __builtin_amdgcn_exp2f(-1.44269504f * x)); }

__device__ __forceinline__ void transpose_item(const float* W, int K, int N, bf16* WT, int k0, int n0, int drow0, LAS float* scr, int lane) {
    float ld[32];
#pragma unroll
    for (int i = 0; i < 32; ++i) { const int kk = 2 * i + (lane >> 5); ld[i] = W[(size_t)(k0 + kk) * N + n0 + (lane & 31)]; }
#pragma unroll
    for (int i = 0; i < 32; ++i) { const int kk = 2 * i + (lane >> 5); scr[kk * 33 + (lane & 31)] = ld[i]; }
    LDS_WAIT(); asm volatile("" ::: "memory");
    const int c = lane & 7;
#pragma unroll
    for (int j = 0; j < 4; ++j) { const int n = (lane >> 3) + 8 * j; const LAS float* s = scr + (8 * c) * 33 + n;
        v4u o; o.x = pk2(s[0 * 33], s[1 * 33]); o.y = pk2(s[2 * 33], s[3 * 33]); o.z = pk2(s[4 * 33], s[5 * 33]); o.w = pk2(s[6 * 33], s[7 * 33]);
        *(GAS v4u*)(WT + (size_t)(drow0 + n) * K + k0 + 8 * c) = o; }
    LDS_WAIT(); asm volatile("" ::: "memory");
}
__device__ __forceinline__ void transpose_matrix(const float* W, int K, int N, bf16* WT, int mode, LAS float* scr, int gw, int NGW, int lane) {
    const int nblk = N / 32, nitems = (K / 64) * nblk;
    for (int it = gw; it < nitems; it += NGW) {
        const int kb = it / nblk, nb = it - kb * nblk, n0 = 32 * nb;
        int drow0 = n0;
        if (mode == 1) { const int up = n0 >= DFF, nn = up ? n0 - DFF : n0; drow0 = (nn >> 7) * 256 + (up ? 128 : 0) + (nn & 127); }
        transpose_item(W, K, N, WT, 64 * kb, n0, drow0, scr, lane);
    }
}

template <bool RES, bool NORM2, bool XI16, bool XO16>
__device__ __forceinline__ void norm_rows(const bf16* gin, const void* x_in, void* x_out, const float* w1, const float* w2, bf16* hout, int gw, int NGW, int lane) {
    for (int m = gw; m < M; m += NGW) {
        float xv[4][8];
#pragma unroll
        for (int j = 0; j < 4; ++j) {
            if (XI16) { const v4u g = *(const GAS v4u*)((const bf16*)x_in + (size_t)m * D + 8 * (64 * j + lane));
                xv[j][0] = bflo(g.x); xv[j][1] = bfhi(g.x); xv[j][2] = bflo(g.y); xv[j][3] = bfhi(g.y); xv[j][4] = bflo(g.z); xv[j][5] = bfhi(g.z); xv[j][6] = bflo(g.w); xv[j][7] = bfhi(g.w); }
            else { const GAS f32x4* xp = (const GAS f32x4*)((const float*)x_in + (size_t)m * D + 8 * (64 * j + lane));
                const f32x4 a = xp[0], b = xp[1]; xv[j][0] = a.x; xv[j][1] = a.y; xv[j][2] = a.z; xv[j][3] = a.w; xv[j][4] = b.x; xv[j][5] = b.y; xv[j][6] = b.z; xv[j][7] = b.w; } }
        if (RES) {
            float gv[4][8]; float ss = 0.f;
#pragma unroll
            for (int j = 0; j < 4; ++j) { const v4u g = *(const GAS v4u*)(gin + (size_t)m * D + 8 * (64 * j + lane));
                gv[j][0] = bflo(g.x); gv[j][1] = bfhi(g.x); gv[j][2] = bflo(g.y); gv[j][3] = bfhi(g.y); gv[j][4] = bflo(g.z); gv[j][5] = bfhi(g.z); gv[j][6] = bflo(g.w); gv[j][7] = bfhi(g.w);
#pragma unroll
                for (int i = 0; i < 8; ++i) ss += gv[j][i] * gv[j][i]; }
            const float r1 = 1.0f / sqrtf(wave_sum(ss) * (1.0f / D) + EPS);
#pragma unroll
            for (int j = 0; j < 4; ++j) { const GAS f32x4* wp = (const GAS f32x4*)(w1 + 8 * (64 * j + lane)); const f32x4 a = wp[0], b = wp[1];
                const float wv[8] = {a.x, a.y, a.z, a.w, b.x, b.y, b.z, b.w};
#pragma unroll
                for (int i = 0; i < 8; ++i) xv[j][i] += gv[j][i] * r1 * wv[i];
                if (XO16) { v4u o; o.x = pk2(xv[j][0], xv[j][1]); o.y = pk2(xv[j][2], xv[j][3]); o.z = pk2(xv[j][4], xv[j][5]); o.w = pk2(xv[j][6], xv[j][7]);
                    *(GAS v4u*)((bf16*)x_out + (size_t)m * D + 8 * (64 * j + lane)) = o; }
                else { GAS f32x4* op = (GAS f32x4*)((float*)x_out + (size_t)m * D + 8 * (64 * j + lane));
                    op[0] = (f32x4){xv[j][0], xv[j][1], xv[j][2], xv[j][3]}; op[1] = (f32x4){xv[j][4], xv[j][5], xv[j][6], xv[j][7]}; } }
        }
        if (NORM2) {
            float ss = 0.f;
#pragma unroll
            for (int j = 0; j < 4; ++j)
#pragma unroll
                for (int i = 0; i < 8; ++i) ss += xv[j][i] * xv[j][i];
            const float r2 = 1.0f / sqrtf(wave_sum(ss) * (1.0f / D) + EPS);
#pragma unroll
            for (int j = 0; j < 4; ++j) { const GAS f32x4* wp = (const GAS f32x4*)(w2 + 8 * (64 * j + lane)); const f32x4 a = wp[0], b = wp[1];
                v4u o; o.x = pk2(xv[j][0] * r2 * a.x, xv[j][1] * r2 * a.y); o.y = pk2(xv[j][2] * r2 * a.z, xv[j][3] * r2 * a.w);
                o.z = pk2(xv[j][4] * r2 * b.x, xv[j][5] * r2 * b.y); o.w = pk2(xv[j][6] * r2 * b.z, xv[j][7] * r2 * b.w);
                *(GAS v4u*)(hout + (size_t)m * D + 8 * (64 * j + lane)) = o; }
        }
    }
}

__device__ __forceinline__ void hgrn_finalize(const bf16* P, const bf16* OD, const float* gnorm, bf16* O, int gw, int NGW, int lane) {
    for (int m = gw; m < M; m += NGW) {
#pragma unroll
        for (int j = 0; j < 4; ++j) {
            const int e0 = 8 * (64 * j + lane);
            const v4u a = *(const GAS v4u*)(OD + (size_t)m * D + e0), b = *(const GAS v4u*)(OD + (size_t)M * D + (size_t)m * D + e0);
            const v4u g = *(const GAS v4u*)(P + (size_t)m * HGRN_N + 4 * D + e0);
            float s[8] = {bflo(a.x) + bflo(b.x), bfhi(a.x) + bfhi(b.x), bflo(a.y) + bflo(b.y), bfhi(a.y) + bfhi(b.y), bflo(a.z) + bflo(b.z), bfhi(a.z) + bfhi(b.z), bflo(a.w) + bflo(b.w), bfhi(a.w) + bfhi(b.w)};
            const float gv[8] = {bflo(g.x), bfhi(g.x), bflo(g.y), bfhi(g.y), bflo(g.z), bfhi(g.z), bflo(g.w), bfhi(g.w)};
            float ss = 0.f;
#pragma unroll
            for (int i = 0; i < 8; ++i) ss += s[i] * s[i];
            ss += __shfl_xor(ss, 1); ss += __shfl_xor(ss, 2); ss += __shfl_xor(ss, 4); ss += __shfl_xor(ss, 8);
            const float r = 1.0f / sqrtf(ss * (1.0f / HD) + EPS);
            const GAS f32x4* wp = (const GAS f32x4*)(gnorm + (e0 & 127)); const f32x4 wa = wp[0], wb = wp[1];
            const float wv[8] = {wa.x, wa.y, wa.z, wa.w, wb.x, wb.y, wb.z, wb.w};
            float o[8];
#pragma unroll
            for (int i = 0; i < 8; ++i) o[i] = s[i] * r * wv[i] * (gv[i] * sigmoid_f(gv[i]));
            v4u w; w.x = pk2(o[0], o[1]); w.y = pk2(o[2], o[3]); w.z = pk2(o[4], o[5]); w.w = pk2(o[6], o[7]);
            *(GAS v4u*)(O + (size_t)m * D + e0) = w;
        }
    }
}

__device__ __forceinline__ void attn_finalize(const bf16* OG, const float* LSE, bf16* O, int gw, int NGW, int lane) {
    for (int m = gw; m < M; m += NGW) {
#pragma unroll
        for (int j = 0; j < 4; ++j) {
            const int e0 = 8 * (64 * j + lane), hh = e0 >> 7;
            const float l0 = LSE[((size_t)0 * M + m) * NH + hh], l1 = LSE[((size_t)1 * M + m) * NH + hh], l2 = LSE[((size_t)2 * M + m) * NH + hh];
            const float mx = fmaxf(l0, fmaxf(l1, l2)); float w0 = __expf(l0 - mx), w1 = __expf(l1 - mx), w2 = __expf(l2 - mx);
            const float inv = 1.0f / (w0 + w1 + w2); w0 *= inv; w1 *= inv; w2 *= inv;
            const v4u a = *(const GAS v4u*)(OG + ((size_t)0 * M + m) * D + e0), b = *(const GAS v4u*)(OG + ((size_t)1 * M + m) * D + e0), c = *(const GAS v4u*)(OG + ((size_t)2 * M + m) * D + e0);
            v4u w;
            w.x = pk2(w0 * bflo(a.x) + w1 * bflo(b.x) + w2 * bflo(c.x), w0 * bfhi(a.x) + w1 * bfhi(b.x) + w2 * bfhi(c.x));
            w.y = pk2(w0 * bflo(a.y) + w1 * bflo(b.y) + w2 * bflo(c.y), w0 * bfhi(a.y) + w1 * bfhi(b.y) + w2 * bfhi(c.y));
            w.z = pk2(w0 * bflo(a.z) + w1 * bflo(b.z) + w2 * bflo(c.z), w0 * bfhi(a.z) + w1 * bfhi(b.z) + w2 * bfhi(c.z));
            w.w = pk2(w0 * bflo(a.w) + w1 * bflo(b.w) + w2 * bflo(c.w), w0 * bfhi(a.w) + w1 * bfhi(b.w) + w2 * bfhi(c.w));
            *(GAS v4u*)(O + (size_t)m * D + e0) = w;
        }
    }
}

typedef short s16x4 __attribute__((ext_vector_type(4)));
typedef short v4i16_t __attribute__((ext_vector_type(4)));
typedef unsigned v2u __attribute__((ext_vector_type(2)));
__device__ __forceinline__ void glds16(const void* gsrc, unsigned lds_dst) { unsigned keep;
    asm volatile("s_mov_b32 %0, m0\n\ts_mov_b32 m0, %2\n\ts_nop 0\n\tglobal_load_lds_dwordx4 %1, off\n\ts_mov_b32 m0, %0" : "=&s"(keep) : "v"(gsrc), "s"(lds_dst) : "memory"); }
__device__ __forceinline__ s16x4 tr_read(LAS const unsigned char* p) { return __builtin_bit_cast(s16x4, __builtin_amdgcn_ds_read_tr16_b64_v4i16((LAS v4i16_t*)p)); }
__device__ __forceinline__ bf16x8 cat44(s16x4 a, s16x4 b) { return (bf16x8){a[0], a[1], a[2], a[3], b[0], b[1], b[2], b[3]}; }
#ifdef PROBE_ADMA2
#define AT_VW "s_waitcnt vmcnt(22)"
#else
#define AT_VW "s_waitcnt vmcnt(13)"
#endif
__device__ __forceinline__ void glds16s_1(const void* sbase, unsigned voff, unsigned lds_dst) { unsigned keep;
    asm volatile("s_mov_b32 %0, m0\n\ts_mov_b32 m0, %3\n\ts_nop 0\n\tglobal_load_lds_dwordx4 %1, %2\n\ts_mov_b32 m0, %0" : "=&s"(keep) : "v"(voff), "s"(sbase), "s"(lds_dst) : "memory"); }
__device__ __forceinline__ void glds16s(const void* sbase, unsigned voff, unsigned lds_dst) { glds16s_1(sbase, voff, lds_dst);
#ifdef PROBE_ADMA2
    glds16s_1(sbase, voff, lds_dst);
#endif
}
__device__ __forceinline__ bf16x8 gload16s(const void* sbase, unsigned voff) { return *(const GAS bf16x8*)((const unsigned char*)sbase + voff); }
__device__ __forceinline__ void attn_core_mfma(LAS unsigned char* lds, const bf16* P, bf16* OG, float* LSE, int vcu, int G) {
    int tid_l = threadIdx.x; asm volatile("" : "+v"(tid_l));
    const int tid = tid_l, lane = tid & 63, w = __builtin_amdgcn_readfirstlane(tid >> 6), fr = lane & 15, q4 = lane >> 4;
    const float sc2 = 0.08838834764831845f * 1.44269504f;
    constexpr int RST = 288, K_OFF = 0, V_OFF = 73728;
    const bool ucons = (3072 % G) == 0; const int USTEP = ucons ? 1 : G, UID0 = ucons ? vcu * (3072 / G) : vcu;
    const int NUN = ucons ? 3072 / G : (vcu < 3072 ? (3072 - vcu + G - 1) / G : 0);
#define AT_SCHED __builtin_amdgcn_sched_barrier(0)
#define AT_DECODE(uid_) const int bi = (uid_) & 31, bhg = (uid_) >> 5, g = bhg % 3, bh = bhg / 3, hh = bh & 15, b = bh >> 4; \
        const int rsh = 2 * g, nbs = 5 - rsh, rho = bi >> nbs, blk = bi & ((1 << nbs) - 1), L = SEQ >> rsh, u0 = blk * 128; \
        const bf16* Qb = P + (size_t)b * SEQ * ATTN_N + ((g * 3 + 0) * NH + hh) * HD; const bf16* Kb = Qb + NH * HD; const bf16* Vb = Kb + NH * HD; \
        (void)L; (void)Qb; (void)Kb; (void)Vb; (void)u0; (void)rho;
    if (w >= 4) {
        const int lw = w - 4;
        int prow[18], pchb[18];
#pragma unroll
        for (int i = 0; i < 18; ++i) { const int sl = (lw + 4 * i) * 64 + lane; prow[i] = sl / 18; const int ch = sl - prow[i] * 18; pchb[i] = (ch < 16 ? ch : 0) * 16; }
#define AT_ROWOFF(i_) ({ int uk_ = u0 - 64 + prow[i_]; uk_ = uk_ < 0 ? 0 : (uk_ >= L ? L - 1 : uk_); (unsigned)(((uk_ << rsh) + rho) * (ATTN_N * 2) + pchb[i_]); })
#define AT_ISSUE(base_, off_) do { _Pragma("unroll") for (int i_ = 0; i_ < 18; ++i_) glds16s(base_, AT_ROWOFF(i_), (unsigned)(size_t)(lds + (off_) + (lw + 4 * i_) * 1024)); } while (0)
        int uid = UID0;
        if (uid < 3072) { AT_DECODE(uid) AT_ISSUE(Kb, K_OFF); AT_ISSUE(Vb, V_OFF); }
        for (int un = 0; un < NUN; ++un, uid += USTEP) {
            const int nuid = (un + 1 < NUN) ? uid + USTEP : 3072;
            asm volatile("s_waitcnt vmcnt(18)" ::: "memory");
            __builtin_amdgcn_s_barrier(); asm volatile("" ::: "memory");
            __builtin_amdgcn_s_barrier(); asm volatile("" ::: "memory");
            if (nuid < 3072) { AT_DECODE(nuid) AT_ISSUE(Kb, K_OFF); asm volatile("s_waitcnt vmcnt(18)" ::: "memory"); }
            else asm volatile("s_waitcnt vmcnt(0)" ::: "memory");
            __builtin_amdgcn_s_barrier(); asm volatile("" ::: "memory");
            __builtin_amdgcn_s_barrier(); asm volatile("" ::: "memory");
            if (nuid < 3072) { AT_DECODE(nuid) AT_ISSUE(Vb, V_OFF); }
        }
#undef AT_ROWOFF
#undef AT_ISSUE
    } else {
        const int cw = w, qp = (lane >> 2) & 3, p4 = lane & 3;
        const int bK = K_OFF + (32 * cw + fr) * RST + q4 * 16;
        const int bV = V_OFF + (32 * cw + 4 * q4 + qp) * RST + p4 * 8;
        bf16x8 qf[2][4];
        int uid = UID0;
        if (uid < 3072) { AT_DECODE(uid)
#pragma unroll
            for (int qi = 0; qi < 2; ++qi) { const unsigned qo = (unsigned)((((u0 + 32 * cw + 16 * qi + fr) << rsh) + rho) * (ATTN_N * 2) + 16 * q4);
#pragma unroll
                for (int ks = 0; ks < 4; ++ks) qf[qi][ks] = gload16s(Qb, qo + 64 * ks); } }
        for (int un = 0; un < NUN; ++un, uid += USTEP) {
            AT_DECODE(uid)
            const int nuid = (un + 1 < NUN) ? uid + USTEP : 3072;
            __builtin_amdgcn_s_barrier(); asm volatile("" ::: "memory");
            f32x4 S[2][9]; bf16x8 kf[2][2][4];
#pragma unroll
            for (int qi = 0; qi < 2; ++qi)
#pragma unroll
                for (int kt = 0; kt < 9; ++kt) S[qi][kt] = (f32x4){0.f, 0.f, 0.f, 0.f};
            AT_SCHED;
#pragma unroll
            for (int jj = 0; jj < 2; ++jj)
#pragma unroll
                for (int ks = 0; ks < 4; ++ks) kf[0][jj][ks] = *(const LAS bf16x8*)(lds + bK + 16 * jj * RST + 64 * ks);
            AT_SCHED;
#pragma unroll
            for (int gi = 0; gi < 5; ++gi) {
                if (gi < 4) {
#pragma unroll
                    for (int jj = 0; jj < 2; ++jj)
#pragma unroll
                        for (int ks = 0; ks < 4; ++ks) kf[(gi + 1) & 1][jj][ks] = *(const LAS bf16x8*)(lds + bK + 16 * (2 * (gi + 1) + jj) * RST + 64 * ks);
                    AT_SCHED; asm volatile("s_waitcnt lgkmcnt(8)" ::: "memory"); AT_SCHED; }
                else { AT_SCHED; asm volatile("s_waitcnt lgkmcnt(0)" ::: "memory"); AT_SCHED; }
#pragma unroll
                for (int jj = 0; jj < 2; ++jj) { const int j = 2 * gi + jj;
#pragma unroll
                    for (int ks = 0; ks < 4; ++ks) {
                        if (j <= 8) S[0][j] = __builtin_amdgcn_mfma_f32_16x16x32_bf16(kf[gi & 1][jj][ks], qf[0][ks], S[0][j], 0, 0, 0);
                        if (j >= 1) S[1][j - 1] = __builtin_amdgcn_mfma_f32_16x16x32_bf16(kf[gi & 1][jj][ks], qf[1][ks], S[1][j - 1], 0, 0, 0); } }
                AT_SCHED; }
            __builtin_amdgcn_s_barrier(); asm volatile("" ::: "memory");
            bf16x8 qn[2][4];
            if (nuid < 3072) {
                const int bi_n = nuid & 31, bhg_n = nuid >> 5, g_n = bhg_n % 3, bh_n = bhg_n / 3, hh_n = bh_n & 15, b_n = bh_n >> 4;
                const int rsh_n = 2 * g_n, nbs_n = 5 - rsh_n, rho_n = bi_n >> nbs_n, blk_n = bi_n & ((1 << nbs_n) - 1), u0_n = blk_n * 128;
                const bf16* Qb_n = P + (size_t)b_n * SEQ * ATTN_N + ((g_n * 3 + 0) * NH + hh_n) * HD;
#pragma unroll
                for (int qi = 0; qi < 2; ++qi) { const unsigned qo = (unsigned)((((u0_n + 32 * cw + 16 * qi + fr) << rsh_n) + rho_n) * (ATTN_N * 2) + 16 * q4);
#pragma unroll
                    for (int ks = 0; ks < 4; ++ks) qn[qi][ks] = gload16s(Qb_n, qo + 64 * ks); } }
            else {
#pragma unroll
                for (int qi = 0; qi < 2; ++qi)
#pragma unroll
                    for (int ks = 0; ks < 4; ++ks) qn[qi][ks] = qf[qi][ks]; }
            float mxs[2], ls[2]; bf16x8 pf[2][5];
#pragma unroll
            for (int qi = 0; qi < 2; ++qi) {
                float mx = -1e30f;
#pragma unroll
                for (int kt = 0; kt < 9; ++kt)
#pragma unroll
                    for (int r = 0; r < 4; ++r) { const int rr = 4 * q4 + r; const int uk = u0 + 32 * cw + 16 * qi - 64 + 16 * kt + rr;
                        const bool ok = (kt > 0 || rr >= fr) && (kt < 8 || rr <= fr) && uk >= 0 && uk < L;
                        const float sv = ok ? S[qi][kt][r] * sc2 : -1e30f; S[qi][kt][r] = sv; mx = fmaxf(mx, sv); }
                mx = fmaxf(mx, __shfl_xor(mx, 16)); mx = fmaxf(mx, __shfl_xor(mx, 32));
                float l = 0.f;
#pragma unroll
                for (int kt = 0; kt < 9; ++kt)
#pragma unroll
                    for (int r = 0; r < 4; ++r) { const float pv = __builtin_amdgcn_exp2f(S[qi][kt][r] - mx); S[qi][kt][r] = pv; l += pv; }
                l += __shfl_xor(l, 16); l += __shfl_xor(l, 32);
                mxs[qi] = mx; ls[qi] = l;
#pragma unroll
                for (int pi = 0; pi < 5; ++pi) { const int ka = 2 * pi - qi, kb = 2 * pi + 1 - qi; v4u pw;
                    if (ka >= 0 && ka <= 8) { pw.x = pg8::cvt_pk_bf16(S[qi][ka][0], S[qi][ka][1]); pw.y = pg8::cvt_pk_bf16(S[qi][ka][2], S[qi][ka][3]); } else { pw.x = 0u; pw.y = 0u; }
                    if (kb >= 0 && kb <= 8) { pw.z = pg8::cvt_pk_bf16(S[qi][kb][0], S[qi][kb][1]); pw.w = pg8::cvt_pk_bf16(S[qi][kb][2], S[qi][kb][3]); } else { pw.z = 0u; pw.w = 0u; }
                    pf[qi][pi] = __builtin_bit_cast(bf16x8, pw); } }
            __builtin_amdgcn_s_barrier(); asm volatile("" ::: "memory");
            f32x4 O[2][8]; s16x4 vr[2][8][2];
#pragma unroll
            for (int qi = 0; qi < 2; ++qi)
#pragma unroll
                for (int dt = 0; dt < 8; ++dt) O[qi][dt] = (f32x4){0.f, 0.f, 0.f, 0.f};
            AT_SCHED;
#pragma unroll
            for (int dt = 0; dt < 8; ++dt) { vr[0][dt][0] = tr_read(lds + bV + 32 * dt); vr[0][dt][1] = tr_read(lds + bV + 16 * RST + 32 * dt); }
            AT_SCHED;
#pragma unroll
            for (int pi = 0; pi < 5; ++pi) {
                if (pi < 4) {
#pragma unroll
                    for (int dt = 0; dt < 4; ++dt) { vr[(pi + 1) & 1][dt][0] = tr_read(lds + bV + 32 * (pi + 1) * RST + 32 * dt); vr[(pi + 1) & 1][dt][1] = tr_read(lds + bV + (32 * (pi + 1) + 16) * RST + 32 * dt); }
                    AT_SCHED; asm volatile("s_waitcnt lgkmcnt(8)" ::: "memory"); AT_SCHED;
#pragma unroll
                    for (int dt = 4; dt < 8; ++dt) { vr[(pi + 1) & 1][dt][0] = tr_read(lds + bV + 32 * (pi + 1) * RST + 32 * dt); vr[(pi + 1) & 1][dt][1] = tr_read(lds + bV + (32 * (pi + 1) + 16) * RST + 32 * dt); }
                    AT_SCHED; }
                else { AT_SCHED; asm volatile("s_waitcnt lgkmcnt(0)" ::: "memory"); AT_SCHED; }
#pragma unroll
                for (int dt = 0; dt < 8; ++dt) { const bf16x8 vf = cat44(vr[pi & 1][dt][0], vr[pi & 1][dt][1]);
                    O[0][dt] = __builtin_amdgcn_mfma_f32_16x16x32_bf16(vf, pf[0][pi], O[0][dt], 0, 0, 0);
                    O[1][dt] = __builtin_amdgcn_mfma_f32_16x16x32_bf16(vf, pf[1][pi], O[1][dt], 0, 0, 0); }
                AT_SCHED; }
            __builtin_amdgcn_s_barrier(); asm volatile("" ::: "memory");
#pragma unroll
            for (int qi = 0; qi < 2; ++qi) { const float il = 1.0f / ls[qi]; const int qtok = ((u0 + 32 * cw + 16 * qi + fr) << rsh) + rho;
                const size_t orow = (size_t)g * M + (size_t)b * SEQ + qtok; bf16* op = OG + orow * D + hh * HD + 4 * q4;
#pragma unroll
                for (int dt = 0; dt < 8; ++dt) { v2u o2; o2.x = pk2(O[qi][dt][0] * il, O[qi][dt][1] * il); o2.y = pk2(O[qi][dt][2] * il, O[qi][dt][3] * il); *(GAS v2u*)(op + 16 * dt) = o2; }
                if (q4 == 0) *(GAS float*)(LSE + orow * NH + hh) = mxs[qi] * 0.6931471805599453f + __logf(ls[qi]); }
#pragma unroll
            for (int qi = 0; qi < 2; ++qi)
#pragma unroll
                for (int ks = 0; ks < 4; ++ks) qf[qi][ks] = qn[qi][ks];
        }
    }
    asm volatile("s_waitcnt vmcnt(0) lgkmcnt(0)" ::: "memory"); __builtin_amdgcn_s_barrier(); asm volatile("" ::: "memory");
#undef AT_SCHED
#undef AT_DECODE
}
typedef float float2_t __attribute__((ext_vector_type(2)));
__device__ __forceinline__ void hgrn_gates(const bf16* P, const float* lbt, bf16* QT, bf16* KT, float* PREF, float* BR, int gw, int NGW, int lane) {
    const unsigned lo = 4u * (unsigned)lane;
    for (int item = gw; item < 8192; item += NGW) {
        const int cb = item & 15, half = (item >> 4) & 1, chunk = (item >> 5) & 127, dir = item >> 12;
        const int cbase = cb * 128; const size_t row0 = (size_t)chunk * 64;
        const float lb0 = lbt[(size_t)dir * 4 * D + cbase + 2 * lane], lb1 = lbt[(size_t)dir * 4 * D + cbase + 2 * lane + 1];
        const unsigned char* fcol = (const unsigned char*)(P + (1 + dir) * D + cbase); const unsigned char* qcol = (const unsigned char*)(P + cbase);
        unsigned char* qt = (unsigned char*)(QT + (size_t)dir * M * D + cbase); unsigned char* kt = (unsigned char*)(KT + (size_t)dir * M * D + cbase);
        unsigned fw[32], qw[32];
#pragma unroll
        for (int j = 0; j < 32; ++j) { const int tau = half ? 32 + j : 31 - j; const size_t t = dir ? row0 + 63 - tau : row0 + tau;
            fw[j] = *(const GAS unsigned*)(fcol + t * (HGRN_N * 2) + lo); qw[j] = *(const GAS unsigned*)(qcol + t * (HGRN_N * 2) + lo); }
        float a0 = 1.f, a1 = 1.f;
#pragma unroll
        for (int j = 0; j < 32; ++j) { const int tau = half ? 32 + j : 31 - j; const size_t t = dir ? row0 + 63 - tau : row0 + tau;
            asm volatile("" : "+v"(fw[j]), "+v"(qw[j]) :: "memory");
            const float g0 = lb0 + (1.0f - lb0) * sigmoid_f(bflo(fw[j])), g1 = lb1 + (1.0f - lb1) * sigmoid_f(bfhi(fw[j]));
            const float q0 = bflo(qw[j]), q1 = bfhi(qw[j]); const float s0 = q0 * sigmoid_f(q0), s1 = q1 * sigmoid_f(q1);
            if (half) { a0 *= g0; a1 *= g1; }
            const float i0 = __builtin_amdgcn_rcpf(fmaxf(a0, 1e-30f)), i1 = __builtin_amdgcn_rcpf(fmaxf(a1, 1e-30f));
            const float e0 = half ? a0 : i0, e1 = half ? a1 : i1, r0 = half ? i0 : a0, r1 = half ? i1 : a1;
            *(GAS unsigned*)(qt + t * (D * 2) + lo) = pk2(s0 * e0, s1 * e1);
            *(GAS unsigned*)(kt + t * (D * 2) + lo) = pk2((1.0f - g0) * r0, (1.0f - g1) * r1);
            if (!half) { a0 *= g0; a1 *= g1; }
        }
        float* dst = (half ? BR : PREF) + ((size_t)dir * (M / 64) + chunk) * D + cbase;
        *(GAS float2_t*)((unsigned char*)dst + 2u * lo) = (float2_t){a0, a1};
    }
}

__device__ __forceinline__ void hgrn_scan_mfma(LAS unsigned char* lds, const bf16* P, const bf16* QT, const bf16* KT, const float* PREF, const float* BR, bf16* OD, int vcu, int G) {
    int tid_l = threadIdx.x; asm volatile("" : "+v"(tid_l));
    const int tid = tid_l, lane = tid & 63, w = __builtin_amdgcn_readfirstlane(tid >> 6), fr = lane & 15, q4 = lane >> 4;
    constexpr int QST = 272, KST = 288, VST = 96;
    constexpr int STG = 43008, QS = 0, KS = 17408, VS = 35840, VEC = 41984;
#define HG_SCHED __builtin_amdgcn_sched_barrier(0)
    for (int unit = vcu; unit < 256; unit += G) {
        const int chain = unit >> 2, slice = unit & 3, b = chain >> 5, hh = (chain >> 1) & 15, dir = chain & 1;
        const size_t dOff = (size_t)dir * M * D;
        const int ck0 = dir ? 63 : 0; const size_t tok00 = (size_t)b * SEQ + (size_t)ck0 * 64;
        if (w >= 4) {
            const int lw = w - 4;
            const unsigned char* src[11]; long sstr[11]; int poff[11];
            const long rstep = (dir ? -64L : 64L);
#pragma unroll
            for (int i = 0; i < 11; ++i) {
                int img, pcl;
                if (i < 4) { img = 0; pcl = lw + 4 * i; } else if (i < 8) { img = 1; pcl = lw + 4 * (i - 4); } else if (i == 8) { img = 2; pcl = lw; }
                else if (i == 9) { img = (lw < 2) ? 2 : (lw == 2 ? 0 : 1); pcl = (lw < 2) ? 4 + lw : 16; }
                else { img = (lw == 0) ? 1 : (lw == 1 ? 3 : 0); pcl = (lw == 0) ? 17 : lw; }
                const int sl = pcl * 64 + lane;
                if (img == 0 || img == 1) { const int RS = img ? 18 : 17; const int row = sl / RS, ch = sl - row * RS, chs = ch < 16 ? ch : 0;
                    src[i] = (const unsigned char*)((img ? KT : QT) + dOff + (tok00 + row) * D + hh * HD + chs * 8); sstr[i] = rstep * D * 2; poff[i] = (img ? KS : QS) + pcl * 1024; }
                else if (img == 2) { const int row = sl / 6, ch = sl - row * 6, chs = ch < 4 ? ch : 0;
                    src[i] = (const unsigned char*)(P + (tok00 + row) * HGRN_N + 3 * D + hh * HD + slice * 32 + chs * 8); sstr[i] = rstep * HGRN_N * 2; poff[i] = VS + pcl * 1024; }
                else { src[i] = (const unsigned char*)(((lane < 32) ? PREF : BR) + ((size_t)dir * (M / 64) + (tok00 >> 6)) * D + hh * HD + 4 * (lane & 31)); sstr[i] = (dir ? -1L : 1L) * D * 4; poff[i] = VEC; } }
#define HG_STAGE(step_, sb_) do { _Pragma("unroll") for (int i_ = 0; i_ < 11; ++i_) \
                glds16(src[i_] + (long)(step_) * sstr[i_], (unsigned)(size_t)(lds + (sb_) + poff[i_])); } while (0)
            HG_STAGE(0, 0); HG_STAGE(1, STG);
            int sbn = 2 * STG;
            for (int step = 0; step < 64; ++step) {
                if (step < 63) asm volatile("s_waitcnt vmcnt(11)" ::: "memory"); else asm volatile("s_waitcnt vmcnt(0)" ::: "memory");
                __builtin_amdgcn_s_barrier(); asm volatile("" ::: "memory");
                if (step + 2 < 64) HG_STAGE(step + 2, sbn);
                sbn = (sbn == 2 * STG) ? 0 : sbn + STG;
            }
#undef HG_STAGE
        } else {
            const int tt = w, qp = (lane >> 2) & 3, p4 = lane & 3;
            const int bQ = QS + (16 * tt + fr) * QST + q4 * 16;
            const int bQ2 = QS + (16 * tt + fr) * QST + q4 * 8;
            const int bK = KS + fr * KST + q4 * 16;
            const int bKc = KS + (4 * q4 + qp) * KST + p4 * 8;
            const int bV = VS + (4 * q4 + qp) * VST + p4 * 8;
            const int bP = VEC + q4 * 16;
            f32x4 S[8][2];
#pragma unroll
            for (int T = 0; T < 8; ++T) { S[T][0] = (f32x4){0.f, 0.f, 0.f, 0.f}; S[T][1] = (f32x4){0.f, 0.f, 0.f, 0.f}; }
            int sb = 0;
            for (int step = 0; step < 64; ++step) {
                __builtin_amdgcn_s_barrier(); asm volatile("" ::: "memory");
                LAS const unsigned char* st = lds + sb;
                HG_SCHED;
                bf16x8 qf[4], kf[2][4]; s16x4 va[2][2][2];
#pragma unroll
                for (int ks = 0; ks < 4; ++ks) qf[ks] = *(const LAS bf16x8*)(st + bQ + 64 * ks);
#pragma unroll
                for (int s4 = 0; s4 < 4; ++s4) kf[0][s4] = *(const LAS bf16x8*)(st + bK + 16 * s4 * KST);
#pragma unroll
                for (int vt = 0; vt < 2; ++vt)
#pragma unroll
                    for (int pi = 0; pi < 2; ++pi) { va[vt][pi][0] = tr_read(st + bV + 32 * pi * VST + 32 * vt); va[vt][pi][1] = tr_read(st + bV + (32 * pi + 16) * VST + 32 * vt); }
                HG_SCHED;
                f32x4 Pt[4];
#pragma unroll
                for (int s4 = 0; s4 < 4; ++s4) Pt[s4] = (f32x4){0.f, 0.f, 0.f, 0.f};
#pragma unroll
                for (int ks = 0; ks < 4; ++ks) {
                    if (ks < 3) {
#pragma unroll
                        for (int s4 = 0; s4 < 4; ++s4) kf[(ks + 1) & 1][s4] = *(const LAS bf16x8*)(st + bK + 16 * s4 * KST + 64 * (ks + 1));
                        HG_SCHED; asm volatile("s_waitcnt lgkmcnt(4)" ::: "memory"); HG_SCHED; }
                    else { HG_SCHED; asm volatile("s_waitcnt lgkmcnt(0)" ::: "memory"); HG_SCHED; }
#pragma unroll
                    for (int s4 = 0; s4 < 4; ++s4) Pt[s4] = __builtin_amdgcn_mfma_f32_16x16x32_bf16(kf[ks & 1][s4], qf[ks], Pt[s4], 0, 0, 0);
                    HG_SCHED; }
                f32x4 pr[8]; s16x4 qa[4], qb[4];
#pragma unroll
                for (int T = 0; T < 8; ++T) pr[T] = *(const LAS f32x4*)(st + bP + 64 * T);
#pragma unroll
                for (int ks = 0; ks < 4; ++ks) { qa[ks] = *(const LAS s16x4*)(st + bQ2 + 64 * ks); qb[ks] = *(const LAS s16x4*)(st + bQ2 + 64 * ks + 32); }
                HG_SCHED;
                const int tix = 16 * tt + fr;
#pragma unroll
                for (int s4 = 0; s4 < 4; ++s4)
#pragma unroll
                    for (int r = 0; r < 4; ++r) { const int six = 16 * s4 + 4 * q4 + r; const bool keep = dir ? (six >= tix) : (six <= tix); Pt[s4][r] = keep ? Pt[s4][r] : 0.f; }
                f32x4 o[2]; o[0] = (f32x4){0.f, 0.f, 0.f, 0.f}; o[1] = (f32x4){0.f, 0.f, 0.f, 0.f};
#pragma unroll
                for (int pi = 0; pi < 2; ++pi) {
                    v4u pw; pw.x = pg8::cvt_pk_bf16(Pt[2 * pi][0], Pt[2 * pi][1]); pw.y = pg8::cvt_pk_bf16(Pt[2 * pi][2], Pt[2 * pi][3]);
                    pw.z = pg8::cvt_pk_bf16(Pt[2 * pi + 1][0], Pt[2 * pi + 1][1]); pw.w = pg8::cvt_pk_bf16(Pt[2 * pi + 1][2], Pt[2 * pi + 1][3]);
#pragma unroll
                    for (int vt = 0; vt < 2; ++vt) o[vt] = __builtin_amdgcn_mfma_f32_16x16x32_bf16(cat44(va[vt][pi][0], va[vt][pi][1]), __builtin_bit_cast(bf16x8, pw), o[vt], 0, 0, 0); }
                HG_SCHED; asm volatile("s_waitcnt lgkmcnt(0)" ::: "memory"); HG_SCHED;
#pragma unroll
                for (int T = 0; T < 8; ++T) { S[T][0] = S[T][0] * pr[T]; S[T][1] = S[T][1] * pr[T]; }
                HG_SCHED;
                s16x4 kc[2][2][2][2]; f32x4 br[2][2];
#pragma unroll
                for (int j = 0; j < 2; ++j) { br[0][j] = *(const LAS f32x4*)(st + bP + 512 + 64 * j);
#pragma unroll
                    for (int pi = 0; pi < 2; ++pi) { kc[0][j][pi][0] = tr_read(st + bKc + 32 * pi * KST + 32 * j); kc[0][j][pi][1] = tr_read(st + bKc + (32 * pi + 16) * KST + 32 * j); } }
                HG_SCHED;
#pragma unroll
                for (int ks = 0; ks < 4; ++ks) { const int T0 = 2 * ks, T1 = 2 * ks + 1; const bf16x8 qq = cat44(qa[ks], qb[ks]);
#pragma unroll
                    for (int vt = 0; vt < 2; ++vt) {
                        v4u aw; aw.x = pg8::cvt_pk_bf16(S[T0][vt][0], S[T0][vt][1]); aw.y = pg8::cvt_pk_bf16(S[T0][vt][2], S[T0][vt][3]);
                        aw.z = pg8::cvt_pk_bf16(S[T1][vt][0], S[T1][vt][1]); aw.w = pg8::cvt_pk_bf16(S[T1][vt][2], S[T1][vt][3]);
                        o[vt] = __builtin_amdgcn_mfma_f32_16x16x32_bf16(__builtin_bit_cast(bf16x8, aw), qq, o[vt], 0, 0, 0); } }
                HG_SCHED;
                { const int ck = dir ? 63 - step : step; const size_t tok = (size_t)b * SEQ + (size_t)ck * 64 + 16 * tt + fr;
#pragma unroll
                  for (int vt = 0; vt < 2; ++vt) { v2u o2; o2.x = pk2(o[vt][0], o[vt][1]); o2.y = pk2(o[vt][2], o[vt][3]);
                    *(GAS v2u*)(OD + dOff + tok * D + hh * HD + slice * 32 + 16 * vt + 4 * q4) = o2; } }
                HG_SCHED;
#pragma unroll
                for (int rd = 0; rd < 4; ++rd) {
                    if (rd < 3) {
#pragma unroll
                        for (int j = 0; j < 2; ++j) { const int T = 2 * (rd + 1) + j; br[(rd + 1) & 1][j] = *(const LAS f32x4*)(st + bP + 512 + 64 * T);
#pragma unroll
                            for (int pi = 0; pi < 2; ++pi) { kc[(rd + 1) & 1][j][pi][0] = tr_read(st + bKc + 32 * pi * KST + 32 * T); kc[(rd + 1) & 1][j][pi][1] = tr_read(st + bKc + (32 * pi + 16) * KST + 32 * T); } }
                        HG_SCHED; asm volatile("s_waitcnt lgkmcnt(10)" ::: "memory"); HG_SCHED; }
                    else { HG_SCHED; asm volatile("s_waitcnt lgkmcnt(0)" ::: "memory"); HG_SCHED; }
#pragma unroll
                    for (int j = 0; j < 2; ++j) { const int T = 2 * rd + j;
#pragma unroll
                        for (int vt = 0; vt < 2; ++vt) {
#pragma unroll
                            for (int pi = 0; pi < 2; ++pi) S[T][vt] = __builtin_amdgcn_mfma_f32_16x16x32_bf16(cat44(kc[rd & 1][j][pi][0], kc[rd & 1][j][pi][1]), cat44(va[vt][pi][0], va[vt][pi][1]), S[T][vt], 0, 0, 0);
                            S[T][vt] = S[T][vt] * br[rd & 1][j]; } }
                    HG_SCHED; }
                sb = (sb == 2 * STG) ? 0 : sb + STG;
            }
        }
        asm volatile("s_waitcnt vmcnt(0) lgkmcnt(0)" ::: "memory"); __builtin_amdgcn_s_barrier(); asm volatile("" ::: "memory");
    }
#undef HG_SCHED
}
struct Args { const float* in[9]; float* out; unsigned char* ws; int ph_lo, ph_hi; };
__global__ void __launch_bounds__(NTHREADS, 2) fwd(Args args) {
    extern __shared__ __attribute__((aligned(16))) unsigned char lds_raw[];
    LAS unsigned char* lds = (LAS unsigned char*)lds_raw;
    volatile LAS unsigned* MISC = (volatile LAS unsigned*)(lds + MISC_OFF);
    const int G = gridDim.x; const int bx = blockIdx.x;
    const int vcu = (G % 8 == 0) ? (bx % 8) * (G / 8) + bx / 8 : bx;
    const int NGW = G * NWAVES;
    unsigned char* ws = args.ws;
    const float* x_in = args.in[0]; const float* norm_w = args.in[1]; const float* w_in_hgrn = args.in[2]; const float* lbnd = args.in[3]; const float* gnorm = args.in[4];
    const float* w_in_attn = args.in[5]; const float* w_out = args.in[6]; const float* w_ffn_in = args.in[7]; const float* w_ffn_out = args.in[8];
    float* xres = args.out;
    float* cosT = (float*)(ws + WS_TAB + TAB_COS); float* sinT = (float*)(ws + WS_TAB + TAB_SIN); float* lbT = (float*)(ws + WS_TAB + TAB_LB);
    bf16* WHG = (bf16*)(ws + WS_WHG); bf16* WAT = (bf16*)(ws + WS_WAT); bf16* WO = (bf16*)(ws + WS_WO); bf16* WF1 = (bf16*)(ws + WS_WF1); bf16* WF2 = (bf16*)(ws + WS_WF2);
    bf16* H = (bf16*)(ws + WS_H); bf16* PROJ = (bf16*)(ws + WS_PROJ); bf16* MIX = (bf16*)(ws + WS_MIX); bf16* OB = (bf16*)(ws + WS_O); bf16* GB = (bf16*)(ws + WS_G);
    float* LSE = (float*)(ws + WS_MIX + 96 * MiB);
    bf16* QT = (bf16*)(ws + WS_PROJ + 160 * MiB); bf16* KT = (bf16*)(ws + WS_PROJ + 224 * MiB); bf16* KH = (bf16*)(ws + WS_KH);
    bf16* XB = (bf16*)(ws + WS_KH);
    float* XSCR = (float*)(ws + WS_MIX); bf16* HSCR = (bf16*)(ws + WS_MIX + 64 * MiB);
    float* PREF = (float*)(ws + WS_KH + 64 * MiB); float* E63V = (float*)(ws + WS_KH + 66 * MiB);

    for (int u = threadIdx.x; u < (LDS_BYTES - LDSCTL_OFF) / 4; u += NTHREADS) ((LAS unsigned*)(lds + LDSCTL_OFF))[u] = 0u;
    __syncthreads();
    const int lo = args.ph_lo, hi = args.ph_hi;
    const int FF1_REM = ((M / 256) * (FFN_N / 256)) % G;
    const bool TAILCVT = FF1_REM != 0 && (hi - lo) == NPHASES && REP_F1 == 1;
    const bool use_bar = (hi - lo) > 1;
    XcdBarrier bar; bar.bar = (unsigned*)(ws + WS_CTL) + CW_BAR; bar.x = 0; bar.st = nullptr;
    if (use_bar) bar = xcd_barrier_post((unsigned*)(ws + WS_CTL) + CW_BAR, MISC + 8);
#ifndef TAIL_ALL
#define TAIL_ALL 0
#endif
#ifndef INP_ALIGN
#define INP_ALIGN true
#endif
#ifndef TAIL_WO
#define TAIL_WO 0
#endif
#ifndef TAIL_F2
#define TAIL_F2 1
#endif
#ifndef MIXMAP
#define MIXMAP vcu
#endif
#define IN(k) (lo <= (k) && (k) < hi)
#define PH_IDS int tid_p = threadIdx.x; asm volatile("" : "+v"(tid_p)); const int lane_p = tid_p & 63; const int wave_p = __builtin_amdgcn_readfirstlane(tid_p >> 6); const int gw_p = vcu * NWAVES + wave_p; (void)lane_p; (void)gw_p;
#ifndef REP_BAR
#define REP_BAR 1
#endif
#define SEAM(k) do { if (IN(k) && IN((k) + 1)) for (int rb = 0; rb < REP_BAR; ++rb) xcd_barrier(bar); } while (0)

    if (IN(0)) for (int rep = 0; rep < REP_PRO; ++rep) {
        PH_IDS
        const int lane = lane_p, gw = gw_p, tid = tid_p;
        LAS float* scr = (LAS float*)(lds + wave_p * 16384);
        for (int s = 0; s < ((TAILCVT && TAIL_ALL) ? 1 : 2); ++s) transpose_matrix(w_in_hgrn + (size_t)s * D * HGRN_N, D, HGRN_N, WHG + (size_t)s * HGRN_N * D, 0, scr, gw, NGW, lane);
        for (int s = 0; s < ((TAILCVT && TAIL_ALL) ? 0 : 2); ++s) transpose_matrix(w_in_attn + (size_t)s * D * ATTN_N, D, ATTN_N, WAT + (size_t)s * ATTN_N * D, 0, scr, gw, NGW, lane);
        for (int s = 0; s < ((TAILCVT && (TAIL_ALL || TAIL_WO)) ? 1 : 4); ++s) transpose_matrix(w_out + (size_t)s * D * D, D, D, WO + (size_t)s * D * D, 0, scr, gw, NGW, lane);
        for (int s = 0; s < (TAILCVT ? 1 : 4); ++s) transpose_matrix(w_ffn_in + (size_t)s * D * FFN_N, D, FFN_N, WF1 + (size_t)s * FFN_N * D, 1, scr, gw, NGW, lane);
        for (int s = 0; s < ((TAILCVT && TAIL_F2) ? 1 : 4); ++s) transpose_matrix(w_ffn_out + (size_t)s * DFF * D, DFF, D, WF2 + (size_t)s * D * DFF, 0, scr, gw, NGW, lane);
        const int gt = vcu * NTHREADS + tid, NGT = G * NTHREADS;
        for (int idx = gt; idx < SEQ * 16; idx += NGT) { const int pos = idx >> 4, i = idx & 15;
            const float inv = powf(500000.0f, -(float)(2 * i) / 32.0f); const float ang = (float)pos * inv; cosT[idx] = cosf(ang); sinT[idx] = sinf(ang); }
        for (int idx = gt; idx < 2 * D; idx += NGT) { const int dir = idx >> 11, c = idx & (D - 1);
            float xl[4]; float mx = -3.0e38f;
#pragma unroll
            for (int l = 0; l < 4; ++l) { xl[l] = lbnd[(size_t)(dir * 4 + l) * D + c]; mx = fmaxf(mx, xl[l]); }
            float sum = 0.f;
#pragma unroll
            for (int l = 0; l < 4; ++l) { xl[l] = expf(xl[l] - mx); sum += xl[l]; }
            float cum = 0.f, c0 = 0.f;
#pragma unroll
            for (int l = 0; l < 4; ++l) { cum += xl[l] / sum; if (l == 0) c0 = cum; lbT[(size_t)(dir * 4 + l) * D + c] = cum - c0; } }
        norm_rows<false, true, false, false>(nullptr, x_in, nullptr, nullptr, norm_w, H, gw, NGW, lane);
    }
    SEAM(0);

    for (int L = 0; L < DEPTH; ++L) {
        const int pb = 1 + 9 * L; const bool hg = (L & 1) == 0; const int slot = L >> 1;
        const float* nw = norm_w + (size_t)L * 4 * D;
        const int NPROJ = hg ? HGRN_N : ATTN_N;
        if (IN(pb)) {
#ifdef STAGGER_US
            { const unsigned long long t0 = __builtin_amdgcn_s_memrealtime(); const unsigned long long dl = (unsigned long long)((bx >> 3) & 3) * (STAGGER_US * 100);
              while (__builtin_amdgcn_s_memrealtime() - t0 < dl) __builtin_amdgcn_s_sleep(8); }
#endif
            if (hg) for (int rep = 0; rep < REP_INH; ++rep) { pg8::Gemm g{H, WHG + (size_t)slot * HGRN_N * D, M, HGRN_N, D}; pg8::StaticOrder S; S.init(M, HGRN_N, G, bx);
                pg8::EpiBf16<0> E{PROJ, HGRN_N, nullptr, 0, 0, 1.f};
                pg8::gemm_phase<pg8::EpiBf16<0>, pg8::StaticOrder, INP_ALIGN, true>(lds, g, S, E); }
            else for (int rep = 0; rep < REP_INA; ++rep) { pg8::Gemm g{H, WAT + (size_t)((REP_INA_COLD && rep + 1 < REP_INA) ? (slot ^ 1) : slot) * ATTN_N * D, M, ATTN_N, D}; pg8::StaticOrder S; S.init(M, ATTN_N, G, bx);
                pg8::EpiRope E{PROJ, ATTN_N, cosT, sinT};
                pg8::gemm_phase<pg8::EpiRope, pg8::StaticOrder, INP_ALIGN, true>(lds, g, S, E); }
        }
        SEAM(pb);
        if (hg) {
            if (IN(pb + 1)) for (int rep = 0; rep < REP_GATES; ++rep) { PH_IDS hgrn_gates(PROJ, lbT + (size_t)L * D, QT, KT, PREF, E63V, gw_p, NGW, lane_p); }
            SEAM(pb + 1);
        }
        if (IN(pb + 2)) {
            if (hg) for (int rep = 0; rep < REP_SCAN; ++rep) hgrn_scan_mfma(lds, PROJ, QT, KT, PREF, E63V, MIX, MIXMAP, G);
            else for (int rep = 0; rep < REP_ATTN; ++rep) attn_core_mfma(lds, PROJ, MIX, LSE, MIXMAP, G);
        }
        SEAM(pb + 2);
        if (IN(pb + 3)) for (int rep = 0; rep < REP_FIN; ++rep) {
            PH_IDS
            const int lane = lane_p, gw = gw_p;
            if (hg) hgrn_finalize(PROJ, MIX, gnorm + (size_t)slot * HD, OB, gw, NGW, lane);
            else attn_finalize(MIX, LSE, OB, gw, NGW, lane);
        }
        SEAM(pb + 3);
        if (IN(pb + 4)) for (int rep = 0; rep < REP_WO; ++rep) {
            pg8::Gemm g{OB, WO + (size_t)L * D * D, M, D, D}; pg8::StaticOrder S; S.init(M, D, G, bx);
            pg8::EpiBf16<0> E{GB, D, nullptr, 0, 0, 1.f};
            pg8::gemm_phase<pg8::EpiBf16<0>, pg8::StaticOrder, true, true>(lds, g, S, E);
        }
        SEAM(pb + 4);
        if (IN(pb + 5)) for (int rep = 0; rep < REP_NORM; ++rep) { PH_IDS if (L == 0 && rep == 0) norm_rows<true, true, false, true>(GB, x_in, XB, nw + D, nw + 2 * D, H, gw_p, NGW, lane_p);
            else norm_rows<true, true, true, true>(GB, XB, rep ? (void*)XSCR : (void*)XB, nw + D, nw + 2 * D, rep ? HSCR : H, gw_p, NGW, lane_p); }
        SEAM(pb + 5);
        if (IN(pb + 6)) for (int rep = 0; rep < REP_F1; ++rep) {
            pg8::Gemm g{H, WF1 + (size_t)L * FFN_N * D, M, FFN_N, D}; pg8::StaticOrder S; S.init(M, FFN_N, G, bx);
            pg8::EpiSwiGLU E{PROJ, DFF};
            pg8::gemm_phase<pg8::EpiSwiGLU, pg8::StaticOrder, true, true>(lds, g, S, E);
            if (TAILCVT && L + 1 < DEPTH && bx >= FF1_REM) {
                PH_IDS
                LAS float* scr = (LAS float*)(lds + wave_p * 16384); const int gw2 = (bx - FF1_REM) * NWAVES + wave_p, ngw2 = (G - FF1_REM) * NWAVES;
                transpose_matrix(w_ffn_in + (size_t)(L + 1) * D * FFN_N, D, FFN_N, WF1 + (size_t)(L + 1) * FFN_N * D, 1, scr, gw2, ngw2, lane_p);
                if (TAIL_ALL) { const int L1 = L + 1, slot1 = L1 >> 1;
                    if (L1 & 1) transpose_matrix(w_in_attn + (size_t)slot1 * D * ATTN_N, D, ATTN_N, WAT + (size_t)slot1 * ATTN_N * D, 0, scr, gw2, ngw2, lane_p);
                    else transpose_matrix(w_in_hgrn + (size_t)slot1 * D * HGRN_N, D, HGRN_N, WHG + (size_t)slot1 * HGRN_N * D, 0, scr, gw2, ngw2, lane_p);
                    transpose_matrix(w_out + (size_t)L1 * D * D, D, D, WO + (size_t)L1 * D * D, 0, scr, gw2, ngw2, lane_p); }
                if (TAIL_F2) transpose_matrix(w_ffn_out + (size_t)(L + 1) * DFF * D, DFF, D, WF2 + (size_t)(L + 1) * D * DFF, 0, scr, gw2, ngw2, lane_p);
                if (TAIL_WO && !TAIL_ALL) transpose_matrix(w_out + (size_t)(L + 1) * D * D, D, D, WO + (size_t)(L + 1) * D * D, 0, scr, gw2, ngw2, lane_p);
            }
        }
        SEAM(pb + 6);
        if (IN(pb + 7)) for (int rep = 0; rep < REP_F2; ++rep) {
            pg8::Gemm g{PROJ, WF2 + (size_t)L * D * DFF, M, D, DFF}; pg8::StaticOrder S; S.init(M, D, G, bx);
            pg8::EpiBf16<0> E{GB, D, nullptr, 0, 0, 1.f};
            pg8::gemm_phase<pg8::EpiBf16<0>, pg8::StaticOrder, true, true>(lds, g, S, E);
        }
        SEAM(pb + 7);
        if (IN(pb + 8)) for (int rep = 0; rep < REP_NORM; ++rep) {
            PH_IDS
            const int lane = lane_p, gw = gw_p;
            if (L + 1 < DEPTH) norm_rows<true, true, true, true>(GB, XB, rep ? (void*)XSCR : (void*)XB, nw + 3 * D, nw + 4 * D, rep ? HSCR : H, gw, NGW, lane);
            else norm_rows<true, false, true, false>(GB, XB, rep ? XSCR : xres, nw + 3 * D, nullptr, nullptr, gw, NGW, lane);
        }
        SEAM(pb + 8);
    }
#undef IN
#undef SEAM
}

#ifndef MK_PER_PHASE
#define MK_PER_PHASE 0
#endif
extern "C" void kernel_launch(void* const* d_in, const int* in_sizes, int n_in, void* d_out, int out_size, void* d_ws, size_t ws_size, hipStream_t stream) {
    static int grid = 0;
    if (grid == 0) {
        if (n_in != 9 || in_sizes[0] != M * D || out_size != M * D || ws_size < WS_END) { fprintf(stderr, "kernel_launch: unexpected shapes (n_in %d, in0 %d, out %d, ws %zu); nothing launched\n", n_in, n_in > 0 ? in_sizes[0] : -1, out_size, ws_size); grid = -1; return; }
        int dev = 0, cus = 0, per_cu = 0;
        if (hipGetDevice(&dev) != hipSuccess || hipDeviceGetAttribute(&cus, hipDeviceAttributeMultiprocessorCount, dev) != hipSuccess) { grid = -1; return; }
        if (hipFuncSetAttribute((const void*)fwd, hipFuncAttributeMaxDynamicSharedMemorySize, LDS_BYTES) != hipSuccess) { fprintf(stderr, "kernel_launch: hipFuncSetAttribute failed\n"); grid = -1; return; }
        if (hipOccupancyMaxActiveBlocksPerMultiprocessor(&per_cu, (const void*)fwd, NTHREADS, LDS_BYTES) != hipSuccess || per_cu < 1) fprintf(stderr, "kernel_launch: occupancy query reports %d\n", per_cu);
        (void)hipGetLastError();
        grid = cus;
    }
    if (grid < 0) return;
    if (hipMemsetAsync((char*)d_ws + WS_CTL, 0, CTL_ZERO_BYTES, stream) != hipSuccess) return;
    Args a{};
    for (int i = 0; i < 9; ++i) a.in[i] = (const float*)d_in[i];
    a.out = (float*)d_out; a.ws = (unsigned char*)d_ws;
#if MK_PER_PHASE
    for (int p = 0; p < NPHASES; ++p) { a.ph_lo = p; a.ph_hi = p + 1; hipLaunchKernelGGL(fwd, dim3(grid), dim3(NTHREADS), LDS_BYTES, stream, a); }
#else
    a.ph_lo = 0; a.ph_hi = NPHASES; hipLaunchKernelGGL(fwd, dim3(grid), dim3(NTHREADS), LDS_BYTES, stream, a);
#endif
}
```

```cpp
#include <hip/hip_runtime.h>
#include <cstdio>
#include <cstdint>
#define I8_IN 0xE
#ifndef QKV_ADJ
#define QKV_ADJ 0
#endif
#ifdef EPI_NT
#define PG8_ST(v, p) __builtin_nontemporal_store((v), (p))
#elif defined(EPI_ASM)
#define PG8_XSTR(x) #x
#define PG8_STR(x) PG8_XSTR(x)
#define PG8_ST(v, p) asm volatile("global_store_dwordx4 %0, %1, off " PG8_STR(EPI_ASM) "\n\ts_nop 2" :: "v"(p), "v"(v) : "memory")
#else
#define PG8_ST(v, p) (*(p) = (v))
#endif
#ifndef PG8_WGM
#define PG8_WGM 8
#endif
namespace pg8 {
#define PG8_LAS __attribute__((address_space(3)))
typedef unsigned short bf16_t;
typedef short bf16x8 __attribute__((ext_vector_type(8)));
typedef float f32x4 __attribute__((ext_vector_type(4)));
typedef unsigned u32x4 __attribute__((ext_vector_type(4)));
typedef int i32x4 __attribute__((ext_vector_type(4)));
constexpr int BM = 256, BK = 64, HALF = 128, HTB = HALF * BK * 2  , STAGE_BYTES = 8 * HTB, NXCD = 8, WGM = PG8_WGM;

__host__ __device__ __forceinline__ int lds_byte(int r, int c) { const int st = (r >> 4) * 2 + (c >> 5), rr = r & 15, cc = c & 31, ob = rr * 64 + cc * 2; return st * 1024 + (ob ^ (((ob >> 9) & 1) << 5)); }
__host__ __device__ __forceinline__ void stage_rc(int b, int& R, int& C) { const int st = b / 1024, sb = b % 1024, swz = sb ^ (((sb >> 9) & 1) << 5); R = (st >> 1) * 16 + swz / 64; C = (st & 1) * 32 + (swz % 64) / 2; }
__host__ __device__ __forceinline__ int perm32(int rho) { const int n = rho >> 4, i = rho & 15; return 8 * (i >> 2) + 4 * n + (i & 3); }

struct Unit { int pm, pn; };
struct Gemm { const bf16_t* A; const bf16_t* Bt; int M, N, K; };

struct StaticOrder {
    int nM, nN, nwg, G, c;
    __host__ __device__ void init(int M, int N, int G_, int c_) { nM = M / BM; nN = N / BM; nwg = nM * nN; G = G_; c = c_; }
    __host__ __device__ bool next(int i, Unit& u) const {
        const long L = (long)i * G + c; if (L >= nwg) return false;
        int wgid = (int)L; { const int q = nwg / NXCD, r = nwg % NXCD, xcd = wgid % NXCD, off = wgid / NXCD; wgid = (xcd < r ? xcd * (q + 1) : r * (q + 1) + (xcd - r) * q) + off; }
        const int nig = WGM * nN, gid = wgid / nig, fm = gid * WGM, gsz = (nM - fm) < WGM ? (nM - fm) : WGM;
        u.pm = fm + ((wgid % nig) % gsz); u.pn = (wgid % nig) / gsz; return true;
    }
    __device__ __forceinline__ void a_ready(const Unit&) const {}
    __device__ __forceinline__ void done(const Unit&) const {}
};

__device__ __forceinline__ unsigned cvt_pk_bf16(float lo, float hi) { unsigned r; asm volatile("v_cvt_pk_bf16_f32 %0, %1, %2" : "=v"(r) : "v"(lo), "v"(hi)); return r; }
typedef float f32x2 __attribute__((ext_vector_type(2)));
__device__ __forceinline__ f32x2 gelu_pk(f32x2 v) {
    const f32x2 av = __builtin_elementwise_abs(v), d = av * 0.2316418882f + 1.0f;
    f32x2 t; t.x = __builtin_amdgcn_rcpf(d.x); t.y = __builtin_amdgcn_rcpf(d.y);
    f32x2 q = t * 0.5307027145f + (-0.7265760135f); q = q * t + 0.7107068705f; q = q * t + (-0.142248368f); q = q * t + 0.127414796f; q = q * t;
    const f32x2 s = (v * v) * (-0.72134752044f);
    f32x2 e; e.x = __builtin_amdgcn_exp2f(s.x); e.y = __builtin_amdgcn_exp2f(s.y);
    const f32x2 m = v * (q * e), r = v - m;
    f32x2 o; o.x = v.x < 0.f ? m.x : r.x; o.y = v.y < 0.f ? m.y : r.y; return o;
}

__device__ __forceinline__ f32x4 acc_f(const f32x4& a, float) { return a; }
__device__ __forceinline__ f32x4 acc_f(const i32x4& a, float sc) { return (f32x4){(float)a[0] * sc, (float)a[1] * sc, (float)a[2] * sc, (float)a[3] * sc}; }
template <bool Q> struct AccSel { typedef f32x4 t; }; template <> struct AccSel<true> { typedef i32x4 t; };
template <int ACT  , bool Q = false> struct EpiBf16 {
    static constexpr int NST = 16;
    static constexpr bool PERM = true, AFTER_DRAIN = false, I8 = Q; typedef typename AccSel<Q>::t acc_t; static_assert(ACT == 0 || ACT == 1, "EpiBf16: ACT is 0 (none) or 1 (gelu_pk)");
    bf16_t* O; int ldc; const float* bias; int split_cols; size_t split_stride; float scale0; const float* rs = nullptr; float wsc = 1.f; const PG8_LAS float* rsl = nullptr;
    __device__ __forceinline__ void operator()(const acc_t (&acc)[2][2][4][2], const Unit& u, int wr, int wc, int fr, int fq) const {
        const int row0 = u.pm * BM + wr * 64 + fr; int colt = u.pn * BM; bf16_t* base = O;
        float sc = 1.f; if (split_cols) { const int t = colt / split_cols; base += (size_t)t * split_stride; colt -= t * split_cols; if (t == 0) sc = scale0; }
        const int col0 = colt + wc * 32 + 8 * fq, bcol0 = u.pn * BM + wc * 32 + 8 * fq;
        float rsq[2][4];
        if constexpr (Q) {
#pragma unroll
            for (int ai = 0; ai < 2; ++ai)
#pragma unroll
                for (int m = 0; m < 4; ++m) rsq[ai][m] = rsl[wr * 64 + fr + ai * HALF + m * 16] * wsc; }
        f32x4 bv[2][2];
#pragma unroll
        for (int bj = 0; bj < 2; ++bj)
#pragma unroll
            for (int n = 0; n < 2; ++n) bv[bj][n] = bias ? *(const f32x4*)(bias + bcol0 + bj * HALF + 4 * n) : (f32x4){0.f, 0.f, 0.f, 0.f};
#pragma unroll
        for (int ai = 0; ai < 2; ++ai)
#pragma unroll
            for (int m = 0; m < 4; ++m) { bf16_t* rowp = base + (size_t)(row0 + ai * HALF + m * 16) * ldc + col0; const float qs = Q ? rsq[ai][m] : 1.f;
#pragma unroll
                for (int bj = 0; bj < 2; ++bj) { f32x4 v0 = acc_f(acc[ai][bj][m][0], qs), v1 = acc_f(acc[ai][bj][m][1], qs); if constexpr (!Q) { v0 = v0 + bv[bj][0]; v1 = v1 + bv[bj][1]; }
                    if (ACT == 1) { f32x2 a = gelu_pk((f32x2){v0[0], v0[1]}), b = gelu_pk((f32x2){v0[2], v0[3]}), c = gelu_pk((f32x2){v1[0], v1[1]}), d = gelu_pk((f32x2){v1[2], v1[3]});
                        v0 = (f32x4){a.x, a.y, b.x, b.y}; v1 = (f32x4){c.x, c.y, d.x, d.y}; }
                    v0 = v0 * sc; v1 = v1 * sc; u32x4 w; w.x = cvt_pk_bf16(v0[0], v0[1]); w.y = cvt_pk_bf16(v0[2], v0[3]); w.z = cvt_pk_bf16(v1[0], v1[1]); w.w = cvt_pk_bf16(v1[2], v1[3]);
                    PG8_ST(w, (u32x4*)(rowp + bj * HALF)); } }
    }
};

#ifndef PG8_PRESTAGE
#define PG8_PRESTAGE 0
#endif
template <class Epi, class Sched, bool ALIGN_EPI = false, bool SP2 = false>
__device__ __forceinline__ void gemm_phase(PG8_LAS unsigned char* lds, const Gemm g, const Sched& S, const Epi& E) {
    int tid_l = threadIdx.x; asm volatile("" : "+v"(tid_l));
    const int tid = tid_l, wid = __builtin_amdgcn_readfirstlane(tid >> 6), lane = tid & 63, wr = wid >> 2, wc = wid & 3, fr = lane & 15, fq = lane >> 4;
    const int K = g.K * (Epi::I8 ? 1 : 2) / 2, nt = K / BK;
    unsigned voffA[2], voffB[2];
#pragma unroll
    for (int i = 0; i < 2; ++i) { int R, C; stage_rc(tid * 16 + i * 8192, R, C); const int Rb = Epi::PERM ? ((R & ~31) + perm32(R & 31)) : R;
        voffA[i] = (unsigned)(R * K + C) * 2u; voffB[i] = (unsigned)(Rb * K + C) * 2u; }
    const size_t kstep = (size_t)(BK * 2);
    const size_t hstep = (size_t)HALF * K * 2;
    const size_t tstep = 2 * hstep;
    const unsigned ldsw = (unsigned)wid * 1024u;
    const int aoff = lds_byte(wr * 64 + fr, fq * 8), boff = lds_byte(wc * 32 + fr, fq * 8);
#define PG8_SA(b, h) (((b) * 2 + (h)) * HTB)
#define PG8_SB(b, h) ((4 + (b) * 2 + (h)) * HTB)
#define PG8_STAGE(bufoff, gbase, voff) do { _Pragma("unroll") for (int _i = 0; _i < 2; ++_i) \
        __builtin_amdgcn_global_load_lds((const unsigned*)((const char*)(gbase) + (voff)[_i]), (PG8_LAS unsigned*)(lds + (bufoff) + ldsw + _i * 8192), 16, 0, 0); } while (0)
#define PG8_LDA(dst, b, h) do { _Pragma("unroll") for (int m = 0; m < 4; ++m) _Pragma("unroll") for (int k = 0; k < 2; ++k) dst[m][k] = *(const PG8_LAS bf16x8*)(lds + PG8_SA(b, h) + aoff + m * 2048 + k * 1024); } while (0)
#define PG8_LDB(dst, b, h) do { _Pragma("unroll") for (int n = 0; n < 2; ++n) _Pragma("unroll") for (int k = 0; k < 2; ++k) dst[n][k] = *(const PG8_LAS bf16x8*)(lds + PG8_SB(b, h) + boff + n * 2048 + k * 1024); } while (0)
#define PG8_MMA(ai, bj, At, Bt) do { __builtin_amdgcn_s_setprio(1); _Pragma("unroll") for (int m = 0; m < 4; ++m) _Pragma("unroll") for (int n = 0; n < 2; ++n) _Pragma("unroll") for (int k = 0; k < 2; ++k) \
        { if constexpr (Epi::I8) acc[ai][bj][m][n] = __builtin_amdgcn_mfma_i32_16x16x64_i8(__builtin_bit_cast(i32x4, Bt[n][k]), __builtin_bit_cast(i32x4, At[m][k]), acc[ai][bj][m][n], 0, 0, 0); \
          else acc[ai][bj][m][n] = __builtin_amdgcn_mfma_f32_16x16x32_bf16(Bt[n][k], At[m][k], acc[ai][bj][m][n], 0, 0, 0); } __builtin_amdgcn_s_setprio(0); } while (0)
#define PG8_WAIT_V(n) asm volatile("s_waitcnt vmcnt(" #n ")" ::: "memory")
#define PG8_WAIT_VX(c) do { const int c_ = PRE_OK ? __builtin_amdgcn_readfirstlane((c) ? 1 : 0) : 0; \
        if constexpr (!PRE_OK) asm volatile("s_waitcnt vmcnt(8)" ::: "memory"); \
        else if constexpr (Epi::NST == 16) asm volatile("s_waitcnt vmcnt(26)\n\ts_cmp_lg_u32 %0, 0\n\ts_cbranch_scc1 1\n\ts_waitcnt vmcnt(8)" :: "s"(c_) : "memory", "scc"); \
        else if constexpr (Epi::NST == 8) asm volatile("s_waitcnt vmcnt(18)\n\ts_cmp_lg_u32 %0, 0\n\ts_cbranch_scc1 1\n\ts_waitcnt vmcnt(8)" :: "s"(c_) : "memory", "scc"); \
        else asm volatile("s_waitcnt vmcnt(8)" ::: "memory"); } while (0)
#define PG8_WAIT_L(n) asm volatile("s_waitcnt lgkmcnt(" #n ")" ::: "memory")
#define PG8_BAR __builtin_amdgcn_s_barrier()
#define PG8_SCHED __builtin_amdgcn_sched_barrier(0)
    Unit cur, nxt; int ui = 0;
    if (!S.next(0, cur)) return;
    typename Epi::acc_t acc[2][2][4][2];
#pragma unroll
    for (int a = 0; a < 2; ++a)
#pragma unroll
        for (int b = 0; b < 2; ++b)
#pragma unroll
            for (int m = 0; m < 4; ++m)
#pragma unroll
                for (int n = 0; n < 2; ++n) acc[a][b][m][n] = (typename Epi::acc_t){0, 0, 0, 0};
    bf16x8 At[4][2], B0[2][2], B1[2][2];
    const char* cA = (const char*)g.A + (size_t)cur.pm * tstep; const char* cB = (const char*)g.Bt + (size_t)cur.pn * tstep;
    S.a_ready(cur);
    if constexpr (SP2) {
        PG8_STAGE(PG8_SB(0, 0), cB, voffB); PG8_STAGE(PG8_SB(0, 1), cB + hstep, voffB); PG8_STAGE(PG8_SA(0, 0), cA, voffA); PG8_STAGE(PG8_SA(0, 1), cA + hstep, voffA);
        if (wr == 1) PG8_BAR;
        PG8_WAIT_V(2); PG8_BAR;
        PG8_STAGE(PG8_SB(1, 0), cB + kstep, voffB); PG8_STAGE(PG8_SA(1, 0), cA + kstep, voffA); PG8_STAGE(PG8_SB(1, 1), cB + hstep + kstep, voffB);
        PG8_WAIT_V(6); PG8_BAR;
    } else {
        PG8_STAGE(PG8_SB(0, 0), cB, voffB); PG8_STAGE(PG8_SA(0, 0), cA, voffA); PG8_STAGE(PG8_SB(0, 1), cB + hstep, voffB); PG8_STAGE(PG8_SA(0, 1), cA + hstep, voffA);
        if (wr == 1) PG8_BAR;
        PG8_WAIT_V(4); PG8_BAR;
        PG8_STAGE(PG8_SB(1, 0), cB + kstep, voffB); PG8_STAGE(PG8_SA(1, 0), cA + kstep, voffA); PG8_STAGE(PG8_SB(1, 1), cB + hstep + kstep, voffB);
        PG8_WAIT_V(6); PG8_BAR;
    }
    constexpr bool PRE_OK = PG8_PRESTAGE && SP2 && ALIGN_EPI && !Epi::AFTER_DRAIN && (Epi::NST == 16 || Epi::NST == 8);
    bool pre = false;
    for (;;) {
        const bool has_next = S.next(ui + 1, nxt);
        const char* nA = has_next ? (const char*)g.A + (size_t)nxt.pm * tstep : cA; const char* nB = has_next ? (const char*)g.Bt + (size_t)nxt.pn * tstep : cB;
        for (int t = 0; t < nt; t += 2) {
            const bool last = (t == nt - 2);
            const char* a1 = cA + (size_t)(t + 1) * kstep;
            const char* a2 = last ? nA : cA + (size_t)(t + 2) * kstep; const char* b2 = last ? nB : cB + (size_t)(t + 2) * kstep;
            const char* a3 = a2 + kstep; const char* b3 = b2 + kstep;
            if (last && has_next) S.a_ready(nxt);
            if constexpr (SP2) {
            const bool rx = PRE_OK && t == 0 && pre;
            PG8_LDB(B0, 0, 0); PG8_LDB(B1, 0, 1); PG8_SCHED; PG8_LDA(At, 0, 0); PG8_STAGE(PG8_SA(1, 1), a1 + hstep, voffA);
            PG8_WAIT_VX(rx); PG8_WAIT_L(0); PG8_BAR; PG8_MMA(0, 0, At, B0); PG8_MMA(0, 1, At, B1); PG8_BAR; PG8_SCHED;
            PG8_LDA(At, 0, 1); PG8_STAGE(PG8_SB(0, 0), b2, voffB); PG8_STAGE(PG8_SB(0, 1), b2 + hstep, voffB); PG8_STAGE(PG8_SA(0, 0), a2, voffA);
            PG8_WAIT_VX(rx); PG8_WAIT_L(0); PG8_BAR; PG8_MMA(1, 0, At, B0); PG8_MMA(1, 1, At, B1); PG8_BAR; PG8_SCHED;
            PG8_LDB(B0, 1, 0); PG8_LDB(B1, 1, 1); PG8_SCHED; PG8_LDA(At, 1, 0); PG8_STAGE(PG8_SA(0, 1), a2 + hstep, voffA);
            PG8_WAIT_VX(rx); PG8_WAIT_L(0); PG8_BAR; PG8_MMA(0, 0, At, B0); PG8_MMA(0, 1, At, B1); PG8_BAR; PG8_SCHED;
            PG8_LDA(At, 1, 1); PG8_STAGE(PG8_SB(1, 0), b3, voffB); PG8_STAGE(PG8_SB(1, 1), b3 + hstep, voffB); PG8_STAGE(PG8_SA(1, 0), a3, voffA);
            PG8_WAIT_V(8); PG8_WAIT_L(0); PG8_BAR; PG8_MMA(1, 0, At, B0); PG8_MMA(1, 1, At, B1); PG8_BAR; PG8_SCHED;
            } else {
            PG8_LDB(B0, 0, 0); PG8_SCHED; PG8_LDA(At, 0, 0); PG8_STAGE(PG8_SA(1, 1), a1 + hstep, voffA);
            PG8_WAIT_L(8); PG8_BAR; PG8_WAIT_L(0); PG8_MMA(0, 0, At, B0); PG8_BAR; PG8_SCHED;
            PG8_LDB(B1, 0, 1); PG8_STAGE(PG8_SB(0, 0), b2, voffB);
            PG8_BAR; PG8_WAIT_L(0); PG8_MMA(0, 1, At, B1); PG8_BAR;
            PG8_LDA(At, 0, 1); PG8_STAGE(PG8_SA(0, 0), a2, voffA);
            PG8_BAR; PG8_WAIT_L(0); PG8_MMA(1, 0, At, B0); PG8_BAR; PG8_SCHED;
            PG8_STAGE(PG8_SB(0, 1), b2 + hstep, voffB);
            PG8_WAIT_V(6); PG8_BAR; PG8_MMA(1, 1, At, B1); PG8_BAR;
            PG8_LDB(B0, 1, 0); PG8_SCHED; PG8_LDA(At, 1, 0); PG8_STAGE(PG8_SA(0, 1), a2 + hstep, voffA);
            PG8_WAIT_L(8); PG8_BAR; PG8_WAIT_L(0); PG8_MMA(0, 0, At, B0); PG8_BAR; PG8_SCHED;
            PG8_LDB(B1, 1, 1); PG8_STAGE(PG8_SB(1, 0), b3, voffB);
            PG8_BAR; PG8_WAIT_L(0); PG8_MMA(0, 1, At, B1); PG8_BAR;
            PG8_LDA(At, 1, 1); PG8_STAGE(PG8_SA(1, 0), a3, voffA);
            PG8_BAR; PG8_WAIT_L(0); PG8_MMA(1, 0, At, B0); PG8_BAR; PG8_SCHED;
            PG8_STAGE(PG8_SB(1, 1), b3 + hstep, voffB);
            PG8_WAIT_V(6); PG8_BAR; PG8_MMA(1, 1, At, B1); PG8_BAR;
            }
        }
        if constexpr (ALIGN_EPI) { if (wr == 0) PG8_BAR; }
        if constexpr (PRE_OK) { pre = has_next; if (has_next) PG8_STAGE(PG8_SA(1, 1), nA + kstep + hstep, voffA); }
        if constexpr (!Epi::AFTER_DRAIN) { E(acc, cur, wr, wc, fr, fq);
#ifdef PROBE_EPI2
            asm volatile("" ::: "memory"); E(acc, cur, wr, wc, fr, fq);
#endif
            S.done(cur); }
        if (!has_next) break;
#pragma unroll
        for (int a = 0; a < 2; ++a)
#pragma unroll
            for (int b = 0; b < 2; ++b)
#pragma unroll
                for (int m = 0; m < 4; ++m)
#pragma unroll
                    for (int n = 0; n < 2; ++n) acc[a][b][m][n] = (typename Epi::acc_t){0, 0, 0, 0};
        cur = nxt; cA = nA; cB = nB; ++ui;
        if constexpr (ALIGN_EPI) { if (wr == 1) PG8_BAR; }
    }
    PG8_WAIT_V(0);
    if constexpr (!ALIGN_EPI) { if (wr == 0) PG8_BAR; }
    PG8_BAR;
    if constexpr (Epi::AFTER_DRAIN) { E.fused(acc, cur, wr, wc, fr, fq, lds, wid, lane); S.done(cur); }
#undef PG8_SA
#undef PG8_SB
#undef PG8_STAGE
#undef PG8_LDA
#undef PG8_LDB
#undef PG8_MMA
#undef PG8_WAIT_V
#undef PG8_WAIT_VX
#undef PG8_WAIT_L
#undef PG8_BAR
#undef PG8_SCHED
}
}
namespace pg8 {
__device__ __forceinline__ float silu_f(float x) { return x * __builtin_amdgcn_rcpf(1.0f + __builtin_amdgcn_exp2f(-1.44269504f * x)); }
struct EpiSwiGLU {
    static constexpr int NST = 8;
    static constexpr bool PERM = true, AFTER_DRAIN = false, I8 = false; typedef f32x4 acc_t;
    bf16_t* O; int ldc; bf16_t* O2;
    __device__ __forceinline__ void operator()(const f32x4 (&acc)[2][2][4][2], const Unit& u, int wr, int wc, int fr, int fq) const {
        const int row0 = u.pm * BM + wr * 64 + fr; const int col0 = u.pn * HALF + wc * 32 + 8 * fq;
#pragma unroll
        for (int ai = 0; ai < 2; ++ai)
#pragma unroll
            for (int m = 0; m < 4; ++m) { bf16_t* rowp = O + (size_t)(row0 + ai * HALF + m * 16) * ldc + col0;
                const f32x4 g0 = acc[ai][0][m][0], g1 = acc[ai][0][m][1], u0 = acc[ai][1][m][0], u1 = acc[ai][1][m][1];
                u32x4 w; w.x = cvt_pk_bf16(silu_f(g0[0]) * u0[0], silu_f(g0[1]) * u0[1]); w.y = cvt_pk_bf16(silu_f(g0[2]) * u0[2], silu_f(g0[3]) * u0[3]);
                w.z = cvt_pk_bf16(silu_f(g1[0]) * u1[0], silu_f(g1[1]) * u1[1]); w.w = cvt_pk_bf16(silu_f(g1[2]) * u1[2], silu_f(g1[3]) * u1[3]);
                PG8_ST(w, (u32x4*)rowp);
#ifdef PROBE_F1X
                *(u32x4*)(O2 + (size_t)(row0 + ai * HALF + m * 16) * ldc + col0) = w;
#endif
                }
    }
};

struct EpiSwiGLU8 {
    static constexpr int NST = 8;
    static constexpr bool PERM = true, AFTER_DRAIN = false, I8 = true; typedef i32x4 acc_t;
    bf16_t* O; int ldc; const float* rs; float wsc; const PG8_LAS float* rsl = nullptr;
    __device__ __forceinline__ void operator()(const i32x4 (&acc)[2][2][4][2], const Unit& u, int wr, int wc, int fr, int fq) const {
        const int row0 = u.pm * BM + wr * 64 + fr; const int col0 = u.pn * HALF + wc * 32 + 8 * fq;
        float rsv[2][4];
#pragma unroll
        for (int ai = 0; ai < 2; ++ai)
#pragma unroll
            for (int m = 0; m < 4; ++m) rsv[ai][m] = rsl[wr * 64 + fr + ai * HALF + m * 16] * wsc;
#pragma unroll
        for (int ai = 0; ai < 2; ++ai)
#pragma unroll
            for (int m = 0; m < 4; ++m) { bf16_t* rowp = O + (size_t)(row0 + ai * HALF + m * 16) * ldc + col0; const float sc = rsv[ai][m];
                f32x4 g0, g1, u0, u1;
#pragma unroll
                for (int i = 0; i < 4; ++i) { g0[i] = (float)acc[ai][0][m][0][i] * sc; g1[i] = (float)acc[ai][0][m][1][i] * sc; u0[i] = (float)acc[ai][1][m][0][i] * sc; u1[i] = (float)acc[ai][1][m][1][i] * sc; }
                u32x4 w; w.x = cvt_pk_bf16(silu_f(g0[0]) * u0[0], silu_f(g0[1]) * u0[1]); w.y = cvt_pk_bf16(silu_f(g0[2]) * u0[2], silu_f(g0[3]) * u0[3]);
                w.z = cvt_pk_bf16(silu_f(g1[0]) * u1[0], silu_f(g1[1]) * u1[1]); w.w = cvt_pk_bf16(silu_f(g1[2]) * u1[2], silu_f(g1[3]) * u1[3]);
                PG8_ST(w, (u32x4*)rowp); }
    }
};
struct HybridOrder {
    bool panel; StaticOrder so; int q, r, nunits;
    __device__ void init(int M_, int N_, int G_, int bx_, int vcu_, bool panel_) { panel = panel_; so.init(M_, N_, G_, bx_); q = vcu_ >> 5; r = vcu_ & 31; nunits = 4 * (N_ / BM); }
    __device__ bool next(int i, Unit& u) const { if (!panel) return so.next(i, u); const int j = r + 32 * i; if (j >= nunits) return false; u.pm = 4 * q + (j & 3); u.pn = j >> 2; return true; }
    __device__ __forceinline__ void a_ready(const Unit&) const {}
    __device__ __forceinline__ void done(const Unit&) const {}
};
}
#ifdef ROPE_NT
#define PG8_ST_ROPE(v, p) __builtin_nontemporal_store((v), (p))
#else
#define PG8_ST_ROPE(v, p) PG8_ST(v, p)
#endif
namespace pg8 {
template <bool Q> struct EpiRopeT {
    static constexpr int NST = 16;
    static constexpr bool PERM = true, AFTER_DRAIN = false, I8 = Q; typedef typename AccSel<Q>::t acc_t;
    bf16_t* O; int ldc; const float* cosT; const float* sinT; const float* rs = nullptr; float wsc = 1.f; const PG8_LAS float* rsl = nullptr;
    __device__ __forceinline__ void operator()(const acc_t (&acc)[2][2][4][2], const Unit& u, int wr, int wc, int fr, int fq) const {
        const int row0 = u.pm * BM + wr * 64 + fr; const int colt = u.pn * BM; const int col0 = colt + wc * 32 + 8 * fq;
#if QKV_ADJ
        const int jb0 = (colt >> 7) % 3;
        const bool rot = (wc == 0);
        const bool rotb[2] = {rot && jb0 < 2, rot && ((jb0 + 1) % 3) < 2};
#else
        const bool rot = (((colt >> 11) % 3) < 2) && (wc == 0);
        const bool rotb[2] = {rot, rot};
#endif
        const int dd0 = 8 * (fq & 1); const float sgn = (fq < 2) ? -1.0f : 1.0f;
        float rsq[2][4];
        if constexpr (Q) {
#pragma unroll
            for (int ai = 0; ai < 2; ++ai)
#pragma unroll
                for (int m = 0; m < 4; ++m) rsq[ai][m] = rsl[wr * 64 + fr + ai * HALF + m * 16] * wsc; }
#pragma unroll
        for (int ai = 0; ai < 2; ++ai)
#pragma unroll
            for (int m = 0; m < 4; ++m) { const int row = row0 + ai * HALF + m * 16; bf16_t* rowp = O + (size_t)row * ldc + col0;
                f32x4 c0 = (f32x4){1.f, 1.f, 1.f, 1.f}, c1 = c0, s0 = (f32x4){0.f, 0.f, 0.f, 0.f}, s1 = s0;
                if (rot) { const int pos = row & 4095; const f32x4* cp = (const f32x4*)(cosT + pos * 16 + dd0); const f32x4* sp = (const f32x4*)(sinT + pos * 16 + dd0);
                    c0 = cp[0]; c1 = cp[1]; s0 = sp[0] * sgn; s1 = sp[1] * sgn; }
#pragma unroll
                for (int bj = 0; bj < 2; ++bj) { const float qs = Q ? rsq[ai][m] : 1.f; f32x4 v0 = acc_f(acc[ai][bj][m][0], qs), v1 = acc_f(acc[ai][bj][m][1], qs);
                    if (rotb[bj]) { f32x4 p0, p1;
#pragma unroll
                        for (int i = 0; i < 4; ++i) { p0[i] = __shfl_xor(v0[i], 32); p1[i] = __shfl_xor(v1[i], 32); }
                        v0 = v0 * c0 + p0 * s0; v1 = v1 * c1 + p1 * s1; }
                    u32x4 w; w.x = cvt_pk_bf16(v0[0], v0[1]); w.y = cvt_pk_bf16(v0[2], v0[3]); w.z = cvt_pk_bf16(v1[0], v1[1]); w.w = cvt_pk_bf16(v1[2], v1[3]);
                    PG8_ST_ROPE(w, (u32x4*)(rowp + bj * HALF)); } }
    }
};
typedef EpiRopeT<false> EpiRope;
}
#define GAS __attribute__((address_space(1)))
#define LAS __attribute__((address_space(3)))
typedef unsigned short bf16;
typedef unsigned v4u __attribute__((ext_vector_type(4)));
typedef float f32x4 __attribute__((ext_vector_type(4)));
typedef short bf16x8 __attribute__((ext_vector_type(8)));
typedef GAS unsigned gu32;
typedef GAS unsigned long long gu64;
#define RLX_AGENT __ATOMIC_RELAXED, __HIP_MEMORY_SCOPE_AGENT
#define LDS_WAIT() asm volatile("s_waitcnt lgkmcnt(0)" ::: "memory")
#define VM_WAIT() asm volatile("s_waitcnt vmcnt(0)" ::: "memory")
__device__ __forceinline__ unsigned long long rt() { return __builtin_amdgcn_s_memrealtime(); }
__device__ __forceinline__ unsigned f2bf(float f) { unsigned u = __builtin_bit_cast(unsigned, f); return (u + 0x7fffu + ((u >> 16) & 1u)) >> 16; }
__device__ __forceinline__ unsigned pk2(float lo, float hi) { return f2bf(lo) | (f2bf(hi) << 16); }

#define XB_TMO      128
#define XB_XCNT(j)  (256  + 64 * (j))
#define XB_XSUB(j)  (1280 + 64 * (j))
#define XB_XGEN(j)  (2304 + 64 * (j))
#define XB_TOP      3328
#define XB_TOPGEN   3392
#define XCD_BAR_WORDS 3456
#define XB_SPIN_CAP (1u << 18)

__device__ __forceinline__ unsigned xb_ld(unsigned* p)              { return __hip_atomic_load(p, __ATOMIC_RELAXED, __HIP_MEMORY_SCOPE_AGENT); }
__device__ __forceinline__ unsigned xb_add(unsigned* p, unsigned v) { return __hip_atomic_fetch_add(p, v, __ATOMIC_RELAXED, __HIP_MEMORY_SCOPE_AGENT); }
__device__ __forceinline__ unsigned xb_xcc_id() { return (unsigned)__builtin_amdgcn_s_getreg((3 << 11) | 20) & 0xFu; }
#define XB_SPIN(cond, bar) do { unsigned _sp = 0; while (cond) { __builtin_amdgcn_s_sleep(1); \
    if ((++_sp & 255u) == 0u) { if (xb_ld(&(bar)[XB_TMO])) break; if (_sp > XB_SPIN_CAP) { atomicAdd(&(bar)[XB_TMO], 1u); break; } } } } while (0)

struct XcdBarrier {
    unsigned* bar; unsigned x;
    volatile LAS unsigned* st;
};

__device__ __forceinline__ XcdBarrier xcd_barrier_post(unsigned* bar, volatile LAS unsigned* st) {
    XcdBarrier b; b.bar = bar; b.x = xb_xcc_id(); b.st = st;
    if (threadIdx.x == 0) (void)xb_add(&bar[XB_XCNT(b.x)], 1u);
    return b;
}
__device__ __forceinline__ void xcd_barrier_complete(unsigned* bar, unsigned x, unsigned& nloc, unsigned& nx) {
    const unsigned G = gridDim.x * gridDim.y * gridDim.z;
    unsigned sum, cnt, mine, sp = 0u;
    for (;;) {
        sum = 0u; cnt = 0u; mine = 0u;
#pragma unroll
        for (unsigned j = 0; j < 16; ++j) { const unsigned c = xb_ld(&bar[XB_XCNT(j)]); sum += c; cnt += (c > 0u) ? 1u : 0u; mine = (j == x) ? c : mine; }
        if (sum == G) break;
        __builtin_amdgcn_s_sleep(1);
        if ((++sp & 255u) == 0u) { if (xb_ld(&bar[XB_TMO])) break; if (sp > XB_SPIN_CAP) { atomicAdd(&bar[XB_TMO], 1u); break; } }
    }
    nloc = mine > 0u ? mine : 1u; nx = cnt > 0u ? cnt : 1u;
}

__device__ __forceinline__ void xcd_barrier(const XcdBarrier& b) {
    asm volatile("s_waitcnt vmcnt(0)" ::: "memory");
    __syncthreads();
    if (threadIdx.x == 0) {
        unsigned* bar = b.bar;
        __builtin_amdgcn_s_waitcnt(0);
        unsigned nloc = b.st[0], nx = b.st[1];
        if (nloc == 0u) { xcd_barrier_complete(bar, b.x, nloc, nx); b.st[0] = nloc; b.st[1] = nx; }
        const unsigned old = xb_add(&bar[XB_XSUB(b.x)], 1u);
        const unsigned gen = old / nloc;
        if (old + 1u == (gen + 1u) * nloc) {
#ifndef PROBE_NO_WBL2
            __builtin_amdgcn_fence(__ATOMIC_RELEASE, "agent");
#endif
            asm volatile("s_waitcnt vmcnt(0)" ::: "memory");
            const unsigned og = xb_add(&bar[XB_TOP], 1u);
            const unsigned tg = og / nx;
            if (og + 1u == (tg + 1u) * nx) xb_add(&bar[XB_TOPGEN], 1u);
            else XB_SPIN(xb_ld(&bar[XB_TOPGEN]) == tg, bar);
            __builtin_amdgcn_fence(__ATOMIC_ACQUIRE, "agent");
            xb_add(&bar[XB_XGEN(b.x)], 1u);
            asm volatile("s_waitcnt vmcnt(0)" ::: "memory");
        } else {
            XB_SPIN(xb_ld(&bar[XB_XGEN(b.x)]) == gen, bar);
            __builtin_amdgcn_fence(__ATOMIC_ACQUIRE, "agent");
            asm volatile("s_waitcnt vmcnt(0)" ::: "memory");
        }
    }
    __syncthreads();
}

#define XB_LSUB(j)  (12288 + 64 * (j))
#define XB_LGEN(j)  (13312 + 64 * (j))
__device__ __forceinline__ void xcd_local_barrier(const XcdBarrier& b) {
    asm volatile("s_waitcnt vmcnt(0)" ::: "memory");
    __syncthreads();
    if (threadIdx.x == 0) {
        unsigned* bar = b.bar;
        __builtin_amdgcn_s_waitcnt(0);
        const unsigned nloc = b.st[0];
        const unsigned old = xb_add(&bar[XB_LSUB(b.x)], 1u);
        const unsigned gen = old / nloc;
        if (old + 1u == (gen + 1u) * nloc) xb_add(&bar[XB_LGEN(b.x)], 1u);
        else XB_SPIN(xb_ld(&bar[XB_LGEN(b.x)]) == gen, bar);
        __builtin_amdgcn_fence(__ATOMIC_ACQUIRE, "agent");
        asm volatile("s_waitcnt vmcnt(0)" ::: "memory");
    }
    __syncthreads();
}

constexpr int NWAVES = 8, NTHREADS = 512;
constexpr int BATCH = 2, SEQ = 4096, D = 2048, M = BATCH * SEQ, DEPTH = 4, NH = 16, HD = 128;
constexpr int HGRN_N = 5 * D, ATTN_N = 9 * D, DFF = 5632, FFN_N = 2 * DFF;
constexpr float EPS = 1e-6f;
constexpr int NPHASES = 1 + 9 * DEPTH;
#ifndef TAIL_ALL
#define TAIL_ALL 0
#endif
#ifndef TAIL_WO
#define TAIL_WO 0
#endif
#ifndef TAIL_SPLIT
#define TAIL_SPLIT 75
#endif
#ifndef TAIL_F2_PCT
#define TAIL_F2_PCT 100
#endif
#ifndef MIXMAP
#define MIXMAP vcu
#endif
#ifndef INP_ALIGN
#define INP_ALIGN true
#endif
#ifndef ONE_ALIGN
#define ONE_ALIGN true
#endif
#ifndef ATTN_SECT
#define ATTN_SECT 0
#endif
#ifndef F1_I8
#define F1_I8 0xE
#endif
#define F1Q(L_) (Q8OK && (((F1_I8) >> (L_)) & 1))
#ifndef I8_IN
#define I8_IN 0xC
#endif
#ifndef I8_WO
#define I8_WO 0x0
#endif
#define INQ(L_) (Q8OK && (((I8_IN) >> (L_)) & 1))
#define WOQ(L_) (Q8OK && (((I8_WO) >> (L_)) & 1))
#ifndef W8_CLIP
#define W8_CLIP 3.7f
#endif
#ifndef XCD_LOCAL_BAR
#define XCD_LOCAL_BAR 1
#endif
#ifndef PANEL_MODE
#define PANEL_MODE 1
#endif
#ifndef CVT_IN_SCAN
#define CVT_IN_SCAN 0
#endif
#ifndef GEMM_SP2
#define GEMM_SP2 true
#endif
#ifndef XCC_TRUE_MAP
#define XCC_TRUE_MAP 1
#endif
#define ATT_MODE (QKV_ADJ ? 2 : 0)
#ifndef REP_PRO
#define REP_PRO 1
#endif
#ifndef REP_INH
#define REP_INH 1
#endif
#ifndef REP_INA_COLD
#define REP_INA_COLD 0
#endif
#ifndef REP_INA
#define REP_INA 1
#endif
#ifndef REP_WO
#define REP_WO 1
#endif
#ifndef REP_F1
#define REP_F1 1
#endif
#ifndef REP_F2
#define REP_F2 1
#endif
#ifndef REP_GATES
#define REP_GATES 1
#endif
#ifndef REP_SCAN
#define REP_SCAN 1
#endif
#ifndef REP_ATTN
#define REP_ATTN 1
#endif
#ifndef REP_FIN
#define REP_FIN 1
#endif
#ifndef REP_NORM
#define REP_NORM 1
#endif

static_assert(TAIL_ALL == 0 && TAIL_WO == 0, "the in-phase conversion only takes the FFN weights");
constexpr size_t MiB = 1u << 20;
constexpr size_t WS_CTL = 0, CTL_ZERO_BYTES = 1 * MiB;
constexpr size_t WS_TAB = 1 * MiB;
constexpr size_t TAB_COS = 0, TAB_SIN = 262144, TAB_LB = 524288, TAB_RSA = 655360;
constexpr size_t CTL_WSTAT = 131072;
constexpr int WSTAT_PER_THREAD = 4;
constexpr size_t TAB_RSO = 688128;

constexpr size_t WS_WHG = 2 * MiB;
constexpr size_t WS_WAT = 82 * MiB;
constexpr size_t WS_WO = 226 * MiB;
constexpr size_t WS_WF1 = 258 * MiB;
constexpr size_t WS_WF2 = 434 * MiB;
constexpr size_t WS_H = 522 * MiB;
constexpr size_t WS_PROJ = 554 * MiB;
constexpr size_t WS_MIX = 842 * MiB;
constexpr size_t WS_O = 942 * MiB;
constexpr size_t WS_G = 974 * MiB;
constexpr size_t WS_KH = 1006 * MiB;
constexpr size_t WS_H8 = 1076 * MiB;
constexpr size_t WS_END = 1092 * MiB;
constexpr int CW_BAR = 4096, CW_TICK = 8192;

constexpr int RING_BYTES = 147456;
constexpr int LDSCTL_OFF = RING_BYTES, MISC_OFF = LDSCTL_OFF + 320;
constexpr int LDS_BYTES = 163840;

__device__ __forceinline__ float bf2f(unsigned short b) { return __builtin_bit_cast(float, (unsigned)b << 16); }
__device__ __forceinline__ float bflo(unsigned w) { return __builtin_bit_cast(float, w << 16); }
__device__ __forceinline__ float bfhi(unsigned w) { return __builtin_bit_cast(float, w & 0xffff0000u); }
__device__ __forceinline__ float wave_sum(float v) {
#pragma unroll
    for (int o = 1; o < 64; o <<= 1) v += __shfl_xor(v, o);
    return v;
}
__device__ __forceinline__ float sigmoid_f(float x) { return __builtin_amdgcn_rcpf(1.0f + __builtin_amdgcn_exp2f(-1.44269504f * x)); }

__device__ __forceinline__ unsigned q8x4(float a, float b, float c, float d) {
    const int ia = (int)__builtin_rintf(fminf(fmaxf(a, -127.f), 127.f)), ib = (int)__builtin_rintf(fminf(fmaxf(b, -127.f), 127.f)), ic = (int)__builtin_rintf(fminf(fmaxf(c, -127.f), 127.f)), id = (int)__builtin_rintf(fminf(fmaxf(d, -127.f), 127.f));
    return (unsigned)(ia & 255) | ((unsigned)(ib & 255) << 8) | ((unsigned)(ic & 255) << 16) | ((unsigned)(id & 255) << 24);
}
typedef unsigned v2u __attribute__((ext_vector_type(2)));
__device__ __forceinline__ void transpose_item(const float* W, int K, int N, bf16* WT, int k0, int n0, int drow0, LAS float* scr, int lane, float q8) {
    float ld[32];
#pragma unroll
    for (int i = 0; i < 32; ++i) { const int kk = 2 * i + (lane >> 5); ld[i] = W[(size_t)(k0 + kk) * N + n0 + (lane & 31)]; }
#pragma unroll
    for (int i = 0; i < 32; ++i) { const int kk = 2 * i + (lane >> 5); scr[kk * 33 + (lane & 31)] = ld[i]; }
    LDS_WAIT(); asm volatile("" ::: "memory");
    const int c = lane & 7;
#pragma unroll
    for (int j = 0; j < 4; ++j) { const int n = (lane >> 3) + 8 * j; const LAS float* s = scr + (8 * c) * 33 + n;
        if (q8 != 0.f) { v2u o; o.x = q8x4(s[0 * 33] * q8, s[1 * 33] * q8, s[2 * 33] * q8, s[3 * 33] * q8); o.y = q8x4(s[4 * 33] * q8, s[5 * 33] * q8, s[6 * 33] * q8, s[7 * 33] * q8);
            *(GAS v2u*)((signed char*)WT + (size_t)(drow0 + n) * K + k0 + 8 * c) = o; }
        else { v4u o; o.x = pk2(s[0 * 33], s[1 * 33]); o.y = pk2(s[2 * 33], s[3 * 33]); o.z = pk2(s[4 * 33], s[5 * 33]); o.w = pk2(s[6 * 33], s[7 * 33]);
            *(GAS v4u*)(WT + (size_t)(drow0 + n) * K + k0 + 8 * c) = o; } }
    LDS_WAIT(); asm volatile("" ::: "memory");
}
__device__ __forceinline__ void transpose_matrix(const float* W, int K, int N, bf16* WT, int mode, LAS float* scr, int gw, int NGW, int lane, int pct0 = 0, int pct1 = 100, float q8 = 0.f) {
    const int nblk = N / 32, nitems = (K / 64) * nblk; const int it0 = (int)((long)nitems * pct0 / 100), it1 = (int)((long)nitems * pct1 / 100);
    for (int it = it0 + gw; it < it1; it += NGW) {
        const int kb = it / nblk, nb = it - kb * nblk, n0 = 32 * nb;
        int drow0 = n0;
        if (mode == 1) { const int up = n0 >= DFF, nn = up ? n0 - DFF : n0; drow0 = (nn >> 7) * 256 + (up ? 128 : 0) + (nn & 127); }
        if (mode == 2) { const int blk = n0 >> 7, gg = blk / 48, jj = (blk >> 4) % 3, hh = blk & 15; drow0 = ((gg * 16 + hh) * 3 + jj) * 128 + (n0 & 127); }
        transpose_item(W, K, N, WT, 64 * kb, n0, drow0, scr, lane, q8);
    }
}

#ifdef THIN_WT
#define THIN_XSTR(x) #x
#define THIN_STR(x) THIN_XSTR(x)
#define THIN_ST16(p, v) asm volatile("global_store_dwordx4 %0, %1, off " THIN_STR(THIN_WT) "\n\ts_nop 2" :: "v"((const void*)(p)), "v"(v) : "memory")
#else
#define THIN_ST16(p, v) (*(GAS v4u*)(p) = (v))
#endif
__device__ __forceinline__ int rowmap(int v, bool panel) { return panel ? (((v & 2047) >> 8) << 10) + (v & 255) + ((v >> 11) << 8) : v; }
template <bool RES, bool NORM2, bool XI16, bool XO16, bool H8 = false>
__device__ __forceinline__ void norm_rows(const bf16* gin, const void* x_in, void* x_out, const float* w1, const float* w2, bf16* hout, int gw, int NGW, int lane, bool panel, float* rsout = nullptr) {
    for (int m0 = gw; m0 < M; m0 += 2 * NGW) {
        v4u xq[2][4]; f32x4 xa[2][4], xb[2][4]; v4u gq[2][4];
#pragma unroll
        for (int rr = 0; rr < 2; ++rr) { const int mv = m0 + rr * NGW; const int m = rowmap(mv, panel);
            if (mv < M) {
#pragma unroll
                for (int j = 0; j < 4; ++j) {
                    if (XI16) xq[rr][j] = *(const GAS v4u*)((const bf16*)x_in + (size_t)m * D + 8 * (64 * j + lane));
                    else { const GAS f32x4* xp = (const GAS f32x4*)((const float*)x_in + (size_t)m * D + 8 * (64 * j + lane)); xa[rr][j] = xp[0]; xb[rr][j] = xp[1]; }
                    if (RES) gq[rr][j] = *(const GAS v4u*)(gin + (size_t)m * D + 8 * (64 * j + lane)); } } }
#pragma unroll
        for (int rr = 0; rr < 2; ++rr) { const int mv = m0 + rr * NGW; const int m = rowmap(mv, panel);
            if (mv < M) {
                float xv[4][8];
#pragma unroll
                for (int j = 0; j < 4; ++j) {
                    if (XI16) { const v4u g = xq[rr][j];
                        xv[j][0] = bflo(g.x); xv[j][1] = bfhi(g.x); xv[j][2] = bflo(g.y); xv[j][3] = bfhi(g.y); xv[j][4] = bflo(g.z); xv[j][5] = bfhi(g.z); xv[j][6] = bflo(g.w); xv[j][7] = bfhi(g.w); }
                    else { const f32x4 a = xa[rr][j], b = xb[rr][j]; xv[j][0] = a.x; xv[j][1] = a.y; xv[j][2] = a.z; xv[j][3] = a.w; xv[j][4] = b.x; xv[j][5] = b.y; xv[j][6] = b.z; xv[j][7] = b.w; } }
                if (RES) {
                    float gv[4][8]; float ss = 0.f;
#pragma unroll
                    for (int j = 0; j < 4; ++j) { const v4u g = gq[rr][j];
                        gv[j][0] = bflo(g.x); gv[j][1] = bfhi(g.x); gv[j][2] = bflo(g.y); gv[j][3] = bfhi(g.y); gv[j][4] = bflo(g.z); gv[j][5] = bfhi(g.z); gv[j][6] = bflo(g.w); gv[j][7] = bfhi(g.w);
#pragma unroll
                        for (int i = 0; i < 8; ++i) ss += gv[j][i] * gv[j][i]; }
                    const float r1 = 1.0f / sqrtf(wave_sum(ss) * (1.0f / D) + EPS);
#pragma unroll
                    for (int j = 0; j < 4; ++j) { const GAS f32x4* wp = (const GAS f32x4*)(w1 + 8 * (64 * j + lane)); const f32x4 a = wp[0], b = wp[1];
                        const float wv[8] = {a.x, a.y, a.z, a.w, b.x, b.y, b.z, b.w};
#pragma unroll
                        for (int i = 0; i < 8; ++i) xv[j][i] += gv[j][i] * r1 * wv[i];
                        if (XO16) { v4u o; o.x = pk2(xv[j][0], xv[j][1]); o.y = pk2(xv[j][2], xv[j][3]); o.z = pk2(xv[j][4], xv[j][5]); o.w = pk2(xv[j][6], xv[j][7]);
                            THIN_ST16((bf16*)x_out + (size_t)m * D + 8 * (64 * j + lane), o); }
                        else { GAS f32x4* op = (GAS f32x4*)((float*)x_out + (size_t)m * D + 8 * (64 * j + lane));
                            op[0] = (f32x4){xv[j][0], xv[j][1], xv[j][2], xv[j][3]}; op[1] = (f32x4){xv[j][4], xv[j][5], xv[j][6], xv[j][7]}; } }
                }
                if (NORM2) {
                    float ss = 0.f;
#pragma unroll
                    for (int j = 0; j < 4; ++j)
#pragma unroll
                        for (int i = 0; i < 8; ++i) ss += xv[j][i] * xv[j][i];
                    const float r2 = 1.0f / sqrtf(wave_sum(ss) * (1.0f / D) + EPS);
                    if constexpr (H8) {
                        float am = 0.f;
#pragma unroll
                        for (int j = 0; j < 4; ++j) { const GAS f32x4* wp = (const GAS f32x4*)(w2 + 8 * (64 * j + lane)); const f32x4 a = wp[0], b = wp[1]; const float wv[8] = {a.x, a.y, a.z, a.w, b.x, b.y, b.z, b.w};
#pragma unroll
                            for (int i = 0; i < 8; ++i) { xv[j][i] = xv[j][i] * r2 * wv[i]; am = fmaxf(am, fabsf(xv[j][i])); } }
#pragma unroll
                        for (int o = 1; o < 64; o <<= 1) am = fmaxf(am, __shfl_xor(am, o));
                        am = fmaxf(am, 1e-20f); const float qi = 127.0f / am;
#pragma unroll
                        for (int j = 0; j < 4; ++j) { v2u o; o.x = q8x4(xv[j][0] * qi, xv[j][1] * qi, xv[j][2] * qi, xv[j][3] * qi); o.y = q8x4(xv[j][4] * qi, xv[j][5] * qi, xv[j][6] * qi, xv[j][7] * qi);
                            *(GAS v2u*)((signed char*)hout + (size_t)m * D + 8 * (64 * j + lane)) = o; }
                        if (lane == 0) rsout[m] = am * (1.0f / 127.0f);
                    } else {
#pragma unroll
                    for (int j = 0; j < 4; ++j) { const GAS f32x4* wp = (const GAS f32x4*)(w2 + 8 * (64 * j + lane)); const f32x4 a = wp[0], b = wp[1];
                        v4u o; o.x = pk2(xv[j][0] * r2 * a.x, xv[j][1] * r2 * a.y); o.y = pk2(xv[j][2] * r2 * a.z, xv[j][3] * r2 * a.w);
                        o.z = pk2(xv[j][4] * r2 * b.x, xv[j][5] * r2 * b.y); o.w = pk2(xv[j][6] * r2 * b.z, xv[j][7] * r2 * b.w);
                        THIN_ST16(hout + (size_t)m * D + 8 * (64 * j + lane), o); }
                    }
                }
            } }
    }
}

__device__ __forceinline__ void store_row_q8(const float (&v)[4][8], signed char* rowp, float* rsp, int lane) {
    float am = 0.f;
#pragma unroll
    for (int j = 0; j < 4; ++j)
#pragma unroll
        for (int i = 0; i < 8; ++i) am = fmaxf(am, fabsf(v[j][i]));
#pragma unroll
    for (int o = 1; o < 64; o <<= 1) am = fmaxf(am, __shfl_xor(am, o));
    am = fmaxf(am, 1e-20f); const float qi = 127.0f / am;
#pragma unroll
    for (int j = 0; j < 4; ++j) { v2u o; o.x = q8x4(v[j][0] * qi, v[j][1] * qi, v[j][2] * qi, v[j][3] * qi); o.y = q8x4(v[j][4] * qi, v[j][5] * qi, v[j][6] * qi, v[j][7] * qi);
        *(GAS v2u*)(rowp + 8 * (64 * j + lane)) = o; }
    if (lane == 0) *rsp = am * (1.0f / 127.0f);
}
template <bool O8>
__device__ __forceinline__ void hgrn_finalize(const bf16* P, const bf16* OD, const float* gnorm, bf16* O, int gw, int NGW, int lane, bool panel, float* rsout) {
    for (int m0 = gw; m0 < M; m0 += 2 * NGW) {
        v4u a[2][4], b[2][4], g[2][4];
#pragma unroll
        for (int rr = 0; rr < 2; ++rr) { const int mv = m0 + rr * NGW; const int m = rowmap(mv, panel);
            if (mv < M) {
#pragma unroll
                for (int j = 0; j < 4; ++j) { const int e0 = 8 * (64 * j + lane);
                    a[rr][j] = *(const GAS v4u*)(OD + (size_t)m * D + e0); b[rr][j] = *(const GAS v4u*)(OD + (size_t)M * D + (size_t)m * D + e0);
                    g[rr][j] = *(const GAS v4u*)(P + (size_t)m * HGRN_N + 4 * D + e0); } } }
        f32x4 wa[4], wb[4];
#pragma unroll
        for (int j = 0; j < 4; ++j) { const GAS f32x4* wp = (const GAS f32x4*)(gnorm + ((8 * (64 * j + lane)) & 127)); wa[j] = wp[0]; wb[j] = wp[1]; }
#pragma unroll
        for (int rr = 0; rr < 2; ++rr) { const int mv = m0 + rr * NGW; const int m = rowmap(mv, panel);
            if (mv < M) {
                float ov[4][8];
#pragma unroll
                for (int j = 0; j < 4; ++j) { const int e0 = 8 * (64 * j + lane); const v4u A = a[rr][j], B = b[rr][j], Gv = g[rr][j];
                    float s[8] = {bflo(A.x) + bflo(B.x), bfhi(A.x) + bfhi(B.x), bflo(A.y) + bflo(B.y), bfhi(A.y) + bfhi(B.y), bflo(A.z) + bflo(B.z), bfhi(A.z) + bfhi(B.z), bflo(A.w) + bflo(B.w), bfhi(A.w) + bfhi(B.w)};
                    const float gv[8] = {bflo(Gv.x), bfhi(Gv.x), bflo(Gv.y), bfhi(Gv.y), bflo(Gv.z), bfhi(Gv.z), bflo(Gv.w), bfhi(Gv.w)};
                    float ss = 0.f;
#pragma unroll
                    for (int i = 0; i < 8; ++i) ss += s[i] * s[i];
                    ss += __shfl_xor(ss, 1); ss += __shfl_xor(ss, 2); ss += __shfl_xor(ss, 4); ss += __shfl_xor(ss, 8);
                    const float r = 1.0f / sqrtf(ss * (1.0f / HD) + EPS);
                    const float wv[8] = {wa[j].x, wa[j].y, wa[j].z, wa[j].w, wb[j].x, wb[j].y, wb[j].z, wb[j].w};
                    float o[8];
#pragma unroll
                    for (int i = 0; i < 8; ++i) o[i] = s[i] * r * wv[i] * (gv[i] * sigmoid_f(gv[i]));
                    if constexpr (O8) {
#pragma unroll
                        for (int i = 0; i < 8; ++i) ov[j][i] = o[i]; }
                    else { v4u w; w.x = pk2(o[0], o[1]); w.y = pk2(o[2], o[3]); w.z = pk2(o[4], o[5]); w.w = pk2(o[6], o[7]);
                        THIN_ST16(O + (size_t)m * D + e0, w); } }
                if constexpr (O8) store_row_q8(ov, (signed char*)O + (size_t)m * D, rsout + m, lane); else (void)ov; } }
    }
}

template <bool O8>
__device__ __forceinline__ void attn_finalize(const bf16* OG, const float* LSE, bf16* O, int gw, int NGW, int lane, bool panel, float* rsout) {
    for (int m0 = gw; m0 < M; m0 += 2 * NGW) {
        v4u a[2][4], b[2][4], c[2][4]; float l0[2][4], l1[2][4], l2[2][4];
#pragma unroll
        for (int rr = 0; rr < 2; ++rr) { const int mv = m0 + rr * NGW; const int m = rowmap(mv, panel);
            if (mv < M) {
#pragma unroll
                for (int j = 0; j < 4; ++j) { const int e0 = 8 * (64 * j + lane), hh = e0 >> 7;
                    l0[rr][j] = LSE[((size_t)0 * M + m) * NH + hh]; l1[rr][j] = LSE[((size_t)1 * M + m) * NH + hh]; l2[rr][j] = LSE[((size_t)2 * M + m) * NH + hh];
                    a[rr][j] = *(const GAS v4u*)(OG + ((size_t)0 * M + m) * D + e0); b[rr][j] = *(const GAS v4u*)(OG + ((size_t)1 * M + m) * D + e0); c[rr][j] = *(const GAS v4u*)(OG + ((size_t)2 * M + m) * D + e0); } } }
#pragma unroll
        for (int rr = 0; rr < 2; ++rr) { const int mv = m0 + rr * NGW; const int m = rowmap(mv, panel);
            if (mv < M) {
                float ov[4][8];
#pragma unroll
                for (int j = 0; j < 4; ++j) { const int e0 = 8 * (64 * j + lane); const v4u A = a[rr][j], B = b[rr][j], C = c[rr][j];
                    const float mx = fmaxf(l0[rr][j], fmaxf(l1[rr][j], l2[rr][j])); float w0 = __expf(l0[rr][j] - mx), w1 = __expf(l1[rr][j] - mx), w2 = __expf(l2[rr][j] - mx);
                    const float inv = 1.0f / (w0 + w1 + w2); w0 *= inv; w1 *= inv; w2 *= inv;
                    const float o[8] = {w0 * bflo(A.x) + w1 * bflo(B.x) + w2 * bflo(C.x), w0 * bfhi(A.x) + w1 * bfhi(B.x) + w2 * bfhi(C.x), w0 * bflo(A.y) + w1 * bflo(B.y) + w2 * bflo(C.y), w0 * bfhi(A.y) + w1 * bfhi(B.y) + w2 * bfhi(C.y),
                                        w0 * bflo(A.z) + w1 * bflo(B.z) + w2 * bflo(C.z), w0 * bfhi(A.z) + w1 * bfhi(B.z) + w2 * bfhi(C.z), w0 * bflo(A.w) + w1 * bflo(B.w) + w2 * bflo(C.w), w0 * bfhi(A.w) + w1 * bfhi(B.w) + w2 * bfhi(C.w)};
                    if constexpr (O8) {
#pragma unroll
                        for (int i = 0; i < 8; ++i) ov[j][i] = o[i]; }
                    else { v4u w; w.x = pk2(o[0], o[1]); w.y = pk2(o[2], o[3]); w.z = pk2(o[4], o[5]); w.w = pk2(o[6], o[7]);
                        THIN_ST16(O + (size_t)m * D + e0, w); } }
                if constexpr (O8) store_row_q8(ov, (signed char*)O + (size_t)m * D, rsout + m, lane); else (void)ov; } }
    }
}

typedef short s16x4 __attribute__((ext_vector_type(4)));
typedef short v4i16_t __attribute__((ext_vector_type(4)));
typedef unsigned v2u __attribute__((ext_vector_type(2)));
__device__ __forceinline__ void glds16(const void* gsrc, unsigned lds_dst) { unsigned keep;
    asm volatile("s_mov_b32 %0, m0\n\ts_mov_b32 m0, %2\n\ts_nop 0\n\tglobal_load_lds_dwordx4 %1, off\n\ts_mov_b32 m0, %0" : "=&s"(keep) : "v"(gsrc), "s"(lds_dst) : "memory"); }
__device__ __forceinline__ s16x4 tr_read(LAS const unsigned char* p) { return __builtin_bit_cast(s16x4, __builtin_amdgcn_ds_read_tr16_b64_v4i16((LAS v4i16_t*)p)); }
__device__ __forceinline__ bf16x8 cat44(s16x4 a, s16x4 b) { return (bf16x8){a[0], a[1], a[2], a[3], b[0], b[1], b[2], b[3]}; }
#ifdef PROBE_ADMA2
#define AT_VW "s_waitcnt vmcnt(22)"
#else
#define AT_VW "s_waitcnt vmcnt(13)"
#endif
__device__ __forceinline__ void glds16s_1(const void* sbase, unsigned voff, unsigned lds_dst) { unsigned keep;
    asm volatile("s_mov_b32 %0, m0\n\ts_mov_b32 m0, %3\n\ts_nop 0\n\tglobal_load_lds_dwordx4 %1, %2\n\ts_mov_b32 m0, %0" : "=&s"(keep) : "v"(voff), "s"(sbase), "s"(lds_dst) : "memory"); }
__device__ __forceinline__ void glds16s(const void* sbase, unsigned voff, unsigned lds_dst) { glds16s_1(sbase, voff, lds_dst);
#ifdef PROBE_ADMA2
    glds16s_1(sbase, voff, lds_dst);
#endif
}
__device__ __forceinline__ void glds16m(const void* sbase, unsigned voff, unsigned lds_dst) {
    asm volatile("s_mov_b32 m0, %2\n\ts_nop 0\n\tglobal_load_lds_dwordx4 %0, %1" :: "v"(voff), "s"(sbase), "s"(lds_dst) : "memory", "m0"); }
__device__ __forceinline__ bf16x8 gload16s(const void* sbase, unsigned voff) { return *(const GAS bf16x8*)((const unsigned char*)sbase + voff); }
__device__ __forceinline__ void attn_core_mfma(LAS unsigned char* lds, const bf16* P, bf16* OG, float* LSE, int vcu, int G, int gsel) {
    const int NU = (gsel >= 0) ? 1024 : 3072;
    int tid_l = threadIdx.x; asm volatile("" : "+v"(tid_l));
    const int tid = tid_l, lane = tid & 63, w = __builtin_amdgcn_readfirstlane(tid >> 6), fr = lane & 15, q4 = lane >> 4;
    const float sc2 = 0.08838834764831845f * 1.44269504f;
    constexpr int RST = 288, K_OFF = 0, V_OFF = 73728;
    const bool ucons = (NU % G) == 0; const int USTEP = ucons ? 1 : G, UID0 = ucons ? vcu * (NU / G) : vcu;
    const int NUN = ucons ? NU / G : (vcu < NU ? (NU - vcu + G - 1) / G : 0);
#define AT_SCHED __builtin_amdgcn_sched_barrier(0)
#define AT_DECODE(uid_) const int bi = (uid_) & 31, bhg = (uid_) >> 5, g = (gsel >= 0) ? gsel : bhg % 3, bh = (gsel >= 0) ? bhg : bhg / 3, hh = bh & 15, b = bh >> 4; \
        const int rsh = 2 * g, nbs = 5 - rsh, rho = bi >> nbs, blk = bi & ((1 << nbs) - 1), L = SEQ >> rsh, u0 = blk * 128; \
        const bf16* Qb = P + (size_t)b * SEQ * ATTN_N + (QKV_ADJ ? ((g * NH + hh) * 3) * HD : ((g * 3 + 0) * NH + hh) * HD); const bf16* Kb = Qb + (QKV_ADJ ? HD : NH * HD); const bf16* Vb = Kb + (QKV_ADJ ? HD : NH * HD); \
        (void)L; (void)Qb; (void)Kb; (void)Vb; (void)u0; (void)rho;
    if (w >= 4) {
        const int lw = w - 4;
        int prow[9], pchb[9];
#pragma unroll
        for (int i = 0; i < 9; ++i) { const int sl = (lw + 4 * i) * 64 + lane; prow[i] = sl / 18; const int ch = sl - prow[i] * 18; pchb[i] = (ch < 16 ? ch : 0) * 16; }
#define AT_ROWOFF(i_, h_) ({ int uk_ = u0 - 64 + 128 * (h_) + prow[i_]; uk_ = uk_ < 0 ? 0 : (uk_ >= L ? L - 1 : uk_); const unsigned x_ = (unsigned)((uk_ << rsh) + rho); (((x_ << 3) + x_) << 12) + (unsigned)pchb[i_]; })
#define AT_PREP() do { _Pragma("unroll") for (int i_ = 0; i_ < 9; ++i_) { of0[i_] = AT_ROWOFF(i_, 0); of1[i_] = AT_ROWOFF(i_, 1); } } while (0)
#define AT_GO(base_, off_, cont_, par_) do { \
            if (!(cont_)) { _Pragma("unroll") for (int i_ = 0; i_ < 9; ++i_) glds16m(base_, of0[i_], (unsigned)(size_t)(lds + (off_) + ((par_) & 1) * 36864 + (lw + 4 * i_) * 1024)); } \
            _Pragma("unroll") for (int i_ = 0; i_ < 9; ++i_) glds16m(base_, of1[i_], (unsigned)(size_t)(lds + (off_) + (((par_) + 1) & 1) * 36864 + (lw + 4 * i_) * 1024)); } while (0)
#define AT_WAITN(n9_) do { if (n9_) asm volatile("s_waitcnt vmcnt(9)" ::: "memory"); else asm volatile("s_waitcnt vmcnt(18)" ::: "memory"); } while (0)
        unsigned of0[9], of1[9];
        int uid = UID0; int par = 0; bool cont = false;
        const bf16* nKb = P; const bf16* nVb = P;
        if (uid < NU) { AT_DECODE(uid) AT_PREP(); AT_GO(Kb, K_OFF, false, 0); AT_GO(Vb, V_OFF, false, 0); }
        for (int un = 0; un < NUN; ++un, uid += USTEP) {
            const int nuid = (un + 1 < NUN) ? uid + USTEP : NU;
            bool ncont = false; int npar = 0;
            if (nuid < NU) { AT_DECODE(nuid) ncont = ucons && blk != 0; npar = ncont ? (par ^ 1) : 0; nKb = Kb; nVb = Vb; AT_PREP(); }
            AT_WAITN(cont);
            __builtin_amdgcn_s_barrier(); asm volatile("" ::: "memory");
            __builtin_amdgcn_s_barrier(); asm volatile("" ::: "memory");
            if (nuid < NU) { AT_GO(nKb, K_OFF, ncont, npar); AT_WAITN(ncont); }
            else asm volatile("s_waitcnt vmcnt(0)" ::: "memory");
            __builtin_amdgcn_s_barrier(); asm volatile("" ::: "memory");
            __builtin_amdgcn_s_barrier(); asm volatile("" ::: "memory");
            if (nuid < NU) { AT_GO(nVb, V_OFF, ncont, npar); }
            cont = ncont; par = npar;
        }
#undef AT_WAITN
#undef AT_PREP
#undef AT_GO
#undef AT_ROWOFF
    } else {
        const int cw = w, qp = (lane >> 2) & 3, p4 = lane & 3;
        const int bKl = K_OFF + fr * RST + q4 * 16;
        const int bVl = V_OFF + (4 * q4 + qp) * RST + p4 * 8;
        bf16x8 qf[2][4];
        int uid = UID0;
        if (uid < NU) { AT_DECODE(uid)
#pragma unroll
            for (int qi = 0; qi < 2; ++qi) { const unsigned qo = (unsigned)((((u0 + 32 * cw + 16 * qi + fr) << rsh) + rho) * (ATTN_N * 2) + 16 * q4);
#pragma unroll
                for (int ks = 0; ks < 4; ++ks) qf[qi][ks] = gload16s(Qb, qo + 64 * ks); } }
        int par = 0;
        for (int un = 0; un < NUN; ++un, uid += USTEP) {
            AT_DECODE(uid)
            const int nuid = (un + 1 < NUN) ? uid + USTEP : NU;
            par = (ucons && un > 0 && blk != 0) ? (par ^ 1) : 0;
#define AT_PT(t_) ((((t_) + 8 * par) & 15) * (16 * RST))
            __builtin_amdgcn_s_barrier(); asm volatile("" ::: "memory");
            f32x4 S[2][9]; bf16x8 kf[2][2][4];
#ifdef PROBE_ATC
            for (int rr_ = 0; rr_ < PROBE_ATC; ++rr_) {
#endif
#pragma unroll
            for (int qi = 0; qi < 2; ++qi)
#pragma unroll
                for (int kt = 0; kt < 9; ++kt) S[qi][kt] = (f32x4){0.f, 0.f, 0.f, 0.f};
            AT_SCHED;
#pragma unroll
            for (int jj = 0; jj < 2; ++jj)
#pragma unroll
                for (int ks = 0; ks < 4; ++ks) kf[0][jj][ks] = *(const LAS bf16x8*)(lds + bKl + AT_PT(2 * cw + jj) + 64 * ks);
            AT_SCHED;
#pragma unroll
            for (int gi = 0; gi < 5; ++gi) {
                if (gi < 4) {
#pragma unroll
                    for (int jj = 0; jj < 2; ++jj)
#pragma unroll
                        for (int ks = 0; ks < 4; ++ks) kf[(gi + 1) & 1][jj][ks] = *(const LAS bf16x8*)(lds + bKl + AT_PT(2 * cw + 2 * (gi + 1) + jj) + 64 * ks);
                    AT_SCHED; asm volatile("s_waitcnt lgkmcnt(8)" ::: "memory"); AT_SCHED; }
                else { AT_SCHED; asm volatile("s_waitcnt lgkmcnt(0)" ::: "memory"); AT_SCHED; }
#pragma unroll
                for (int jj = 0; jj < 2; ++jj) { const int j = 2 * gi + jj;
#pragma unroll
                    for (int ks = 0; ks < 4; ++ks) {
                        if (j <= 8) S[0][j] = __builtin_amdgcn_mfma_f32_16x16x32_bf16(kf[gi & 1][jj][ks], qf[0][ks], S[0][j], 0, 0, 0);
                        if (j >= 1) S[1][j - 1] = __builtin_amdgcn_mfma_f32_16x16x32_bf16(kf[gi & 1][jj][ks], qf[1][ks], S[1][j - 1], 0, 0, 0); } }
                AT_SCHED; }
#ifdef PROBE_ATC
            }
#endif
            __builtin_amdgcn_s_barrier(); asm volatile("" ::: "memory");
            bf16x8 qn[2][4];
            if (nuid < NU) {
                const int bi_n = nuid & 31, bhg_n = nuid >> 5, g_n = (gsel >= 0) ? gsel : bhg_n % 3, bh_n = (gsel >= 0) ? bhg_n : bhg_n / 3, hh_n = bh_n & 15, b_n = bh_n >> 4;
                const int rsh_n = 2 * g_n, nbs_n = 5 - rsh_n, rho_n = bi_n >> nbs_n, blk_n = bi_n & ((1 << nbs_n) - 1), u0_n = blk_n * 128;
                const bf16* Qb_n = P + (size_t)b_n * SEQ * ATTN_N + (QKV_ADJ ? ((g_n * NH + hh_n) * 3) * HD : ((g_n * 3 + 0) * NH + hh_n) * HD);
#pragma unroll
                for (int qi = 0; qi < 2; ++qi) { const unsigned qo = (unsigned)((((u0_n + 32 * cw + 16 * qi + fr) << rsh_n) + rho_n) * (ATTN_N * 2) + 16 * q4);
#pragma unroll
                    for (int ks = 0; ks < 4; ++ks) qn[qi][ks] = gload16s(Qb_n, qo + 64 * ks); } }
            else {
#pragma unroll
                for (int qi = 0; qi < 2; ++qi)
#pragma unroll
                    for (int ks = 0; ks < 4; ++ks) qn[qi][ks] = qf[qi][ks]; }
            float mxs[2], ls[2]; bf16x8 pf[2][5];
#pragma unroll
            for (int qi = 0; qi < 2; ++qi) {
                float mx = -1e30f;
#pragma unroll
                for (int kt = 0; kt < 9; ++kt)
#pragma unroll
                    for (int r = 0; r < 4; ++r) { const int rr = 4 * q4 + r; const int uk = u0 + 32 * cw + 16 * qi - 64 + 16 * kt + rr;
                        const bool ok = (kt > 0 || rr >= fr) && (kt < 8 || rr <= fr) && uk >= 0 && uk < L;
                        const float sv = ok ? S[qi][kt][r] * sc2 : -1e30f; S[qi][kt][r] = sv; mx = fmaxf(mx, sv); }
                mx = fmaxf(mx, __shfl_xor(mx, 16)); mx = fmaxf(mx, __shfl_xor(mx, 32));
                float l = 0.f;
#pragma unroll
                for (int kt = 0; kt < 9; ++kt)
#pragma unroll
                    for (int r = 0; r < 4; ++r) { const float pv = __builtin_amdgcn_exp2f(S[qi][kt][r] - mx); S[qi][kt][r] = pv; l += pv; }
                l += __shfl_xor(l, 16); l += __shfl_xor(l, 32);
                mxs[qi] = mx; ls[qi] = l;
#pragma unroll
                for (int pi = 0; pi < 5; ++pi) { const int ka = 2 * pi - qi, kb = 2 * pi + 1 - qi; v4u pw;
                    if (ka >= 0 && ka <= 8) { pw.x = pg8::cvt_pk_bf16(S[qi][ka][0], S[qi][ka][1]); pw.y = pg8::cvt_pk_bf16(S[qi][ka][2], S[qi][ka][3]); } else { pw.x = 0u; pw.y = 0u; }
                    if (kb >= 0 && kb <= 8) { pw.z = pg8::cvt_pk_bf16(S[qi][kb][0], S[qi][kb][1]); pw.w = pg8::cvt_pk_bf16(S[qi][kb][2], S[qi][kb][3]); } else { pw.z = 0u; pw.w = 0u; }
                    pf[qi][pi] = __builtin_bit_cast(bf16x8, pw); } }
            __builtin_amdgcn_s_barrier(); asm volatile("" ::: "memory");
            f32x4 O[2][8]; s16x4 vr[2][8][2];
#ifdef PROBE_ATC
            for (int rr_ = 0; rr_ < PROBE_ATC; ++rr_) {
#endif
#pragma unroll
            for (int qi = 0; qi < 2; ++qi)
#pragma unroll
                for (int dt = 0; dt < 8; ++dt) O[qi][dt] = (f32x4){0.f, 0.f, 0.f, 0.f};
            AT_SCHED;
#pragma unroll
            for (int dt = 0; dt < 8; ++dt) { vr[0][dt][0] = tr_read(lds + bVl + AT_PT(2 * cw) + 32 * dt); vr[0][dt][1] = tr_read(lds + bVl + AT_PT(2 * cw + 1) + 32 * dt); }
            AT_SCHED;
#pragma unroll
            for (int pi = 0; pi < 5; ++pi) {
                if (pi < 4) {
#pragma unroll
                    for (int dt = 0; dt < 4; ++dt) { vr[(pi + 1) & 1][dt][0] = tr_read(lds + bVl + AT_PT(2 * cw + 2 * (pi + 1)) + 32 * dt); vr[(pi + 1) & 1][dt][1] = tr_read(lds + bVl + AT_PT(2 * cw + 2 * (pi + 1) + 1) + 32 * dt); }
                    AT_SCHED; asm volatile("s_waitcnt lgkmcnt(8)" ::: "memory"); AT_SCHED;
#pragma unroll
                    for (int dt = 4; dt < 8; ++dt) { vr[(pi + 1) & 1][dt][0] = tr_read(lds + bVl + AT_PT(2 * cw + 2 * (pi + 1)) + 32 * dt); vr[(pi + 1) & 1][dt][1] = tr_read(lds + bVl + AT_PT(2 * cw + 2 * (pi + 1) + 1) + 32 * dt); }
                    AT_SCHED; }
                else { AT_SCHED; asm volatile("s_waitcnt lgkmcnt(0)" ::: "memory"); AT_SCHED; }
#pragma unroll
                for (int dt = 0; dt < 8; ++dt) { const bf16x8 vf = cat44(vr[pi & 1][dt][0], vr[pi & 1][dt][1]);
                    O[0][dt] = __builtin_amdgcn_mfma_f32_16x16x32_bf16(vf, pf[0][pi], O[0][dt], 0, 0, 0);
                    O[1][dt] = __builtin_amdgcn_mfma_f32_16x16x32_bf16(vf, pf[1][pi], O[1][dt], 0, 0, 0); }
                AT_SCHED; }
#ifdef PROBE_ATC
            }
#endif
            __builtin_amdgcn_s_barrier(); asm volatile("" ::: "memory");
#pragma unroll
            for (int qi = 0; qi < 2; ++qi) { const float il = 1.0f / ls[qi]; const int qtok = ((u0 + 32 * cw + 16 * qi + fr) << rsh) + rho;
                const size_t orow = (size_t)g * M + (size_t)b * SEQ + qtok; bf16* op = OG + orow * D + hh * HD + 4 * q4;
#pragma unroll
                for (int dt = 0; dt < 8; ++dt) { v2u o2; o2.x = pk2(O[qi][dt][0] * il, O[qi][dt][1] * il); o2.y = pk2(O[qi][dt][2] * il, O[qi][dt][3] * il); *(GAS v2u*)(op + 16 * dt) = o2; }
                if (q4 == 0) *(GAS float*)(LSE + orow * NH + hh) = mxs[qi] * 0.6931471805599453f + __logf(ls[qi]); }
#pragma unroll
            for (int qi = 0; qi < 2; ++qi)
#pragma unroll
                for (int ks = 0; ks < 4; ++ks) qf[qi][ks] = qn[qi][ks];
        }
    }
    asm volatile("s_waitcnt vmcnt(0) lgkmcnt(0)" ::: "memory"); __builtin_amdgcn_s_barrier(); asm volatile("" ::: "memory");
#undef AT_PT
#undef AT_SCHED
#undef AT_DECODE
}
typedef float float2_t __attribute__((ext_vector_type(2)));
__device__ __forceinline__ void hgrn_gates(const bf16* P, const float* lbt, bf16* QT, bf16* KT, float* PREF, float* BR, int gw, int NGW, int lane, bool panel) {
    const unsigned lo = 4u * (unsigned)lane;
    for (int item = gw; item < 8192; item += NGW) {
        const int li = (item & 255) + ((item >> 11) << 8), pq = (item & 2047) >> 8;
        const int cb = item & 15, half = (item >> 4) & 1, chunk = panel ? 16 * pq + (li >> 6) : (item >> 5) & 127, dir = panel ? (li >> 5) & 1 : item >> 12;
        const int cbase = cb * 128; const size_t row0 = (size_t)chunk * 64;
        const float lb0 = lbt[(size_t)dir * 4 * D + cbase + 2 * lane], lb1 = lbt[(size_t)dir * 4 * D + cbase + 2 * lane + 1];
        const unsigned char* fcol = (const unsigned char*)(P + (1 + dir) * D + cbase); const unsigned char* qcol = (const unsigned char*)(P + cbase);
        unsigned char* qt = (unsigned char*)(QT + (size_t)dir * M * D + cbase); unsigned char* kt = (unsigned char*)(KT + (size_t)dir * M * D + cbase);
        unsigned fw[32], qw[32];
#pragma unroll
        for (int j = 0; j < 32; ++j) { const int tau = half ? 32 + j : 31 - j; const size_t t = dir ? row0 + 63 - tau : row0 + tau;
            fw[j] = *(const GAS unsigned*)(fcol + t * (HGRN_N * 2) + lo); qw[j] = *(const GAS unsigned*)(qcol + t * (HGRN_N * 2) + lo); }
        float a0 = 1.f, a1 = 1.f;
#pragma unroll
        for (int j = 0; j < 32; ++j) { const int tau = half ? 32 + j : 31 - j; const size_t t = dir ? row0 + 63 - tau : row0 + tau;
            asm volatile("" : "+v"(fw[j]), "+v"(qw[j]) :: "memory");
            const float g0 = lb0 + (1.0f - lb0) * sigmoid_f(bflo(fw[j])), g1 = lb1 + (1.0f - lb1) * sigmoid_f(bfhi(fw[j]));
            const float q0 = bflo(qw[j]), q1 = bfhi(qw[j]); const float s0 = q0 * sigmoid_f(q0), s1 = q1 * sigmoid_f(q1);
            if (half) { a0 *= g0; a1 *= g1; }
            const float i0 = __builtin_amdgcn_rcpf(fmaxf(a0, 1e-30f)), i1 = __builtin_amdgcn_rcpf(fmaxf(a1, 1e-30f));
            const float e0 = half ? a0 : i0, e1 = half ? a1 : i1, r0 = half ? i0 : a0, r1 = half ? i1 : a1;
            *(GAS unsigned*)(qt + t * (D * 2) + lo) = pk2(s0 * e0, s1 * e1);
            *(GAS unsigned*)(kt + t * (D * 2) + lo) = pk2((1.0f - g0) * r0, (1.0f - g1) * r1);
            if (!half) { a0 *= g0; a1 *= g1; }
        }
        float* dst = (half ? BR : PREF) + ((size_t)dir * (M / 64) + chunk) * D + cbase;
        *(GAS float2_t*)((unsigned char*)dst + 2u * lo) = (float2_t){a0, a1};
    }
}

struct CvtSeg { const float* W; bf16* WT; int N; int nb; };
struct CvtPlan { CvtSeg seg[4]; int nseg; };
__device__ __forceinline__ void hgrn_scan_mfma(LAS unsigned char* lds, const bf16* P, const bf16* QT, const bf16* KT, const float* PREF, const float* BR, bf16* OD, int vcu, int G, const CvtPlan& cv) {
    int tid_l = threadIdx.x; asm volatile("" : "+v"(tid_l));
    const int w = __builtin_amdgcn_readfirstlane(tid_l >> 6);
    constexpr int QST = 272, KST = 288, VST = 96;
    constexpr int STG = 43008, QS = 0, KS = 17408, VS = 35840, VEC = 41984;
#define HG_SCHED __builtin_amdgcn_sched_barrier(0)
    for (int unit = vcu; unit < 256; unit += (G < 256 ? G : 256)) {
        const int chain = unit >> 2, slice = unit & 3, b = chain >> 5, hh = (chain >> 1) & 15, dir = chain & 1;
        const size_t dOff = (size_t)dir * M * D;
        const int ck0 = dir ? 63 : 0; const size_t tok00 = (size_t)b * SEQ + (size_t)ck0 * 64;
        if (w < 4) {
            int lane_k = threadIdx.x & 63; asm volatile("" : "+v"(lane_k));
            const int tt = w, qp = (lane_k >> 2) & 3, p4 = lane_k & 3, fr = lane_k & 15, q4 = lane_k >> 4;
            const int bQ = QS + (16 * tt + fr) * QST + q4 * 16;
            const int bQ2 = QS + (16 * tt + fr) * QST + q4 * 8;
            const int bK = KS + fr * KST + q4 * 16;
            const int bKc = KS + (4 * q4 + qp) * KST + p4 * 8;
            const int bV = VS + (4 * q4 + qp) * VST + p4 * 8;
            const int bP = VEC + q4 * 16;
            f32x4 S[8][2];
#pragma unroll
            for (int T = 0; T < 8; ++T) { S[T][0] = (f32x4){0.f, 0.f, 0.f, 0.f}; S[T][1] = (f32x4){0.f, 0.f, 0.f, 0.f}; }
            int sb = 0;
            for (int step = 0; step < 64; ++step) {
                __builtin_amdgcn_s_barrier(); asm volatile("" ::: "memory");
                LAS const unsigned char* st = lds + sb;
                HG_SCHED;
                bf16x8 qf[4], kf[2][4]; s16x4 va[2][2][2];
#pragma unroll
                for (int ks = 0; ks < 4; ++ks) qf[ks] = *(const LAS bf16x8*)(st + bQ + 64 * ks);
#pragma unroll
                for (int s4 = 0; s4 < 4; ++s4) kf[0][s4] = *(const LAS bf16x8*)(st + bK + 16 * s4 * KST);
#pragma unroll
                for (int vt = 0; vt < 2; ++vt)
#pragma unroll
                    for (int pi = 0; pi < 2; ++pi) { va[vt][pi][0] = tr_read(st + bV + 32 * pi * VST + 32 * vt); va[vt][pi][1] = tr_read(st + bV + (32 * pi + 16) * VST + 32 * vt); }
                HG_SCHED;
                f32x4 Pt[4];
#pragma unroll
                for (int s4 = 0; s4 < 4; ++s4) Pt[s4] = (f32x4){0.f, 0.f, 0.f, 0.f};
#pragma unroll
                for (int ks = 0; ks < 4; ++ks) {
                    if (ks < 3) {
#pragma unroll
                        for (int s4 = 0; s4 < 4; ++s4) kf[(ks + 1) & 1][s4] = *(const LAS bf16x8*)(st + bK + 16 * s4 * KST + 64 * (ks + 1));
                        HG_SCHED; asm volatile("s_waitcnt lgkmcnt(4)" ::: "memory"); HG_SCHED; }
                    else { HG_SCHED; asm volatile("s_waitcnt lgkmcnt(0)" ::: "memory"); HG_SCHED; }
#pragma unroll
                    for (int s4 = 0; s4 < 4; ++s4) Pt[s4] = __builtin_amdgcn_mfma_f32_16x16x32_bf16(kf[ks & 1][s4], qf[ks], Pt[s4], 0, 0, 0);
                    HG_SCHED; }
                f32x4 pr[8]; s16x4 qa[4], qb[4];
#pragma unroll
                for (int T = 0; T < 8; ++T) pr[T] = *(const LAS f32x4*)(st + bP + 64 * T);
#pragma unroll
                for (int ks = 0; ks < 4; ++ks) { qa[ks] = *(const LAS s16x4*)(st + bQ2 + 64 * ks); qb[ks] = *(const LAS s16x4*)(st + bQ2 + 64 * ks + 32); }
                HG_SCHED;
                const int tix = 16 * tt + fr;
#pragma unroll
                for (int s4 = 0; s4 < 4; ++s4)
#pragma unroll
                    for (int r = 0; r < 4; ++r) { const int six = 16 * s4 + 4 * q4 + r; const bool keep = dir ? (six >= tix) : (six <= tix); Pt[s4][r] = keep ? Pt[s4][r] : 0.f; }
                f32x4 o[2]; o[0] = (f32x4){0.f, 0.f, 0.f, 0.f}; o[1] = (f32x4){0.f, 0.f, 0.f, 0.f};
#pragma unroll
                for (int pi = 0; pi < 2; ++pi) {
                    v4u pw; pw.x = pg8::cvt_pk_bf16(Pt[2 * pi][0], Pt[2 * pi][1]); pw.y = pg8::cvt_pk_bf16(Pt[2 * pi][2], Pt[2 * pi][3]);
                    pw.z = pg8::cvt_pk_bf16(Pt[2 * pi + 1][0], Pt[2 * pi + 1][1]); pw.w = pg8::cvt_pk_bf16(Pt[2 * pi + 1][2], Pt[2 * pi + 1][3]);
#pragma unroll
                    for (int vt = 0; vt < 2; ++vt) o[vt] = __builtin_amdgcn_mfma_f32_16x16x32_bf16(cat44(va[vt][pi][0], va[vt][pi][1]), __builtin_bit_cast(bf16x8, pw), o[vt], 0, 0, 0); }
                HG_SCHED; asm volatile("s_waitcnt lgkmcnt(0)" ::: "memory"); HG_SCHED;
#pragma unroll
                for (int T = 0; T < 8; ++T) { S[T][0] = S[T][0] * pr[T]; S[T][1] = S[T][1] * pr[T]; }
                HG_SCHED;
                s16x4 kc[2][2][2][2]; f32x4 br[2][2];
#pragma unroll
                for (int j = 0; j < 2; ++j) { br[0][j] = *(const LAS f32x4*)(st + bP + 512 + 64 * j);
#pragma unroll
                    for (int pi = 0; pi < 2; ++pi) { kc[0][j][pi][0] = tr_read(st + bKc + 32 * pi * KST + 32 * j); kc[0][j][pi][1] = tr_read(st + bKc + (32 * pi + 16) * KST + 32 * j); } }
                HG_SCHED;
#pragma unroll
                for (int ks = 0; ks < 4; ++ks) { const int T0 = 2 * ks, T1 = 2 * ks + 1; const bf16x8 qq = cat44(qa[ks], qb[ks]);
#pragma unroll
                    for (int vt = 0; vt < 2; ++vt) {
                        v4u aw; aw.x = pg8::cvt_pk_bf16(S[T0][vt][0], S[T0][vt][1]); aw.y = pg8::cvt_pk_bf16(S[T0][vt][2], S[T0][vt][3]);
                        aw.z = pg8::cvt_pk_bf16(S[T1][vt][0], S[T1][vt][1]); aw.w = pg8::cvt_pk_bf16(S[T1][vt][2], S[T1][vt][3]);
                        o[vt] = __builtin_amdgcn_mfma_f32_16x16x32_bf16(__builtin_bit_cast(bf16x8, aw), qq, o[vt], 0, 0, 0); } }
                HG_SCHED;
                { const int ck = dir ? 63 - step : step; const size_t tok = (size_t)b * SEQ + (size_t)ck * 64 + 16 * tt + fr;
#pragma unroll
                  for (int vt = 0; vt < 2; ++vt) { v2u o2; o2.x = pk2(o[vt][0], o[vt][1]); o2.y = pk2(o[vt][2], o[vt][3]);
                    *(GAS v2u*)(OD + dOff + tok * D + hh * HD + slice * 32 + 16 * vt + 4 * q4) = o2; } }
                HG_SCHED;
#pragma unroll
                for (int rd = 0; rd < 4; ++rd) {
                    if (rd < 3) {
#pragma unroll
                        for (int j = 0; j < 2; ++j) { const int T = 2 * (rd + 1) + j; br[(rd + 1) & 1][j] = *(const LAS f32x4*)(st + bP + 512 + 64 * T);
#pragma unroll
                            for (int pi = 0; pi < 2; ++pi) { kc[(rd + 1) & 1][j][pi][0] = tr_read(st + bKc + 32 * pi * KST + 32 * T); kc[(rd + 1) & 1][j][pi][1] = tr_read(st + bKc + (32 * pi + 16) * KST + 32 * T); } }
                        HG_SCHED; asm volatile("s_waitcnt lgkmcnt(10)" ::: "memory"); HG_SCHED; }
                    else { HG_SCHED; asm volatile("s_waitcnt lgkmcnt(0)" ::: "memory"); HG_SCHED; }
#pragma unroll
                    for (int j = 0; j < 2; ++j) { const int T = 2 * rd + j;
#pragma unroll
                        for (int vt = 0; vt < 2; ++vt) {
#pragma unroll
                            for (int pi = 0; pi < 2; ++pi) S[T][vt] = __builtin_amdgcn_mfma_f32_16x16x32_bf16(cat44(kc[rd & 1][j][pi][0], kc[rd & 1][j][pi][1]), cat44(va[vt][pi][0], va[vt][pi][1]), S[T][vt], 0, 0, 0);
                            S[T][vt] = S[T][vt] * br[rd & 1][j]; } }
                    HG_SCHED; }
                sb = (sb == 2 * STG) ? 0 : sb + STG;
            }
        } else if (w < 6) {
            const int lw = w - 4; int lane_d = threadIdx.x & 63; asm volatile("" : "+v"(lane_d));
            const unsigned char* src[21]; long sstr[21]; int poff[21];
            const long rstep = (dir ? -64L : 64L);
#pragma unroll
            for (int i = 0; i < 21; ++i) {
                int img, pcl;
                if (i < 8) { img = 0; pcl = lw + 2 * i; } else if (i < 16) { img = 1; pcl = lw + 2 * (i - 8); } else if (i < 19) { img = 2; pcl = lw + 2 * (i - 16); }
                else if (i == 19) { img = lw; pcl = 16; }
                else { img = (lw == 0) ? 1 : 3; pcl = (lw == 0) ? 17 : 0; }
                const int sl = pcl * 64 + lane_d;
                if (img == 0 || img == 1) { const int RS = img ? 18 : 17; const int row = sl / RS, ch = sl - row * RS, chs = ch < 16 ? ch : 0;
                    src[i] = (const unsigned char*)((img ? KT : QT) + dOff + (tok00 + row) * D + hh * HD + chs * 8); sstr[i] = rstep * D * 2; poff[i] = (img ? KS : QS) + pcl * 1024; }
                else if (img == 2) { const int row = sl / 6, ch = sl - row * 6, chs = ch < 4 ? ch : 0;
                    src[i] = (const unsigned char*)(P + (tok00 + row) * HGRN_N + 3 * D + hh * HD + slice * 32 + chs * 8); sstr[i] = rstep * HGRN_N * 2; poff[i] = VS + pcl * 1024; }
                else { src[i] = (const unsigned char*)(((lane_d < 32) ? PREF : BR) + ((size_t)dir * (M / 64) + (tok00 >> 6)) * D + hh * HD + 4 * (lane_d & 31)); sstr[i] = (dir ? -1L : 1L) * D * 4; poff[i] = VEC; } }
#define HG_STAGE(step_, sb_) do { _Pragma("unroll") for (int i_ = 0; i_ < 21; ++i_) \
                glds16(src[i_] + (long)(step_) * sstr[i_], (unsigned)(size_t)(lds + (sb_) + poff[i_])); } while (0)
            HG_STAGE(0, 0); HG_STAGE(1, STG);
            int sbn = 2 * STG;
            for (int step = 0; step < 64; ++step) {
                if (step < 63) asm volatile("s_waitcnt vmcnt(21)" ::: "memory"); else asm volatile("s_waitcnt vmcnt(0)" ::: "memory");
                __builtin_amdgcn_s_barrier(); asm volatile("" ::: "memory");
                if (step + 2 < 64) HG_STAGE(step + 2, sbn);
                sbn = (sbn == 2 * STG) ? 0 : sbn + STG;
            }
#undef HG_STAGE
        } else {
            int lane_c = threadIdx.x & 63; asm volatile("" : "+v"(lane_c));
            int chunk = vcu * 2 + (w - 6); const float* cW = nullptr; bf16* cWT = nullptr; int cN = 0, cnb = -1;
#pragma unroll
            for (int sg = 0; sg < 4; ++sg) if (sg < cv.nseg && cnb < 0) { if (chunk < cv.seg[sg].nb) { cW = cv.seg[sg].W; cWT = cv.seg[sg].WT; cN = cv.seg[sg].N; cnb = chunk; } else chunk -= cv.seg[sg].nb; }
            const bool act = cnb >= 0;
            const unsigned char* wb = act ? (const unsigned char*)(cW + cnb * 64) : (const unsigned char*)P;
            unsigned char* ob = act ? (unsigned char*)(cWT + (size_t)cnb * 64 * D) : (unsigned char*)OD;
            const unsigned llo = 4u * (unsigned)lane_c, slo = (unsigned)lane_c * (unsigned)(D * 2);
            const size_t rstr = (size_t)cN * 4;
#define CV_LOAD(b_, s_) do { _Pragma("unroll") for (int j_ = 0; j_ < 32; ++j_) ld[b_][j_] = *(const GAS float*)(wb + (size_t)(32 * (s_) + j_) * rstr + llo); } while (0)
#define CV_STORE(b_, s_) do { _Pragma("unroll") for (int g_ = 0; g_ < 4; ++g_) { v4u o_; o_.x = pk2(ld[b_][8 * g_ + 0], ld[b_][8 * g_ + 1]); o_.y = pk2(ld[b_][8 * g_ + 2], ld[b_][8 * g_ + 3]); \
                o_.z = pk2(ld[b_][8 * g_ + 4], ld[b_][8 * g_ + 5]); o_.w = pk2(ld[b_][8 * g_ + 6], ld[b_][8 * g_ + 7]); *(GAS v4u*)(ob + (size_t)(2 * (32 * (s_) + 8 * g_)) + slo) = o_; } } while (0)
            if (act) {
                float ld[2][32];
                for (int s2 = 0; s2 < 64; s2 += 2) {
#pragma unroll
                    for (int u = 0; u < 2; ++u) { const int st_ = s2 + u;
                        __builtin_amdgcn_s_barrier(); asm volatile("" ::: "memory");
                        if (st_ >= 2) CV_STORE(u, st_ - 2);
                        CV_LOAD(u, st_); }
                }
                CV_STORE(0, 62); CV_STORE(1, 63);
            } else {
                for (int st_ = 0; st_ < 64; ++st_) { __builtin_amdgcn_s_barrier(); asm volatile("" ::: "memory"); }
            }
#undef CV_LOAD
#undef CV_STORE
        }
        asm volatile("s_waitcnt vmcnt(0) lgkmcnt(0)" ::: "memory"); __builtin_amdgcn_s_barrier(); asm volatile("" ::: "memory");
    }
#undef HG_SCHED
}
__device__ __forceinline__ float w8_scale(const unsigned char* ws, int t, int nsamp) {
    const unsigned long long sm = __hip_atomic_load((const unsigned long long*)(ws + WS_CTL + CTL_WSTAT + 64 * t), __ATOMIC_RELAXED, __HIP_MEMORY_SCOPE_AGENT);
    const float var = fmaxf((float)sm * (1.0f / 1099511627776.0f) / (float)nsamp, 1e-30f);
    return 127.0f / (W8_CLIP * sqrtf(var));
}
struct Args { const float* in[9]; float* out; unsigned char* ws; int ph_lo, ph_hi; };
__global__ void __launch_bounds__(NTHREADS, 2) fwd(Args args) {
    extern __shared__ __attribute__((aligned(16))) unsigned char lds_raw[];
    LAS unsigned char* lds = (LAS unsigned char*)lds_raw;
    volatile LAS unsigned* MISC = (volatile LAS unsigned*)(lds + MISC_OFF);
    const int G = gridDim.x; const int hwbx = blockIdx.x;
    bool XL = false;
    int bx = hwbx;
    int vcu = (G % 8 == 0) ? (bx % 8) * (G / 8) + bx / 8 : bx;
    const int NGW = G * NWAVES;
    unsigned char* const ws_k = args.ws; unsigned char* ws = ws_k;
    const float* x_in = args.in[0]; const float* norm_w = args.in[1]; const float* w_in_hgrn = args.in[2]; const float* lbnd = args.in[3]; const float* gnorm = args.in[4];
    const float* w_in_attn = args.in[5]; const float* w_out = args.in[6]; const float* w_ffn_in = args.in[7]; const float* w_ffn_out = args.in[8];
    float* xres = args.out;
#define PH_WS unsigned char* ws = ws_k; asm volatile("" : "+s"(ws));
#define cosT ((float*)(ws + WS_TAB + TAB_COS))
#define sinT ((float*)(ws + WS_TAB + TAB_SIN))
#define lbT ((float*)(ws + WS_TAB + TAB_LB))
#define WHG ((bf16*)(ws + WS_WHG))
#define WAT ((bf16*)(ws + WS_WAT))
#define WO ((bf16*)(ws + WS_WO))
#define WF1 ((bf16*)(ws + WS_WF1))
#define WF2 ((bf16*)(ws + WS_WF2))
#define H ((bf16*)(ws + WS_H))
#define PROJ ((bf16*)(ws + WS_PROJ))
#define MIX ((bf16*)(ws + WS_MIX))
#define OB ((bf16*)(ws + WS_O))
#define GB ((bf16*)(ws + WS_G))
#define LSE ((float*)(ws + WS_MIX + 96 * MiB))
#define QT ((bf16*)(ws + WS_PROJ + 160 * MiB))
#define KT ((bf16*)(ws + WS_PROJ + 224 * MiB))
#define ACT MIX
#define H8 ((signed char*)(ws + WS_H8))
#define RSA ((float*)(ws + WS_TAB + TAB_RSA))
#define RSO ((float*)(ws + WS_TAB + TAB_RSO))
#define WSC(t_) __builtin_bit_cast(float, (unsigned)MISC[32 + (t_)])
#define RS_TO_LDS(src_) do { int t_ = threadIdx.x; asm volatile("" : "+v"(t_)); if (t_ < 256) MISC[64 + t_] = __builtin_bit_cast(unsigned, (src_)[(4 * (vcu >> 5) + (vcu & 3)) * 256 + t_]); __syncthreads(); } while (0)
#define RSL ((const LAS float*)(lds + MISC_OFF + 256))
#define XB ((bf16*)(ws + WS_KH))
#define XSCR ((float*)(ws + WS_MIX))
#define HSCR ((bf16*)(ws + WS_MIX + 64 * MiB))
#define PREF ((float*)(ws + WS_KH + 64 * MiB))
#define E63V ((float*)(ws + WS_KH + 66 * MiB))

    for (int u = threadIdx.x; u < (LDS_BYTES - LDSCTL_OFF) / 4; u += NTHREADS) ((LAS unsigned*)(lds + LDSCTL_OFF))[u] = 0u;
    __syncthreads();
    const int lo = args.ph_lo, hi = args.ph_hi;
#if XCC_TRUE_MAP
    if (threadIdx.x == 0) { const unsigned xc = xb_xcc_id() & 7u; const unsigned rk = __hip_atomic_fetch_add((unsigned*)(ws + WS_CTL) + CW_TICK + 64 * xc, 1u, __ATOMIC_RELAXED, __HIP_MEMORY_SCOPE_AGENT); MISC[12] = xc; MISC[13] = rk; }
    __syncthreads();
#endif
    const int FF1_REM = ((M / 256) * (FFN_N / 256)) % G;
    const bool PANEL = PANEL_MODE && G == 256 && (args.ph_hi - args.ph_lo) == NPHASES;
    const bool Q8OK = PANEL;
    const bool DEFER = CVT_IN_SCAN && !QKV_ADJ && !TAIL_ALL && !TAIL_WO && (args.ph_hi - args.ph_lo) == NPHASES && G == 256 && REP_SCAN == 1;
    const bool TAILCVT = FF1_REM != 0 && (hi - lo) == NPHASES && REP_F1 == 1;
    const bool use_bar = (hi - lo) > 1;
    XcdBarrier bar; bar.bar = (unsigned*)(ws + WS_CTL) + CW_BAR; bar.x = 0; bar.st = nullptr;
    if (use_bar) bar = xcd_barrier_post((unsigned*)(ws + WS_CTL) + CW_BAR, MISC + 8);
#define IN(k) (lo <= (k) && (k) < hi)
#define PH_IDS int tid_p = threadIdx.x; asm volatile("" : "+v"(tid_p)); const int lane_p = tid_p & 63; const int wave_p = __builtin_amdgcn_readfirstlane(tid_p >> 6); const int gw_p = vcu * NWAVES + wave_p; (void)lane_p; (void)gw_p;
#ifndef REP_BAR
#define REP_BAR 1
#endif
#define SEAM_L(k) do { if (IN(k) && IN((k) + 1)) { if (XL) xcd_local_barrier(bar); else xcd_barrier(bar); } } while (0)
#ifdef PROBE_BWAIT
    unsigned long long bw_acc = 0;
#ifndef PROBE_BMASK
#define PROBE_BMASK 0x3ff
#endif
#define SEAM(k) do { if (IN(k) && IN((k) + 1)) { const unsigned long long t0_ = __builtin_amdgcn_s_memrealtime(); xcd_barrier(bar); const int kb_ = (k) == 0 ? 9 : ((k) - 1) % 9; if ((PROBE_BMASK >> kb_) & 1) bw_acc += __builtin_amdgcn_s_memrealtime() - t0_; } } while (0)
#else
#define SEAM(k) do { if (IN(k) && IN((k) + 1)) for (int rb = 0; rb < REP_BAR; ++rb) xcd_barrier(bar); } while (0)
#endif

    if (IN(0)) { PH_IDS PH_WS
        const int gt = vcu * NTHREADS + tid_p; const int NGT = G * NTHREADS;
#pragma unroll 1
        for (int t = 0; t < 12; ++t) {
            const bool used = t < 4 ? F1Q(t) : t < 6 ? INQ(2 * (t - 4)) : t < 8 ? INQ(2 * (t - 6) + 1) : WOQ(t - 8);
            if (!used) continue;
            const float* Wp = t < 4 ? w_ffn_in + (size_t)t * D * FFN_N : t < 6 ? w_in_hgrn + (size_t)(t - 4) * D * HGRN_N : t < 8 ? w_in_attn + (size_t)(t - 6) * D * ATTN_N : w_out + (size_t)(t - 8) * D * D;
            const size_t total = t < 4 ? (size_t)D * FFN_N : t < 6 ? (size_t)D * HGRN_N : t < 8 ? (size_t)D * ATTN_N : (size_t)D * D;
            const size_t stride = total / ((size_t)NGT * WSTAT_PER_THREAD);
            float ss = 0.f;
#pragma unroll
            for (int j = 0; j < WSTAT_PER_THREAD; ++j) { const float w = Wp[((size_t)gt + (size_t)j * NGT) * stride]; ss += w * w; }
            ss = wave_sum(ss);
            if (lane_p == 0) __hip_atomic_fetch_add((unsigned long long*)(ws + WS_CTL + CTL_WSTAT + 64 * t), (unsigned long long)(ss * 1099511627776.0f), __ATOMIC_RELAXED, __HIP_MEMORY_SCOPE_AGENT);
        }
    }
    if (use_bar && IN(0) && (F1_I8 | I8_IN | I8_WO)) xcd_barrier(bar);
    if (F1_I8 | I8_IN | I8_WO) {
        if (threadIdx.x < 12) MISC[32 + threadIdx.x] = __builtin_bit_cast(unsigned, w8_scale(ws, (int)threadIdx.x, G * NTHREADS * WSTAT_PER_THREAD));
        __syncthreads();
    }
    if (IN(0)) for (int rep = 0; rep < REP_PRO; ++rep) {
        PH_WS PH_IDS
        const int lane = lane_p, gw = gw_p, tid = tid_p;
        LAS float* scr = (LAS float*)(lds + wave_p * 16384);
        for (int s = 0; s < ((DEFER || (TAILCVT && TAIL_ALL)) ? 1 : 2); ++s) transpose_matrix(w_in_hgrn + (size_t)s * D * HGRN_N, D, HGRN_N, WHG + (size_t)s * HGRN_N * D, 0, scr, gw, NGW, lane, 0, 100, INQ(2 * s) ? WSC(4 + s) : 0.f);
        for (int s = 0; s < ((DEFER || (TAILCVT && TAIL_ALL)) ? 0 : 2); ++s) transpose_matrix(w_in_attn + (size_t)s * D * ATTN_N, D, ATTN_N, WAT + (size_t)s * ATTN_N * D, ATT_MODE, scr, gw, NGW, lane, 0, 100, INQ(2 * s + 1) ? WSC(6 + s) : 0.f);
        for (int s = 0; s < ((DEFER || (TAILCVT && (TAIL_ALL || TAIL_WO))) ? 1 : 4); ++s) transpose_matrix(w_out + (size_t)s * D * D, D, D, WO + (size_t)s * D * D, 0, scr, gw, NGW, lane, 0, 100, WOQ(s) ? WSC(8 + s) : 0.f);
        for (int s = 0; s < (TAILCVT ? 1 : 4); ++s) transpose_matrix(w_ffn_in + (size_t)s * D * FFN_N, D, FFN_N, WF1 + (size_t)s * FFN_N * D, 1, scr, gw, NGW, lane, 0, 100, F1Q(s) ? WSC(s) : 0.f);
        for (int s = 0; s < 4; ++s) transpose_matrix(w_ffn_out + (size_t)s * DFF * D, DFF, D, WF2 + (size_t)s * D * DFF, 0, scr, gw, NGW, lane, (TAILCVT && s > 0) ? TAIL_F2_PCT : 0, 100);
        const int gt = vcu * NTHREADS + tid, NGT = G * NTHREADS;
        for (int idx = gt; idx < SEQ * 16; idx += NGT) { const int pos = idx >> 4, i = idx & 15;
            const float inv = powf(500000.0f, -(float)(2 * i) / 32.0f); const float ang = (float)pos * inv; cosT[idx] = cosf(ang); sinT[idx] = sinf(ang); }
        for (int idx = gt; idx < 2 * D; idx += NGT) { const int dir = idx >> 11, c = idx & (D - 1);
            float xl[4]; float mx = -3.0e38f;
#pragma unroll
            for (int l = 0; l < 4; ++l) { xl[l] = lbnd[(size_t)(dir * 4 + l) * D + c]; mx = fmaxf(mx, xl[l]); }
            float sum = 0.f;
#pragma unroll
            for (int l = 0; l < 4; ++l) { xl[l] = expf(xl[l] - mx); sum += xl[l]; }
            float cum = 0.f, c0 = 0.f;
#pragma unroll
            for (int l = 0; l < 4; ++l) { cum += xl[l] / sum; if (l == 0) c0 = cum; lbT[(size_t)(dir * 4 + l) * D + c] = cum - c0; } }
        if (INQ(0)) norm_rows<false, true, false, false, true>(nullptr, x_in, nullptr, nullptr, norm_w, (bf16*)H8, gw, NGW, lane, false, RSA);
        else norm_rows<false, true, false, false>(nullptr, x_in, nullptr, nullptr, norm_w, H, gw, NGW, lane, false);
    }
    SEAM(0);
#if XCC_TRUE_MAP
    if (use_bar && lo == 0 && (G % 8) == 0) {
        bool okm = true;
#pragma unroll
        for (int j = 0; j < 8; ++j) okm = okm && (__hip_atomic_load((unsigned*)(ws + WS_CTL) + CW_TICK + 64 * j, __ATOMIC_RELAXED, __HIP_MEMORY_SCOPE_AGENT) == (unsigned)(G / 8));
        if (okm) { const int xc = (int)MISC[12], rk = (int)MISC[13]; bx = rk * 8 + xc; vcu = xc * (G / 8) + rk; XL = PANEL && XCD_LOCAL_BAR && G == 256; }
    }
#endif
#ifdef PROBE_WR
    if (IN(0)) { PH_IDS
        const int wr_ = wave_p >> 2, wc_ = wave_p & 3, fr_ = lane_p & 15, fq_ = lane_p >> 4;
        for (int rep = 0; rep < PROBE_WR_N; ++rep) {
            pg8::HybridOrder S; S.init(M, ATTN_N, G, bx, vcu, PANEL); pg8::Unit u; S.next(rep % 9, u);
            v4u w; w.x = 0x3f803f80u; w.y = w.x; w.z = w.x; w.w = w.x;
            if (PROBE_WR == 1) {
#pragma unroll
                for (int ai = 0; ai < 2; ++ai)
#pragma unroll
                    for (int m = 0; m < 4; ++m)
#pragma unroll
                        for (int bj = 0; bj < 2; ++bj) *(GAS v4u*)(PROJ + (size_t)(u.pm * 256 + wr_ * 64 + fr_ + ai * 128 + m * 16) * ATTN_N + u.pn * 256 + wc_ * 32 + 8 * fq_ + bj * 128) = w;
            } else {
#pragma unroll
                for (int i = 0; i < 16; ++i) *(GAS v4u*)((unsigned char*)PROJ + ((size_t)(u.pm * 72 + u.pn) * 131072) + wave_p * 16384 + i * 1024 + lane_p * 16) = w;
            }
            asm volatile("s_waitcnt vmcnt(0)" ::: "memory"); __syncthreads();
        }
    }
    SEAM(0);
#endif

    for (int L = 0; L < DEPTH; ++L) {
        const int pb = 1 + 9 * L; const bool hg = (L & 1) == 0; const int slot = L >> 1;
        const float* nw = norm_w + (size_t)L * 4 * D;
        const int NPROJ = hg ? HGRN_N : ATTN_N;
        if (IN(pb)) { PH_WS
#ifdef STAGGER_US
            { const unsigned long long t0 = __builtin_amdgcn_s_memrealtime(); const unsigned long long dl = (unsigned long long)((bx >> 3) & 3) * (STAGGER_US * 100);
              while (__builtin_amdgcn_s_memrealtime() - t0 < dl) __builtin_amdgcn_s_sleep(8); }
#endif
            if (hg && INQ(L)) { pg8::Gemm g{(const bf16*)H8, WHG + (size_t)slot * HGRN_N * D, M, HGRN_N, D}; pg8::HybridOrder S; S.init(M, HGRN_N, G, bx, vcu, PANEL);
                RS_TO_LDS(RSA); pg8::EpiBf16<0, true> E{PROJ, HGRN_N, nullptr, 0, 0, 1.f, RSA, 1.0f / WSC(4 + slot), RSL};
                pg8::gemm_phase<pg8::EpiBf16<0, true>, pg8::HybridOrder, INP_ALIGN, GEMM_SP2>(lds, g, S, E); }
            else if (hg) for (int rep = 0; rep < REP_INH; ++rep) { pg8::Gemm g{H, WHG + (size_t)slot * HGRN_N * D, M, HGRN_N, D}; pg8::HybridOrder S; S.init(M, HGRN_N, G, bx, vcu, PANEL);
                pg8::EpiBf16<0> E{PROJ, HGRN_N, nullptr, 0, 0, 1.f};
                pg8::gemm_phase<pg8::EpiBf16<0>, pg8::HybridOrder, INP_ALIGN, GEMM_SP2>(lds, g, S, E); }
            else if (INQ(L)) { pg8::Gemm g{(const bf16*)H8, WAT + (size_t)slot * ATTN_N * D, M, ATTN_N, D}; pg8::HybridOrder S; S.init(M, ATTN_N, G, bx, vcu, PANEL);
                RS_TO_LDS(RSA); pg8::EpiRopeT<true> E{PROJ, ATTN_N, cosT, sinT, RSA, 1.0f / WSC(6 + slot), RSL};
                pg8::gemm_phase<pg8::EpiRopeT<true>, pg8::HybridOrder, INP_ALIGN, GEMM_SP2>(lds, g, S, E); }
            else if (ATTN_SECT && use_bar) {
                for (int gs = 0; gs < 3; ++gs) {
                    { pg8::Gemm g{H, WAT + (size_t)slot * ATTN_N * D + (size_t)gs * 3 * D * D, M, 3 * D, D}; pg8::HybridOrder S; S.init(M, 3 * D, G, bx, vcu, PANEL);
                      pg8::EpiRope E{PROJ + gs * 3 * D, ATTN_N, cosT, sinT};
                      pg8::gemm_phase<pg8::EpiRope, pg8::HybridOrder, INP_ALIGN, GEMM_SP2>(lds, g, S, E); }
                    xcd_barrier(bar);
                    attn_core_mfma(lds, PROJ, MIX, LSE, MIXMAP, G, gs);
                    if (gs < 2) xcd_barrier(bar);
                }
            }
            else for (int rep = 0; rep < REP_INA; ++rep) { pg8::Gemm g{H, WAT + (size_t)((REP_INA_COLD && rep + 1 < REP_INA) ? (slot ^ 1) : slot) * ATTN_N * D, M, ATTN_N, D}; pg8::HybridOrder S; S.init(M, ATTN_N, G, bx, vcu, PANEL);
                pg8::EpiRope E{PROJ, ATTN_N, cosT, sinT};
                pg8::gemm_phase<pg8::EpiRope, pg8::HybridOrder, INP_ALIGN, GEMM_SP2>(lds, g, S, E); }
        }
        if (hg) SEAM_L(pb); else SEAM(pb);
        if (hg) {
            if (IN(pb + 1)) for (int rep = 0; rep < REP_GATES; ++rep) { PH_WS PH_IDS hgrn_gates(PROJ, lbT + (size_t)L * D, QT, KT, PREF, E63V, gw_p, NGW, lane_p, PANEL); }
            SEAM(pb + 1);
        }
#ifdef PROBE_CLKM
        unsigned long long qc0 = 0, qr0 = 0; if (L == PROBE_CLKM - 1 && IN(pb + 2)) { qc0 = clock64(); qr0 = __builtin_amdgcn_s_memrealtime(); }
#endif
        if (IN(pb + 2)) { PH_WS
            if (hg) for (int rep = 0; rep < REP_SCAN; ++rep) {
                CvtPlan cv{}; cv.nseg = 0;
                if (DEFER && L == 0) { cv.seg[0] = CvtSeg{w_in_attn, WAT, ATTN_N, ATTN_N / 64}; cv.seg[1] = CvtSeg{w_out + (size_t)1 * D * D, WO + (size_t)1 * D * D, D, D / 64};
                    cv.seg[2] = CvtSeg{w_in_hgrn + (size_t)1 * D * HGRN_N, WHG + (size_t)1 * HGRN_N * D, HGRN_N, HGRN_N / 64}; cv.seg[3] = CvtSeg{w_out + (size_t)2 * D * D, WO + (size_t)2 * D * D, D, D / 64}; cv.nseg = 4; }
                if (DEFER && L == 2) { cv.seg[0] = CvtSeg{w_in_attn + (size_t)1 * D * ATTN_N, WAT + (size_t)1 * ATTN_N * D, ATTN_N, ATTN_N / 64}; cv.seg[1] = CvtSeg{w_out + (size_t)3 * D * D, WO + (size_t)3 * D * D, D, D / 64}; cv.nseg = 2; }
                hgrn_scan_mfma(lds, PROJ, QT, KT, PREF, E63V, MIX, MIXMAP, G, cv); }
            else if (!(ATTN_SECT && use_bar)) for (int rep = 0; rep < REP_ATTN; ++rep) attn_core_mfma(lds, PROJ, MIX, LSE, MIXMAP, G, -1);
        }
#ifdef PROBE_CLKM
        if (L == PROBE_CLKM - 1 && IN(pb + 2) && hwbx == 0) { const unsigned long long dc = clock64() - qc0, dr = __builtin_amdgcn_s_memrealtime() - qr0;
            const unsigned long long slp = 10000ull * dc / (dr ? dr : 1); const unsigned long long t0 = __builtin_amdgcn_s_memrealtime();
            while (__builtin_amdgcn_s_memrealtime() - t0 < slp) __builtin_amdgcn_s_sleep(8); }
#endif
        SEAM(pb + 2);
        if (IN(pb + 3)) for (int rep = 0; rep < REP_FIN; ++rep) {
            PH_WS PH_IDS
            const int lane = lane_p, gw = gw_p;
            if (hg) { if (WOQ(L)) hgrn_finalize<true>(PROJ, MIX, gnorm + (size_t)slot * HD, OB, gw, NGW, lane, PANEL, RSO); else hgrn_finalize<false>(PROJ, MIX, gnorm + (size_t)slot * HD, OB, gw, NGW, lane, PANEL, nullptr); }
            else { if (WOQ(L)) attn_finalize<true>(MIX, LSE, OB, gw, NGW, lane, PANEL, RSO); else attn_finalize<false>(MIX, LSE, OB, gw, NGW, lane, PANEL, nullptr); }
        }
        SEAM(pb + 3);
        if (IN(pb + 4)) for (int rep = 0; rep < REP_WO; ++rep) { PH_WS
            pg8::Gemm g{OB, WO + (size_t)L * D * D, M, D, D}; pg8::HybridOrder S; S.init(M, D, G, bx, vcu, PANEL);
            if (WOQ(L)) { RS_TO_LDS(RSO); pg8::EpiBf16<0, true> E{GB, D, nullptr, 0, 0, 1.f, RSO, 1.0f / WSC(8 + L), RSL};
                pg8::gemm_phase<pg8::EpiBf16<0, true>, pg8::HybridOrder, ONE_ALIGN, GEMM_SP2>(lds, g, S, E); }
            else { pg8::EpiBf16<0> E{GB, D, nullptr, 0, 0, 1.f};
                pg8::gemm_phase<pg8::EpiBf16<0>, pg8::HybridOrder, ONE_ALIGN, GEMM_SP2>(lds, g, S, E); }
        }
        SEAM_L(pb + 4);
        if (IN(pb + 5)) for (int rep = 0; rep < REP_NORM; ++rep) { PH_WS PH_IDS
            if (F1Q(L)) { if (L == 0) norm_rows<true, true, false, true, true>(GB, x_in, XB, nw + D, nw + 2 * D, (bf16*)H8, gw_p, NGW, lane_p, PANEL, RSA);
                else norm_rows<true, true, true, true, true>(GB, XB, XB, nw + D, nw + 2 * D, (bf16*)H8, gw_p, NGW, lane_p, PANEL, RSA); }
            else if (L == 0 && rep == 0) norm_rows<true, true, false, true>(GB, x_in, XB, nw + D, nw + 2 * D, H, gw_p, NGW, lane_p, PANEL);
            else norm_rows<true, true, true, true>(GB, XB, rep ? (void*)XSCR : (void*)XB, nw + D, nw + 2 * D, rep ? HSCR : H, gw_p, NGW, lane_p, PANEL); }
        SEAM_L(pb + 5);
        if (IN(pb + 6)) for (int rep = 0; rep < REP_F1; ++rep) { PH_WS
            if (F1Q(L)) { pg8::HybridOrder S; S.init(M, FFN_N, G, bx, vcu, PANEL); pg8::Gemm g{(const bf16*)H8, WF1 + (size_t)L * FFN_N * D, M, FFN_N, D};
                RS_TO_LDS(RSA); pg8::EpiSwiGLU8 E{ACT, DFF, RSA, 1.0f / WSC(L), RSL};
                pg8::gemm_phase<pg8::EpiSwiGLU8, pg8::HybridOrder, true, GEMM_SP2>(lds, g, S, E); }
            else { pg8::HybridOrder S; S.init(M, FFN_N, G, bx, vcu, PANEL); pg8::Gemm g{H, WF1 + (size_t)L * FFN_N * D, M, FFN_N, D};
                pg8::EpiSwiGLU E{ACT, DFF, ACT};
                pg8::gemm_phase<pg8::EpiSwiGLU, pg8::HybridOrder, true, GEMM_SP2>(lds, g, S, E); }
            const bool tailwg = PANEL ? ((vcu & 31) + 32 * 5 >= 4 * (FFN_N / 256)) : (bx >= FF1_REM);
            if (TAILCVT && L + 1 < DEPTH && (tailwg || TAIL_SPLIT < 100)) {
                PH_IDS
                LAS float* scr = (LAS float*)(lds + wave_p * 16384);
                const int cls = PANEL ? ((vcu >> 5) * 16 + (vcu & 31) - (tailwg ? 16 : 0)) : (tailwg ? bx - FF1_REM : bx);
                const int gw2 = cls * NWAVES + wave_p, ngw2 = (tailwg ? (G - FF1_REM) : FF1_REM) * NWAVES;
                const int p0 = tailwg ? 0 : TAIL_SPLIT, p1 = tailwg ? TAIL_SPLIT : 100;
                transpose_matrix(w_ffn_in + (size_t)(L + 1) * D * FFN_N, D, FFN_N, WF1 + (size_t)(L + 1) * FFN_N * D, 1, scr, gw2, ngw2, lane_p, p0, p1, F1Q(L + 1) ? WSC(L + 1) : 0.f);
                transpose_matrix(w_ffn_out + (size_t)(L + 1) * DFF * D, DFF, D, WF2 + (size_t)(L + 1) * D * DFF, 0, scr, gw2, ngw2, lane_p, p0 * TAIL_F2_PCT / 100, p1 * TAIL_F2_PCT / 100);
            }
        }
        SEAM_L(pb + 6);
#ifdef PROBE_CLK
        unsigned long long pc0 = 0, pr0 = 0; if (L == PROBE_CLK - 1 && IN(pb + 7)) { pc0 = clock64(); pr0 = __builtin_amdgcn_s_memrealtime(); }
#endif
        if (IN(pb + 7)) for (int rep = 0; rep < REP_F2; ++rep) { PH_WS
            pg8::Gemm g{ACT, WF2 + (size_t)L * D * DFF, M, D, DFF}; pg8::HybridOrder S; S.init(M, D, G, bx, vcu, PANEL);
            pg8::EpiBf16<0> E{GB, D, nullptr, 0, 0, 1.f};
            pg8::gemm_phase<pg8::EpiBf16<0>, pg8::HybridOrder, ONE_ALIGN, GEMM_SP2>(lds, g, S, E);
        }
#ifdef PROBE_CLK
        if (L == PROBE_CLK - 1 && IN(pb + 7) && hwbx == 0) { const unsigned long long dc = clock64() - pc0, dr = __builtin_amdgcn_s_memrealtime() - pr0;
            const unsigned long long slp = 10000ull * dc / (dr ? dr : 1); const unsigned long long t0 = __builtin_amdgcn_s_memrealtime();
            while (__builtin_amdgcn_s_memrealtime() - t0 < slp) __builtin_amdgcn_s_sleep(8); }
#endif
        SEAM_L(pb + 7);
        if (IN(pb + 8)) for (int rep = 0; rep < REP_NORM; ++rep) {
            PH_WS PH_IDS
            const int lane = lane_p, gw = gw_p;
            if (L + 1 < DEPTH && INQ(L + 1)) norm_rows<true, true, true, true, true>(GB, XB, XB, nw + 3 * D, nw + 4 * D, (bf16*)H8, gw, NGW, lane, PANEL, RSA);
            else if (L + 1 < DEPTH) norm_rows<true, true, true, true>(GB, XB, rep ? (void*)XSCR : (void*)XB, nw + 3 * D, nw + 4 * D, rep ? HSCR : H, gw, NGW, lane, PANEL);
            else norm_rows<true, false, true, false>(GB, XB, rep ? XSCR : xres, nw + 3 * D, nullptr, nullptr, gw, NGW, lane, PANEL);
        }
        SEAM_L(pb + 8);
    }
#ifdef PROBE_BWAIT
    if (hwbx == PROBE_BWAIT - 1) { const unsigned long long t0_ = __builtin_amdgcn_s_memrealtime(); while (__builtin_amdgcn_s_memrealtime() - t0_ < bw_acc) __builtin_amdgcn_s_sleep(8); }
#endif
#undef IN
#undef SEAM
#undef WSC
#undef RS_TO_LDS
#undef RSL
#undef H8
#undef RSA
#undef RSO
#undef PH_WS
#undef cosT
#undef sinT
#undef lbT
#undef WHG
#undef WAT
#undef WO
#undef WF1
#undef WF2
#undef H
#undef PROJ
#undef MIX
#undef OB
#undef GB
#undef LSE
#undef QT
#undef KT
#undef ACT
#undef XB
#undef XSCR
#undef HSCR
#undef PREF
#undef E63V
}

#ifndef MK_PER_PHASE
#define MK_PER_PHASE 0
#endif
extern "C" void kernel_launch(void* const* d_in, const int* in_sizes, int n_in, void* d_out, int out_size, void* d_ws, size_t ws_size, hipStream_t stream) {
    static int grid = 0;
    if (grid == 0) {
        if (n_in != 9 || in_sizes[0] != M * D || out_size != M * D || ws_size < WS_END) { fprintf(stderr, "kernel_launch: unexpected shapes (n_in %d, in0 %d, out %d, ws %zu); nothing launched\n", n_in, n_in > 0 ? in_sizes[0] : -1, out_size, ws_size); grid = -1; return; }
        int dev = 0, cus = 0, per_cu = 0;
        if (hipGetDevice(&dev) != hipSuccess || hipDeviceGetAttribute(&cus, hipDeviceAttributeMultiprocessorCount, dev) != hipSuccess) { grid = -1; return; }
        if (hipFuncSetAttribute((const void*)fwd, hipFuncAttributeMaxDynamicSharedMemorySize, LDS_BYTES) != hipSuccess) { fprintf(stderr, "kernel_launch: hipFuncSetAttribute failed\n"); grid = -1; return; }
        if (hipOccupancyMaxActiveBlocksPerMultiprocessor(&per_cu, (const void*)fwd, NTHREADS, LDS_BYTES) != hipSuccess || per_cu < 1) fprintf(stderr, "kernel_launch: occupancy query reports %d\n", per_cu);
        (void)hipGetLastError();
        grid = cus;
    }
    if (grid < 0) return;
    if (hipMemsetAsync((char*)d_ws + WS_CTL, 0, CTL_ZERO_BYTES, stream) != hipSuccess) return;
    Args a{};
    for (int i = 0; i < 9; ++i) a.in[i] = (const float*)d_in[i];
    a.out = (float*)d_out; a.ws = (unsigned char*)d_ws;
#if MK_PER_PHASE
    for (int p = 0; p < NPHASES; ++p) { a.ph_lo = p; a.ph_hi = p + 1; hipLaunchKernelGGL(fwd, dim3(grid), dim3(NTHREADS), LDS_BYTES, stream, a); }
#else
    a.ph_lo = 0; a.ph_hi = NPHASES; hipLaunchKernelGGL(fwd, dim3(grid), dim3(NTHREADS), LDS_BYTES, stream, a);
#endif
}
```

```cpp
#include <hip/hip_runtime.h>
#include <cstdio>
#include <cstdint>
#define I8_IN 0xE
#define F1_I8 0xF
#ifndef QKV_ADJ
#define QKV_ADJ 0
#endif
#ifdef EPI_NT
#define PG8_ST(v, p) __builtin_nontemporal_store((v), (p))
#elif defined(EPI_ASM)
#define PG8_XSTR(x) #x
#define PG8_STR(x) PG8_XSTR(x)
#define PG8_ST(v, p) asm volatile("global_store_dwordx4 %0, %1, off " PG8_STR(EPI_ASM) "\n\ts_nop 2" :: "v"(p), "v"(v) : "memory")
#else
#define PG8_ST(v, p) (*(p) = (v))
#endif
#ifndef PG8_WGM
#define PG8_WGM 8
#endif
namespace pg8 {
#define PG8_LAS __attribute__((address_space(3)))
typedef unsigned short bf16_t;
typedef short bf16x8 __attribute__((ext_vector_type(8)));
typedef float f32x4 __attribute__((ext_vector_type(4)));
typedef unsigned u32x4 __attribute__((ext_vector_type(4)));
typedef int i32x4 __attribute__((ext_vector_type(4)));
constexpr int BM = 256, BK = 64, HALF = 128, HTB = HALF * BK * 2  , STAGE_BYTES = 8 * HTB, NXCD = 8, WGM = PG8_WGM;

__host__ __device__ __forceinline__ int lds_byte(int r, int c) { const int st = (r >> 4) * 2 + (c >> 5), rr = r & 15, cc = c & 31, ob = rr * 64 + cc * 2; return st * 1024 + (ob ^ (((ob >> 9) & 1) << 5)); }
__host__ __device__ __forceinline__ void stage_rc(int b, int& R, int& C) { const int st = b / 1024, sb = b % 1024, swz = sb ^ (((sb >> 9) & 1) << 5); R = (st >> 1) * 16 + swz / 64; C = (st & 1) * 32 + (swz % 64) / 2; }
__host__ __device__ __forceinline__ int perm32(int rho) { const int n = rho >> 4, i = rho & 15; return 8 * (i >> 2) + 4 * n + (i & 3); }

struct Unit { int pm, pn; };
struct Gemm { const bf16_t* A; const bf16_t* Bt; int M, N, K; };

struct StaticOrder {
    int nM, nN, nwg, G, c;
    __host__ __device__ void init(int M, int N, int G_, int c_) { nM = M / BM; nN = N / BM; nwg = nM * nN; G = G_; c = c_; }
    __host__ __device__ bool next(int i, Unit& u) const {
        const long L = (long)i * G + c; if (L >= nwg) return false;
        int wgid = (int)L; { const int q = nwg / NXCD, r = nwg % NXCD, xcd = wgid % NXCD, off = wgid / NXCD; wgid = (xcd < r ? xcd * (q + 1) : r * (q + 1) + (xcd - r) * q) + off; }
        const int nig = WGM * nN, gid = wgid / nig, fm = gid * WGM, gsz = (nM - fm) < WGM ? (nM - fm) : WGM;
        u.pm = fm + ((wgid % nig) % gsz); u.pn = (wgid % nig) / gsz; return true;
    }
    __device__ __forceinline__ void a_ready(const Unit&) const {}
    __device__ __forceinline__ void done(const Unit&) const {}
};

__device__ __forceinline__ unsigned cvt_pk_bf16(float lo, float hi) { unsigned r; asm volatile("v_cvt_pk_bf16_f32 %0, %1, %2" : "=v"(r) : "v"(lo), "v"(hi)); return r; }
typedef float f32x2 __attribute__((ext_vector_type(2)));
__device__ __forceinline__ f32x2 gelu_pk(f32x2 v) {
    const f32x2 av = __builtin_elementwise_abs(v), d = av * 0.2316418882f + 1.0f;
    f32x2 t; t.x = __builtin_amdgcn_rcpf(d.x); t.y = __builtin_amdgcn_rcpf(d.y);
    f32x2 q = t * 0.5307027145f + (-0.7265760135f); q = q * t + 0.7107068705f; q = q * t + (-0.142248368f); q = q * t + 0.127414796f; q = q * t;
    const f32x2 s = (v * v) * (-0.72134752044f);
    f32x2 e; e.x = __builtin_amdgcn_exp2f(s.x); e.y = __builtin_amdgcn_exp2f(s.y);
    const f32x2 m = v * (q * e), r = v - m;
    f32x2 o; o.x = v.x < 0.f ? m.x : r.x; o.y = v.y < 0.f ? m.y : r.y; return o;
}

__device__ __forceinline__ f32x4 acc_f(const f32x4& a, float) { return a; }
__device__ __forceinline__ f32x4 acc_f(const i32x4& a, float sc) { return (f32x4){(float)a[0] * sc, (float)a[1] * sc, (float)a[2] * sc, (float)a[3] * sc}; }
template <bool Q> struct AccSel { typedef f32x4 t; }; template <> struct AccSel<true> { typedef i32x4 t; };
template <int ACT  , bool Q = false> struct EpiBf16 {
    static constexpr int NST = 16;
    static constexpr bool PERM = true, AFTER_DRAIN = false, I8 = Q; typedef typename AccSel<Q>::t acc_t; static_assert(ACT == 0 || ACT == 1, "EpiBf16: ACT is 0 (none) or 1 (gelu_pk)");
    bf16_t* O; int ldc; const float* bias; int split_cols; size_t split_stride; float scale0; const float* rs = nullptr; float wsc = 1.f; const PG8_LAS float* rsl = nullptr;
    __device__ __forceinline__ void operator()(const acc_t (&acc)[2][2][4][2], const Unit& u, int wr, int wc, int fr, int fq) const {
        const int row0 = u.pm * BM + wr * 64 + fr; int colt = u.pn * BM; bf16_t* base = O;
        float sc = 1.f; if (split_cols) { const int t = colt / split_cols; base += (size_t)t * split_stride; colt -= t * split_cols; if (t == 0) sc = scale0; }
        const int col0 = colt + wc * 32 + 8 * fq, bcol0 = u.pn * BM + wc * 32 + 8 * fq;
        float rsq[2][4];
        if constexpr (Q) {
#pragma unroll
            for (int ai = 0; ai < 2; ++ai)
#pragma unroll
                for (int m = 0; m < 4; ++m) rsq[ai][m] = rsl[wr * 64 + fr + ai * HALF + m * 16] * wsc; }
        f32x4 bv[2][2];
#pragma unroll
        for (int bj = 0; bj < 2; ++bj)
#pragma unroll
            for (int n = 0; n < 2; ++n) bv[bj][n] = bias ? *(const f32x4*)(bias + bcol0 + bj * HALF + 4 * n) : (f32x4){0.f, 0.f, 0.f, 0.f};
#pragma unroll
        for (int ai = 0; ai < 2; ++ai)
#pragma unroll
            for (int m = 0; m < 4; ++m) { bf16_t* rowp = base + (size_t)(row0 + ai * HALF + m * 16) * ldc + col0; const float qs = Q ? rsq[ai][m] : 1.f;
#pragma unroll
                for (int bj = 0; bj < 2; ++bj) { f32x4 v0 = acc_f(acc[ai][bj][m][0], qs), v1 = acc_f(acc[ai][bj][m][1], qs); if constexpr (!Q) { v0 = v0 + bv[bj][0]; v1 = v1 + bv[bj][1]; }
                    if (ACT == 1) { f32x2 a = gelu_pk((f32x2){v0[0], v0[1]}), b = gelu_pk((f32x2){v0[2], v0[3]}), c = gelu_pk((f32x2){v1[0], v1[1]}), d = gelu_pk((f32x2){v1[2], v1[3]});
                        v0 = (f32x4){a.x, a.y, b.x, b.y}; v1 = (f32x4){c.x, c.y, d.x, d.y}; }
                    v0 = v0 * sc; v1 = v1 * sc; u32x4 w; w.x = cvt_pk_bf16(v0[0], v0[1]); w.y = cvt_pk_bf16(v0[2], v0[3]); w.z = cvt_pk_bf16(v1[0], v1[1]); w.w = cvt_pk_bf16(v1[2], v1[3]);
                    PG8_ST(w, (u32x4*)(rowp + bj * HALF)); } }
    }
};

#ifndef PG8_PRESTAGE
#define PG8_PRESTAGE 0
#endif
template <class Epi, class Sched, bool ALIGN_EPI = false, bool SP2 = false>
__device__ __forceinline__ void gemm_phase(PG8_LAS unsigned char* lds, const Gemm g, const Sched& S, const Epi& E) {
    int tid_l = threadIdx.x; asm volatile("" : "+v"(tid_l));
    const int tid = tid_l, wid = __builtin_amdgcn_readfirstlane(tid >> 6), lane = tid & 63, wr = wid >> 2, wc = wid & 3, fr = lane & 15, fq = lane >> 4;
    const int K = g.K * (Epi::I8 ? 1 : 2) / 2, nt = K / BK;
    unsigned voffA[2], voffB[2];
#pragma unroll
    for (int i = 0; i < 2; ++i) { int R, C; stage_rc(tid * 16 + i * 8192, R, C); const int Rb = Epi::PERM ? ((R & ~31) + perm32(R & 31)) : R;
        voffA[i] = (unsigned)(R * K + C) * 2u; voffB[i] = (unsigned)(Rb * K + C) * 2u; }
    const size_t kstep = (size_t)(BK * 2);
    const size_t hstep = (size_t)HALF * K * 2;
    const size_t tstep = 2 * hstep;
    const unsigned ldsw = (unsigned)wid * 1024u;
    const int aoff = lds_byte(wr * 64 + fr, fq * 8), boff = lds_byte(wc * 32 + fr, fq * 8);
#define PG8_SA(b, h) (((b) * 2 + (h)) * HTB)
#define PG8_SB(b, h) ((4 + (b) * 2 + (h)) * HTB)
#define PG8_STAGE(bufoff, gbase, voff) do { _Pragma("unroll") for (int _i = 0; _i < 2; ++_i) \
        __builtin_amdgcn_global_load_lds((const unsigned*)((const char*)(gbase) + (voff)[_i]), (PG8_LAS unsigned*)(lds + (bufoff) + ldsw + _i * 8192), 16, 0, 0); } while (0)
#define PG8_LDA(dst, b, h) do { _Pragma("unroll") for (int m = 0; m < 4; ++m) _Pragma("unroll") for (int k = 0; k < 2; ++k) dst[m][k] = *(const PG8_LAS bf16x8*)(lds + PG8_SA(b, h) + aoff + m * 2048 + k * 1024); } while (0)
#define PG8_LDB(dst, b, h) do { _Pragma("unroll") for (int n = 0; n < 2; ++n) _Pragma("unroll") for (int k = 0; k < 2; ++k) dst[n][k] = *(const PG8_LAS bf16x8*)(lds + PG8_SB(b, h) + boff + n * 2048 + k * 1024); } while (0)
#define PG8_MMA(ai, bj, At, Bt) do { __builtin_amdgcn_s_setprio(1); _Pragma("unroll") for (int m = 0; m < 4; ++m) _Pragma("unroll") for (int n = 0; n < 2; ++n) _Pragma("unroll") for (int k = 0; k < 2; ++k) \
        { if constexpr (Epi::I8) acc[ai][bj][m][n] = __builtin_amdgcn_mfma_i32_16x16x64_i8(__builtin_bit_cast(i32x4, Bt[n][k]), __builtin_bit_cast(i32x4, At[m][k]), acc[ai][bj][m][n], 0, 0, 0); \
          else acc[ai][bj][m][n] = __builtin_amdgcn_mfma_f32_16x16x32_bf16(Bt[n][k], At[m][k], acc[ai][bj][m][n], 0, 0, 0); } __builtin_amdgcn_s_setprio(0); } while (0)
#define PG8_WAIT_V(n) asm volatile("s_waitcnt vmcnt(" #n ")" ::: "memory")
#define PG8_WAIT_VX(c) do { const int c_ = PRE_OK ? __builtin_amdgcn_readfirstlane((c) ? 1 : 0) : 0; \
        if constexpr (!PRE_OK) asm volatile("s_waitcnt vmcnt(8)" ::: "memory"); \
        else if constexpr (Epi::NST == 16) asm volatile("s_waitcnt vmcnt(26)\n\ts_cmp_lg_u32 %0, 0\n\ts_cbranch_scc1 1\n\ts_waitcnt vmcnt(8)" :: "s"(c_) : "memory", "scc"); \
        else if constexpr (Epi::NST == 8) asm volatile("s_waitcnt vmcnt(18)\n\ts_cmp_lg_u32 %0, 0\n\ts_cbranch_scc1 1\n\ts_waitcnt vmcnt(8)" :: "s"(c_) : "memory", "scc"); \
        else asm volatile("s_waitcnt vmcnt(8)" ::: "memory"); } while (0)
#define PG8_WAIT_L(n) asm volatile("s_waitcnt lgkmcnt(" #n ")" ::: "memory")
#define PG8_BAR __builtin_amdgcn_s_barrier()
#define PG8_SCHED __builtin_amdgcn_sched_barrier(0)
    Unit cur, nxt; int ui = 0;
    if (!S.next(0, cur)) return;
    typename Epi::acc_t acc[2][2][4][2];
#pragma unroll
    for (int a = 0; a < 2; ++a)
#pragma unroll
        for (int b = 0; b < 2; ++b)
#pragma unroll
            for (int m = 0; m < 4; ++m)
#pragma unroll
                for (int n = 0; n < 2; ++n) acc[a][b][m][n] = (typename Epi::acc_t){0, 0, 0, 0};
    bf16x8 At[4][2], B0[2][2], B1[2][2];
    const char* cA = (const char*)g.A + (size_t)cur.pm * tstep; const char* cB = (const char*)g.Bt + (size_t)cur.pn * tstep;
    S.a_ready(cur);
    if constexpr (SP2) {
        PG8_STAGE(PG8_SB(0, 0), cB, voffB); PG8_STAGE(PG8_SB(0, 1), cB + hstep, voffB); PG8_STAGE(PG8_SA(0, 0), cA, voffA); PG8_STAGE(PG8_SA(0, 1), cA + hstep, voffA);
        if (wr == 1) PG8_BAR;
        PG8_WAIT_V(2); PG8_BAR;
        PG8_STAGE(PG8_SB(1, 0), cB + kstep, voffB); PG8_STAGE(PG8_SA(1, 0), cA + kstep, voffA); PG8_STAGE(PG8_SB(1, 1), cB + hstep + kstep, voffB);
        PG8_WAIT_V(6); PG8_BAR;
    } else {
        PG8_STAGE(PG8_SB(0, 0), cB, voffB); PG8_STAGE(PG8_SA(0, 0), cA, voffA); PG8_STAGE(PG8_SB(0, 1), cB + hstep, voffB); PG8_STAGE(PG8_SA(0, 1), cA + hstep, voffA);
        if (wr == 1) PG8_BAR;
        PG8_WAIT_V(4); PG8_BAR;
        PG8_STAGE(PG8_SB(1, 0), cB + kstep, voffB); PG8_STAGE(PG8_SA(1, 0), cA + kstep, voffA); PG8_STAGE(PG8_SB(1, 1), cB + hstep + kstep, voffB);
        PG8_WAIT_V(6); PG8_BAR;
    }
    constexpr bool PRE_OK = PG8_PRESTAGE && SP2 && ALIGN_EPI && !Epi::AFTER_DRAIN && (Epi::NST == 16 || Epi::NST == 8);
    bool pre = false;
    for (;;) {
        const bool has_next = S.next(ui + 1, nxt);
        const char* nA = has_next ? (const char*)g.A + (size_t)nxt.pm * tstep : cA; const char* nB = has_next ? (const char*)g.Bt + (size_t)nxt.pn * tstep : cB;
        for (int t = 0; t < nt; t += 2) {
            const bool last = (t == nt - 2);
            const char* a1 = cA + (size_t)(t + 1) * kstep;
            const char* a2 = last ? nA : cA + (size_t)(t + 2) * kstep; const char* b2 = last ? nB : cB + (size_t)(t + 2) * kstep;
            const char* a3 = a2 + kstep; const char* b3 = b2 + kstep;
            if (last && has_next) S.a_ready(nxt);
            if constexpr (SP2) {
            const bool rx = PRE_OK && t == 0 && pre;
            PG8_LDB(B0, 0, 0); PG8_LDB(B1, 0, 1); PG8_SCHED; PG8_LDA(At, 0, 0); PG8_STAGE(PG8_SA(1, 1), a1 + hstep, voffA);
            PG8_WAIT_VX(rx); PG8_WAIT_L(0); PG8_BAR; PG8_MMA(0, 0, At, B0); PG8_MMA(0, 1, At, B1); PG8_BAR; PG8_SCHED;
            PG8_LDA(At, 0, 1); PG8_STAGE(PG8_SB(0, 0), b2, voffB); PG8_STAGE(PG8_SB(0, 1), b2 + hstep, voffB); PG8_STAGE(PG8_SA(0, 0), a2, voffA);
            PG8_WAIT_VX(rx); PG8_WAIT_L(0); PG8_BAR; PG8_MMA(1, 0, At, B0); PG8_MMA(1, 1, At, B1); PG8_BAR; PG8_SCHED;
            PG8_LDB(B0, 1, 0); PG8_LDB(B1, 1, 1); PG8_SCHED; PG8_LDA(At, 1, 0); PG8_STAGE(PG8_SA(0, 1), a2 + hstep, voffA);
            PG8_WAIT_VX(rx); PG8_WAIT_L(0); PG8_BAR; PG8_MMA(0, 0, At, B0); PG8_MMA(0, 1, At, B1); PG8_BAR; PG8_SCHED;
            PG8_LDA(At, 1, 1); PG8_STAGE(PG8_SB(1, 0), b3, voffB); PG8_STAGE(PG8_SB(1, 1), b3 + hstep, voffB); PG8_STAGE(PG8_SA(1, 0), a3, voffA);
            PG8_WAIT_V(8); PG8_WAIT_L(0); PG8_BAR; PG8_MMA(1, 0, At, B0); PG8_MMA(1, 1, At, B1); PG8_BAR; PG8_SCHED;
            } else {
            PG8_LDB(B0, 0, 0); PG8_SCHED; PG8_LDA(At, 0, 0); PG8_STAGE(PG8_SA(1, 1), a1 + hstep, voffA);
            PG8_WAIT_L(8); PG8_BAR; PG8_WAIT_L(0); PG8_MMA(0, 0, At, B0); PG8_BAR; PG8_SCHED;
            PG8_LDB(B1, 0, 1); PG8_STAGE(PG8_SB(0, 0), b2, voffB);
            PG8_BAR; PG8_WAIT_L(0); PG8_MMA(0, 1, At, B1); PG8_BAR;
            PG8_LDA(At, 0, 1); PG8_STAGE(PG8_SA(0, 0), a2, voffA);
            PG8_BAR; PG8_WAIT_L(0); PG8_MMA(1, 0, At, B0); PG8_BAR; PG8_SCHED;
            PG8_STAGE(PG8_SB(0, 1), b2 + hstep, voffB);
            PG8_WAIT_V(6); PG8_BAR; PG8_MMA(1, 1, At, B1); PG8_BAR;
            PG8_LDB(B0, 1, 0); PG8_SCHED; PG8_LDA(At, 1, 0); PG8_STAGE(PG8_SA(0, 1), a2 + hstep, voffA);
            PG8_WAIT_L(8); PG8_BAR; PG8_WAIT_L(0); PG8_MMA(0, 0, At, B0); PG8_BAR; PG8_SCHED;
            PG8_LDB(B1, 1, 1); PG8_STAGE(PG8_SB(1, 0), b3, voffB);
            PG8_BAR; PG8_WAIT_L(0); PG8_MMA(0, 1, At, B1); PG8_BAR;
            PG8_LDA(At, 1, 1); PG8_STAGE(PG8_SA(1, 0), a3, voffA);
            PG8_BAR; PG8_WAIT_L(0); PG8_MMA(1, 0, At, B0); PG8_BAR; PG8_SCHED;
            PG8_STAGE(PG8_SB(1, 1), b3 + hstep, voffB);
            PG8_WAIT_V(6); PG8_BAR; PG8_MMA(1, 1, At, B1); PG8_BAR;
            }
        }
        if constexpr (ALIGN_EPI) { if (wr == 0) PG8_BAR; }
        if constexpr (PRE_OK) { pre = has_next; if (has_next) PG8_STAGE(PG8_SA(1, 1), nA + kstep + hstep, voffA); }
        if constexpr (!Epi::AFTER_DRAIN) { E(acc, cur, wr, wc, fr, fq);
#ifdef PROBE_EPI2
            asm volatile("" ::: "memory"); E(acc, cur, wr, wc, fr, fq);
#endif
            S.done(cur); }
        if (!has_next) break;
#pragma unroll
        for (int a = 0; a < 2; ++a)
#pragma unroll
            for (int b = 0; b < 2; ++b)
#pragma unroll
                for (int m = 0; m < 4; ++m)
#pragma unroll
                    for (int n = 0; n < 2; ++n) acc[a][b][m][n] = (typename Epi::acc_t){0, 0, 0, 0};
        cur = nxt; cA = nA; cB = nB; ++ui;
        if constexpr (ALIGN_EPI) { if (wr == 1) PG8_BAR; }
    }
    PG8_WAIT_V(0);
    if constexpr (!ALIGN_EPI) { if (wr == 0) PG8_BAR; }
    PG8_BAR;
    if constexpr (Epi::AFTER_DRAIN) { E.fused(acc, cur, wr, wc, fr, fq, lds, wid, lane); S.done(cur); }
#undef PG8_SA
#undef PG8_SB
#undef PG8_STAGE
#undef PG8_LDA
#undef PG8_LDB
#undef PG8_MMA
#undef PG8_WAIT_V
#undef PG8_WAIT_VX
#undef PG8_WAIT_L
#undef PG8_BAR
#undef PG8_SCHED
}
}
namespace pg8 {
__device__ __forceinline__ float silu_f(float x) { return x * __builtin_amdgcn_rcpf(1.0f + __builtin_amdgcn_exp2f(-1.44269504f * x)); }
struct EpiSwiGLU {
    static constexpr int NST = 8;
    static constexpr bool PERM = true, AFTER_DRAIN = false, I8 = false; typedef f32x4 acc_t;
    bf16_t* O; int ldc; bf16_t* O2;
    __device__ __forceinline__ void operator()(const f32x4 (&acc)[2][2][4][2], const Unit& u, int wr, int wc, int fr, int fq) const {
        const int row0 = u.pm * BM + wr * 64 + fr; const int col0 = u.pn * HALF + wc * 32 + 8 * fq;
#pragma unroll
        for (int ai = 0; ai < 2; ++ai)
#pragma unroll
            for (int m = 0; m < 4; ++m) { bf16_t* rowp = O + (size_t)(row0 + ai * HALF + m * 16) * ldc + col0;
                const f32x4 g0 = acc[ai][0][m][0], g1 = acc[ai][0][m][1], u0 = acc[ai][1][m][0], u1 = acc[ai][1][m][1];
                u32x4 w; w.x = cvt_pk_bf16(silu_f(g0[0]) * u0[0], silu_f(g0[1]) * u0[1]); w.y = cvt_pk_bf16(silu_f(g0[2]) * u0[2], silu_f(g0[3]) * u0[3]);
                w.z = cvt_pk_bf16(silu_f(g1[0]) * u1[0], silu_f(g1[1]) * u1[1]); w.w = cvt_pk_bf16(silu_f(g1[2]) * u1[2], silu_f(g1[3]) * u1[3]);
                PG8_ST(w, (u32x4*)rowp);
#ifdef PROBE_F1X
                *(u32x4*)(O2 + (size_t)(row0 + ai * HALF + m * 16) * ldc + col0) = w;
#endif
                }
    }
};

struct EpiSwiGLU8 {
    static constexpr int NST = 8;
    static constexpr bool PERM = true, AFTER_DRAIN = false, I8 = true; typedef i32x4 acc_t;
    bf16_t* O; int ldc; const float* rs; float wsc; const PG8_LAS float* rsl = nullptr;
    __device__ __forceinline__ void operator()(const i32x4 (&acc)[2][2][4][2], const Unit& u, int wr, int wc, int fr, int fq) const {
        const int row0 = u.pm * BM + wr * 64 + fr; const int col0 = u.pn * HALF + wc * 32 + 8 * fq;
        float rsv[2][4];
#pragma unroll
        for (int ai = 0; ai < 2; ++ai)
#pragma unroll
            for (int m = 0; m < 4; ++m) rsv[ai][m] = rsl[wr * 64 + fr + ai * HALF + m * 16] * wsc;
#pragma unroll
        for (int ai = 0; ai < 2; ++ai)
#pragma unroll
            for (int m = 0; m < 4; ++m) { bf16_t* rowp = O + (size_t)(row0 + ai * HALF + m * 16) * ldc + col0; const float sc = rsv[ai][m];
                f32x4 g0, g1, u0, u1;
#pragma unroll
                for (int i = 0; i < 4; ++i) { g0[i] = (float)acc[ai][0][m][0][i] * sc; g1[i] = (float)acc[ai][0][m][1][i] * sc; u0[i] = (float)acc[ai][1][m][0][i] * sc; u1[i] = (float)acc[ai][1][m][1][i] * sc; }
                u32x4 w; w.x = cvt_pk_bf16(silu_f(g0[0]) * u0[0], silu_f(g0[1]) * u0[1]); w.y = cvt_pk_bf16(silu_f(g0[2]) * u0[2], silu_f(g0[3]) * u0[3]);
                w.z = cvt_pk_bf16(silu_f(g1[0]) * u1[0], silu_f(g1[1]) * u1[1]); w.w = cvt_pk_bf16(silu_f(g1[2]) * u1[2], silu_f(g1[3]) * u1[3]);
                PG8_ST(w, (u32x4*)rowp); }
    }
};
struct HybridOrder {
    bool panel; StaticOrder so; int q, r, nunits;
    __device__ void init(int M_, int N_, int G_, int bx_, int vcu_, bool panel_) { panel = panel_; so.init(M_, N_, G_, bx_); q = vcu_ >> 5; r = vcu_ & 31; nunits = 4 * (N_ / BM); }
    __device__ bool next(int i, Unit& u) const { if (!panel) return so.next(i, u); const int j = r + 32 * i; if (j >= nunits) return false; u.pm = 4 * q + (j & 3); u.pn = j >> 2; return true; }
    __device__ __forceinline__ void a_ready(const Unit&) const {}
    __device__ __forceinline__ void done(const Unit&) const {}
};
}
#ifdef ROPE_NT
#define PG8_ST_ROPE(v, p) __builtin_nontemporal_store((v), (p))
#else
#define PG8_ST_ROPE(v, p) PG8_ST(v, p)
#endif
namespace pg8 {
template <bool Q> struct EpiRopeT {
    static constexpr int NST = 16;
    static constexpr bool PERM = true, AFTER_DRAIN = false, I8 = Q; typedef typename AccSel<Q>::t acc_t;
    bf16_t* O; int ldc; const float* cosT; const float* sinT; const float* rs = nullptr; float wsc = 1.f; const PG8_LAS float* rsl = nullptr;
    __device__ __forceinline__ void operator()(const acc_t (&acc)[2][2][4][2], const Unit& u, int wr, int wc, int fr, int fq) const {
        const int row0 = u.pm * BM + wr * 64 + fr; const int colt = u.pn * BM; const int col0 = colt + wc * 32 + 8 * fq;
#if QKV_ADJ
        const int jb0 = (colt >> 7) % 3;
        const bool rot = (wc == 0);
        const bool rotb[2] = {rot && jb0 < 2, rot && ((jb0 + 1) % 3) < 2};
#else
        const bool rot = (((colt >> 11) % 3) < 2) && (wc == 0);
        const bool rotb[2] = {rot, rot};
#endif
        const int dd0 = 8 * (fq & 1); const float sgn = (fq < 2) ? -1.0f : 1.0f;
        float rsq[2][4];
        if constexpr (Q) {
#pragma unroll
            for (int ai = 0; ai < 2; ++ai)
#pragma unroll
                for (int m = 0; m < 4; ++m) rsq[ai][m] = rsl[wr * 64 + fr + ai * HALF + m * 16] * wsc; }
#pragma unroll
        for (int ai = 0; ai < 2; ++ai)
#pragma unroll
            for (int m = 0; m < 4; ++m) { const int row = row0 + ai * HALF + m * 16; bf16_t* rowp = O + (size_t)row * ldc + col0;
                f32x4 c0 = (f32x4){1.f, 1.f, 1.f, 1.f}, c1 = c0, s0 = (f32x4){0.f, 0.f, 0.f, 0.f}, s1 = s0;
                if (rot) { const int pos = row & 4095; const f32x4* cp = (const f32x4*)(cosT + pos * 16 + dd0); const f32x4* sp = (const f32x4*)(sinT + pos * 16 + dd0);
                    c0 = cp[0]; c1 = cp[1]; s0 = sp[0] * sgn; s1 = sp[1] * sgn; }
#pragma unroll
                for (int bj = 0; bj < 2; ++bj) { const float qs = Q ? rsq[ai][m] : 1.f; f32x4 v0 = acc_f(acc[ai][bj][m][0], qs), v1 = acc_f(acc[ai][bj][m][1], qs);
                    if (rotb[bj]) { f32x4 p0, p1;
#pragma unroll
                        for (int i = 0; i < 4; ++i) { p0[i] = __shfl_xor(v0[i], 32); p1[i] = __shfl_xor(v1[i], 32); }
                        v0 = v0 * c0 + p0 * s0; v1 = v1 * c1 + p1 * s1; }
                    u32x4 w; w.x = cvt_pk_bf16(v0[0], v0[1]); w.y = cvt_pk_bf16(v0[2], v0[3]); w.z = cvt_pk_bf16(v1[0], v1[1]); w.w = cvt_pk_bf16(v1[2], v1[3]);
                    PG8_ST_ROPE(w, (u32x4*)(rowp + bj * HALF)); } }
    }
};
typedef EpiRopeT<false> EpiRope;
}
#define GAS __attribute__((address_space(1)))
#define LAS __attribute__((address_space(3)))
typedef unsigned short bf16;
typedef unsigned v4u __attribute__((ext_vector_type(4)));
typedef float f32x4 __attribute__((ext_vector_type(4)));
typedef short bf16x8 __attribute__((ext_vector_type(8)));
typedef GAS unsigned gu32;
typedef GAS unsigned long long gu64;
#define RLX_AGENT __ATOMIC_RELAXED, __HIP_MEMORY_SCOPE_AGENT
#define LDS_WAIT() asm volatile("s_waitcnt lgkmcnt(0)" ::: "memory")
#define VM_WAIT() asm volatile("s_waitcnt vmcnt(0)" ::: "memory")
__device__ __forceinline__ unsigned long long rt() { return __builtin_amdgcn_s_memrealtime(); }
__device__ __forceinline__ unsigned f2bf(float f) { unsigned u = __builtin_bit_cast(unsigned, f); return (u + 0x7fffu + ((u >> 16) & 1u)) >> 16; }
__device__ __forceinline__ unsigned pk2(float lo, float hi) { return f2bf(lo) | (f2bf(hi) << 16); }

#define XB_TMO      128
#define XB_XCNT(j)  (256  + 64 * (j))
#define XB_XSUB(j)  (1280 + 64 * (j))
#define XB_XGEN(j)  (2304 + 64 * (j))
#define XB_TOP      3328
#define XB_TOPGEN   3392
#define XCD_BAR_WORDS 3456
#define XB_SPIN_CAP (1u << 18)

__device__ __forceinline__ unsigned xb_ld(unsigned* p)              { return __hip_atomic_load(p, __ATOMIC_RELAXED, __HIP_MEMORY_SCOPE_AGENT); }
__device__ __forceinline__ unsigned xb_add(unsigned* p, unsigned v) { return __hip_atomic_fetch_add(p, v, __ATOMIC_RELAXED, __HIP_MEMORY_SCOPE_AGENT); }
__device__ __forceinline__ unsigned xb_xcc_id() { return (unsigned)__builtin_amdgcn_s_getreg((3 << 11) | 20) & 0xFu; }
#define XB_SPIN(cond, bar) do { unsigned _sp = 0; while (cond) { __builtin_amdgcn_s_sleep(1); \
    if ((++_sp & 255u) == 0u) { if (xb_ld(&(bar)[XB_TMO])) break; if (_sp > XB_SPIN_CAP) { atomicAdd(&(bar)[XB_TMO], 1u); break; } } } } while (0)

struct XcdBarrier {
    unsigned* bar; unsigned x;
    volatile LAS unsigned* st;
};

__device__ __forceinline__ XcdBarrier xcd_barrier_post(unsigned* bar, volatile LAS unsigned* st) {
    XcdBarrier b; b.bar = bar; b.x = xb_xcc_id(); b.st = st;
    if (threadIdx.x == 0) (void)xb_add(&bar[XB_XCNT(b.x)], 1u);
    return b;
}
__device__ __forceinline__ void xcd_barrier_complete(unsigned* bar, unsigned x, unsigned& nloc, unsigned& nx) {
    const unsigned G = gridDim.x * gridDim.y * gridDim.z;
    unsigned sum, cnt, mine, sp = 0u;
    for (;;) {
        sum = 0u; cnt = 0u; mine = 0u;
#pragma unroll
        for (unsigned j = 0; j < 16; ++j) { const unsigned c = xb_ld(&bar[XB_XCNT(j)]); sum += c; cnt += (c > 0u) ? 1u : 0u; mine = (j == x) ? c : mine; }
        if (sum == G) break;
        __builtin_amdgcn_s_sleep(1);
        if ((++sp & 255u) == 0u) { if (xb_ld(&bar[XB_TMO])) break; if (sp > XB_SPIN_CAP) { atomicAdd(&bar[XB_TMO], 1u); break; } }
    }
    nloc = mine > 0u ? mine : 1u; nx = cnt > 0u ? cnt : 1u;
}

__device__ __forceinline__ void xcd_barrier(const XcdBarrier& b) {
    asm volatile("s_waitcnt vmcnt(0)" ::: "memory");
    __syncthreads();
    if (threadIdx.x == 0) {
        unsigned* bar = b.bar;
        __builtin_amdgcn_s_waitcnt(0);
        unsigned nloc = b.st[0], nx = b.st[1];
        if (nloc == 0u) { xcd_barrier_complete(bar, b.x, nloc, nx); b.st[0] = nloc; b.st[1] = nx; }
        const unsigned old = xb_add(&bar[XB_XSUB(b.x)], 1u);
        const unsigned gen = old / nloc;
        if (old + 1u == (gen + 1u) * nloc) {
#ifndef PROBE_NO_WBL2
            __builtin_amdgcn_fence(__ATOMIC_RELEASE, "agent");
#endif
            asm volatile("s_waitcnt vmcnt(0)" ::: "memory");
            const unsigned og = xb_add(&bar[XB_TOP], 1u);
            const unsigned tg = og / nx;
            if (og + 1u == (tg + 1u) * nx) xb_add(&bar[XB_TOPGEN], 1u);
            else XB_SPIN(xb_ld(&bar[XB_TOPGEN]) == tg, bar);
            __builtin_amdgcn_fence(__ATOMIC_ACQUIRE, "agent");
            xb_add(&bar[XB_XGEN(b.x)], 1u);
            asm volatile("s_waitcnt vmcnt(0)" ::: "memory");
        } else {
            XB_SPIN(xb_ld(&bar[XB_XGEN(b.x)]) == gen, bar);
            __builtin_amdgcn_fence(__ATOMIC_ACQUIRE, "agent");
            asm volatile("s_waitcnt vmcnt(0)" ::: "memory");
        }
    }
    __syncthreads();
}

#define XB_LSUB(j)  (12288 + 64 * (j))
#define XB_LGEN(j)  (13312 + 64 * (j))
__device__ __forceinline__ void xcd_local_barrier(const XcdBarrier& b) {
    asm volatile("s_waitcnt vmcnt(0)" ::: "memory");
    __syncthreads();
    if (threadIdx.x == 0) {
        unsigned* bar = b.bar;
        __builtin_amdgcn_s_waitcnt(0);
        const unsigned nloc = b.st[0];
        const unsigned old = xb_add(&bar[XB_LSUB(b.x)], 1u);
        const unsigned gen = old / nloc;
        if (old + 1u == (gen + 1u) * nloc) xb_add(&bar[XB_LGEN(b.x)], 1u);
        else XB_SPIN(xb_ld(&bar[XB_LGEN(b.x)]) == gen, bar);
        __builtin_amdgcn_fence(__ATOMIC_ACQUIRE, "agent");
        asm volatile("s_waitcnt vmcnt(0)" ::: "memory");
    }
    __syncthreads();
}

constexpr int NWAVES = 8, NTHREADS = 512;
constexpr int BATCH = 2, SEQ = 4096, D = 2048, M = BATCH * SEQ, DEPTH = 4, NH = 16, HD = 128;
constexpr int HGRN_N = 5 * D, ATTN_N = 9 * D, DFF = 5632, FFN_N = 2 * DFF;
constexpr float EPS = 1e-6f;
constexpr int NPHASES = 1 + 9 * DEPTH;
#ifndef TAIL_ALL
#define TAIL_ALL 0
#endif
#ifndef TAIL_WO
#define TAIL_WO 0
#endif
#ifndef TAIL_F2_PCT
#define TAIL_F2_PCT 100
#endif
#ifndef MIXMAP
#define MIXMAP vcu
#endif
#ifndef INP_ALIGN
#define INP_ALIGN true
#endif
#ifndef ONE_ALIGN
#define ONE_ALIGN true
#endif
#ifndef ATTN_SECT
#define ATTN_SECT 0
#endif
#ifndef F1_I8
#define F1_I8 0xE
#endif
#define F1Q(L_) (Q8OK && (((F1_I8) >> (L_)) & 1))
#ifndef I8_IN
#define I8_IN 0xC
#endif
#ifndef I8_WO
#define I8_WO 0x0
#endif
#define INQ(L_) (Q8OK && (((I8_IN) >> (L_)) & 1))
#define WOQ(L_) (Q8OK && (((I8_WO) >> (L_)) & 1))
#ifndef W8_CLIP
#define W8_CLIP 3.7f
#endif
#ifndef XCD_LOCAL_BAR
#define XCD_LOCAL_BAR 1
#endif
#ifndef PANEL_MODE
#define PANEL_MODE 1
#endif
#ifndef CVT_IN_SCAN
#define CVT_IN_SCAN 0
#endif
#ifndef GEMM_SP2
#define GEMM_SP2 true
#endif
#ifndef XCC_TRUE_MAP
#define XCC_TRUE_MAP 1
#endif
#define ATT_MODE (QKV_ADJ ? 2 : 0)
#ifndef REP_PRO
#define REP_PRO 1
#endif
#ifndef REP_INH
#define REP_INH 1
#endif
#ifndef REP_INA_COLD
#define REP_INA_COLD 0
#endif
#ifndef REP_INA
#define REP_INA 1
#endif
#ifndef REP_WO
#define REP_WO 1
#endif
#ifndef REP_F1
#define REP_F1 1
#endif
#ifndef REP_F2
#define REP_F2 1
#endif
#ifndef REP_GATES
#define REP_GATES 1
#endif
#ifndef REP_SCAN
#define REP_SCAN 1
#endif
#ifndef REP_ATTN
#define REP_ATTN 1
#endif
#ifndef REP_FIN
#define REP_FIN 1
#endif
#ifndef REP_NORM
#define REP_NORM 1
#endif

constexpr size_t MiB = 1u << 20;
constexpr size_t WS_CTL = 0, CTL_ZERO_BYTES = 1 * MiB;
constexpr size_t WS_TAB = 1 * MiB;
constexpr size_t TAB_COS = 0, TAB_SIN = 262144, TAB_LB = 524288, TAB_RSA = 655360;
constexpr size_t CTL_WSTAT = 131072;
constexpr int WSTAT_PER_THREAD = 4;
constexpr size_t TAB_RSO = 688128;

constexpr size_t WS_WHG = 2 * MiB;
constexpr size_t WS_WAT = 82 * MiB;
constexpr size_t WS_WO = 226 * MiB;
constexpr size_t WS_WF1 = 258 * MiB;
constexpr size_t WS_WF2 = 434 * MiB;
constexpr size_t WS_H = 522 * MiB;
constexpr size_t WS_PROJ = 554 * MiB;
constexpr size_t WS_MIX = 842 * MiB;
constexpr size_t WS_O = 942 * MiB;
constexpr size_t WS_G = 974 * MiB;
constexpr size_t WS_KH = 1006 * MiB;
constexpr size_t WS_H8 = 1076 * MiB;
constexpr size_t WS_END = 1092 * MiB;
constexpr int CW_BAR = 4096, CW_TICK = 8192;

constexpr int RING_BYTES = 147456;
constexpr int LDSCTL_OFF = RING_BYTES, MISC_OFF = LDSCTL_OFF + 320;
constexpr int LDS_BYTES = 163840;

__device__ __forceinline__ float bf2f(unsigned short b) { return __builtin_bit_cast(float, (unsigned)b << 16); }
__device__ __forceinline__ float bflo(unsigned w) { return __builtin_bit_cast(float, w << 16); }
__device__ __forceinline__ float bfhi(unsigned w) { return __builtin_bit_cast(float, w & 0xffff0000u); }
__device__ __forceinline__ float wave_sum(float v) {
#pragma unroll
    for (int o = 1; o < 64; o <<= 1) v += __shfl_xor(v, o);
    return v;
}
__device__ __forceinline__ float sigmoid_f(float x) { return __builtin_amdgcn_rcpf(1.0f + __builtin_amdgcn_exp2f(-1.44269504f * x)); }

__device__ __forceinline__ unsigned q8x4(float a, float b, float c, float d) {
    const int ia = (int)__builtin_rintf(fminf(fmaxf(a, -127.f), 127.f)), ib = (int)__builtin_rintf(fminf(fmaxf(b, -127.f), 127.f)), ic = (int)__builtin_rintf(fminf(fmaxf(c, -127.f), 127.f)), id = (int)__builtin_rintf(fminf(fmaxf(d, -127.f), 127.f));
    return (unsigned)(ia & 255) | ((unsigned)(ib & 255) << 8) | ((unsigned)(ic & 255) << 16) | ((unsigned)(id & 255) << 24);
}
typedef unsigned v2u __attribute__((ext_vector_type(2)));
__device__ __forceinline__ void transpose_item(const float* W, int K, int N, bf16* WT, int k0, int n0, int drow0, LAS float* scr, int lane, float q8) {
    float ld[32];
#pragma unroll
    for (int i = 0; i < 32; ++i) { const int kk = 2 * i + (lane >> 5); ld[i] = W[(size_t)(k0 + kk) * N + n0 + (lane & 31)]; }
#pragma unroll
    for (int i = 0; i < 32; ++i) { const int kk = 2 * i + (lane >> 5); scr[kk * 33 + (lane & 31)] = ld[i]; }
    LDS_WAIT(); asm volatile("" ::: "memory");
    const int c = lane & 7;
#pragma unroll
    for (int j = 0; j < 4; ++j) { const int n = (lane >> 3) + 8 * j; const LAS float* s = scr + (8 * c) * 33 + n;
        if (q8 != 0.f) { v2u o; o.x = q8x4(s[0 * 33] * q8, s[1 * 33] * q8, s[2 * 33] * q8, s[3 * 33] * q8); o.y = q8x4(s[4 * 33] * q8, s[5 * 33] * q8, s[6 * 33] * q8, s[7 * 33] * q8);
            *(GAS v2u*)((signed char*)WT + (size_t)(drow0 + n) * K + k0 + 8 * c) = o; }
        else { v4u o; o.x = pk2(s[0 * 33], s[1 * 33]); o.y = pk2(s[2 * 33], s[3 * 33]); o.z = pk2(s[4 * 33], s[5 * 33]); o.w = pk2(s[6 * 33], s[7 * 33]);
            *(GAS v4u*)(WT + (size_t)(drow0 + n) * K + k0 + 8 * c) = o; } }
    LDS_WAIT(); asm volatile("" ::: "memory");
}
__device__ __forceinline__ void transpose_matrix(const float* W, int K, int N, bf16* WT, int mode, LAS float* scr, int gw, int NGW, int lane, int pct0 = 0, int pct1 = 100, float q8 = 0.f) {
    const int nblk = N / 32, nitems = (K / 64) * nblk; const int it0 = (int)((long)nitems * pct0 / 100), it1 = (int)((long)nitems * pct1 / 100);
    for (int it = it0 + gw; it < it1; it += NGW) {
        const int kb = it / nblk, nb = it - kb * nblk, n0 = 32 * nb;
        int drow0 = n0;
        if (mode == 1) { const int up = n0 >= DFF, nn = up ? n0 - DFF : n0; drow0 = (nn >> 7) * 256 + (up ? 128 : 0) + (nn & 127); }
        if (mode == 2) { const int blk = n0 >> 7, gg = blk / 48, jj = (blk >> 4) % 3, hh = blk & 15; drow0 = ((gg * 16 + hh) * 3 + jj) * 128 + (n0 & 127); }
        transpose_item(W, K, N, WT, 64 * kb, n0, drow0, scr, lane, q8);
    }
}

#ifdef THIN_WT
#define THIN_XSTR(x) #x
#define THIN_STR(x) THIN_XSTR(x)
#define THIN_ST16(p, v) asm volatile("global_store_dwordx4 %0, %1, off " THIN_STR(THIN_WT) "\n\ts_nop 2" :: "v"((const void*)(p)), "v"(v) : "memory")
#else
#define THIN_ST16(p, v) (*(GAS v4u*)(p) = (v))
#endif
__device__ __forceinline__ int rowmap(int v, bool panel) { return panel ? (((v & 2047) >> 8) << 10) + (v & 255) + ((v >> 11) << 8) : v; }
template <bool RES, bool NORM2, bool XI16, bool XO16, bool H8 = false>
__device__ __forceinline__ void norm_rows(const bf16* gin, const void* x_in, void* x_out, const float* w1, const float* w2, bf16* hout, int gw, int NGW, int lane, bool panel, float* rsout = nullptr) {
    for (int m0 = gw; m0 < M; m0 += 2 * NGW) {
        v4u xq[2][4]; f32x4 xa[2][4], xb[2][4]; v4u gq[2][4];
#pragma unroll
        for (int rr = 0; rr < 2; ++rr) { const int mv = m0 + rr * NGW; const int m = rowmap(mv, panel);
            if (mv < M) {
#pragma unroll
                for (int j = 0; j < 4; ++j) {
                    if (XI16) xq[rr][j] = *(const GAS v4u*)((const bf16*)x_in + (size_t)m * D + 8 * (64 * j + lane));
                    else { const GAS f32x4* xp = (const GAS f32x4*)((const float*)x_in + (size_t)m * D + 8 * (64 * j + lane)); xa[rr][j] = xp[0]; xb[rr][j] = xp[1]; }
                    if (RES) gq[rr][j] = *(const GAS v4u*)(gin + (size_t)m * D + 8 * (64 * j + lane)); } } }
#pragma unroll
        for (int rr = 0; rr < 2; ++rr) { const int mv = m0 + rr * NGW; const int m = rowmap(mv, panel);
            if (mv < M) {
                float xv[4][8];
#pragma unroll
                for (int j = 0; j < 4; ++j) {
                    if (XI16) { const v4u g = xq[rr][j];
                        xv[j][0] = bflo(g.x); xv[j][1] = bfhi(g.x); xv[j][2] = bflo(g.y); xv[j][3] = bfhi(g.y); xv[j][4] = bflo(g.z); xv[j][5] = bfhi(g.z); xv[j][6] = bflo(g.w); xv[j][7] = bfhi(g.w); }
                    else { const f32x4 a = xa[rr][j], b = xb[rr][j]; xv[j][0] = a.x; xv[j][1] = a.y; xv[j][2] = a.z; xv[j][3] = a.w; xv[j][4] = b.x; xv[j][5] = b.y; xv[j][6] = b.z; xv[j][7] = b.w; } }
                if (RES) {
                    float gv[4][8]; float ss = 0.f;
#pragma unroll
                    for (int j = 0; j < 4; ++j) { const v4u g = gq[rr][j];
                        gv[j][0] = bflo(g.x); gv[j][1] = bfhi(g.x); gv[j][2] = bflo(g.y); gv[j][3] = bfhi(g.y); gv[j][4] = bflo(g.z); gv[j][5] = bfhi(g.z); gv[j][6] = bflo(g.w); gv[j][7] = bfhi(g.w);
#pragma unroll
                        for (int i = 0; i < 8; ++i) ss += gv[j][i] * gv[j][i]; }
                    const float r1 = 1.0f / sqrtf(wave_sum(ss) * (1.0f / D) + EPS);
#pragma unroll
                    for (int j = 0; j < 4; ++j) { const GAS f32x4* wp = (const GAS f32x4*)(w1 + 8 * (64 * j + lane)); const f32x4 a = wp[0], b = wp[1];
                        const float wv[8] = {a.x, a.y, a.z, a.w, b.x, b.y, b.z, b.w};
#pragma unroll
                        for (int i = 0; i < 8; ++i) xv[j][i] += gv[j][i] * r1 * wv[i];
                        if (XO16) { v4u o; o.x = pk2(xv[j][0], xv[j][1]); o.y = pk2(xv[j][2], xv[j][3]); o.z = pk2(xv[j][4], xv[j][5]); o.w = pk2(xv[j][6], xv[j][7]);
                            THIN_ST16((bf16*)x_out + (size_t)m * D + 8 * (64 * j + lane), o); }
                        else { GAS f32x4* op = (GAS f32x4*)((float*)x_out + (size_t)m * D + 8 * (64 * j + lane));
                            op[0] = (f32x4){xv[j][0], xv[j][1], xv[j][2], xv[j][3]}; op[1] = (f32x4){xv[j][4], xv[j][5], xv[j][6], xv[j][7]}; } }
                }
                if (NORM2) {
                    float ss = 0.f;
#pragma unroll
                    for (int j = 0; j < 4; ++j)
#pragma unroll
                        for (int i = 0; i < 8; ++i) ss += xv[j][i] * xv[j][i];
                    const float r2 = 1.0f / sqrtf(wave_sum(ss) * (1.0f / D) + EPS);
                    if constexpr (H8) {
                        float am = 0.f;
#pragma unroll
                        for (int j = 0; j < 4; ++j) { const GAS f32x4* wp = (const GAS f32x4*)(w2 + 8 * (64 * j + lane)); const f32x4 a = wp[0], b = wp[1]; const float wv[8] = {a.x, a.y, a.z, a.w, b.x, b.y, b.z, b.w};
#pragma unroll
                            for (int i = 0; i < 8; ++i) { xv[j][i] = xv[j][i] * r2 * wv[i]; am = fmaxf(am, fabsf(xv[j][i])); } }
#pragma unroll
                        for (int o = 1; o < 64; o <<= 1) am = fmaxf(am, __shfl_xor(am, o));
                        am = fmaxf(am, 1e-20f); const float qi = 127.0f / am;
#pragma unroll
                        for (int j = 0; j < 4; ++j) { v2u o; o.x = q8x4(xv[j][0] * qi, xv[j][1] * qi, xv[j][2] * qi, xv[j][3] * qi); o.y = q8x4(xv[j][4] * qi, xv[j][5] * qi, xv[j][6] * qi, xv[j][7] * qi);
                            *(GAS v2u*)((signed char*)hout + (size_t)m * D + 8 * (64 * j + lane)) = o; }
                        if (lane == 0) rsout[m] = am * (1.0f / 127.0f);
                    } else {
#pragma unroll
                    for (int j = 0; j < 4; ++j) { const GAS f32x4* wp = (const GAS f32x4*)(w2 + 8 * (64 * j + lane)); const f32x4 a = wp[0], b = wp[1];
                        v4u o; o.x = pk2(xv[j][0] * r2 * a.x, xv[j][1] * r2 * a.y); o.y = pk2(xv[j][2] * r2 * a.z, xv[j][3] * r2 * a.w);
                        o.z = pk2(xv[j][4] * r2 * b.x, xv[j][5] * r2 * b.y); o.w = pk2(xv[j][6] * r2 * b.z, xv[j][7] * r2 * b.w);
                        THIN_ST16(hout + (size_t)m * D + 8 * (64 * j + lane), o); }
                    }
                }
            } }
    }
}

__device__ __forceinline__ void store_row_q8(const float (&v)[4][8], signed char* rowp, float* rsp, int lane) {
    float am = 0.f;
#pragma unroll
    for (int j = 0; j < 4; ++j)
#pragma unroll
        for (int i = 0; i < 8; ++i) am = fmaxf(am, fabsf(v[j][i]));
#pragma unroll
    for (int o = 1; o < 64; o <<= 1) am = fmaxf(am, __shfl_xor(am, o));
    am = fmaxf(am, 1e-20f); const float qi = 127.0f / am;
#pragma unroll
    for (int j = 0; j < 4; ++j) { v2u o; o.x = q8x4(v[j][0] * qi, v[j][1] * qi, v[j][2] * qi, v[j][3] * qi); o.y = q8x4(v[j][4] * qi, v[j][5] * qi, v[j][6] * qi, v[j][7] * qi);
        *(GAS v2u*)(rowp + 8 * (64 * j + lane)) = o; }
    if (lane == 0) *rsp = am * (1.0f / 127.0f);
}
template <bool O8>
__device__ __forceinline__ void hgrn_finalize(const bf16* P, const bf16* OD, const float* gnorm, bf16* O, int gw, int NGW, int lane, bool panel, float* rsout) {
    for (int m0 = gw; m0 < M; m0 += 2 * NGW) {
        v4u a[2][4], b[2][4], g[2][4];
#pragma unroll
        for (int rr = 0; rr < 2; ++rr) { const int mv = m0 + rr * NGW; const int m = rowmap(mv, panel);
            if (mv < M) {
#pragma unroll
                for (int j = 0; j < 4; ++j) { const int e0 = 8 * (64 * j + lane);
                    a[rr][j] = *(const GAS v4u*)(OD + (size_t)m * D + e0); b[rr][j] = *(const GAS v4u*)(OD + (size_t)M * D + (size_t)m * D + e0);
                    g[rr][j] = *(const GAS v4u*)(P + (size_t)m * HGRN_N + 4 * D + e0); } } }
        f32x4 wa[4], wb[4];
#pragma unroll
        for (int j = 0; j < 4; ++j) { const GAS f32x4* wp = (const GAS f32x4*)(gnorm + ((8 * (64 * j + lane)) & 127)); wa[j] = wp[0]; wb[j] = wp[1]; }
#pragma unroll
        for (int rr = 0; rr < 2; ++rr) { const int mv = m0 + rr * NGW; const int m = rowmap(mv, panel);
            if (mv < M) {
                float ov[4][8];
#pragma unroll
                for (int j = 0; j < 4; ++j) { const int e0 = 8 * (64 * j + lane); const v4u A = a[rr][j], B = b[rr][j], Gv = g[rr][j];
                    float s[8] = {bflo(A.x) + bflo(B.x), bfhi(A.x) + bfhi(B.x), bflo(A.y) + bflo(B.y), bfhi(A.y) + bfhi(B.y), bflo(A.z) + bflo(B.z), bfhi(A.z) + bfhi(B.z), bflo(A.w) + bflo(B.w), bfhi(A.w) + bfhi(B.w)};
                    const float gv[8] = {bflo(Gv.x), bfhi(Gv.x), bflo(Gv.y), bfhi(Gv.y), bflo(Gv.z), bfhi(Gv.z), bflo(Gv.w), bfhi(Gv.w)};
                    float ss = 0.f;
#pragma unroll
                    for (int i = 0; i < 8; ++i) ss += s[i] * s[i];
                    ss += __shfl_xor(ss, 1); ss += __shfl_xor(ss, 2); ss += __shfl_xor(ss, 4); ss += __shfl_xor(ss, 8);
                    const float r = 1.0f / sqrtf(ss * (1.0f / HD) + EPS);
                    const float wv[8] = {wa[j].x, wa[j].y, wa[j].z, wa[j].w, wb[j].x, wb[j].y, wb[j].z, wb[j].w};
                    float o[8];
#pragma unroll
                    for (int i = 0; i < 8; ++i) o[i] = s[i] * r * wv[i] * (gv[i] * sigmoid_f(gv[i]));
                    if constexpr (O8) {
#pragma unroll
                        for (int i = 0; i < 8; ++i) ov[j][i] = o[i]; }
                    else { v4u w; w.x = pk2(o[0], o[1]); w.y = pk2(o[2], o[3]); w.z = pk2(o[4], o[5]); w.w = pk2(o[6], o[7]);
                        THIN_ST16(O + (size_t)m * D + e0, w); } }
                if constexpr (O8) store_row_q8(ov, (signed char*)O + (size_t)m * D, rsout + m, lane); else (void)ov; } }
    }
}

template <bool O8>
__device__ __forceinline__ void attn_finalize(const bf16* OG, const float* LSE, bf16* O, int gw, int NGW, int lane, bool panel, float* rsout) {
    for (int m0 = gw; m0 < M; m0 += 2 * NGW) {
        v4u a[2][4], b[2][4], c[2][4]; float l0[2][4], l1[2][4], l2[2][4];
#pragma unroll
        for (int rr = 0; rr < 2; ++rr) { const int mv = m0 + rr * NGW; const int m = rowmap(mv, panel);
            if (mv < M) {
#pragma unroll
                for (int j = 0; j < 4; ++j) { const int e0 = 8 * (64 * j + lane), hh = e0 >> 7;
                    l0[rr][j] = LSE[((size_t)0 * M + m) * NH + hh]; l1[rr][j] = LSE[((size_t)1 * M + m) * NH + hh]; l2[rr][j] = LSE[((size_t)2 * M + m) * NH + hh];
                    a[rr][j] = *(const GAS v4u*)(OG + ((size_t)0 * M + m) * D + e0); b[rr][j] = *(const GAS v4u*)(OG + ((size_t)1 * M + m) * D + e0); c[rr][j] = *(const GAS v4u*)(OG + ((size_t)2 * M + m) * D + e0); } } }
#pragma unroll
        for (int rr = 0; rr < 2; ++rr) { const int mv = m0 + rr * NGW; const int m = rowmap(mv, panel);
            if (mv < M) {
                float ov[4][8];
#pragma unroll
                for (int j = 0; j < 4; ++j) { const int e0 = 8 * (64 * j + lane); const v4u A = a[rr][j], B = b[rr][j], C = c[rr][j];
                    const float mx = fmaxf(l0[rr][j], fmaxf(l1[rr][j], l2[rr][j])); float w0 = __expf(l0[rr][j] - mx), w1 = __expf(l1[rr][j] - mx), w2 = __expf(l2[rr][j] - mx);
                    const float inv = 1.0f / (w0 + w1 + w2); w0 *= inv; w1 *= inv; w2 *= inv;
                    const float o[8] = {w0 * bflo(A.x) + w1 * bflo(B.x) + w2 * bflo(C.x), w0 * bfhi(A.x) + w1 * bfhi(B.x) + w2 * bfhi(C.x), w0 * bflo(A.y) + w1 * bflo(B.y) + w2 * bflo(C.y), w0 * bfhi(A.y) + w1 * bfhi(B.y) + w2 * bfhi(C.y),
                                        w0 * bflo(A.z) + w1 * bflo(B.z) + w2 * bflo(C.z), w0 * bfhi(A.z) + w1 * bfhi(B.z) + w2 * bfhi(C.z), w0 * bflo(A.w) + w1 * bflo(B.w) + w2 * bflo(C.w), w0 * bfhi(A.w) + w1 * bfhi(B.w) + w2 * bfhi(C.w)};
                    if constexpr (O8) {
#pragma unroll
                        for (int i = 0; i < 8; ++i) ov[j][i] = o[i]; }
                    else { v4u w; w.x = pk2(o[0], o[1]); w.y = pk2(o[2], o[3]); w.z = pk2(o[4], o[5]); w.w = pk2(o[6], o[7]);
                        THIN_ST16(O + (size_t)m * D + e0, w); } }
                if constexpr (O8) store_row_q8(ov, (signed char*)O + (size_t)m * D, rsout + m, lane); else (void)ov; } }
    }
}

typedef short s16x4 __attribute__((ext_vector_type(4)));
typedef short v4i16_t __attribute__((ext_vector_type(4)));
typedef unsigned v2u __attribute__((ext_vector_type(2)));
__device__ __forceinline__ void glds16(const void* gsrc, unsigned lds_dst) { unsigned keep;
    asm volatile("s_mov_b32 %0, m0\n\ts_mov_b32 m0, %2\n\ts_nop 0\n\tglobal_load_lds_dwordx4 %1, off\n\ts_mov_b32 m0, %0" : "=&s"(keep) : "v"(gsrc), "s"(lds_dst) : "memory"); }
__device__ __forceinline__ s16x4 tr_read(LAS const unsigned char* p) { return __builtin_bit_cast(s16x4, __builtin_amdgcn_ds_read_tr16_b64_v4i16((LAS v4i16_t*)p)); }
__device__ __forceinline__ bf16x8 cat44(s16x4 a, s16x4 b) { return (bf16x8){a[0], a[1], a[2], a[3], b[0], b[1], b[2], b[3]}; }
#ifdef PROBE_ADMA2
#define AT_VW "s_waitcnt vmcnt(22)"
#else
#define AT_VW "s_waitcnt vmcnt(13)"
#endif
__device__ __forceinline__ void glds16s_1(const void* sbase, unsigned voff, unsigned lds_dst) { unsigned keep;
    asm volatile("s_mov_b32 %0, m0\n\ts_mov_b32 m0, %3\n\ts_nop 0\n\tglobal_load_lds_dwordx4 %1, %2\n\ts_mov_b32 m0, %0" : "=&s"(keep) : "v"(voff), "s"(sbase), "s"(lds_dst) : "memory"); }
__device__ __forceinline__ void glds16s(const void* sbase, unsigned voff, unsigned lds_dst) { glds16s_1(sbase, voff, lds_dst);
#ifdef PROBE_ADMA2
    glds16s_1(sbase, voff, lds_dst);
#endif
}
__device__ __forceinline__ void glds16m(const void* sbase, unsigned voff, unsigned lds_dst) {
    asm volatile("s_mov_b32 m0, %2\n\ts_nop 0\n\tglobal_load_lds_dwordx4 %0, %1" :: "v"(voff), "s"(sbase), "s"(lds_dst) : "memory", "m0"); }
__device__ __forceinline__ bf16x8 gload16s(const void* sbase, unsigned voff) { return *(const GAS bf16x8*)((const unsigned char*)sbase + voff); }
__device__ __forceinline__ void attn_core_mfma(LAS unsigned char* lds, const bf16* P, bf16* OG, float* LSE, int vcu, int G, int gsel) {
    const int NU = (gsel >= 0) ? 1024 : 3072;
    int tid_l = threadIdx.x; asm volatile("" : "+v"(tid_l));
    const int tid = tid_l, lane = tid & 63, w = __builtin_amdgcn_readfirstlane(tid >> 6), fr = lane & 15, q4 = lane >> 4;
    const float sc2 = 0.08838834764831845f * 1.44269504f;
    constexpr int RST = 288, K_OFF = 0, V_OFF = 73728;
    const bool ucons = (NU % G) == 0; const int USTEP = ucons ? 1 : G, UID0 = ucons ? vcu * (NU / G) : vcu;
    const int NUN = ucons ? NU / G : (vcu < NU ? (NU - vcu + G - 1) / G : 0);
#define AT_SCHED __builtin_amdgcn_sched_barrier(0)
#define AT_DECODE(uid_) const int bi = (uid_) & 31, bhg = (uid_) >> 5, g = (gsel >= 0) ? gsel : bhg % 3, bh = (gsel >= 0) ? bhg : bhg / 3, hh = bh & 15, b = bh >> 4; \
        const int rsh = 2 * g, nbs = 5 - rsh, rho = bi >> nbs, blk = bi & ((1 << nbs) - 1), L = SEQ >> rsh, u0 = blk * 128; \
        const bf16* Qb = P + (size_t)b * SEQ * ATTN_N + (QKV_ADJ ? ((g * NH + hh) * 3) * HD : ((g * 3 + 0) * NH + hh) * HD); const bf16* Kb = Qb + (QKV_ADJ ? HD : NH * HD); const bf16* Vb = Kb + (QKV_ADJ ? HD : NH * HD); \
        (void)L; (void)Qb; (void)Kb; (void)Vb; (void)u0; (void)rho;
    if (w >= 4) {
        const int lw = w - 4;
        int prow[9], pchb[9];
#pragma unroll
        for (int i = 0; i < 9; ++i) { const int sl = (lw + 4 * i) * 64 + lane; prow[i] = sl / 18; const int ch = sl - prow[i] * 18; pchb[i] = (ch < 16 ? ch : 0) * 16; }
#define AT_ROWOFF(i_, h_) ({ int uk_ = u0 - 64 + 128 * (h_) + prow[i_]; uk_ = uk_ < 0 ? 0 : (uk_ >= L ? L - 1 : uk_); const unsigned x_ = (unsigned)((uk_ << rsh) + rho); (((x_ << 3) + x_) << 12) + (unsigned)pchb[i_]; })
#define AT_PREP() do { _Pragma("unroll") for (int i_ = 0; i_ < 9; ++i_) { of0[i_] = AT_ROWOFF(i_, 0); of1[i_] = AT_ROWOFF(i_, 1); } } while (0)
#define AT_GO(base_, off_, cont_, par_) do { \
            if (!(cont_)) { _Pragma("unroll") for (int i_ = 0; i_ < 9; ++i_) glds16m(base_, of0[i_], (unsigned)(size_t)(lds + (off_) + ((par_) & 1) * 36864 + (lw + 4 * i_) * 1024)); } \
            _Pragma("unroll") for (int i_ = 0; i_ < 9; ++i_) glds16m(base_, of1[i_], (unsigned)(size_t)(lds + (off_) + (((par_) + 1) & 1) * 36864 + (lw + 4 * i_) * 1024)); } while (0)
#define AT_WAITN(n9_) do { if (n9_) asm volatile("s_waitcnt vmcnt(9)" ::: "memory"); else asm volatile("s_waitcnt vmcnt(18)" ::: "memory"); } while (0)
        unsigned of0[9], of1[9];
        int uid = UID0; int par = 0; bool cont = false;
        const bf16* nKb = P; const bf16* nVb = P;
        if (uid < NU) { AT_DECODE(uid) AT_PREP(); AT_GO(Kb, K_OFF, false, 0); AT_GO(Vb, V_OFF, false, 0); }
        for (int un = 0; un < NUN; ++un, uid += USTEP) {
            const int nuid = (un + 1 < NUN) ? uid + USTEP : NU;
            bool ncont = false; int npar = 0;
            if (nuid < NU) { AT_DECODE(nuid) ncont = ucons && blk != 0; npar = ncont ? (par ^ 1) : 0; nKb = Kb; nVb = Vb; AT_PREP(); }
            AT_WAITN(cont);
            __builtin_amdgcn_s_barrier(); asm volatile("" ::: "memory");
            __builtin_amdgcn_s_barrier(); asm volatile("" ::: "memory");
            if (nuid < NU) { AT_GO(nKb, K_OFF, ncont, npar); AT_WAITN(ncont); }
            else asm volatile("s_waitcnt vmcnt(0)" ::: "memory");
            __builtin_amdgcn_s_barrier(); asm volatile("" ::: "memory");
            __builtin_amdgcn_s_barrier(); asm volatile("" ::: "memory");
            if (nuid < NU) { AT_GO(nVb, V_OFF, ncont, npar); }
            cont = ncont; par = npar;
        }
#undef AT_WAITN
#undef AT_PREP
#undef AT_GO
#undef AT_ROWOFF
    } else {
        const int cw = w, qp = (lane >> 2) & 3, p4 = lane & 3;
        const int bKl = K_OFF + fr * RST + q4 * 16;
        const int bVl = V_OFF + (4 * q4 + qp) * RST + p4 * 8;
        bf16x8 qf[2][4];
        int uid = UID0;
        if (uid < NU) { AT_DECODE(uid)
#pragma unroll
            for (int qi = 0; qi < 2; ++qi) { const unsigned qo = (unsigned)((((u0 + 32 * cw + 16 * qi + fr) << rsh) + rho) * (ATTN_N * 2) + 16 * q4);
#pragma unroll
                for (int ks = 0; ks < 4; ++ks) qf[qi][ks] = gload16s(Qb, qo + 64 * ks); } }
        int par = 0;
        for (int un = 0; un < NUN; ++un, uid += USTEP) {
            AT_DECODE(uid)
            const int nuid = (un + 1 < NUN) ? uid + USTEP : NU;
            par = (ucons && un > 0 && blk != 0) ? (par ^ 1) : 0;
#define AT_PT(t_) ((((t_) + 8 * par) & 15) * (16 * RST))
            __builtin_amdgcn_s_barrier(); asm volatile("" ::: "memory");
            f32x4 S[2][9]; bf16x8 kf[2][2][4];
#ifdef PROBE_ATC
            for (int rr_ = 0; rr_ < PROBE_ATC; ++rr_) {
#endif
#pragma unroll
            for (int qi = 0; qi < 2; ++qi)
#pragma unroll
                for (int kt = 0; kt < 9; ++kt) S[qi][kt] = (f32x4){0.f, 0.f, 0.f, 0.f};
            AT_SCHED;
#pragma unroll
            for (int jj = 0; jj < 2; ++jj)
#pragma unroll
                for (int ks = 0; ks < 4; ++ks) kf[0][jj][ks] = *(const LAS bf16x8*)(lds + bKl + AT_PT(2 * cw + jj) + 64 * ks);
            AT_SCHED;
#pragma unroll
            for (int gi = 0; gi < 5; ++gi) {
                if (gi < 4) {
#pragma unroll
                    for (int jj = 0; jj < 2; ++jj)
#pragma unroll
                        for (int ks = 0; ks < 4; ++ks) kf[(gi + 1) & 1][jj][ks] = *(const LAS bf16x8*)(lds + bKl + AT_PT(2 * cw + 2 * (gi + 1) + jj) + 64 * ks);
                    AT_SCHED; asm volatile("s_waitcnt lgkmcnt(8)" ::: "memory"); AT_SCHED; }
                else { AT_SCHED; asm volatile("s_waitcnt lgkmcnt(0)" ::: "memory"); AT_SCHED; }
#pragma unroll
                for (int jj = 0; jj < 2; ++jj) { const int j = 2 * gi + jj;
#pragma unroll
                    for (int ks = 0; ks < 4; ++ks) {
                        if (j <= 8) S[0][j] = __builtin_amdgcn_mfma_f32_16x16x32_bf16(kf[gi & 1][jj][ks], qf[0][ks], S[0][j], 0, 0, 0);
                        if (j >= 1) S[1][j - 1] = __builtin_amdgcn_mfma_f32_16x16x32_bf16(kf[gi & 1][jj][ks], qf[1][ks], S[1][j - 1], 0, 0, 0); } }
                AT_SCHED; }
#ifdef PROBE_ATC
            }
#endif
            __builtin_amdgcn_s_barrier(); asm volatile("" ::: "memory");
            bf16x8 qn[2][4];
            if (nuid < NU) {
                const int bi_n = nuid & 31, bhg_n = nuid >> 5, g_n = (gsel >= 0) ? gsel : bhg_n % 3, bh_n = (gsel >= 0) ? bhg_n : bhg_n / 3, hh_n = bh_n & 15, b_n = bh_n >> 4;
                const int rsh_n = 2 * g_n, nbs_n = 5 - rsh_n, rho_n = bi_n >> nbs_n, blk_n = bi_n & ((1 << nbs_n) - 1), u0_n = blk_n * 128;
                const bf16* Qb_n = P + (size_t)b_n * SEQ * ATTN_N + (QKV_ADJ ? ((g_n * NH + hh_n) * 3) * HD : ((g_n * 3 + 0) * NH + hh_n) * HD);
#pragma unroll
                for (int qi = 0; qi < 2; ++qi) { const unsigned qo = (unsigned)((((u0_n + 32 * cw + 16 * qi + fr) << rsh_n) + rho_n) * (ATTN_N * 2) + 16 * q4);
#pragma unroll
                    for (int ks = 0; ks < 4; ++ks) qn[qi][ks] = gload16s(Qb_n, qo + 64 * ks); } }
            else {
#pragma unroll
                for (int qi = 0; qi < 2; ++qi)
#pragma unroll
                    for (int ks = 0; ks < 4; ++ks) qn[qi][ks] = qf[qi][ks]; }
            float mxs[2], ls[2]; bf16x8 pf[2][5];
#pragma unroll
            for (int qi = 0; qi < 2; ++qi) {
                float mx = -1e30f;
#pragma unroll
                for (int kt = 0; kt < 9; ++kt)
#pragma unroll
                    for (int r = 0; r < 4; ++r) { const int rr = 4 * q4 + r; const int uk = u0 + 32 * cw + 16 * qi - 64 + 16 * kt + rr;
                        const bool ok = (kt > 0 || rr >= fr) && (kt < 8 || rr <= fr) && uk >= 0 && uk < L;
                        const float sv = ok ? S[qi][kt][r] * sc2 : -1e30f; S[qi][kt][r] = sv; mx = fmaxf(mx, sv); }
                mx = fmaxf(mx, __shfl_xor(mx, 16)); mx = fmaxf(mx, __shfl_xor(mx, 32));
                float l = 0.f;
#pragma unroll
                for (int kt = 0; kt < 9; ++kt)
#pragma unroll
                    for (int r = 0; r < 4; ++r) { const float pv = __builtin_amdgcn_exp2f(S[qi][kt][r] - mx); S[qi][kt][r] = pv; l += pv; }
                l += __shfl_xor(l, 16); l += __shfl_xor(l, 32);
                mxs[qi] = mx; ls[qi] = l;
#pragma unroll
                for (int pi = 0; pi < 5; ++pi) { const int ka = 2 * pi - qi, kb = 2 * pi + 1 - qi; v4u pw;
                    if (ka >= 0 && ka <= 8) { pw.x = pg8::cvt_pk_bf16(S[qi][ka][0], S[qi][ka][1]); pw.y = pg8::cvt_pk_bf16(S[qi][ka][2], S[qi][ka][3]); } else { pw.x = 0u; pw.y = 0u; }
                    if (kb >= 0 && kb <= 8) { pw.z = pg8::cvt_pk_bf16(S[qi][kb][0], S[qi][kb][1]); pw.w = pg8::cvt_pk_bf16(S[qi][kb][2], S[qi][kb][3]); } else { pw.z = 0u; pw.w = 0u; }
                    pf[qi][pi] = __builtin_bit_cast(bf16x8, pw); } }
            __builtin_amdgcn_s_barrier(); asm volatile("" ::: "memory");
            f32x4 O[2][8]; s16x4 vr[2][8][2];
#ifdef PROBE_ATC
            for (int rr_ = 0; rr_ < PROBE_ATC; ++rr_) {
#endif
#pragma unroll
            for (int qi = 0; qi < 2; ++qi)
#pragma unroll
                for (int dt = 0; dt < 8; ++dt) O[qi][dt] = (f32x4){0.f, 0.f, 0.f, 0.f};
            AT_SCHED;
#pragma unroll
            for (int dt = 0; dt < 8; ++dt) { vr[0][dt][0] = tr_read(lds + bVl + AT_PT(2 * cw) + 32 * dt); vr[0][dt][1] = tr_read(lds + bVl + AT_PT(2 * cw + 1) + 32 * dt); }
            AT_SCHED;
#pragma unroll
            for (int pi = 0; pi < 5; ++pi) {
                if (pi < 4) {
#pragma unroll
                    for (int dt = 0; dt < 4; ++dt) { vr[(pi + 1) & 1][dt][0] = tr_read(lds + bVl + AT_PT(2 * cw + 2 * (pi + 1)) + 32 * dt); vr[(pi + 1) & 1][dt][1] = tr_read(lds + bVl + AT_PT(2 * cw + 2 * (pi + 1) + 1) + 32 * dt); }
                    AT_SCHED; asm volatile("s_waitcnt lgkmcnt(8)" ::: "memory"); AT_SCHED;
#pragma unroll
                    for (int dt = 4; dt < 8; ++dt) { vr[(pi + 1) & 1][dt][0] = tr_read(lds + bVl + AT_PT(2 * cw + 2 * (pi + 1)) + 32 * dt); vr[(pi + 1) & 1][dt][1] = tr_read(lds + bVl + AT_PT(2 * cw + 2 * (pi + 1) + 1) + 32 * dt); }
                    AT_SCHED; }
                else { AT_SCHED; asm volatile("s_waitcnt lgkmcnt(0)" ::: "memory"); AT_SCHED; }
#pragma unroll
                for (int dt = 0; dt < 8; ++dt) { const bf16x8 vf = cat44(vr[pi & 1][dt][0], vr[pi & 1][dt][1]);
                    O[0][dt] = __builtin_amdgcn_mfma_f32_16x16x32_bf16(vf, pf[0][pi], O[0][dt], 0, 0, 0);
                    O[1][dt] = __builtin_amdgcn_mfma_f32_16x16x32_bf16(vf, pf[1][pi], O[1][dt], 0, 0, 0); }
                AT_SCHED; }
#ifdef PROBE_ATC
            }
#endif
            __builtin_amdgcn_s_barrier(); asm volatile("" ::: "memory");
#pragma unroll
            for (int qi = 0; qi < 2; ++qi) { const float il = 1.0f / ls[qi]; const int qtok = ((u0 + 32 * cw + 16 * qi + fr) << rsh) + rho;
                const size_t orow = (size_t)g * M + (size_t)b * SEQ + qtok; bf16* op = OG + orow * D + hh * HD + 4 * q4;
#pragma unroll
                for (int dt = 0; dt < 8; ++dt) { v2u o2; o2.x = pk2(O[qi][dt][0] * il, O[qi][dt][1] * il); o2.y = pk2(O[qi][dt][2] * il, O[qi][dt][3] * il); *(GAS v2u*)(op + 16 * dt) = o2; }
                if (q4 == 0) *(GAS float*)(LSE + orow * NH + hh) = mxs[qi] * 0.6931471805599453f + __logf(ls[qi]); }
#pragma unroll
            for (int qi = 0; qi < 2; ++qi)
#pragma unroll
                for (int ks = 0; ks < 4; ++ks) qf[qi][ks] = qn[qi][ks];
        }
    }
    asm volatile("s_waitcnt vmcnt(0) lgkmcnt(0)" ::: "memory"); __builtin_amdgcn_s_barrier(); asm volatile("" ::: "memory");
#undef AT_PT
#undef AT_SCHED
#undef AT_DECODE
}
typedef float float2_t __attribute__((ext_vector_type(2)));
__device__ __forceinline__ void hgrn_gates(const bf16* P, const float* lbt, bf16* QT, bf16* KT, float* PREF, float* BR, int gw, int NGW, int lane, bool panel) {
    const unsigned lo = 4u * (unsigned)lane;
    for (int item = gw; item < 8192; item += NGW) {
        const int li = (item & 255) + ((item >> 11) << 8), pq = (item & 2047) >> 8;
        const int cb = item & 15, half = (item >> 4) & 1, chunk = panel ? 16 * pq + (li >> 6) : (item >> 5) & 127, dir = panel ? (li >> 5) & 1 : item >> 12;
        const int cbase = cb * 128; const size_t row0 = (size_t)chunk * 64;
        const float lb0 = lbt[(size_t)dir * 4 * D + cbase + 2 * lane], lb1 = lbt[(size_t)dir * 4 * D + cbase + 2 * lane + 1];
        const unsigned char* fcol = (const unsigned char*)(P + (1 + dir) * D + cbase); const unsigned char* qcol = (const unsigned char*)(P + cbase);
        unsigned char* qt = (unsigned char*)(QT + (size_t)dir * M * D + cbase); unsigned char* kt = (unsigned char*)(KT + (size_t)dir * M * D + cbase);
        unsigned fw[32], qw[32];
#pragma unroll
        for (int j = 0; j < 32; ++j) { const int tau = half ? 32 + j : 31 - j; const size_t t = dir ? row0 + 63 - tau : row0 + tau;
            fw[j] = *(const GAS unsigned*)(fcol + t * (HGRN_N * 2) + lo); qw[j] = *(const GAS unsigned*)(qcol + t * (HGRN_N * 2) + lo); }
        float a0 = 1.f, a1 = 1.f;
#pragma unroll
        for (int j = 0; j < 32; ++j) { const int tau = half ? 32 + j : 31 - j; const size_t t = dir ? row0 + 63 - tau : row0 + tau;
            asm volatile("" : "+v"(fw[j]), "+v"(qw[j]) :: "memory");
            const float g0 = lb0 + (1.0f - lb0) * sigmoid_f(bflo(fw[j])), g1 = lb1 + (1.0f - lb1) * sigmoid_f(bfhi(fw[j]));
            const float q0 = bflo(qw[j]), q1 = bfhi(qw[j]); const float s0 = q0 * sigmoid_f(q0), s1 = q1 * sigmoid_f(q1);
            if (half) { a0 *= g0; a1 *= g1; }
            const float i0 = __builtin_amdgcn_rcpf(fmaxf(a0, 1e-30f)), i1 = __builtin_amdgcn_rcpf(fmaxf(a1, 1e-30f));
            const float e0 = half ? a0 : i0, e1 = half ? a1 : i1, r0 = half ? i0 : a0, r1 = half ? i1 : a1;
            *(GAS unsigned*)(qt + t * (D * 2) + lo) = pk2(s0 * e0, s1 * e1);
            *(GAS unsigned*)(kt + t * (D * 2) + lo) = pk2((1.0f - g0) * r0, (1.0f - g1) * r1);
            if (!half) { a0 *= g0; a1 *= g1; }
        }
        float* dst = (half ? BR : PREF) + ((size_t)dir * (M / 64) + chunk) * D + cbase;
        *(GAS float2_t*)((unsigned char*)dst + 2u * lo) = (float2_t){a0, a1};
    }
}

struct CvtSeg { const float* W; bf16* WT; int N; int nb; };
struct CvtPlan { CvtSeg seg[4]; int nseg; };
__device__ __forceinline__ void hgrn_scan_mfma(LAS unsigned char* lds, const bf16* P, const bf16* QT, const bf16* KT, const float* PREF, const float* BR, bf16* OD, int vcu, int G, const CvtPlan& cv) {
    int tid_l = threadIdx.x; asm volatile("" : "+v"(tid_l));
    const int w = __builtin_amdgcn_readfirstlane(tid_l >> 6);
    constexpr int QST = 272, KST = 288, VST = 96;
    constexpr int STG = 43008, QS = 0, KS = 17408, VS = 35840, VEC = 41984;
#define HG_SCHED __builtin_amdgcn_sched_barrier(0)
    for (int unit = vcu; unit < 256; unit += (G < 256 ? G : 256)) {
        const int chain = unit >> 2, slice = unit & 3, b = chain >> 5, hh = (chain >> 1) & 15, dir = chain & 1;
        const size_t dOff = (size_t)dir * M * D;
        const int ck0 = dir ? 63 : 0; const size_t tok00 = (size_t)b * SEQ + (size_t)ck0 * 64;
        if (w < 4) {
            int lane_k = threadIdx.x & 63; asm volatile("" : "+v"(lane_k));
            const int tt = w, qp = (lane_k >> 2) & 3, p4 = lane_k & 3, fr = lane_k & 15, q4 = lane_k >> 4;
            const int bQ = QS + (16 * tt + fr) * QST + q4 * 16;
            const int bQ2 = QS + (16 * tt + fr) * QST + q4 * 8;
            const int bK = KS + fr * KST + q4 * 16;
            const int bKc = KS + (4 * q4 + qp) * KST + p4 * 8;
            const int bV = VS + (4 * q4 + qp) * VST + p4 * 8;
            const int bP = VEC + q4 * 16;
            f32x4 S[8][2];
#pragma unroll
            for (int T = 0; T < 8; ++T) { S[T][0] = (f32x4){0.f, 0.f, 0.f, 0.f}; S[T][1] = (f32x4){0.f, 0.f, 0.f, 0.f}; }
            int sb = 0;
            for (int step = 0; step < 64; ++step) {
                __builtin_amdgcn_s_barrier(); asm volatile("" ::: "memory");
                LAS const unsigned char* st = lds + sb;
                HG_SCHED;
                bf16x8 qf[4], kf[2][4]; s16x4 va[2][2][2];
#pragma unroll
                for (int ks = 0; ks < 4; ++ks) qf[ks] = *(const LAS bf16x8*)(st + bQ + 64 * ks);
#pragma unroll
                for (int s4 = 0; s4 < 4; ++s4) kf[0][s4] = *(const LAS bf16x8*)(st + bK + 16 * s4 * KST);
#pragma unroll
                for (int vt = 0; vt < 2; ++vt)
#pragma unroll
                    for (int pi = 0; pi < 2; ++pi) { va[vt][pi][0] = tr_read(st + bV + 32 * pi * VST + 32 * vt); va[vt][pi][1] = tr_read(st + bV + (32 * pi + 16) * VST + 32 * vt); }
                HG_SCHED;
                f32x4 Pt[4];
#pragma unroll
                for (int s4 = 0; s4 < 4; ++s4) Pt[s4] = (f32x4){0.f, 0.f, 0.f, 0.f};
#pragma unroll
                for (int ks = 0; ks < 4; ++ks) {
                    if (ks < 3) {
#pragma unroll
                        for (int s4 = 0; s4 < 4; ++s4) kf[(ks + 1) & 1][s4] = *(const LAS bf16x8*)(st + bK + 16 * s4 * KST + 64 * (ks + 1));
                        HG_SCHED; asm volatile("s_waitcnt lgkmcnt(4)" ::: "memory"); HG_SCHED; }
                    else { HG_SCHED; asm volatile("s_waitcnt lgkmcnt(0)" ::: "memory"); HG_SCHED; }
#pragma unroll
                    for (int s4 = 0; s4 < 4; ++s4) Pt[s4] = __builtin_amdgcn_mfma_f32_16x16x32_bf16(kf[ks & 1][s4], qf[ks], Pt[s4], 0, 0, 0);
                    HG_SCHED; }
                f32x4 pr[8]; s16x4 qa[4], qb[4];
#pragma unroll
                for (int T = 0; T < 8; ++T) pr[T] = *(const LAS f32x4*)(st + bP + 64 * T);
#pragma unroll
                for (int ks = 0; ks < 4; ++ks) { qa[ks] = *(const LAS s16x4*)(st + bQ2 + 64 * ks); qb[ks] = *(const LAS s16x4*)(st + bQ2 + 64 * ks + 32); }
                HG_SCHED;
                const int tix = 16 * tt + fr;
#pragma unroll
                for (int s4 = 0; s4 < 4; ++s4)
#pragma unroll
                    for (int r = 0; r < 4; ++r) { const int six = 16 * s4 + 4 * q4 + r; const bool keep = dir ? (six >= tix) : (six <= tix); Pt[s4][r] = keep ? Pt[s4][r] : 0.f; }
                f32x4 o[2]; o[0] = (f32x4){0.f, 0.f, 0.f, 0.f}; o[1] = (f32x4){0.f, 0.f, 0.f, 0.f};
#pragma unroll
                for (int pi = 0; pi < 2; ++pi) {
                    v4u pw; pw.x = pg8::cvt_pk_bf16(Pt[2 * pi][0], Pt[2 * pi][1]); pw.y = pg8::cvt_pk_bf16(Pt[2 * pi][2], Pt[2 * pi][3]);
                    pw.z = pg8::cvt_pk_bf16(Pt[2 * pi + 1][0], Pt[2 * pi + 1][1]); pw.w = pg8::cvt_pk_bf16(Pt[2 * pi + 1][2], Pt[2 * pi + 1][3]);
#pragma unroll
                    for (int vt = 0; vt < 2; ++vt) o[vt] = __builtin_amdgcn_mfma_f32_16x16x32_bf16(cat44(va[vt][pi][0], va[vt][pi][1]), __builtin_bit_cast(bf16x8, pw), o[vt], 0, 0, 0); }
                HG_SCHED; asm volatile("s_waitcnt lgkmcnt(0)" ::: "memory"); HG_SCHED;
#pragma unroll
                for (int T = 0; T < 8; ++T) { S[T][0] = S[T][0] * pr[T]; S[T][1] = S[T][1] * pr[T]; }
                HG_SCHED;
                s16x4 kc[2][2][2][2]; f32x4 br[2][2];
#pragma unroll
                for (int j = 0; j < 2; ++j) { br[0][j] = *(const LAS f32x4*)(st + bP + 512 + 64 * j);
#pragma unroll
                    for (int pi = 0; pi < 2; ++pi) { kc[0][j][pi][0] = tr_read(st + bKc + 32 * pi * KST + 32 * j); kc[0][j][pi][1] = tr_read(st + bKc + (32 * pi + 16) * KST + 32 * j); } }
                HG_SCHED;
#pragma unroll
                for (int ks = 0; ks < 4; ++ks) { const int T0 = 2 * ks, T1 = 2 * ks + 1; const bf16x8 qq = cat44(qa[ks], qb[ks]);
#pragma unroll
                    for (int vt = 0; vt < 2; ++vt) {
                        v4u aw; aw.x = pg8::cvt_pk_bf16(S[T0][vt][0], S[T0][vt][1]); aw.y = pg8::cvt_pk_bf16(S[T0][vt][2], S[T0][vt][3]);
                        aw.z = pg8::cvt_pk_bf16(S[T1][vt][0], S[T1][vt][1]); aw.w = pg8::cvt_pk_bf16(S[T1][vt][2], S[T1][vt][3]);
                        o[vt] = __builtin_amdgcn_mfma_f32_16x16x32_bf16(__builtin_bit_cast(bf16x8, aw), qq, o[vt], 0, 0, 0); } }
                HG_SCHED;
                { const int ck = dir ? 63 - step : step; const size_t tok = (size_t)b * SEQ + (size_t)ck * 64 + 16 * tt + fr;
#pragma unroll
                  for (int vt = 0; vt < 2; ++vt) { v2u o2; o2.x = pk2(o[vt][0], o[vt][1]); o2.y = pk2(o[vt][2], o[vt][3]);
                    *(GAS v2u*)(OD + dOff + tok * D + hh * HD + slice * 32 + 16 * vt + 4 * q4) = o2; } }
                HG_SCHED;
#pragma unroll
                for (int rd = 0; rd < 4; ++rd) {
                    if (rd < 3) {
#pragma unroll
                        for (int j = 0; j < 2; ++j) { const int T = 2 * (rd + 1) + j; br[(rd + 1) & 1][j] = *(const LAS f32x4*)(st + bP + 512 + 64 * T);
#pragma unroll
                            for (int pi = 0; pi < 2; ++pi) { kc[(rd + 1) & 1][j][pi][0] = tr_read(st + bKc + 32 * pi * KST + 32 * T); kc[(rd + 1) & 1][j][pi][1] = tr_read(st + bKc + (32 * pi + 16) * KST + 32 * T); } }
                        HG_SCHED; asm volatile("s_waitcnt lgkmcnt(10)" ::: "memory"); HG_SCHED; }
                    else { HG_SCHED; asm volatile("s_waitcnt lgkmcnt(0)" ::: "memory"); HG_SCHED; }
#pragma unroll
                    for (int j = 0; j < 2; ++j) { const int T = 2 * rd + j;
#pragma unroll
                        for (int vt = 0; vt < 2; ++vt) {
#pragma unroll
                            for (int pi = 0; pi < 2; ++pi) S[T][vt] = __builtin_amdgcn_mfma_f32_16x16x32_bf16(cat44(kc[rd & 1][j][pi][0], kc[rd & 1][j][pi][1]), cat44(va[vt][pi][0], va[vt][pi][1]), S[T][vt], 0, 0, 0);
                            S[T][vt] = S[T][vt] * br[rd & 1][j]; } }
                    HG_SCHED; }
                sb = (sb == 2 * STG) ? 0 : sb + STG;
            }
        } else if (w < 6) {
            const int lw = w - 4; int lane_d = threadIdx.x & 63; asm volatile("" : "+v"(lane_d));
            const unsigned char* src[21]; long sstr[21]; int poff[21];
            const long rstep = (dir ? -64L : 64L);
#pragma unroll
            for (int i = 0; i < 21; ++i) {
                int img, pcl;
                if (i < 8) { img = 0; pcl = lw + 2 * i; } else if (i < 16) { img = 1; pcl = lw + 2 * (i - 8); } else if (i < 19) { img = 2; pcl = lw + 2 * (i - 16); }
                else if (i == 19) { img = lw; pcl = 16; }
                else { img = (lw == 0) ? 1 : 3; pcl = (lw == 0) ? 17 : 0; }
                const int sl = pcl * 64 + lane_d;
                if (img == 0 || img == 1) { const int RS = img ? 18 : 17; const int row = sl / RS, ch = sl - row * RS, chs = ch < 16 ? ch : 0;
                    src[i] = (const unsigned char*)((img ? KT : QT) + dOff + (tok00 + row) * D + hh * HD + chs * 8); sstr[i] = rstep * D * 2; poff[i] = (img ? KS : QS) + pcl * 1024; }
                else if (img == 2) { const int row = sl / 6, ch = sl - row * 6, chs = ch < 4 ? ch : 0;
                    src[i] = (const unsigned char*)(P + (tok00 + row) * HGRN_N + 3 * D + hh * HD + slice * 32 + chs * 8); sstr[i] = rstep * HGRN_N * 2; poff[i] = VS + pcl * 1024; }
                else { src[i] = (const unsigned char*)(((lane_d < 32) ? PREF : BR) + ((size_t)dir * (M / 64) + (tok00 >> 6)) * D + hh * HD + 4 * (lane_d & 31)); sstr[i] = (dir ? -1L : 1L) * D * 4; poff[i] = VEC; } }
#define HG_STAGE(step_, sb_) do { _Pragma("unroll") for (int i_ = 0; i_ < 21; ++i_) \
                glds16(src[i_] + (long)(step_) * sstr[i_], (unsigned)(size_t)(lds + (sb_) + poff[i_])); } while (0)
            HG_STAGE(0, 0); HG_STAGE(1, STG);
            int sbn = 2 * STG;
            for (int step = 0; step < 64; ++step) {
                if (step < 63) asm volatile("s_waitcnt vmcnt(21)" ::: "memory"); else asm volatile("s_waitcnt vmcnt(0)" ::: "memory");
                __builtin_amdgcn_s_barrier(); asm volatile("" ::: "memory");
                if (step + 2 < 64) HG_STAGE(step + 2, sbn);
                sbn = (sbn == 2 * STG) ? 0 : sbn + STG;
            }
#undef HG_STAGE
        } else {
            int lane_c = threadIdx.x & 63; asm volatile("" : "+v"(lane_c));
            int chunk = vcu * 2 + (w - 6); const float* cW = nullptr; bf16* cWT = nullptr; int cN = 0, cnb = -1;
#pragma unroll
            for (int sg = 0; sg < 4; ++sg) if (sg < cv.nseg && cnb < 0) { if (chunk < cv.seg[sg].nb) { cW = cv.seg[sg].W; cWT = cv.seg[sg].WT; cN = cv.seg[sg].N; cnb = chunk; } else chunk -= cv.seg[sg].nb; }
            const bool act = cnb >= 0;
            const unsigned char* wb = act ? (const unsigned char*)(cW + cnb * 64) : (const unsigned char*)P;
            unsigned char* ob = act ? (unsigned char*)(cWT + (size_t)cnb * 64 * D) : (unsigned char*)OD;
            const unsigned llo = 4u * (unsigned)lane_c, slo = (unsigned)lane_c * (unsigned)(D * 2);
            const size_t rstr = (size_t)cN * 4;
#define CV_LOAD(b_, s_) do { _Pragma("unroll") for (int j_ = 0; j_ < 32; ++j_) ld[b_][j_] = *(const GAS float*)(wb + (size_t)(32 * (s_) + j_) * rstr + llo); } while (0)
#define CV_STORE(b_, s_) do { _Pragma("unroll") for (int g_ = 0; g_ < 4; ++g_) { v4u o_; o_.x = pk2(ld[b_][8 * g_ + 0], ld[b_][8 * g_ + 1]); o_.y = pk2(ld[b_][8 * g_ + 2], ld[b_][8 * g_ + 3]); \
                o_.z = pk2(ld[b_][8 * g_ + 4], ld[b_][8 * g_ + 5]); o_.w = pk2(ld[b_][8 * g_ + 6], ld[b_][8 * g_ + 7]); *(GAS v4u*)(ob + (size_t)(2 * (32 * (s_) + 8 * g_)) + slo) = o_; } } while (0)
            if (act) {
                float ld[2][32];
                for (int s2 = 0; s2 < 64; s2 += 2) {
#pragma unroll
                    for (int u = 0; u < 2; ++u) { const int st_ = s2 + u;
                        __builtin_amdgcn_s_barrier(); asm volatile("" ::: "memory");
                        if (st_ >= 2) CV_STORE(u, st_ - 2);
                        CV_LOAD(u, st_); }
                }
                CV_STORE(0, 62); CV_STORE(1, 63);
            } else {
                for (int st_ = 0; st_ < 64; ++st_) { __builtin_amdgcn_s_barrier(); asm volatile("" ::: "memory"); }
            }
#undef CV_LOAD
#undef CV_STORE
        }
        asm volatile("s_waitcnt vmcnt(0) lgkmcnt(0)" ::: "memory"); __builtin_amdgcn_s_barrier(); asm volatile("" ::: "memory");
    }
#undef HG_SCHED
}
__device__ __forceinline__ float w8_scale(const unsigned char* ws, int t, int nsamp) {
    const unsigned long long sm = __hip_atomic_load((const unsigned long long*)(ws + WS_CTL + CTL_WSTAT + 64 * t), __ATOMIC_RELAXED, __HIP_MEMORY_SCOPE_AGENT);
    const float var = fmaxf((float)sm * (1.0f / 1099511627776.0f) / (float)nsamp, 1e-30f);
    return 127.0f / (W8_CLIP * sqrtf(var));
}
struct Args { const float* in[9]; float* out; unsigned char* ws; int ph_lo, ph_hi; };
__global__ void __launch_bounds__(NTHREADS, 2) fwd(Args args) {
    extern __shared__ __attribute__((aligned(16))) unsigned char lds_raw[];
    LAS unsigned char* lds = (LAS unsigned char*)lds_raw;
    volatile LAS unsigned* MISC = (volatile LAS unsigned*)(lds + MISC_OFF);
    const int G = gridDim.x; const int hwbx = blockIdx.x;
    bool XL = false;
    int bx = hwbx;
    int vcu = (G % 8 == 0) ? (bx % 8) * (G / 8) + bx / 8 : bx;
    const int NGW = G * NWAVES;
    unsigned char* const ws_k = args.ws; unsigned char* ws = ws_k;
    const float* x_in = args.in[0]; const float* norm_w = args.in[1]; const float* w_in_hgrn = args.in[2]; const float* lbnd = args.in[3]; const float* gnorm = args.in[4];
    const float* w_in_attn = args.in[5]; const float* w_out = args.in[6]; const float* w_ffn_in = args.in[7]; const float* w_ffn_out = args.in[8];
    float* xres = args.out;
#define PH_WS unsigned char* ws = ws_k; asm volatile("" : "+s"(ws));
#define cosT ((float*)(ws + WS_TAB + TAB_COS))
#define sinT ((float*)(ws + WS_TAB + TAB_SIN))
#define lbT ((float*)(ws + WS_TAB + TAB_LB))
#define WHG ((bf16*)(ws + WS_WHG))
#define WAT ((bf16*)(ws + WS_WAT))
#define WO ((bf16*)(ws + WS_WO))
#define WF1 ((bf16*)(ws + WS_WF1))
#define WF2 ((bf16*)(ws + WS_WF2))
#define H ((bf16*)(ws + WS_H))
#define PROJ ((bf16*)(ws + WS_PROJ))
#define MIX ((bf16*)(ws + WS_MIX))
#define OB ((bf16*)(ws + WS_O))
#define GB ((bf16*)(ws + WS_G))
#define LSE ((float*)(ws + WS_MIX + 96 * MiB))
#define QT ((bf16*)(ws + WS_PROJ + 160 * MiB))
#define KT ((bf16*)(ws + WS_PROJ + 224 * MiB))
#define ACT MIX
#define H8 ((signed char*)(ws + WS_H8))
#define RSA ((float*)(ws + WS_TAB + TAB_RSA))
#define RSO ((float*)(ws + WS_TAB + TAB_RSO))
#define WSC(t_) __builtin_bit_cast(float, (unsigned)MISC[32 + (t_)])
#define RS_TO_LDS(src_) do { int t_ = threadIdx.x; asm volatile("" : "+v"(t_)); if (t_ < 256) MISC[64 + t_] = __builtin_bit_cast(unsigned, (src_)[(4 * (vcu >> 5) + (vcu & 3)) * 256 + t_]); __syncthreads(); } while (0)
#define RSL ((const LAS float*)(lds + MISC_OFF + 256))
#define XB ((bf16*)(ws + WS_KH))
#define XSCR ((float*)(ws + WS_MIX))
#define HSCR ((bf16*)(ws + WS_MIX + 64 * MiB))
#define PREF ((float*)(ws + WS_KH + 64 * MiB))
#define E63V ((float*)(ws + WS_KH + 66 * MiB))

    for (int u = threadIdx.x; u < (LDS_BYTES - LDSCTL_OFF) / 4; u += NTHREADS) ((LAS unsigned*)(lds + LDSCTL_OFF))[u] = 0u;
    __syncthreads();
    const int lo = args.ph_lo, hi = args.ph_hi;
#if XCC_TRUE_MAP
    if (threadIdx.x == 0) { const unsigned xc = xb_xcc_id() & 7u; const unsigned rk = __hip_atomic_fetch_add((unsigned*)(ws + WS_CTL) + CW_TICK + 64 * xc, 1u, __ATOMIC_RELAXED, __HIP_MEMORY_SCOPE_AGENT); MISC[12] = xc; MISC[13] = rk; }
    __syncthreads();
#endif
    const int FF1_REM = ((M / 256) * (FFN_N / 256)) % G;
    const bool PANEL = PANEL_MODE && G == 256 && (args.ph_hi - args.ph_lo) == NPHASES;
    const bool Q8OK = PANEL;
    const bool DEFER = CVT_IN_SCAN && !QKV_ADJ && !TAIL_ALL && !TAIL_WO && (args.ph_hi - args.ph_lo) == NPHASES && G == 256 && REP_SCAN == 1;
    const bool TAILCVT = FF1_REM != 0 && (hi - lo) == NPHASES && REP_F1 == 1;
    const bool use_bar = (hi - lo) > 1;
    XcdBarrier bar; bar.bar = (unsigned*)(ws + WS_CTL) + CW_BAR; bar.x = 0; bar.st = nullptr;
    if (use_bar) bar = xcd_barrier_post((unsigned*)(ws + WS_CTL) + CW_BAR, MISC + 8);
#define IN(k) (lo <= (k) && (k) < hi)
#define PH_IDS int tid_p = threadIdx.x; asm volatile("" : "+v"(tid_p)); const int lane_p = tid_p & 63; const int wave_p = __builtin_amdgcn_readfirstlane(tid_p >> 6); const int gw_p = vcu * NWAVES + wave_p; (void)lane_p; (void)gw_p;
#ifndef REP_BAR
#define REP_BAR 1
#endif
#define SEAM_L(k) do { if (IN(k) && IN((k) + 1)) { if (XL) xcd_local_barrier(bar); else xcd_barrier(bar); } } while (0)
#ifdef PROBE_BWAIT
    unsigned long long bw_acc = 0;
#ifndef PROBE_BMASK
#define PROBE_BMASK 0x3ff
#endif
#define SEAM(k) do { if (IN(k) && IN((k) + 1)) { const unsigned long long t0_ = __builtin_amdgcn_s_memrealtime(); xcd_barrier(bar); const int kb_ = (k) == 0 ? 9 : ((k) - 1) % 9; if ((PROBE_BMASK >> kb_) & 1) bw_acc += __builtin_amdgcn_s_memrealtime() - t0_; } } while (0)
#else
#define SEAM(k) do { if (IN(k) && IN((k) + 1)) for (int rb = 0; rb < REP_BAR; ++rb) xcd_barrier(bar); } while (0)
#endif

    if (IN(0)) { PH_IDS PH_WS
        const int gt = vcu * NTHREADS + tid_p; const int NGT = G * NTHREADS;
#pragma unroll 1
        for (int t = 0; t < 12; ++t) {
            const bool used = t < 4 ? F1Q(t) : t < 6 ? INQ(2 * (t - 4)) : t < 8 ? INQ(2 * (t - 6) + 1) : WOQ(t - 8);
            if (!used) continue;
            const float* Wp = t < 4 ? w_ffn_in + (size_t)t * D * FFN_N : t < 6 ? w_in_hgrn + (size_t)(t - 4) * D * HGRN_N : t < 8 ? w_in_attn + (size_t)(t - 6) * D * ATTN_N : w_out + (size_t)(t - 8) * D * D;
            const size_t total = t < 4 ? (size_t)D * FFN_N : t < 6 ? (size_t)D * HGRN_N : t < 8 ? (size_t)D * ATTN_N : (size_t)D * D;
            const size_t stride = total / ((size_t)NGT * WSTAT_PER_THREAD);
            float ss = 0.f;
#pragma unroll
            for (int j = 0; j < WSTAT_PER_THREAD; ++j) { const float w = Wp[((size_t)gt + (size_t)j * NGT) * stride]; ss += w * w; }
            ss = wave_sum(ss);
            if (lane_p == 0) __hip_atomic_fetch_add((unsigned long long*)(ws + WS_CTL + CTL_WSTAT + 64 * t), (unsigned long long)(ss * 1099511627776.0f), __ATOMIC_RELAXED, __HIP_MEMORY_SCOPE_AGENT);
        }
    }
    if (use_bar && IN(0) && (F1_I8 | I8_IN | I8_WO)) xcd_barrier(bar);
    if (F1_I8 | I8_IN | I8_WO) {
        if (threadIdx.x < 12) MISC[32 + threadIdx.x] = __builtin_bit_cast(unsigned, w8_scale(ws, (int)threadIdx.x, G * NTHREADS * WSTAT_PER_THREAD));
        __syncthreads();
    }
    if (IN(0)) for (int rep = 0; rep < REP_PRO; ++rep) {
        PH_WS PH_IDS
        const int lane = lane_p, gw = gw_p, tid = tid_p;
        LAS float* scr = (LAS float*)(lds + wave_p * 16384);
        for (int s = 0; s < ((DEFER || (TAILCVT && TAIL_ALL)) ? 1 : 2); ++s) transpose_matrix(w_in_hgrn + (size_t)s * D * HGRN_N, D, HGRN_N, WHG + (size_t)s * HGRN_N * D, 0, scr, gw, NGW, lane, 0, 100, INQ(2 * s) ? WSC(4 + s) : 0.f);
        for (int s = 0; s < ((DEFER || (TAILCVT && TAIL_ALL)) ? 0 : 2); ++s) transpose_matrix(w_in_attn + (size_t)s * D * ATTN_N, D, ATTN_N, WAT + (size_t)s * ATTN_N * D, ATT_MODE, scr, gw, NGW, lane, 0, 100, INQ(2 * s + 1) ? WSC(6 + s) : 0.f);
        for (int s = 0; s < ((DEFER || (TAILCVT && (TAIL_ALL || TAIL_WO))) ? 1 : 4); ++s) transpose_matrix(w_out + (size_t)s * D * D, D, D, WO + (size_t)s * D * D, 0, scr, gw, NGW, lane, 0, 100, WOQ(s) ? WSC(8 + s) : 0.f);
        for (int s = 0; s < (TAILCVT ? 1 : 4); ++s) transpose_matrix(w_ffn_in + (size_t)s * D * FFN_N, D, FFN_N, WF1 + (size_t)s * FFN_N * D, 1, scr, gw, NGW, lane, 0, 100, F1Q(s) ? WSC(s) : 0.f);
        for (int s = 0; s < 4; ++s) transpose_matrix(w_ffn_out + (size_t)s * DFF * D, DFF, D, WF2 + (size_t)s * D * DFF, 0, scr, gw, NGW, lane, (TAILCVT && s > 0) ? TAIL_F2_PCT : 0, 100);
        const int gt = vcu * NTHREADS + tid, NGT = G * NTHREADS;
        for (int idx = gt; idx < SEQ * 16; idx += NGT) { const int pos = idx >> 4, i = idx & 15;
            const float inv = powf(500000.0f, -(float)(2 * i) / 32.0f); const float ang = (float)pos * inv; cosT[idx] = cosf(ang); sinT[idx] = sinf(ang); }
        for (int idx = gt; idx < 2 * D; idx += NGT) { const int dir = idx >> 11, c = idx & (D - 1);
            float xl[4]; float mx = -3.0e38f;
#pragma unroll
            for (int l = 0; l < 4; ++l) { xl[l] = lbnd[(size_t)(dir * 4 + l) * D + c]; mx = fmaxf(mx, xl[l]); }
            float sum = 0.f;
#pragma unroll
            for (int l = 0; l < 4; ++l) { xl[l] = expf(xl[l] - mx); sum += xl[l]; }
            float cum = 0.f, c0 = 0.f;
#pragma unroll
            for (int l = 0; l < 4; ++l) { cum += xl[l] / sum; if (l == 0) c0 = cum; lbT[(size_t)(dir * 4 + l) * D + c] = cum - c0; } }
        if (INQ(0)) norm_rows<false, true, false, false, true>(nullptr, x_in, nullptr, nullptr, norm_w, (bf16*)H8, gw, NGW, lane, false, RSA);
        else norm_rows<false, true, false, false>(nullptr, x_in, nullptr, nullptr, norm_w, H, gw, NGW, lane, false);
    }
    SEAM(0);
#if XCC_TRUE_MAP
    if (use_bar && lo == 0 && (G % 8) == 0) {
        bool okm = true;
#pragma unroll
        for (int j = 0; j < 8; ++j) okm = okm && (__hip_atomic_load((unsigned*)(ws + WS_CTL) + CW_TICK + 64 * j, __ATOMIC_RELAXED, __HIP_MEMORY_SCOPE_AGENT) == (unsigned)(G / 8));
        if (okm) { const int xc = (int)MISC[12], rk = (int)MISC[13]; bx = rk * 8 + xc; vcu = xc * (G / 8) + rk; XL = PANEL && XCD_LOCAL_BAR && G == 256; }
    }
#endif
#ifdef PROBE_WR
    if (IN(0)) { PH_IDS
        const int wr_ = wave_p >> 2, wc_ = wave_p & 3, fr_ = lane_p & 15, fq_ = lane_p >> 4;
        for (int rep = 0; rep < PROBE_WR_N; ++rep) {
            pg8::HybridOrder S; S.init(M, ATTN_N, G, bx, vcu, PANEL); pg8::Unit u; S.next(rep % 9, u);
            v4u w; w.x = 0x3f803f80u; w.y = w.x; w.z = w.x; w.w = w.x;
            if (PROBE_WR == 1) {
#pragma unroll
                for (int ai = 0; ai < 2; ++ai)
#pragma unroll
                    for (int m = 0; m < 4; ++m)
#pragma unroll
                        for (int bj = 0; bj < 2; ++bj) *(GAS v4u*)(PROJ + (size_t)(u.pm * 256 + wr_ * 64 + fr_ + ai * 128 + m * 16) * ATTN_N + u.pn * 256 + wc_ * 32 + 8 * fq_ + bj * 128) = w;
            } else {
#pragma unroll
                for (int i = 0; i < 16; ++i) *(GAS v4u*)((unsigned char*)PROJ + ((size_t)(u.pm * 72 + u.pn) * 131072) + wave_p * 16384 + i * 1024 + lane_p * 16) = w;
            }
            asm volatile("s_waitcnt vmcnt(0)" ::: "memory"); __syncthreads();
        }
    }
    SEAM(0);
#endif

    for (int L = 0; L < DEPTH; ++L) {
        const int pb = 1 + 9 * L; const bool hg = (L & 1) == 0; const int slot = L >> 1;
        const float* nw = norm_w + (size_t)L * 4 * D;
        const int NPROJ = hg ? HGRN_N : ATTN_N;
        if (IN(pb)) { PH_WS
#ifdef STAGGER_US
            { const unsigned long long t0 = __builtin_amdgcn_s_memrealtime(); const unsigned long long dl = (unsigned long long)((bx >> 3) & 3) * (STAGGER_US * 100);
              while (__builtin_amdgcn_s_memrealtime() - t0 < dl) __builtin_amdgcn_s_sleep(8); }
#endif
            if (hg && INQ(L)) { pg8::Gemm g{(const bf16*)H8, WHG + (size_t)slot * HGRN_N * D, M, HGRN_N, D}; pg8::HybridOrder S; S.init(M, HGRN_N, G, bx, vcu, PANEL);
                RS_TO_LDS(RSA); pg8::EpiBf16<0, true> E{PROJ, HGRN_N, nullptr, 0, 0, 1.f, RSA, 1.0f / WSC(4 + slot), RSL};
                pg8::gemm_phase<pg8::EpiBf16<0, true>, pg8::HybridOrder, INP_ALIGN, GEMM_SP2>(lds, g, S, E); }
            else if (hg) for (int rep = 0; rep < REP_INH; ++rep) { pg8::Gemm g{H, WHG + (size_t)slot * HGRN_N * D, M, HGRN_N, D}; pg8::HybridOrder S; S.init(M, HGRN_N, G, bx, vcu, PANEL);
                pg8::EpiBf16<0> E{PROJ, HGRN_N, nullptr, 0, 0, 1.f};
                pg8::gemm_phase<pg8::EpiBf16<0>, pg8::HybridOrder, INP_ALIGN, GEMM_SP2>(lds, g, S, E); }
            else if (INQ(L)) { pg8::Gemm g{(const bf16*)H8, WAT + (size_t)slot * ATTN_N * D, M, ATTN_N, D}; pg8::HybridOrder S; S.init(M, ATTN_N, G, bx, vcu, PANEL);
                RS_TO_LDS(RSA); pg8::EpiRopeT<true> E{PROJ, ATTN_N, cosT, sinT, RSA, 1.0f / WSC(6 + slot), RSL};
                pg8::gemm_phase<pg8::EpiRopeT<true>, pg8::HybridOrder, INP_ALIGN, GEMM_SP2>(lds, g, S, E); }
            else if (ATTN_SECT && use_bar) {
                for (int gs = 0; gs < 3; ++gs) {
                    { pg8::Gemm g{H, WAT + (size_t)slot * ATTN_N * D + (size_t)gs * 3 * D * D, M, 3 * D, D}; pg8::HybridOrder S; S.init(M, 3 * D, G, bx, vcu, PANEL);
                      pg8::EpiRope E{PROJ + gs * 3 * D, ATTN_N, cosT, sinT};
                      pg8::gemm_phase<pg8::EpiRope, pg8::HybridOrder, INP_ALIGN, GEMM_SP2>(lds, g, S, E); }
                    xcd_barrier(bar);
                    attn_core_mfma(lds, PROJ, MIX, LSE, MIXMAP, G, gs);
                    if (gs < 2) xcd_barrier(bar);
                }
            }
            else for (int rep = 0; rep < REP_INA; ++rep) { pg8::Gemm g{H, WAT + (size_t)((REP_INA_COLD && rep + 1 < REP_INA) ? (slot ^ 1) : slot) * ATTN_N * D, M, ATTN_N, D}; pg8::HybridOrder S; S.init(M, ATTN_N, G, bx, vcu, PANEL);
                pg8::EpiRope E{PROJ, ATTN_N, cosT, sinT};
                pg8::gemm_phase<pg8::EpiRope, pg8::HybridOrder, INP_ALIGN, GEMM_SP2>(lds, g, S, E); }
        }
        if (hg) SEAM_L(pb); else SEAM(pb);
        if (hg) {
            if (IN(pb + 1)) for (int rep = 0; rep < REP_GATES; ++rep) { PH_WS PH_IDS hgrn_gates(PROJ, lbT + (size_t)L * D, QT, KT, PREF, E63V, gw_p, NGW, lane_p, PANEL); }
            SEAM(pb + 1);
        }
#ifdef PROBE_CLKM
        unsigned long long qc0 = 0, qr0 = 0; if (L == PROBE_CLKM - 1 && IN(pb + 2)) { qc0 = clock64(); qr0 = __builtin_amdgcn_s_memrealtime(); }
#endif
        if (IN(pb + 2)) { PH_WS
            if (hg) for (int rep = 0; rep < REP_SCAN; ++rep) {
                CvtPlan cv{}; cv.nseg = 0;
                if (DEFER && L == 0) { cv.seg[0] = CvtSeg{w_in_attn, WAT, ATTN_N, ATTN_N / 64}; cv.seg[1] = CvtSeg{w_out + (size_t)1 * D * D, WO + (size_t)1 * D * D, D, D / 64};
                    cv.seg[2] = CvtSeg{w_in_hgrn + (size_t)1 * D * HGRN_N, WHG + (size_t)1 * HGRN_N * D, HGRN_N, HGRN_N / 64}; cv.seg[3] = CvtSeg{w_out + (size_t)2 * D * D, WO + (size_t)2 * D * D, D, D / 64}; cv.nseg = 4; }
                if (DEFER && L == 2) { cv.seg[0] = CvtSeg{w_in_attn + (size_t)1 * D * ATTN_N, WAT + (size_t)1 * ATTN_N * D, ATTN_N, ATTN_N / 64}; cv.seg[1] = CvtSeg{w_out + (size_t)3 * D * D, WO + (size_t)3 * D * D, D, D / 64}; cv.nseg = 2; }
                hgrn_scan_mfma(lds, PROJ, QT, KT, PREF, E63V, MIX, MIXMAP, G, cv); }
            else if (!(ATTN_SECT && use_bar)) for (int rep = 0; rep < REP_ATTN; ++rep) attn_core_mfma(lds, PROJ, MIX, LSE, MIXMAP, G, -1);
        }
#ifdef PROBE_CLKM
        if (L == PROBE_CLKM - 1 && IN(pb + 2) && hwbx == 0) { const unsigned long long dc = clock64() - qc0, dr = __builtin_amdgcn_s_memrealtime() - qr0;
            const unsigned long long slp = 10000ull * dc / (dr ? dr : 1); const unsigned long long t0 = __builtin_amdgcn_s_memrealtime();
            while (__builtin_amdgcn_s_memrealtime() - t0 < slp) __builtin_amdgcn_s_sleep(8); }
#endif
        SEAM(pb + 2);
        if (IN(pb + 3)) for (int rep = 0; rep < REP_FIN; ++rep) {
            PH_WS PH_IDS
            const int lane = lane_p, gw = gw_p;
            if (hg) { if (WOQ(L)) hgrn_finalize<true>(PROJ, MIX, gnorm + (size_t)slot * HD, OB, gw, NGW, lane, PANEL, RSO); else hgrn_finalize<false>(PROJ, MIX, gnorm + (size_t)slot * HD, OB, gw, NGW, lane, PANEL, nullptr); }
            else { if (WOQ(L)) attn_finalize<true>(MIX, LSE, OB, gw, NGW, lane, PANEL, RSO); else attn_finalize<false>(MIX, LSE, OB, gw, NGW, lane, PANEL, nullptr); }
        }
        SEAM(pb + 3);
        if (IN(pb + 4)) for (int rep = 0; rep < REP_WO; ++rep) { PH_WS
            pg8::Gemm g{OB, WO + (size_t)L * D * D, M, D, D}; pg8::HybridOrder S; S.init(M, D, G, bx, vcu, PANEL);
            if (WOQ(L)) { RS_TO_LDS(RSO); pg8::EpiBf16<0, true> E{GB, D, nullptr, 0, 0, 1.f, RSO, 1.0f / WSC(8 + L), RSL};
                pg8::gemm_phase<pg8::EpiBf16<0, true>, pg8::HybridOrder, ONE_ALIGN, GEMM_SP2>(lds, g, S, E); }
            else { pg8::EpiBf16<0> E{GB, D, nullptr, 0, 0, 1.f};
                pg8::gemm_phase<pg8::EpiBf16<0>, pg8::HybridOrder, ONE_ALIGN, GEMM_SP2>(lds, g, S, E); }
        }
        SEAM_L(pb + 4);
        if (IN(pb + 5)) for (int rep = 0; rep < REP_NORM; ++rep) { PH_WS PH_IDS
            if (F1Q(L)) { if (L == 0) norm_rows<true, true, false, true, true>(GB, x_in, XB, nw + D, nw + 2 * D, (bf16*)H8, gw_p, NGW, lane_p, PANEL, RSA);
                else norm_rows<true, true, true, true, true>(GB, XB, XB, nw + D, nw + 2 * D, (bf16*)H8, gw_p, NGW, lane_p, PANEL, RSA); }
            else if (L == 0 && rep == 0) norm_rows<true, true, false, true>(GB, x_in, XB, nw + D, nw + 2 * D, H, gw_p, NGW, lane_p, PANEL);
            else norm_rows<true, true, true, true>(GB, XB, rep ? (void*)XSCR : (void*)XB, nw + D, nw + 2 * D, rep ? HSCR : H, gw_p, NGW, lane_p, PANEL); }
        SEAM_L(pb + 5);
        if (IN(pb + 6)) for (int rep = 0; rep < REP_F1; ++rep) { PH_WS
            if (F1Q(L)) { pg8::HybridOrder S; S.init(M, FFN_N, G, bx, vcu, PANEL); pg8::Gemm g{(const bf16*)H8, WF1 + (size_t)L * FFN_N * D, M, FFN_N, D};
                RS_TO_LDS(RSA); pg8::EpiSwiGLU8 E{ACT, DFF, RSA, 1.0f / WSC(L), RSL};
                pg8::gemm_phase<pg8::EpiSwiGLU8, pg8::HybridOrder, true, GEMM_SP2>(lds, g, S, E); }
            else { pg8::HybridOrder S; S.init(M, FFN_N, G, bx, vcu, PANEL); pg8::Gemm g{H, WF1 + (size_t)L * FFN_N * D, M, FFN_N, D};
                pg8::EpiSwiGLU E{ACT, DFF, ACT};
                pg8::gemm_phase<pg8::EpiSwiGLU, pg8::HybridOrder, true, GEMM_SP2>(lds, g, S, E); }
            const bool tailwg = PANEL ? ((vcu & 31) + 32 * 5 >= 4 * (FFN_N / 256)) : (bx >= FF1_REM);
            if (TAILCVT && L + 1 < DEPTH && tailwg) {
                PH_IDS
                LAS float* scr = (LAS float*)(lds + wave_p * 16384); const int gw2 = (PANEL ? ((vcu >> 5) * 16 + (vcu & 31) - 16) : (bx - FF1_REM)) * NWAVES + wave_p, ngw2 = (G - FF1_REM) * NWAVES;
                transpose_matrix(w_ffn_in + (size_t)(L + 1) * D * FFN_N, D, FFN_N, WF1 + (size_t)(L + 1) * FFN_N * D, 1, scr, gw2, ngw2, lane_p, 0, 100, F1Q(L + 1) ? WSC(L + 1) : 0.f);
                if (TAIL_ALL) { const int L1 = L + 1, slot1 = L1 >> 1;
                    if (L1 & 1) transpose_matrix(w_in_attn + (size_t)slot1 * D * ATTN_N, D, ATTN_N, WAT + (size_t)slot1 * ATTN_N * D, ATT_MODE, scr, gw2, ngw2, lane_p);
                    else transpose_matrix(w_in_hgrn + (size_t)slot1 * D * HGRN_N, D, HGRN_N, WHG + (size_t)slot1 * HGRN_N * D, 0, scr, gw2, ngw2, lane_p);
                    transpose_matrix(w_out + (size_t)L1 * D * D, D, D, WO + (size_t)L1 * D * D, 0, scr, gw2, ngw2, lane_p); }
                transpose_matrix(w_ffn_out + (size_t)(L + 1) * DFF * D, DFF, D, WF2 + (size_t)(L + 1) * D * DFF, 0, scr, gw2, ngw2, lane_p, 0, TAIL_F2_PCT);
                if (TAIL_WO && !TAIL_ALL) transpose_matrix(w_out + (size_t)(L + 1) * D * D, D, D, WO + (size_t)(L + 1) * D * D, 0, scr, gw2, ngw2, lane_p);
            }
        }
        SEAM_L(pb + 6);
#ifdef PROBE_CLK
        unsigned long long pc0 = 0, pr0 = 0; if (L == PROBE_CLK - 1 && IN(pb + 7)) { pc0 = clock64(); pr0 = __builtin_amdgcn_s_memrealtime(); }
#endif
        if (IN(pb + 7)) for (int rep = 0; rep < REP_F2; ++rep) { PH_WS
            pg8::Gemm g{ACT, WF2 + (size_t)L * D * DFF, M, D, DFF}; pg8::HybridOrder S; S.init(M, D, G, bx, vcu, PANEL);
            pg8::EpiBf16<0> E{GB, D, nullptr, 0, 0, 1.f};
            pg8::gemm_phase<pg8::EpiBf16<0>, pg8::HybridOrder, ONE_ALIGN, GEMM_SP2>(lds, g, S, E);
        }
#ifdef PROBE_CLK
        if (L == PROBE_CLK - 1 && IN(pb + 7) && hwbx == 0) { const unsigned long long dc = clock64() - pc0, dr = __builtin_amdgcn_s_memrealtime() - pr0;
            const unsigned long long slp = 10000ull * dc / (dr ? dr : 1); const unsigned long long t0 = __builtin_amdgcn_s_memrealtime();
            while (__builtin_amdgcn_s_memrealtime() - t0 < slp) __builtin_amdgcn_s_sleep(8); }
#endif
        SEAM_L(pb + 7);
        if (IN(pb + 8)) for (int rep = 0; rep < REP_NORM; ++rep) {
            PH_WS PH_IDS
            const int lane = lane_p, gw = gw_p;
            if (L + 1 < DEPTH && INQ(L + 1)) norm_rows<true, true, true, true, true>(GB, XB, XB, nw + 3 * D, nw + 4 * D, (bf16*)H8, gw, NGW, lane, PANEL, RSA);
            else if (L + 1 < DEPTH) norm_rows<true, true, true, true>(GB, XB, rep ? (void*)XSCR : (void*)XB, nw + 3 * D, nw + 4 * D, rep ? HSCR : H, gw, NGW, lane, PANEL);
            else norm_rows<true, false, true, false>(GB, XB, rep ? XSCR : xres, nw + 3 * D, nullptr, nullptr, gw, NGW, lane, PANEL);
        }
        SEAM_L(pb + 8);
    }
#ifdef PROBE_BWAIT
    if (hwbx == PROBE_BWAIT - 1) { const unsigned long long t0_ = __builtin_amdgcn_s_memrealtime(); while (__builtin_amdgcn_s_memrealtime() - t0_ < bw_acc) __builtin_amdgcn_s_sleep(8); }
#endif
#undef IN
#undef SEAM
#undef WSC
#undef RS_TO_LDS
#undef RSL
#undef H8
#undef RSA
#undef RSO
#undef PH_WS
#undef cosT
#undef sinT
#undef lbT
#undef WHG
#undef WAT
#undef WO
#undef WF1
#undef WF2
#undef H
#undef PROJ
#undef MIX
#undef OB
#undef GB
#undef LSE
#undef QT
#undef KT
#undef ACT
#undef XB
#undef XSCR
#undef HSCR
#undef PREF
#undef E63V
}

#ifndef MK_PER_PHASE
#define MK_PER_PHASE 0
#endif
extern "C" void kernel_launch(void* const* d_in, const int* in_sizes, int n_in, void* d_out, int out_size, void* d_ws, size_t ws_size, hipStream_t stream) {
    static int grid = 0;
    if (grid == 0) {
        if (n_in != 9 || in_sizes[0] != M * D || out_size != M * D || ws_size < WS_END) { fprintf(stderr, "kernel_launch: unexpected shapes (n_in %d, in0 %d, out %d, ws %zu); nothing launched\n", n_in, n_in > 0 ? in_sizes[0] : -1, out_size, ws_size); grid = -1; return; }
        int dev = 0, cus = 0, per_cu = 0;
        if (hipGetDevice(&dev) != hipSuccess || hipDeviceGetAttribute(&cus, hipDeviceAttributeMultiprocessorCount, dev) != hipSuccess) { grid = -1; return; }
        if (hipFuncSetAttribute((const void*)fwd, hipFuncAttributeMaxDynamicSharedMemorySize, LDS_BYTES) != hipSuccess) { fprintf(stderr, "kernel_launch: hipFuncSetAttribute failed\n"); grid = -1; return; }
        if (hipOccupancyMaxActiveBlocksPerMultiprocessor(&per_cu, (const void*)fwd, NTHREADS, LDS_BYTES) != hipSuccess || per_cu < 1) fprintf(stderr, "kernel_launch: occupancy query reports %d\n", per_cu);
        (void)hipGetLastError();
        grid = cus;
    }
    if (grid < 0) return;
    if (hipMemsetAsync((char*)d_ws + WS_CTL, 0, CTL_ZERO_BYTES, stream) != hipSuccess) return;
    Args a{};
    for (int i = 0; i < 9; ++i) a.in[i] = (const float*)d_in[i];
    a.out = (float*)d_out; a.ws = (unsigned char*)d_ws;
#if MK_PER_PHASE
    for (int p = 0; p < NPHASES; ++p) { a.ph_lo = p; a.ph_hi = p + 1; hipLaunchKernelGGL(fwd, dim3(grid), dim3(NTHREADS), LDS_BYTES, stream, a); }
#else
    a.ph_lo = 0; a.ph_hi = NPHASES; hipLaunchKernelGGL(fwd, dim3(grid), dim3(NTHREADS), LDS_BYTES, stream, a);
#endif
}
```
